# Optimizing an MI355X kernel written in HIP

```python
import jax, jax.numpy as jnp
from jax import lax
import numpy as np

D_MODEL = 1024
BATCH = 8
SEQ = 4096
DEPTH = 2

HEAD_DIM = 64
N_Q_HEADS = D_MODEL // HEAD_DIM
N_KV_HEADS = 4
GQA_GROUP = N_Q_HEADS // N_KV_HEADS
ATT_WIDTH = N_Q_HEADS * HEAD_DIM
KV_WIDTH = N_KV_HEADS * HEAD_DIM
ATT_IN = 2 * ATT_WIDTH + 2 * KV_WIDTH
WINDOW = 128
BLOCK = 128
ROPE_THETA = 10000.0
MASK_VALUE = -1e30

RWKV_HEAD = 64
RWKV_HEADS = D_MODEL // RWKV_HEAD
RWKV_WIDTH = RWKV_HEADS * RWKV_HEAD
DECAY_LORA = 64
AAA_LORA = 64
N_LERP = 6
GN_EPS = 64e-5

PLE_DIM = 256
NORM_EPS = 1e-6
N_ATTN_LAYERS = (DEPTH + 1) // 2
N_RWKV_LAYERS = DEPTH // 2

kernel_name = 'hybrid_swa_sink_rwkv7_ple'


def rms_norm(x, g):
    xf = x.astype(jnp.float32)
    y = xf * lax.rsqrt(jnp.mean(xf * xf, axis=-1, keepdims=True) + NORM_EPS)
    return (y * g.astype(jnp.float32)).astype(x.dtype)


def rope(x, pos):
    half = HEAD_DIM // 2
    inv = ROPE_THETA ** (-jnp.arange(half, dtype=jnp.float32) / half)
    ang = pos.astype(jnp.float32)[:, None] * inv[None, :]
    cos = jnp.cos(ang)[None, :, None, :]
    sin = jnp.sin(ang)[None, :, None, :]
    xf = x.astype(jnp.float32)
    x1, x2 = xf[..., :half], xf[..., half:]
    out = jnp.concatenate([x1 * cos - x2 * sin, x2 * cos + x1 * sin], axis=-1)
    return out.astype(x.dtype)


def swa_sink_mixer(h, w_in, b_in, sinks, w_out):
    B, T, _ = h.shape
    nb = T // BLOCK
    proj = h @ w_in + b_in
    q, k, v, z = jnp.split(proj, [ATT_WIDTH, ATT_WIDTH + KV_WIDTH, ATT_WIDTH + 2 * KV_WIDTH], axis=-1)
    pos = jnp.arange(T)
    q = rope(q.reshape(B, T, N_Q_HEADS, HEAD_DIM), pos)
    k = rope(k.reshape(B, T, N_KV_HEADS, HEAD_DIM), pos)
    v = v.reshape(B, T, N_KV_HEADS, HEAD_DIM)
    qb = q.reshape(B, nb, BLOCK, N_KV_HEADS, GQA_GROUP, HEAD_DIM)
    kb = k.reshape(B, nb, BLOCK, N_KV_HEADS, HEAD_DIM)
    vb = v.reshape(B, nb, BLOCK, N_KV_HEADS, HEAD_DIM)
    pad = ((0, 0), (1, 0), (0, 0), (0, 0), (0, 0))
    kw = jnp.concatenate([jnp.pad(kb, pad)[:, :-1], kb], axis=2)
    vw = jnp.concatenate([jnp.pad(vb, pad)[:, :-1], vb], axis=2)
    s = jnp.einsum('bnqkgd,bnskd->bnkgqs', qb, kw).astype(jnp.float32) * (HEAD_DIM ** -0.5)
    qi = jnp.arange(BLOCK)[:, None] + BLOCK
    si = jnp.arange(2 * BLOCK)[None, :]
    diff = qi - si
    band = (diff >= 0) & (diff < WINDOW)
    has_prev = (jnp.arange(nb)[:, None] > 0) | (jnp.arange(2 * BLOCK)[None, :] >= BLOCK)
    mask = band[None, :, :] & has_prev[:, None, :]
    s = jnp.where(mask[None, :, None, None, :, :], s, MASK_VALUE)
    sink = jnp.broadcast_to(sinks.astype(jnp.float32).reshape(N_KV_HEADS, GQA_GROUP)[None, None, :, :, None, None],
                            s.shape[:-1] + (1,))
    probs = jax.nn.softmax(jnp.concatenate([s, sink], axis=-1), axis=-1)[..., :-1]
    o = jnp.einsum('bnkgqs,bnskd->bnqkgd', probs.astype(vw.dtype), vw).reshape(B, T, ATT_WIDTH)
    return (o * jax.nn.silu(z)) @ w_out


def rwkv7_mixer(h, mu, w_in, w0, w1, w2, a0, a1, a2, k_k, k_a, r_k, gn_g, gn_b, w_out):
    B, T, C = h.shape
    H, N = RWKV_HEADS, RWKV_HEAD
    xx = jnp.pad(h, ((0, 0), (1, 0), (0, 0)))[:, :-1] - h
    xs = h[None] + xx[None] * mu[:, None, None, :]
    proj = jnp.einsum('cbtd,dce->cbte', xs[:4], w_in.reshape(C, 4, RWKV_WIDTH))
    r, k, v, z = proj[0], proj[1], proj[2], proj[3]
    xw, xa = xs[4], xs[5]
    w = -jax.nn.softplus(-(w0 + jnp.tanh(xw @ w1) @ w2)) - 0.5
    decay = jnp.exp(-jnp.exp(w.astype(jnp.float32)))
    a = jax.nn.sigmoid(a0 + (xa @ a1) @ a2)
    r4 = r.reshape(B, T, H, N).astype(jnp.float32)
    k4 = k.reshape(B, T, H, N).astype(jnp.float32)
    v4 = v.reshape(B, T, H, N).astype(jnp.float32)
    a4 = a.reshape(B, T, H, N).astype(jnp.float32)
    d4 = decay.reshape(B, T, H, N)
    kk = k4 * k_k.reshape(H, N).astype(jnp.float32)
    kk = kk / jnp.maximum(jnp.sqrt(jnp.sum(kk * kk, axis=-1, keepdims=True)), 1e-12)
    k4 = k4 * (1.0 + (a4 - 1.0) * k_a.reshape(H, N).astype(jnp.float32))

    def step(S, inp):
        r_t, d_t, k_t, v_t, kk_t, a_t = inp
        sa = jnp.einsum('bhvk,bhk->bhv', S, -kk_t)
        S = S * d_t[:, :, None, :] + sa[..., None] * (kk_t * a_t)[:, :, None, :] + v_t[..., None] * k_t[:, :, None, :]
        y = jnp.einsum('bhvk,bhk->bhv', S, r_t)
        return S, y

    seq_in = tuple(jnp.swapaxes(t, 0, 1) for t in (r4, d4, k4, v4, kk, a4))
    S0 = jnp.zeros((B, H, N, N), jnp.float32)
    _, ys = lax.scan(step, S0, seq_in)
    y = jnp.swapaxes(ys, 0, 1)
    mean = jnp.mean(y, axis=-1, keepdims=True)
    var = jnp.mean(jnp.square(y - mean), axis=-1, keepdims=True)
    y = ((y - mean) * lax.rsqrt(var + GN_EPS)).reshape(B, T, C) * gn_g.astype(jnp.float32) + gn_b.astype(jnp.float32)
    bonus = jnp.sum(r4 * k4 * r_k.astype(jnp.float32), axis=-1, keepdims=True) * v4
    y = (y + bonus.reshape(B, T, C)).astype(h.dtype)
    return (y * jax.nn.silu(z)) @ w_out


def setup_inputs(seed: int = 0) -> dict:
    key = jax.random.key(seed)
    ks = jax.random.split(key, 32)
    f = jnp.float32
    nA, nR = N_ATTN_LAYERS, N_RWKV_LAYERS
    C = D_MODEL

    def nrm(k, shape, scale):
        return jax.random.normal(k, shape, f) * scale

    return {
        'x': jax.random.normal(ks[0], (BATCH, SEQ, C), f),
        'p': jax.random.normal(ks[1], (DEPTH, BATCH, SEQ, PLE_DIM), f),
        'norm_g': 1.0 + nrm(ks[2], (DEPTH, C), 0.02),
        'attn_w_in': nrm(ks[3], (nA, C, ATT_IN), C ** -0.5),
        'attn_b_in': nrm(ks[4], (nA, ATT_IN), 0.02),
        'attn_sinks': nrm(ks[5], (nA, N_Q_HEADS), 0.5),
        'attn_w_out': nrm(ks[6], (nA, ATT_WIDTH, C), ATT_WIDTH ** -0.5),
        'rwkv_mu': jax.random.uniform(ks[7], (nR, N_LERP, C), f),
        'rwkv_w_in': nrm(ks[8], (nR, C, 4 * RWKV_WIDTH), C ** -0.5),
        'rwkv_w0': -2.0 + nrm(ks[9], (nR, RWKV_WIDTH), 1.0),
        'rwkv_w1': nrm(ks[10], (nR, C, DECAY_LORA), C ** -0.5),
        'rwkv_w2': nrm(ks[11], (nR, DECAY_LORA, RWKV_WIDTH), 0.1 * DECAY_LORA ** -0.5),
        'rwkv_a0': nrm(ks[12], (nR, RWKV_WIDTH), 0.1),
        'rwkv_a1': nrm(ks[13], (nR, C, AAA_LORA), C ** -0.5),
        'rwkv_a2': nrm(ks[14], (nR, AAA_LORA, RWKV_WIDTH), AAA_LORA ** -0.5),
        'rwkv_k_k': 0.85 + nrm(ks[15], (nR, RWKV_WIDTH), 0.05),
        'rwkv_k_a': 1.0 + nrm(ks[16], (nR, RWKV_WIDTH), 0.05),
        'rwkv_r_k': nrm(ks[17], (nR, RWKV_HEADS, RWKV_HEAD), 0.1),
        'rwkv_gn_g': 1.0 + nrm(ks[18], (nR, RWKV_WIDTH), 0.02),
        'rwkv_gn_b': nrm(ks[19], (nR, RWKV_WIDTH), 0.02),
        'rwkv_w_out': nrm(ks[20], (nR, RWKV_WIDTH, C), RWKV_WIDTH ** -0.5),
        'ple_w_proj': nrm(ks[21], (DEPTH, PLE_DIM, C), PLE_DIM ** -0.5),
        'ple_w_gate': nrm(ks[22], (DEPTH, C, C), C ** -0.5),
        'final_norm_g': 1.0 + nrm(ks[23], (C,), 0.02),
    }


def reference(x, p, norm_g, attn_w_in, attn_b_in, attn_sinks, attn_w_out,
              rwkv_mu, rwkv_w_in, rwkv_w0, rwkv_w1, rwkv_w2, rwkv_a0, rwkv_a1, rwkv_a2,
              rwkv_k_k, rwkv_k_a, rwkv_r_k, rwkv_gn_g, rwkv_gn_b, rwkv_w_out,
              ple_w_proj, ple_w_gate, final_norm_g):
    h = x
    for i in range(DEPTH):
        hn = rms_norm(h, norm_g[i])
        j = i // 2
        if i % 2 == 0:
            m = swa_sink_mixer(hn, attn_w_in[j], attn_b_in[j], attn_sinks[j], attn_w_out[j])
        else:
            m = rwkv7_mixer(hn, rwkv_mu[j], rwkv_w_in[j], rwkv_w0[j], rwkv_w1[j], rwkv_w2[j],
                            rwkv_a0[j], rwkv_a1[j], rwkv_a2[j], rwkv_k_k[j], rwkv_k_a[j], rwkv_r_k[j],
                            rwkv_gn_g[j], rwkv_gn_b[j], rwkv_w_out[j])
        h = h + m
        h = h + jax.nn.sigmoid(h @ ple_w_gate[i]) * (p[i] @ ple_w_proj[i])
    return rms_norm(h, final_norm_g)
```

```cpp
#include <hip/hip_runtime.h>
#include <hip/hip_cooperative_groups.h>
#include <cstdio>
#include <cstdint>
namespace cg = cooperative_groups;
namespace pg8 {
#define PG8_LAS __attribute__((address_space(3)))
typedef unsigned short bf16_t;
typedef short bf16x8 __attribute__((ext_vector_type(8)));
typedef float f32x4 __attribute__((ext_vector_type(4)));
typedef unsigned u32x4 __attribute__((ext_vector_type(4)));
constexpr int BM = 256, BK = 64, HALF = 128, HTB = HALF * BK * 2  , STAGE_BYTES = 8 * HTB, NXCD = 8, WGM = 8;

__host__ __device__ __forceinline__ int lds_byte(int r, int c) { const int st = (r >> 4) * 2 + (c >> 5), rr = r & 15, cc = c & 31, ob = rr * 64 + cc * 2; return st * 1024 + (ob ^ (((ob >> 9) & 1) << 5)); }
__host__ __device__ __forceinline__ void stage_rc(int b, int& R, int& C) { const int st = b / 1024, sb = b % 1024, swz = sb ^ (((sb >> 9) & 1) << 5); R = (st >> 1) * 16 + swz / 64; C = (st & 1) * 32 + (swz % 64) / 2; }
__host__ __device__ __forceinline__ int perm32(int rho) { const int n = rho >> 4, i = rho & 15; return 8 * (i >> 2) + 4 * n + (i & 3); }

struct Unit { int pm, pn; };
struct Gemm { const bf16_t* A; const bf16_t* Bt; int M, N, K; const bf16_t* A2 = nullptr; int nsplit = 1 << 30;
    __host__ __device__ __forceinline__ const bf16_t* asel(int pn) const { return pn < nsplit ? A : A2; } };

struct StaticOrder {
    int nM, nN, nwg, G, c;
    __host__ __device__ void init(int M, int N, int G_, int c_) { nM = M / BM; nN = N / BM; nwg = nM * nN; G = G_; c = c_; }
    __host__ __device__ bool next(int i, Unit& u) const {
        const long L = (long)i * G + c; if (L >= nwg) return false;
        int wgid = (int)L; { const int q = nwg / NXCD, r = nwg % NXCD, xcd = wgid % NXCD, off = wgid / NXCD; wgid = (xcd < r ? xcd * (q + 1) : r * (q + 1) + (xcd - r) * q) + off; }
        const int nig = WGM * nN, gid = wgid / nig, fm = gid * WGM, gsz = (nM - fm) < WGM ? (nM - fm) : WGM;
        u.pm = fm + ((wgid % nig) % gsz); u.pn = (wgid % nig) / gsz; return true;
    }
    __device__ __forceinline__ void a_ready(const Unit&) const {}
    __device__ __forceinline__ void done(const Unit&) const {}
};

__device__ __forceinline__ unsigned cvt_pk_bf16(float lo, float hi) { unsigned r; asm volatile("v_cvt_pk_bf16_f32 %0, %1, %2" : "=v"(r) : "v"(lo), "v"(hi)); return r; }
typedef float f32x2 __attribute__((ext_vector_type(2)));
__device__ __forceinline__ float bf2f(unsigned short b) { return __uint_as_float((unsigned)b << 16); }
__device__ __forceinline__ float bflo(unsigned w) { return __uint_as_float(w << 16); }
__device__ __forceinline__ float bfhi(unsigned w) { return __uint_as_float(w & 0xffff0000u); }
__device__ __forceinline__ float fsigmoid(float x) { return __builtin_amdgcn_rcpf(1.0f + __expf(-x)); }
__device__ __forceinline__ u32x4 pack8(const f32x4 a, const f32x4 b) { u32x4 w; w.x = cvt_pk_bf16(a[0], a[1]); w.y = cvt_pk_bf16(a[2], a[3]); w.z = cvt_pk_bf16(b[0], b[1]); w.w = cvt_pk_bf16(b[2], b[3]); return w; }
__device__ __forceinline__ void unpack8(const u32x4 w, f32x4& a, f32x4& b) { a = (f32x4){bflo(w.x), bfhi(w.x), bflo(w.y), bfhi(w.y)}; b = (f32x4){bflo(w.z), bfhi(w.z), bflo(w.w), bfhi(w.w)}; }

constexpr float QSCALE = 0.125f * 1.4426950408889634f;

struct EpiQKVZ {
    static constexpr bool PERM = true, AFTER_DRAIN = false;
    bf16_t* O; const float* bias; const float* cs; const float* sn;
    __device__ __forceinline__ void operator()(const f32x4 (&acc)[2][2][4][2], const Unit& u, int wr, int wc, int fr, int fq) const {
        const int row0 = u.pm * BM + wr * 64 + fr, col0 = u.pn * BM + wc * 32 + 8 * fq;
        const bool rope = u.pn < 5; const float sc = u.pn < 4 ? QSCALE : 1.0f;
        const int j4 = 4 * (4 * (wc & 1) + fq);
#pragma unroll
        for (int ai = 0; ai < 2; ++ai)
#pragma unroll
            for (int m = 0; m < 4; ++m) {
                const int row = row0 + ai * HALF + m * 16, pos = row & 4095;
                f32x4 c = (f32x4){1.f, 1.f, 1.f, 1.f}, s = (f32x4){0.f, 0.f, 0.f, 0.f};
                if (rope) { c = *(const f32x4*)(cs + pos * 32 + j4); s = *(const f32x4*)(sn + pos * 32 + j4); }
                bf16_t* rowp = O + (size_t)row * 2560 + col0;
#pragma unroll
                for (int bj = 0; bj < 2; ++bj) {
                    const f32x4 v0 = acc[ai][bj][m][0] + *(const f32x4*)(bias + col0 + bj * HALF), v1 = acc[ai][bj][m][1] + *(const f32x4*)(bias + col0 + bj * HALF + 4);
                    f32x4 o0 = v0, o1 = v1;
                    o0 = (v0 * c - v1 * s) * sc; o1 = (v1 * c + v0 * s) * sc;
                    *(u32x4*)(rowp + bj * HALF) = pack8(o0, o1);
                }
            }
    }
};
struct EpiStore {
    static constexpr bool PERM = true, AFTER_DRAIN = false;
    bf16_t* O; int ldc;
    __device__ __forceinline__ void operator()(const f32x4 (&acc)[2][2][4][2], const Unit& u, int wr, int wc, int fr, int fq) const {
        const int row0 = u.pm * BM + wr * 64 + fr, col0 = u.pn * BM + wc * 32 + 8 * fq;
#pragma unroll
        for (int ai = 0; ai < 2; ++ai)
#pragma unroll
            for (int m = 0; m < 4; ++m) { bf16_t* rowp = O + (size_t)(row0 + ai * HALF + m * 16) * ldc + col0;
#pragma unroll
                for (int bj = 0; bj < 2; ++bj) *(u32x4*)(rowp + bj * HALF) = pack8(acc[ai][bj][m][0], acc[ai][bj][m][1]); }
    }
};
struct EpiStore2 {
    static constexpr bool PERM = true, AFTER_DRAIN = false;
    bf16_t* O1; bf16_t* O2; int nsplit; int ldc;
    __device__ __forceinline__ void operator()(const f32x4 (&acc)[2][2][4][2], const Unit& u, int wr, int wc, int fr, int fq) const {
        const bool first = u.pn < nsplit; bf16_t* O = first ? O1 : O2;
        const int row0 = u.pm * BM + wr * 64 + fr, col0 = (first ? u.pn : u.pn - nsplit) * BM + wc * 32 + 8 * fq;
#pragma unroll
        for (int ai = 0; ai < 2; ++ai)
#pragma unroll
            for (int m = 0; m < 4; ++m) { bf16_t* rowp = O + (size_t)(row0 + ai * HALF + m * 16) * ldc + col0;
#pragma unroll
                for (int bj = 0; bj < 2; ++bj) *(u32x4*)(rowp + bj * HALF) = pack8(acc[ai][bj][m][0], acc[ai][bj][m][1]); }
    }
};
template <bool BF> struct EpiRes {
    static constexpr bool PERM = true, AFTER_DRAIN = false;
    const void* base; bf16_t* O;
    __device__ __forceinline__ void operator()(const f32x4 (&acc)[2][2][4][2], const Unit& u, int wr, int wc, int fr, int fq) const {
        const int row0 = u.pm * BM + wr * 64 + fr, col0 = u.pn * BM + wc * 32 + 8 * fq;
#pragma unroll
        for (int ai = 0; ai < 2; ++ai)
#pragma unroll
            for (int m = 0; m < 4; ++m) { const size_t off = (size_t)(row0 + ai * HALF + m * 16) * 1024 + col0;
#pragma unroll
                for (int bj = 0; bj < 2; ++bj) { f32x4 b0, b1;
                    if (BF) { unpack8(*(const u32x4*)((const bf16_t*)base + off + bj * HALF), b0, b1); }
                    else { b0 = *(const f32x4*)((const float*)base + off + bj * HALF); b1 = *(const f32x4*)((const float*)base + off + bj * HALF + 4); }
                    *(u32x4*)(O + off + bj * HALF) = pack8(b0 + acc[ai][bj][m][0], b1 + acc[ai][bj][m][1]); } }
    }
};
template <bool F32OUT> struct EpiGate {
    static constexpr bool PERM = true, AFTER_DRAIN = false;
    const bf16_t* hpre; const bf16_t* pp; void* O;
    __device__ __forceinline__ void operator()(const f32x4 (&acc)[2][2][4][2], const Unit& u, int wr, int wc, int fr, int fq) const {
        const int row0 = u.pm * BM + wr * 64 + fr, col0 = u.pn * BM + wc * 32 + 8 * fq;
#pragma unroll
        for (int ai = 0; ai < 2; ++ai)
#pragma unroll
            for (int m = 0; m < 4; ++m) { const size_t off = (size_t)(row0 + ai * HALF + m * 16) * 1024 + col0;
#pragma unroll
                for (int bj = 0; bj < 2; ++bj) { f32x4 h0, h1, p0, p1;
                    unpack8(*(const u32x4*)(hpre + off + bj * HALF), h0, h1); unpack8(*(const u32x4*)(pp + off + bj * HALF), p0, p1);
                    f32x4 g0, g1;
#pragma unroll
                    for (int e = 0; e < 4; ++e) { g0[e] = fsigmoid(acc[ai][bj][m][0][e]); g1[e] = fsigmoid(acc[ai][bj][m][1][e]); }
                    const f32x4 o0 = h0 + g0 * p0, o1 = h1 + g1 * p1;
                    if (F32OUT) { *(f32x4*)((float*)O + off + bj * HALF) = o0; *(f32x4*)((float*)O + off + bj * HALF + 4) = o1; }
                    else *(u32x4*)((bf16_t*)O + off + bj * HALF) = pack8(o0, o1); } }
    }
};
struct EpiWA {
    static constexpr bool PERM = true, AFTER_DRAIN = false;
    bf16_t* O; const float* w0; const float* a0;
    __device__ __forceinline__ void operator()(const f32x4 (&acc)[2][2][4][2], const Unit& u, int wr, int wc, int fr, int fq) const {
        const int row0 = u.pm * BM + wr * 64 + fr, col0 = u.pn * BM + wc * 32 + 8 * fq;
        const bool isw = u.pn < 4; const float* bvec = isw ? (w0 + col0) : (a0 + col0 - 1024); const float mul = isw ? -0.6065306597126334f : 1.0f;
#pragma unroll
        for (int ai = 0; ai < 2; ++ai)
#pragma unroll
            for (int m = 0; m < 4; ++m) { bf16_t* rowp = O + (size_t)(row0 + ai * HALF + m * 16) * 2048 + col0;
#pragma unroll
                for (int bj = 0; bj < 2; ++bj) { f32x4 o0, o1; const f32x4 b0 = *(const f32x4*)(bvec + bj * HALF), b1 = *(const f32x4*)(bvec + bj * HALF + 4);
#pragma unroll
                    for (int e = 0; e < 4; ++e) { o0[e] = mul * fsigmoid(acc[ai][bj][m][0][e] + b0[e]); o1[e] = mul * fsigmoid(acc[ai][bj][m][1][e] + b1[e]); }
                    *(u32x4*)(rowp + bj * HALF) = pack8(o0, o1); } }
    }
};
template <class Epi, class Sched, bool ALIGN_EPI = false, bool SP2 = false>
__device__ __forceinline__ void gemm_phase(PG8_LAS unsigned char* lds, const Gemm g, const Sched& S, const Epi& E, const int tid_in) {
    const int tid = tid_in, wid = __builtin_amdgcn_readfirstlane(tid >> 6), lane = tid & 63, wr = wid >> 2, wc = wid & 3, fr = lane & 15, fq = lane >> 4;
    const int K = g.K, nt = K / BK;
    unsigned voffA[2], voffB[2];
#pragma unroll
    for (int i = 0; i < 2; ++i) { int R, C; stage_rc(tid * 16 + i * 8192, R, C); const int Rb = Epi::PERM ? ((R & ~31) + perm32(R & 31)) : R;
        voffA[i] = (unsigned)(R * K + C) * 2u; voffB[i] = (unsigned)(Rb * K + C) * 2u; }
    const size_t kstep = (size_t)(BK * 2);
    const size_t hstep = (size_t)HALF * K * 2;
    const size_t tstep = 2 * hstep;
    const unsigned ldsw = (unsigned)wid * 1024u;
    const int aoff = lds_byte(wr * 64 + fr, fq * 8), boff = lds_byte(wc * 32 + fr, fq * 8);
#define PG8_SA(b, h) (((b) * 2 + (h)) * HTB)
#define PG8_SB(b, h) ((4 + (b) * 2 + (h)) * HTB)
#define PG8_STAGE(bufoff, gbase, voff) do { _Pragma("unroll") for (int _i = 0; _i < 2; ++_i) \
        __builtin_amdgcn_global_load_lds((const unsigned*)((const char*)(gbase) + (voff)[_i]), (PG8_LAS unsigned*)(lds + (bufoff) + ldsw + _i * 8192), 16, 0, 0); } while (0)
#define PG8_LDA(dst, b, h) do { _Pragma("unroll") for (int m = 0; m < 4; ++m) _Pragma("unroll") for (int k = 0; k < 2; ++k) dst[m][k] = *(const PG8_LAS bf16x8*)(lds + PG8_SA(b, h) + aoff + m * 2048 + k * 1024); } while (0)
#define PG8_LDB(dst, b, h) do { _Pragma("unroll") for (int n = 0; n < 2; ++n) _Pragma("unroll") for (int k = 0; k < 2; ++k) dst[n][k] = *(const PG8_LAS bf16x8*)(lds + PG8_SB(b, h) + boff + n * 2048 + k * 1024); } while (0)
#define PG8_MMA(ai, bj, At, Bt) do { __builtin_amdgcn_s_setprio(1); _Pragma("unroll") for (int m = 0; m < 4; ++m) _Pragma("unroll") for (int n = 0; n < 2; ++n) _Pragma("unroll") for (int k = 0; k < 2; ++k) \
        acc[ai][bj][m][n] = __builtin_amdgcn_mfma_f32_16x16x32_bf16(Bt[n][k], At[m][k], acc[ai][bj][m][n], 0, 0, 0); __builtin_amdgcn_s_setprio(0); } while (0)
#define PG8_WAIT_V(n) asm volatile("s_waitcnt vmcnt(" #n ")" ::: "memory")
#define PG8_WAIT_L(n) asm volatile("s_waitcnt lgkmcnt(" #n ")" ::: "memory")
#define PG8_BAR __builtin_amdgcn_s_barrier()
#define PG8_SCHED __builtin_amdgcn_sched_barrier(0)
    Unit cur, nxt; int ui = 0;
    if (!S.next(0, cur)) return;
    f32x4 acc[2][2][4][2];
#pragma unroll
    for (int a = 0; a < 2; ++a)
#pragma unroll
        for (int b = 0; b < 2; ++b)
#pragma unroll
            for (int m = 0; m < 4; ++m)
#pragma unroll
                for (int n = 0; n < 2; ++n) acc[a][b][m][n] = (f32x4){0.f, 0.f, 0.f, 0.f};
    bf16x8 At[4][2], B0[2][2], B1[2][2];
    const char* cA = (const char*)g.asel(cur.pn) + (size_t)cur.pm * tstep; const char* cB = (const char*)g.Bt + (size_t)cur.pn * tstep;
    S.a_ready(cur);
    if constexpr (SP2) {
        PG8_STAGE(PG8_SB(0, 0), cB, voffB); PG8_STAGE(PG8_SB(0, 1), cB + hstep, voffB); PG8_STAGE(PG8_SA(0, 0), cA, voffA); PG8_STAGE(PG8_SA(0, 1), cA + hstep, voffA);
        if (wr == 1) PG8_BAR;
        PG8_WAIT_V(2); PG8_BAR;
        PG8_STAGE(PG8_SB(1, 0), cB + kstep, voffB); PG8_STAGE(PG8_SA(1, 0), cA + kstep, voffA); PG8_STAGE(PG8_SB(1, 1), cB + hstep + kstep, voffB);
        PG8_WAIT_V(6); PG8_BAR;
    } else {
        PG8_STAGE(PG8_SB(0, 0), cB, voffB); PG8_STAGE(PG8_SA(0, 0), cA, voffA); PG8_STAGE(PG8_SB(0, 1), cB + hstep, voffB); PG8_STAGE(PG8_SA(0, 1), cA + hstep, voffA);
        if (wr == 1) PG8_BAR;
        PG8_WAIT_V(4); PG8_BAR;
        PG8_STAGE(PG8_SB(1, 0), cB + kstep, voffB); PG8_STAGE(PG8_SA(1, 0), cA + kstep, voffA); PG8_STAGE(PG8_SB(1, 1), cB + hstep + kstep, voffB);
        PG8_WAIT_V(6); PG8_BAR;
    }
    for (;;) {
        const bool has_next = S.next(ui + 1, nxt);
        const char* nA = has_next ? (const char*)g.asel(nxt.pn) + (size_t)nxt.pm * tstep : cA; const char* nB = has_next ? (const char*)g.Bt + (size_t)nxt.pn * tstep : cB;
        for (int t = 0; t < nt; t += 2) {
            const bool last = (t == nt - 2);
            const char* a1 = cA + (size_t)(t + 1) * kstep;
            const char* a2 = last ? nA : cA + (size_t)(t + 2) * kstep; const char* b2 = last ? nB : cB + (size_t)(t + 2) * kstep;
            const char* a3 = a2 + kstep; const char* b3 = b2 + kstep;
            if (last && has_next) S.a_ready(nxt);
            if constexpr (SP2) {
            PG8_LDB(B0, 0, 0); PG8_LDB(B1, 0, 1); PG8_SCHED; PG8_LDA(At, 0, 0); PG8_STAGE(PG8_SA(1, 1), a1 + hstep, voffA);
            PG8_WAIT_V(8); PG8_WAIT_L(0); PG8_BAR; PG8_MMA(0, 0, At, B0); PG8_MMA(0, 1, At, B1); PG8_BAR; PG8_SCHED;
            PG8_LDA(At, 0, 1); PG8_STAGE(PG8_SB(0, 0), b2, voffB); PG8_STAGE(PG8_SB(0, 1), b2 + hstep, voffB); PG8_STAGE(PG8_SA(0, 0), a2, voffA);
            PG8_WAIT_V(8); PG8_WAIT_L(0); PG8_BAR; PG8_MMA(1, 0, At, B0); PG8_MMA(1, 1, At, B1); PG8_BAR; PG8_SCHED;
            PG8_LDB(B0, 1, 0); PG8_LDB(B1, 1, 1); PG8_SCHED; PG8_LDA(At, 1, 0); PG8_STAGE(PG8_SA(0, 1), a2 + hstep, voffA);
            PG8_WAIT_V(8); PG8_WAIT_L(0); PG8_BAR; PG8_MMA(0, 0, At, B0); PG8_MMA(0, 1, At, B1); PG8_BAR; PG8_SCHED;
            PG8_LDA(At, 1, 1); PG8_STAGE(PG8_SB(1, 0), b3, voffB); PG8_STAGE(PG8_SB(1, 1), b3 + hstep, voffB); PG8_STAGE(PG8_SA(1, 0), a3, voffA);
            PG8_WAIT_V(8); PG8_WAIT_L(0); PG8_BAR; PG8_MMA(1, 0, At, B0); PG8_MMA(1, 1, At, B1); PG8_BAR; PG8_SCHED;
            } else {
            PG8_LDB(B0, 0, 0); PG8_SCHED; PG8_LDA(At, 0, 0); PG8_STAGE(PG8_SA(1, 1), a1 + hstep, voffA);
            PG8_WAIT_L(8); PG8_BAR; PG8_WAIT_L(0); PG8_MMA(0, 0, At, B0); PG8_BAR; PG8_SCHED;
            PG8_LDB(B1, 0, 1); PG8_STAGE(PG8_SB(0, 0), b2, voffB);
            PG8_BAR; PG8_WAIT_L(0); PG8_MMA(0, 1, At, B1); PG8_BAR;
            PG8_LDA(At, 0, 1); PG8_STAGE(PG8_SA(0, 0), a2, voffA);
            PG8_BAR; PG8_WAIT_L(0); PG8_MMA(1, 0, At, B0); PG8_BAR; PG8_SCHED;
            PG8_STAGE(PG8_SB(0, 1), b2 + hstep, voffB);
            PG8_WAIT_V(6); PG8_BAR; PG8_MMA(1, 1, At, B1); PG8_BAR;
            PG8_LDB(B0, 1, 0); PG8_SCHED; PG8_LDA(At, 1, 0); PG8_STAGE(PG8_SA(0, 1), a2 + hstep, voffA);
            PG8_WAIT_L(8); PG8_BAR; PG8_WAIT_L(0); PG8_MMA(0, 0, At, B0); PG8_BAR; PG8_SCHED;
            PG8_LDB(B1, 1, 1); PG8_STAGE(PG8_SB(1, 0), b3, voffB);
            PG8_BAR; PG8_WAIT_L(0); PG8_MMA(0, 1, At, B1); PG8_BAR;
            PG8_LDA(At, 1, 1); PG8_STAGE(PG8_SA(1, 0), a3, voffA);
            PG8_BAR; PG8_WAIT_L(0); PG8_MMA(1, 0, At, B0); PG8_BAR; PG8_SCHED;
            PG8_STAGE(PG8_SB(1, 1), b3 + hstep, voffB);
            PG8_WAIT_V(6); PG8_BAR; PG8_MMA(1, 1, At, B1); PG8_BAR;
            }
        }
        if constexpr (ALIGN_EPI) { if (wr == 0) PG8_BAR; }
        if constexpr (!Epi::AFTER_DRAIN) { E(acc, cur, wr, wc, fr, fq); S.done(cur); }
        if (!has_next) break;
#pragma unroll
        for (int a = 0; a < 2; ++a)
#pragma unroll
            for (int b = 0; b < 2; ++b)
#pragma unroll
                for (int m = 0; m < 4; ++m)
#pragma unroll
                    for (int n = 0; n < 2; ++n) acc[a][b][m][n] = (f32x4){0.f, 0.f, 0.f, 0.f};
        cur = nxt; cA = nA; cB = nB; ++ui;
        if constexpr (ALIGN_EPI) { if (wr == 1) PG8_BAR; }
    }
    PG8_WAIT_V(0);
    if constexpr (!ALIGN_EPI) { if (wr == 0) PG8_BAR; }
    PG8_BAR;
    if constexpr (Epi::AFTER_DRAIN) { E.fused(acc, cur, wr, wc, fr, fq, lds, wid, lane); S.done(cur); }
#undef PG8_SA
#undef PG8_SB
#undef PG8_STAGE
#undef PG8_LDA
#undef PG8_LDB
#undef PG8_MMA
#undef PG8_WAIT_V
#undef PG8_WAIT_L
#undef PG8_BAR
#undef PG8_SCHED
}
}
using pg8::bf16_t; using pg8::bf16x8; using pg8::f32x4; using pg8::u32x4; using pg8::cvt_pk_bf16; using pg8::bf2f; using pg8::bflo; using pg8::bfhi; using pg8::fsigmoid; using pg8::pack8; using pg8::unpack8;
#define LAS __attribute__((address_space(3)))
typedef unsigned u32x2 __attribute__((ext_vector_type(2)));
typedef float f32x2 __attribute__((ext_vector_type(2)));

constexpr int NB = 8, T = 4096, D = 1024, M = NB * T, PLE = 256, ATT_IN = 2560;
constexpr int NWAVES = 8, NTHR = 512;
constexpr int LDS_BYTES = 147456;

constexpr size_t MiB = 1u << 20;
constexpr size_t WS_WQKVZ = 0;
constexpr size_t WS_WO0   = 5 * MiB;
constexpr size_t WS_WG0   = 7 * MiB;
constexpr size_t WS_WG1   = 9 * MiB;
constexpr size_t WS_WO1   = 11 * MiB;
constexpr size_t WS_WR    = 13 * MiB;
constexpr size_t WS_WP0   = 21 * MiB;
constexpr size_t WS_WP1   = 21 * MiB + 512 * 1024;
constexpr size_t WS_WL    = 22 * MiB;
constexpr size_t WS_W2    = 22 * MiB + 512 * 1024;
constexpr size_t WS_COS   = 23 * MiB;
constexpr size_t WS_SIN   = 23 * MiB + 512 * 1024;
constexpr size_t WS_BIAS  = 24 * MiB;
constexpr size_t WS_CTL   = 25 * MiB;
constexpr size_t WS_PB0   = 32 * MiB;
constexpr size_t WS_L     = 32 * MiB;
constexpr size_t WS_PB1   = 48 * MiB;
constexpr size_t WS_S1    = 64 * MiB;
constexpr size_t WS_QKVZ  = 128 * MiB;
constexpr size_t WS_XS0   = 128 * MiB, WS_XS1 = 192 * MiB, WS_WA = 128 * MiB, WS_A2 = 256 * MiB;
constexpr size_t WS_S2    = 288 * MiB;
constexpr size_t WS_S3    = 352 * MiB;
constexpr size_t WS_S4    = 416 * MiB;
constexpr size_t WS_END   = 480 * MiB;

__device__ __forceinline__ float wave_sum(float v) {
#pragma unroll
    for (int o = 1; o < 64; o <<= 1) v += __shfl_xor(v, o);
    return v;
}
__device__ __forceinline__ float dpp_add(float x, const int ctrl_dummy) { return x; }
#define DPP_XADD(x, ctrl) ((x) + __builtin_bit_cast(float, __builtin_amdgcn_update_dpp(0, __builtin_bit_cast(int, (x)), (ctrl), 0xF, 0xF, true)))
__device__ __forceinline__ float row16_sum(float x) {
    x = DPP_XADD(x, 0xB1);
    x = DPP_XADD(x, 0x4E);
    x = DPP_XADD(x, 0x141);
    x = DPP_XADD(x, 0x140);
    return x;
}

__device__ __forceinline__ void grid_bar(unsigned* ctr, unsigned target, int tid) {
    asm volatile("s_waitcnt vmcnt(0)" ::: "memory");
    __syncthreads();
    if (tid == 0) {
        __builtin_amdgcn_fence(__ATOMIC_RELEASE, "agent");
        asm volatile("s_waitcnt vmcnt(0)" ::: "memory");
        __hip_atomic_fetch_add(ctr, 1u, __ATOMIC_RELAXED, __HIP_MEMORY_SCOPE_AGENT);
        while (__hip_atomic_load(ctr, __ATOMIC_RELAXED, __HIP_MEMORY_SCOPE_AGENT) < target) __builtin_amdgcn_s_sleep(2);
        __builtin_amdgcn_fence(__ATOMIC_ACQUIRE, "agent");
        asm volatile("s_waitcnt vmcnt(0)" ::: "memory");
    }
    __syncthreads();
}
#define XB_TMO      128
#define XB_XCNT(j)  (256  + 64 * (j))
#define XB_XSUB(j)  (1280 + 64 * (j))
#define XB_XGEN(j)  (2304 + 64 * (j))
#define XB_TOP      3328
#define XB_TOPGEN   3392
#define XCD_BAR_WORDS 3456
#define XB_SPIN_CAP (1u << 18)

__device__ __forceinline__ unsigned xb_ld(unsigned* p)              { return __hip_atomic_load(p, __ATOMIC_RELAXED, __HIP_MEMORY_SCOPE_AGENT); }
__device__ __forceinline__ unsigned xb_add(unsigned* p, unsigned v) { return __hip_atomic_fetch_add(p, v, __ATOMIC_RELAXED, __HIP_MEMORY_SCOPE_AGENT); }
__device__ __forceinline__ unsigned xb_xcc_id() { return (unsigned)__builtin_amdgcn_s_getreg((3 << 11) | 20) & 0xFu; }
#define XB_SPIN(cond, bar) do { unsigned _sp = 0; while (cond) { __builtin_amdgcn_s_sleep(1); \
    if ((++_sp & 255u) == 0u) { if (xb_ld(&(bar)[XB_TMO])) break; if (_sp > XB_SPIN_CAP) { atomicAdd(&(bar)[XB_TMO], 1u); break; } } } } while (0)

struct XcdBarrier {
    unsigned* bar; unsigned x;
    volatile LAS unsigned* st;
};

__device__ __forceinline__ XcdBarrier xcd_barrier_post(unsigned* bar, volatile LAS unsigned* st, const int tid_) {
    XcdBarrier b; b.bar = bar; b.x = xb_xcc_id(); b.st = st;
    if (tid_ == 0) (void)xb_add(&bar[XB_XCNT(b.x)], 1u);
    return b;
}
__device__ __forceinline__ void xcd_barrier_complete(unsigned* bar, unsigned x, unsigned& nloc, unsigned& nx) {
    const unsigned G = gridDim.x * gridDim.y * gridDim.z;
    unsigned sum, cnt, mine, sp = 0u;
    for (;;) {
        sum = 0u; cnt = 0u; mine = 0u;
#pragma unroll
        for (unsigned j = 0; j < 16; ++j) { const unsigned c = xb_ld(&bar[XB_XCNT(j)]); sum += c; cnt += (c > 0u) ? 1u : 0u; mine = (j == x) ? c : mine; }
        if (sum == G) break;
        __builtin_amdgcn_s_sleep(1);
        if ((++sp & 255u) == 0u) { if (xb_ld(&bar[XB_TMO])) break; if (sp > XB_SPIN_CAP) { atomicAdd(&bar[XB_TMO], 1u); break; } }
    }
    nloc = mine > 0u ? mine : 1u; nx = cnt > 0u ? cnt : 1u;
}

__device__ __forceinline__ void xcd_barrier(const XcdBarrier& b, const int tid_) {
    asm volatile("s_waitcnt vmcnt(0)" ::: "memory");
    __syncthreads();
    if (tid_ == 0) {
        unsigned* bar = b.bar;
        __builtin_amdgcn_s_waitcnt(0);
        unsigned nloc = b.st[0], nx = b.st[1];
        if (nloc == 0u) { xcd_barrier_complete(bar, b.x, nloc, nx); b.st[0] = nloc; b.st[1] = nx; }
        const unsigned old = xb_add(&bar[XB_XSUB(b.x)], 1u);
        const unsigned gen = old / nloc;
        if (old + 1u == (gen + 1u) * nloc) {
            __builtin_amdgcn_fence(__ATOMIC_RELEASE, "agent");
            asm volatile("s_waitcnt vmcnt(0)" ::: "memory");
            const unsigned og = xb_add(&bar[XB_TOP], 1u);
            const unsigned tg = og / nx;
            if (og + 1u == (tg + 1u) * nx) xb_add(&bar[XB_TOPGEN], 1u);
            else XB_SPIN(xb_ld(&bar[XB_TOPGEN]) == tg, bar);
            __builtin_amdgcn_fence(__ATOMIC_ACQUIRE, "agent");
            xb_add(&bar[XB_XGEN(b.x)], 1u);
            asm volatile("s_waitcnt vmcnt(0)" ::: "memory");
        } else {
            XB_SPIN(xb_ld(&bar[XB_XGEN(b.x)]) == gen, bar);
            __builtin_amdgcn_fence(__ATOMIC_ACQUIRE, "agent");
            asm volatile("s_waitcnt vmcnt(0)" ::: "memory");
        }
    }
    __syncthreads();
}

__device__ __forceinline__ int qk_perm_row(int n) {
    if (n >= 1280) return n;
    const int hd = n & ~63, d = n & 63, dd = d & 31;
    return hd + 8 * (dd >> 2) + 4 * (d >> 5) + (dd & 3);
}
template <int MODE>
__device__ __forceinline__ void transpose_item(const float* W, int K, int N, bf16_t* WT, int row_off, LAS float* scr, int item, int lane, const float* s) {
    const int nblk = N / 32, kb = item / nblk, nb = item % nblk, k0 = 64 * kb, n0 = 32 * nb;
#pragma unroll 8
    for (int i = 0; i < 32; ++i) { const int kk = 2 * i + (lane >> 5); float v = W[(size_t)(k0 + kk) * N + n0 + (lane & 31)];
        if (MODE == 2) v *= s[k0 + kk]; if (MODE == 3) v *= 1.0f - s[k0 + kk];
        scr[kk * 33 + (lane & 31)] = v; }
    asm volatile("s_waitcnt lgkmcnt(0)" ::: "memory");
    const int c = lane & 7;
#pragma unroll
    for (int j = 0; j < 4; ++j) { const int n = (lane >> 3) + 8 * j; const LAS float* sp = scr + (8 * c) * 33 + n;
        u32x4 o; o.x = cvt_pk_bf16(sp[0 * 33], sp[1 * 33]); o.y = cvt_pk_bf16(sp[2 * 33], sp[3 * 33]); o.z = cvt_pk_bf16(sp[4 * 33], sp[5 * 33]); o.w = cvt_pk_bf16(sp[6 * 33], sp[7 * 33]);
        const int dn = (MODE == 1) ? qk_perm_row(n0 + n) : (n0 + n);
        *(u32x4*)(WT + (size_t)(row_off + dn) * K + k0 + 8 * c) = o; }
    asm volatile("s_waitcnt lgkmcnt(0)" ::: "memory");
}

struct Args { const float* in[24]; float* out; unsigned char* ws; int ph_lo, ph_hi; };
typedef const __attribute__((address_space(4))) unsigned char* kptr_t;
__device__ __forceinline__ kptr_t kargs() { kptr_t p = (kptr_t)__builtin_amdgcn_kernarg_segment_ptr(); asm volatile("" : "+s"(p)); return p; }
#define GAS __attribute__((address_space(1)))
__device__ __forceinline__ const float* kin(kptr_t p, int i) { return (const float*)(const GAS float*)*(const unsigned long long __attribute__((address_space(4)))*)(p + 8 * i); }
__device__ __forceinline__ float* kout(kptr_t p) { return (float*)(GAS float*)*(const unsigned long long __attribute__((address_space(4)))*)(p + 8 * 24); }
__device__ __forceinline__ unsigned char* kws(kptr_t p) { return (unsigned char*)(GAS unsigned char*)*(const unsigned long long __attribute__((address_space(4)))*)(p + 8 * 25); }

enum { I_X = 0, I_P, I_NORMG, I_AWIN, I_ABIN, I_ASINK, I_AWOUT, I_MU, I_RWIN, I_W0, I_W1, I_W2, I_A0, I_A1, I_A2, I_KK, I_KA, I_RK, I_GNG, I_GNB, I_RWOUT, I_PWP, I_PWG, I_FNG };
__device__ __forceinline__ void p0_prologue(LAS unsigned char* lds, int G, int bid, int tid) {
    kptr_t kp = kargs();
    const int wave = __builtin_amdgcn_readfirstlane(tid >> 6), lane = tid & 63;
    LAS float* scr = (LAS float*)(lds + wave * 16384);
    const int gw = bid * NWAVES + wave, NGW = G * NWAVES;
    unsigned char* ws = kws(kp);
    const float* mu = kin(kp, I_MU);
    constexpr int N1 = 1280, N2 = 512, N5 = 2048, N6 = 128, N7 = 32;
    constexpr int NITEMS = N1 + 4 * N2 + N5 + 2 * N6 + 4 * N7;
    for (int it = gw; it < NITEMS; it += NGW) {
        int r = it;
        if (r < N1) { transpose_item<1>(kin(kp, I_AWIN), 1024, 2560, (bf16_t*)(ws + WS_WQKVZ), 0, scr, r, lane, nullptr); continue; } r -= N1;
        if (r < N2) { transpose_item<0>(kin(kp, I_AWOUT), 1024, 1024, (bf16_t*)(ws + WS_WO0), 0, scr, r, lane, nullptr); continue; } r -= N2;
        if (r < N2) { transpose_item<0>(kin(kp, I_PWG), 1024, 1024, (bf16_t*)(ws + WS_WG0), 0, scr, r, lane, nullptr); continue; } r -= N2;
        if (r < N2) { transpose_item<0>(kin(kp, I_PWG) + 1024 * 1024, 1024, 1024, (bf16_t*)(ws + WS_WG1), 0, scr, r, lane, nullptr); continue; } r -= N2;
        if (r < N2) { transpose_item<0>(kin(kp, I_RWOUT), 1024, 1024, (bf16_t*)(ws + WS_WO1), 0, scr, r, lane, nullptr); continue; } r -= N2;
        if (r < N5) { transpose_item<0>(kin(kp, I_RWIN), 1024, 4096, (bf16_t*)(ws + WS_WR), 0, scr, r, lane, nullptr); continue; } r -= N5;
        if (r < N6) { transpose_item<0>(kin(kp, I_PWP), 256, 1024, (bf16_t*)(ws + WS_WP0), 0, scr, r, lane, nullptr); continue; } r -= N6;
        if (r < N6) { transpose_item<0>(kin(kp, I_PWP) + 256 * 1024, 256, 1024, (bf16_t*)(ws + WS_WP1), 0, scr, r, lane, nullptr); continue; } r -= N6;
        if (r < N7) { transpose_item<3>(kin(kp, I_W1), 1024, 64, (bf16_t*)(ws + WS_WL), 0, scr, r, lane, mu + 4 * 1024); continue; } r -= N7;
        if (r < N7) { transpose_item<2>(kin(kp, I_W1), 1024, 64, (bf16_t*)(ws + WS_WL), 64, scr, r, lane, mu + 4 * 1024); continue; } r -= N7;
        if (r < N7) { transpose_item<3>(kin(kp, I_A1), 1024, 64, (bf16_t*)(ws + WS_WL), 128, scr, r, lane, mu + 5 * 1024); continue; } r -= N7;
        transpose_item<2>(kin(kp, I_A1), 1024, 64, (bf16_t*)(ws + WS_WL), 192, scr, r, lane, mu + 5 * 1024);
    }
    {
        const float* g0 = kin(kp, I_NORMG); bf16_t* XN = (bf16_t*)(ws + WS_S1);
        f32x4 gv[4];
#pragma unroll
        for (int j = 0; j < 4; ++j) gv[j] = *((const f32x4*)g0 + lane + 64 * j);
        const float* xin = kin(kp, I_X);
        f32x4 nx[4];
        if (gw < M) {
#pragma unroll
            for (int j = 0; j < 4; ++j) nx[j] = *((const f32x4*)(xin + (size_t)gw * D) + lane + 64 * j); }
        for (int m = gw; m < M; m += NGW) {
            f32x4 v[4]; float s = 0.f;
#pragma unroll
            for (int j = 0; j < 4; ++j) { v[j] = nx[j]; s += (v[j].x * v[j].x + v[j].y * v[j].y) + (v[j].z * v[j].z + v[j].w * v[j].w); }
            if (m + NGW < M) {
#pragma unroll
                for (int j = 0; j < 4; ++j) nx[j] = *((const f32x4*)(xin + (size_t)(m + NGW) * D) + lane + 64 * j); }
            const float rstd = 1.0f / sqrtf(wave_sum(s) * (1.0f / D) + 1e-6f);
            u32x2* o8 = (u32x2*)(XN + (size_t)m * D) + lane;
#pragma unroll
            for (int j = 0; j < 4; ++j) { const f32x4 o = v[j] * rstd * gv[j]; u32x2 w; w.x = cvt_pk_bf16(o.x, o.y); w.y = cvt_pk_bf16(o.z, o.w); o8[64 * j] = w; }
        }
    }
    const int gt = bid * NTHR + tid, NGT = G * NTHR;
    {
        const f32x4* p4 = (const f32x4*)kin(kp, I_P); u32x4* o = (u32x4*)(ws + WS_PB0);
        for (int i = gt; i < 2 * M * PLE / 8; i += NGT) { const f32x4 x0 = p4[2 * i], x1 = p4[2 * i + 1]; o[i] = pack8(x0, x1); }
    }
    {
        float* cs = (float*)(ws + WS_COS); float* sn = (float*)(ws + WS_SIN);
        for (int i = gt; i < T * 32; i += NGT) {
            const int pos = i >> 5, f = i & 31;
            const float inv = (float)exp2(-(double)f * (13.287712379549449 / 32.0));
            const float ang = (float)pos * inv;
            double rev = (double)ang * 0.15915494309189535; rev -= floor(rev);
            sn[i] = __builtin_amdgcn_sinf((float)rev); cs[i] = __builtin_amdgcn_cosf((float)rev);
        }
    }
    {
        float* bp = (float*)(ws + WS_BIAS);
        for (int i = gt; i < ATT_IN; i += NGT) bp[qk_perm_row(i)] = kin(kp, I_ABIN)[i];
    }
    {
        bf16_t* W2T = (bf16_t*)(ws + WS_W2); const float* w2 = kin(kp, I_W2); const float* a2 = kin(kp, I_A2);
        for (int i = gt; i < 2048 * 128; i += NGT) {
            const int k = i >> 11, nn = i & 2047;
            float v;
            if (nn < 1024) v = (k < 64) ? w2[k * 1024 + nn] : 0.f; else v = (k >= 64) ? a2[(k - 64) * 1024 + (nn - 1024)] : 0.f;
            W2T[(size_t)nn * 128 + k] = (bf16_t)(cvt_pk_bf16(v, 0.f) & 0xffffu);
        }
    }
}

__device__ __forceinline__ void attn_phase(LAS unsigned char* lds, const bf16_t* QKVZ, const float* sinks, bf16_t* OG, int G, int bid, int tid) {
    const int wave = __builtin_amdgcn_readfirstlane(tid >> 6), lane = tid & 63, fr = lane & 15, fq = lane >> 4;
    constexpr int KP = 144, VP = 528;
    LAS unsigned char* Kl = lds; LAS unsigned char* Vt = lds + 256 * KP;
    for (int unit = bid; unit < 1024; unit += G) {
        const int kvh = unit & 3, n = (unit >> 2) & 31, b = unit >> 7;
        __syncthreads();
#pragma unroll
        for (int i = 0; i < 4; ++i) {
            const int c = tid + 512 * i, key = c >> 3, ch = c & 7, t = 128 * (n - 1) + key;
            u32x4 kv = (u32x4){0u, 0u, 0u, 0u}, vv = (u32x4){0u, 0u, 0u, 0u};
            if (t >= 0) { const bf16_t* rp = QKVZ + (size_t)(b * T + t) * ATT_IN + kvh * 64 + ch * 8; kv = *(const u32x4*)(rp + 1024); vv = *(const u32x4*)(rp + 1280); }
            *(LAS u32x4*)(Kl + key * KP + ch * 16) = kv;
            LAS unsigned short* vp = (LAS unsigned short*)(Vt + (ch * 8) * VP + ((key ^ (ch << 2)) * 2));
            vp[0 * (VP / 2)] = (unsigned short)(vv.x & 0xffffu); vp[1 * (VP / 2)] = (unsigned short)(vv.x >> 16);
            vp[2 * (VP / 2)] = (unsigned short)(vv.y & 0xffffu); vp[3 * (VP / 2)] = (unsigned short)(vv.y >> 16);
            vp[4 * (VP / 2)] = (unsigned short)(vv.z & 0xffffu); vp[5 * (VP / 2)] = (unsigned short)(vv.z >> 16);
            vp[6 * (VP / 2)] = (unsigned short)(vv.w & 0xffffu); vp[7 * (VP / 2)] = (unsigned short)(vv.w >> 16);
        }
        __syncthreads();
        const int g = wave >> 1, qh = wave & 1, h = kvh * 4 + g;
        const float sink2 = sinks[h] * 1.4426950408889634f;
        for (int mt = 0; mt < 4; ++mt) {
            const int qo0 = qh * 64 + mt * 16;
            const size_t row = (size_t)(b * T + n * 128 + qo0 + fr);
            const bf16_t* qp = QKVZ + row * ATT_IN + h * 64 + fq * 8;
            const bf16x8 q0 = *(const bf16x8*)qp, q1 = *(const bf16x8*)(qp + 32);
            const int kt0 = (qh * 4 + mt) < 6 ? (qh * 4 + mt) : 6;
            f32x4 s[10];
#pragma unroll
            for (int kt = 0; kt < 10; ++kt) {
                const LAS unsigned char* kp = Kl + ((kt0 + kt) * 16 + fr) * KP + fq * 16;
                const bf16x8 k0 = *(const LAS bf16x8*)kp, k1 = *(const LAS bf16x8*)(kp + 64);
                f32x4 acc = (f32x4){0.f, 0.f, 0.f, 0.f};
                acc = __builtin_amdgcn_mfma_f32_16x16x32_bf16(k0, q0, acc, 0, 0, 0);
                acc = __builtin_amdgcn_mfma_f32_16x16x32_bf16(k1, q1, acc, 0, 0, 0);
                s[kt] = acc;
            }
            const int qi = 128 + qo0 + fr;
            float mx = sink2;
#pragma unroll
            for (int kt = 0; kt < 10; ++kt)
#pragma unroll
                for (int r = 0; r < 4; ++r) { const int si = (kt0 + kt) * 16 + 4 * fq + r, df = qi - si; const bool ok = (df >= 0) && (df < 128) && (n > 0 || si >= 128);
                    const float v = ok ? s[kt][r] : -1e30f; s[kt][r] = v; mx = fmaxf(mx, v); }
            mx = fmaxf(mx, __shfl_xor(mx, 16)); mx = fmaxf(mx, __shfl_xor(mx, 32));
            float sum = 0.f;
#pragma unroll
            for (int kt = 0; kt < 10; ++kt)
#pragma unroll
                for (int r = 0; r < 4; ++r) { const float p = __builtin_amdgcn_exp2f(s[kt][r] - mx); s[kt][r] = p; sum += p; }
            sum += __shfl_xor(sum, 16); sum += __shfl_xor(sum, 32);
            sum += __builtin_amdgcn_exp2f(sink2 - mx);
            const float inv = 1.0f / sum;
            f32x4 o[4];
#pragma unroll
            for (int dt = 0; dt < 4; ++dt) o[dt] = (f32x4){0.f, 0.f, 0.f, 0.f};
#pragma unroll
            for (int kk = 0; kk < 5; ++kk) {
                const u32x4 pw = pack8(s[2 * kk], s[2 * kk + 1]);
                const bf16x8 pf = __builtin_bit_cast(bf16x8, pw);
#pragma unroll
                for (int dt = 0; dt < 4; ++dt) {
                    const int d = dt * 16 + fr, sw = ((d >> 3) & 7) << 2, keyA = 16 * (kt0 + 2 * kk) + 4 * fq, keyB = keyA + 16;
                    const u32x2 va = *(const LAS u32x2*)(Vt + d * VP + ((keyA ^ sw) * 2)), vb = *(const LAS u32x2*)(Vt + d * VP + ((keyB ^ sw) * 2));
                    const u32x4 vw = (u32x4){va.x, va.y, vb.x, vb.y};
                    o[dt] = __builtin_amdgcn_mfma_f32_16x16x32_bf16(__builtin_bit_cast(bf16x8, vw), pf, o[dt], 0, 0, 0);
                }
            }
            const bf16_t* zp = QKVZ + row * ATT_IN + 1536 + h * 64 + 4 * fq;
            bf16_t* op = OG + row * D + h * 64 + 4 * fq;
#pragma unroll
            for (int dt = 0; dt < 4; ++dt) {
                const u32x2 zw = *(const u32x2*)(zp + dt * 16);
                const float z0 = bflo(zw.x), z1 = bfhi(zw.x), z2 = bflo(zw.y), z3 = bfhi(zw.y);
                const float r0 = o[dt][0] * inv * z0 * fsigmoid(z0), r1 = o[dt][1] * inv * z1 * fsigmoid(z1), r2 = o[dt][2] * inv * z2 * fsigmoid(z2), r3 = o[dt][3] * inv * z3 * fsigmoid(z3);
                u32x2 w; w.x = cvt_pk_bf16(r0, r1); w.y = cvt_pk_bf16(r2, r3);
                *(u32x2*)(op + dt * 16) = w;
            }
        }
    }
}
template <int ROUND>
__device__ __forceinline__ void lerp_phase(const bf16_t* H1, const float* g1, const float* mu, bf16_t* HN, bf16_t* XS0, bf16_t* XS1, int G, int bid, int tid) {
    const int wave = __builtin_amdgcn_readfirstlane(tid >> 6), lane = tid & 63;
    const int gw = bid * NWAVES + wave, NGW = G * NWAVES;
    const float* mu0 = mu + (ROUND == 0 ? 0 : 2) * 1024; const float* mu1 = mu0 + 1024;
    f32x4 gq[4], m0q[4], m1q[4];
#pragma unroll
    for (int q = 0; q < 4; ++q) { const int col = (q >> 1) * 512 + lane * 8 + 4 * (q & 1); gq[q] = *(const f32x4*)(g1 + col); m0q[q] = *(const f32x4*)(mu0 + col); m1q[q] = *(const f32x4*)(mu1 + col); }
    u32x4 rc_[2], rp_[2];
#define LERP_LOAD(mm) do { const bool hp_ = ((mm) & (T - 1)) != 0; _Pragma("unroll") for (int j = 0; j < 2; ++j) { const size_t off_ = (size_t)(mm) * D + j * 512 + lane * 8; \
        rc_[j] = *(const u32x4*)(H1 + off_); rp_[j] = hp_ ? *(const u32x4*)(H1 + off_ - D) : (u32x4){0u, 0u, 0u, 0u}; } } while (0)
    if (gw < M) LERP_LOAD(gw);
    for (int m = gw; m < M; m += NGW) {
        f32x4 c[4], p[4];
        float sc = 0.f, sp = 0.f;
#pragma unroll
        for (int j = 0; j < 2; ++j) { unpack8(rc_[j], c[2 * j], c[2 * j + 1]); unpack8(rp_[j], p[2 * j], p[2 * j + 1]); }
        if (m + NGW < M) LERP_LOAD(m + NGW);
#pragma unroll
        for (int q = 0; q < 4; ++q) { sc += (c[q].x * c[q].x + c[q].y * c[q].y) + (c[q].z * c[q].z + c[q].w * c[q].w); sp += (p[q].x * p[q].x + p[q].y * p[q].y) + (p[q].z * p[q].z + p[q].w * p[q].w); }
        const float rc = 1.0f / sqrtf(wave_sum(sc) * (1.0f / D) + 1e-6f), rp = 1.0f / sqrtf(wave_sum(sp) * (1.0f / D) + 1e-6f);
#pragma unroll
        for (int j = 0; j < 2; ++j) {
            const int col = j * 512 + lane * 8; const size_t off = (size_t)m * D + col;
            f32x4 hn[2], xx[2], o0[2], o1[2];
#pragma unroll
            for (int e = 0; e < 2; ++e) {
                const f32x4 gv = gq[2 * j + e];
                hn[e] = c[2 * j + e] * rc * gv; xx[e] = p[2 * j + e] * rp * gv - hn[e];
                o0[e] = hn[e] + xx[e] * m0q[2 * j + e];
                o1[e] = hn[e] + xx[e] * m1q[2 * j + e];
            }
            if (ROUND == 0) *(u32x4*)(HN + off) = pack8(hn[0], hn[1]);
            *(u32x4*)(XS0 + off) = pack8(o0[0], o0[1]);
            *(u32x4*)(XS1 + off) = pack8(o1[0], o1[1]);
        }
    }
}
__device__ __forceinline__ void lora_mid_phase(const bf16_t* L, bf16_t* A2, int G, int bid, int tid) {
    const int gt = bid * NTHR + tid, NGT = G * NTHR;
    for (int i = gt; i < M * 16; i += NGT) {
        const int m = i >> 4, ch = i & 15, isA = ch >> 3, c8 = (ch & 7) * 8;
        const bool hasprev = (m & (T - 1)) != 0;
        f32x4 u0, u1, v0 = (f32x4){0.f, 0.f, 0.f, 0.f}, v1 = v0;
        unpack8(*(const u32x4*)(L + (size_t)m * 256 + isA * 128 + c8), u0, u1);
        if (hasprev) unpack8(*(const u32x4*)(L + (size_t)(m - 1) * 256 + isA * 128 + 64 + c8), v0, v1);
        u0 += v0; u1 += v1;
        if (!isA) {
#pragma unroll
            for (int e = 0; e < 4; ++e) { u0[e] = tanhf(u0[e]); u1[e] = tanhf(u1[e]); }
        }
        *(u32x4*)(A2 + (size_t)m * 128 + ch * 8) = pack8(u0, u1);
    }
}
#ifndef MK_SCAN_CHUNKED
#define MK_SCAN_CHUNKED 1
#endif
#if MK_SCAN_CHUNKED
typedef __bf16 ck_bf16x2_t __attribute__((ext_vector_type(2)));
__device__ __forceinline__ unsigned ck_cvt(float lo, float hi) { const f32x2 v = {lo, hi}; return __builtin_bit_cast(unsigned, __builtin_convertvector(v, ck_bf16x2_t)); }
constexpr int CK_RP = 144;
constexpr int CK_TP = 40;
constexpr int CK_ABAR = 0, CK_RBAR = 2304, CK_BTIL = 4608, CK_KTIL = 6912;
constexpr int CK_BT_T = 9216, CK_KT_T = 11776;
constexpr int CK_VT = 14336;
constexpr int CK_GAM = 15616;
constexpr int CK_BUF = 15872;
constexpr int CK_LD = 2 * CK_BUF;
constexpr int CK_PRIV = CK_LD + 2 * 4096;
constexpr int CK_PRIV_SZ = 2560;
__device__ __forceinline__ bf16x8 ck_ld2(const LAS unsigned char* p, int off2) {
    const u32x2 a = *(const LAS u32x2*)p, b = *(const LAS u32x2*)(p + off2); return __builtin_bit_cast(bf16x8, (u32x4){a.x, a.y, b.x, b.y}); }
__device__ __forceinline__ bf16x8 ck_ld1(const LAS unsigned char* p) {
    const u32x2 a = *(const LAS u32x2*)p; return __builtin_bit_cast(bf16x8, (u32x4){a.x, a.y, 0u, 0u}); }
__device__ __forceinline__ bf16x8 ck_pk4(const f32x4 x) { return __builtin_bit_cast(bf16x8, (u32x4){ck_cvt(x[0], x[1]), ck_cvt(x[2], x[3]), 0u, 0u}); }
#define CK_MFMA(a, b, c) __builtin_amdgcn_mfma_f32_16x16x32_bf16((a), (b), (c), 0, 0, 0)

__device__ __forceinline__ void scan_phase(LAS unsigned char* lds, const bf16_t* R, const bf16_t* Kb, const bf16_t* V, const bf16_t* WA, const float* k_k, const float* k_a, bf16_t* Y, int G, int bid, int tid) {
    const int wave = __builtin_amdgcn_readfirstlane(tid >> 6), lane = tid & 63, c = lane & 15, g = lane >> 4;
    const int pid = tid - 128, pt = (pid >> 4) & 15, pj = pid & 15;
    const bool producer = (wave >= 2) && (wave < 6), consumer = wave < 2;
    constexpr int NCH = T / 16;
    for (int unit = bid; unit < 256; unit += G) {
        const int b = unit >> 5, h = (unit >> 1) & 15, half = unit & 1;
        const size_t rowbase = (size_t)b * T;
        f32x4 kkw = (f32x4){0.f, 0.f, 0.f, 0.f}, kaw = kkw;
        if (producer) { kkw = *(const f32x4*)(k_k + h * 64 + 4 * pj); kaw = *(const f32x4*)(k_a + h * 64 + 4 * pj); }
        u32x2 rk = (u32x2){0u, 0u}, rr = rk, ra = rk, rl = rk; unsigned rv = 0u, vsave = 0u;
        f32x4 nkk = kkw, be = kkw, kp = kkw, rf = kkw, lf = kkw;
#define CK_LOAD(cn) do { const size_t m_ = rowbase + (size_t)(cn) * 16 + pt; \
            rk = *(const u32x2*)(Kb + m_ * D + h * 64 + 4 * pj); rr = *(const u32x2*)(R + m_ * D + h * 64 + 4 * pj); \
            rl = *(const u32x2*)(WA + m_ * 2048 + h * 64 + 4 * pj); ra = *(const u32x2*)(WA + m_ * 2048 + 1024 + h * 64 + 4 * pj); \
            rv = *(const unsigned*)(V + m_ * D + h * 64 + half * 32 + 2 * pj); } while (0)
#define CK_P1(cn) do { \
            const f32x4 kf_ = (f32x4){bflo(rk.x), bfhi(rk.x), bflo(rk.y), bfhi(rk.y)}, af_ = (f32x4){bflo(ra.x), bfhi(ra.x), bflo(ra.y), bfhi(ra.y)}; \
            lf = (f32x4){bflo(rl.x), bfhi(rl.x), bflo(rl.y), bfhi(rl.y)}; rf = (f32x4){bflo(rr.x), bfhi(rr.x), bflo(rr.y), bfhi(rr.y)}; \
            const f32x4 kv_ = kf_ * kkw; \
            float ss_ = (kv_.x * kv_.x + kv_.y * kv_.y) + (kv_.z * kv_.z + kv_.w * kv_.w); \
            ss_ = row16_sum(ss_); \
            const float invn_ = (ss_ > 1e-24f) ? __builtin_amdgcn_rsqf(ss_) : 1e12f;        \
            const f32x4 kk_ = kv_ * invn_; nkk = -kk_; be = kk_ * af_; \
            kp = kf_ * (1.0f + (af_ - 1.0f) * kaw); vsave = rv; \
            *(LAS f32x4*)(lds + CK_LD + ((cn) & 1) * 4096 + (pt * 64 + 4 * pj) * 4) = lf; } while (0)
        if (producer) { CK_LOAD(0); CK_P1(0); CK_LOAD(1); }
        f32x4 H[4];
#pragma unroll
        for (int kt = 0; kt < 4; ++kt) H[kt] = (f32x4){0.f, 0.f, 0.f, 0.f};
        __syncthreads();
        for (int it = 0; it <= NCH; ++it) {
            if (producer && it < NCH) {
                LAS unsigned char* buf = lds + (it & 1) * CK_BUF;
                const LAS unsigned char* ldp = lds + CK_LD + (it & 1) * 4096 + 16 * pj;
                f32x4 Gc = (f32x4){0.f, 0.f, 0.f, 0.f};
                const int w4 = 4 * (wave - 2);
#pragma unroll
                for (int s4 = 0; s4 < 16; s4 += 4) {
                    if (s4 <= w4) {
                        f32x4 x0 = *(const LAS f32x4*)(ldp + (s4 + 0) * 256), x1 = *(const LAS f32x4*)(ldp + (s4 + 1) * 256), x2 = *(const LAS f32x4*)(ldp + (s4 + 2) * 256), x3 = *(const LAS f32x4*)(ldp + (s4 + 3) * 256);
                        asm volatile("" : "+v"(x0), "+v"(x1), "+v"(x2), "+v"(x3));
                        if (s4 < w4) Gc += (x0 + x1) + (x2 + x3);
                        else { const f32x4 z4 = (f32x4){0.f, 0.f, 0.f, 0.f};
                            Gc += (s4 + 0 <= pt) ? x0 : z4; Gc += (s4 + 1 <= pt) ? x1 : z4; Gc += (s4 + 2 <= pt) ? x2 : z4; Gc += (s4 + 3 <= pt) ? x3 : z4; }
                    }
                }
                const f32x4 Gm = Gc - lf;
                f32x4 eA, eR, eN;
#pragma unroll
                for (int e = 0; e < 4; ++e) { eA[e] = __expf(Gm[e]); eR[e] = __expf(Gc[e]); eN[e] = __expf(-Gc[e]); }
                const f32x4 ab = nkk * eA, rb = rf * eR, bt = be * eN, kt_ = kp * eN;
                const unsigned ab0 = ck_cvt(ab.x, ab.y), ab1 = ck_cvt(ab.z, ab.w), rb0 = ck_cvt(rb.x, rb.y), rb1 = ck_cvt(rb.z, rb.w);
                const unsigned bt0 = ck_cvt(bt.x, bt.y), bt1 = ck_cvt(bt.z, bt.w), kt0 = ck_cvt(kt_.x, kt_.y), kt1 = ck_cvt(kt_.z, kt_.w);
                LAS unsigned char* rowp = buf + pt * CK_RP + pj * 8;
                *(LAS u32x2*)(rowp + CK_ABAR) = (u32x2){ab0, ab1}; *(LAS u32x2*)(rowp + CK_RBAR) = (u32x2){rb0, rb1};
                *(LAS u32x2*)(rowp + CK_BTIL) = (u32x2){bt0, bt1}; *(LAS u32x2*)(rowp + CK_KTIL) = (u32x2){kt0, kt1};
                LAS unsigned short* btT = (LAS unsigned short*)(buf + CK_BT_T + (4 * pj) * CK_TP + pt * 2);
                LAS unsigned short* ktT = (LAS unsigned short*)(buf + CK_KT_T + (4 * pj) * CK_TP + pt * 2);
                constexpr int TS = CK_TP / 2;
                btT[0] = (unsigned short)(bt0 & 0xffffu); btT[TS] = (unsigned short)(bt0 >> 16); btT[2 * TS] = (unsigned short)(bt1 & 0xffffu); btT[3 * TS] = (unsigned short)(bt1 >> 16);
                ktT[0] = (unsigned short)(kt0 & 0xffffu); ktT[TS] = (unsigned short)(kt0 >> 16); ktT[2 * TS] = (unsigned short)(kt1 & 0xffffu); ktT[3 * TS] = (unsigned short)(kt1 >> 16);
                LAS unsigned short* vT = (LAS unsigned short*)(buf + CK_VT + (2 * pj) * CK_TP + pt * 2);
                vT[0] = (unsigned short)(vsave & 0xffffu); vT[TS] = (unsigned short)(vsave >> 16);
                if (pt == 15) *(LAS f32x4*)(buf + CK_GAM + 16 * pj) = eR;
                if (it + 1 < NCH) { CK_P1(it + 1); if (it + 2 < NCH) CK_LOAD(it + 2); }
            }
            if (consumer && it > 0) {
                const int cn = it - 1;
                const LAS unsigned char* buf = lds + (cn & 1) * CK_BUF;
                LAS unsigned char* priv = lds + CK_PRIV + wave * CK_PRIV_SZ;
                LAS float* AabT = (LAS float*)priv; LAS float* Xch = (LAS float*)(priv + 1024); LAS unsigned char* UT = priv + 2048;
                f32x4 xab = (f32x4){0.f, 0.f, 0.f, 0.f}, xak = xab, xrb = xab, xrk = xab;
                bf16x8 pa[2], pr[2];
#pragma unroll
                for (int ks = 0; ks < 2; ++ks) {
                    const LAS unsigned char* rp = buf + c * CK_RP + (32 * ks + 4 * g) * 2;
                    pa[ks] = ck_ld2(rp + CK_ABAR, 32); pr[ks] = ck_ld2(rp + CK_RBAR, 32);
                    const bf16x8 pb = ck_ld2(rp + CK_BTIL, 32), pk = ck_ld2(rp + CK_KTIL, 32);
                    xab = CK_MFMA(pb, pa[ks], xab); xak = CK_MFMA(pk, pa[ks], xak); xrb = CK_MFMA(pb, pr[ks], xrb); xrk = CK_MFMA(pk, pr[ks], xrk);
                }
#pragma unroll
                for (int r = 0; r < 4; ++r) { const int s = 4 * g + r; if (!(s < c)) { xab[r] = 0.f; xak[r] = 0.f; } if (!(s <= c)) { xrb[r] = 0.f; xrk[r] = 0.f; } }
#pragma unroll
                for (int r = 0; r < 4; ++r) AabT[(4 * g + r) * 16 + c] = xab[r];
                const bf16x8 opak = ck_pk4(xak), oprb = ck_pk4(xrb), oprk = ck_pk4(xrk);
                bf16x8 oph[2];
#pragma unroll
                for (int ks = 0; ks < 2; ++ks) oph[ks] = __builtin_bit_cast(bf16x8, (u32x4){ck_cvt(H[2 * ks][0], H[2 * ks][1]), ck_cvt(H[2 * ks][2], H[2 * ks][3]), ck_cvt(H[2 * ks + 1][0], H[2 * ks + 1][1]), ck_cvt(H[2 * ks + 1][2], H[2 * ks + 1][3])});
                const bf16x8 opv = ck_ld1(buf + CK_VT + (wave * 16 + c) * CK_TP + g * 8);
                f32x4 rhs = (f32x4){0.f, 0.f, 0.f, 0.f};
                rhs = CK_MFMA(pa[0], oph[0], rhs); rhs = CK_MFMA(pa[1], oph[1], rhs); rhs = CK_MFMA(opak, opv, rhs);
                *(LAS f32x4*)(Xch + c * 16 + 4 * g) = rhs;
                asm volatile("s_waitcnt lgkmcnt(0)" ::: "memory");
                float u[16];
#pragma unroll
                for (int q = 0; q < 4; ++q) { const f32x4 x = *(const LAS f32x4*)(Xch + c * 16 + 4 * q); u[4 * q] = x[0]; u[4 * q + 1] = x[1]; u[4 * q + 2] = x[2]; u[4 * q + 3] = x[3]; }
                f32x4 cw[15][4];
#define CK_COLLD(ss) do { _Pragma("unroll") for (int q_ = ((ss) + 1) / 4; q_ < 4; ++q_) cw[(ss)][q_] = *(const LAS f32x4*)(AabT + (ss) * 16 + 4 * q_); } while (0)
                CK_COLLD(0); CK_COLLD(1);
#pragma unroll
                for (int s = 0; s < 15; ++s) {
                    if (s + 2 < 15) CK_COLLD(s + 2);
                    __builtin_amdgcn_sched_barrier(0);
#pragma unroll
                    for (int t = s + 1; t < 16; ++t) u[t] += cw[s][t >> 2][t & 3] * u[s];
                }
#undef CK_COLLD
                { u32x4 w0, w1; w0.x = ck_cvt(u[0], u[1]); w0.y = ck_cvt(u[2], u[3]); w0.z = ck_cvt(u[4], u[5]); w0.w = ck_cvt(u[6], u[7]);
                  w1.x = ck_cvt(u[8], u[9]); w1.y = ck_cvt(u[10], u[11]); w1.z = ck_cvt(u[12], u[13]); w1.w = ck_cvt(u[14], u[15]);
                  *(LAS u32x4*)(UT + c * 32) = w0; *(LAS u32x4*)(UT + c * 32 + 16) = w1; }
                asm volatile("s_waitcnt lgkmcnt(0)" ::: "memory");
                const bf16x8 opu = ck_ld1(UT + c * 32 + g * 8);
                f32x4 yy = (f32x4){0.f, 0.f, 0.f, 0.f};
                yy = CK_MFMA(pr[0], oph[0], yy); yy = CK_MFMA(pr[1], oph[1], yy); yy = CK_MFMA(oprb, opu, yy); yy = CK_MFMA(oprk, opv, yy);
                {
                    bf16_t* yp = Y + (rowbase + (size_t)cn * 16 + 4 * g) * D + h * 64 + half * 32 + wave * 16 + c;
#pragma unroll
                    for (int r = 0; r < 4; ++r) yp[(size_t)r * D] = (bf16_t)(ck_cvt(yy[r], 0.f) & 0xffffu);
                }
#pragma unroll
                for (int kt = 0; kt < 4; ++kt) {
                    const bf16x8 opb = ck_ld1(buf + CK_BT_T + (16 * kt + c) * CK_TP + g * 8), opk = ck_ld1(buf + CK_KT_T + (16 * kt + c) * CK_TP + g * 8);
                    f32x4 hh = H[kt];
                    hh = CK_MFMA(opb, opu, hh); hh = CK_MFMA(opk, opv, hh);
                    H[kt] = hh * *(const LAS f32x4*)(buf + CK_GAM + (16 * kt + 4 * g) * 4);
                }
            }
            __syncthreads();
        }
    }
#undef CK_LOAD
#undef CK_P1
}
#else
constexpr int TC = 32;
constexpr int SC_VEC = TC * 5 * 64 * 4;
constexpr int SC_VP = 36;
constexpr int SC_V = 32 * SC_VP * 4;
constexpr int SC_Y = TC * 32 * 4;
constexpr int SC_BUF = SC_VEC + SC_V + SC_Y;
__device__ __forceinline__ void scan_phase(LAS unsigned char* lds, const bf16_t* R, const bf16_t* Kb, const bf16_t* V, const bf16_t* WA, const float* k_k, const float* k_a, bf16_t* Y, int G, int bid, int tid) {
    const int wave = __builtin_amdgcn_readfirstlane(tid >> 6), lane = tid & 63, rg = lane >> 4, cc = lane & 15;
    const int pt = tid >> 4, pj = tid & 15;
    for (int unit = bid; unit < 256; unit += G) {
        const int b = unit >> 5, h = (unit >> 1) & 15, half = unit & 1;
        const size_t rowbase = (size_t)b * T;
        const f32x4 kkw = *(const f32x4*)(k_k + h * 64 + 4 * pj), kaw = *(const f32x4*)(k_a + h * 64 + 4 * pj);
        f32x2 S01 = (f32x2){0.f, 0.f}, S23 = (f32x2){0.f, 0.f};
        u32x2 rk, rr, ra, rl; unsigned rv;
#define SCAN_LOAD(cn) do { const size_t m_ = rowbase + (size_t)(cn) * TC + pt; \
            rk = *(const u32x2*)(Kb + m_ * D + h * 64 + 4 * pj); rr = *(const u32x2*)(R + m_ * D + h * 64 + 4 * pj); \
            rl = *(const u32x2*)(WA + m_ * 2048 + h * 64 + 4 * pj); ra = *(const u32x2*)(WA + m_ * 2048 + 1024 + h * 64 + 4 * pj); \
            rv = *(const unsigned*)(V + m_ * D + h * 64 + half * 32 + 2 * pj); } while (0)
        SCAN_LOAD(0);
        __syncthreads();
        for (int cn = 0; cn < T / TC; ++cn) {
            LAS unsigned char* buf = lds + (cn & 1) * SC_BUF;
            {
                const f32x4 kf = (f32x4){bflo(rk.x), bfhi(rk.x), bflo(rk.y), bfhi(rk.y)}, af = (f32x4){bflo(ra.x), bfhi(ra.x), bflo(ra.y), bfhi(ra.y)};
                const f32x4 lf = (f32x4){bflo(rl.x), bfhi(rl.x), bflo(rl.y), bfhi(rl.y)}, rf = (f32x4){bflo(rr.x), bfhi(rr.x), bflo(rr.y), bfhi(rr.y)};
                const f32x4 kv = kf * kkw;
                float ss = (kv.x * kv.x + kv.y * kv.y) + (kv.z * kv.z + kv.w * kv.w);
                ss = row16_sum(ss);
                const float invn = 1.0f / fmaxf(sqrtf(ss), 1e-12f);
                const f32x4 kk = kv * invn;
                const f32x4 kp = kf * (1.0f + (af - 1.0f) * kaw);
                f32x4 dd; dd.x = __expf(lf.x); dd.y = __expf(lf.y); dd.z = __expf(lf.z); dd.w = __expf(lf.w);
                LAS f32x4* vp = (LAS f32x4*)(buf + pt * 1280) + pj;
                vp[0] = -kk; vp[16] = dd; vp[32] = kk * af; vp[48] = kp; vp[64] = rf;
                LAS float* vv = (LAS float*)(buf + SC_VEC) + (2 * pj) * SC_VP + pt;
                vv[0] = bflo(rv); vv[SC_VP] = bfhi(rv);
            }
            if (cn + 1 < T / TC) SCAN_LOAD(cn + 1);
            __syncthreads();
            if (cn > 0) {
                const LAS float* yb = (const LAS float*)(lds + ((cn - 1) & 1) * SC_BUF + SC_VEC + SC_V + pt * 128) + 2 * pj;
                const size_t m_ = rowbase + (size_t)(cn - 1) * TC + pt;
                *(unsigned*)(Y + m_ * D + h * 64 + half * 32 + 2 * pj) = cvt_pk_bf16(yb[0], yb[1]);
            }
            const int rloc = wave * 4 + rg;
            LAS float* yrow = (LAS float*)(buf + SC_VEC + SC_V) + rloc;
            const unsigned va0 = (unsigned)(size_t)(buf + cc * 16), ra0 = (unsigned)(size_t)(buf + SC_VEC + rloc * SC_VP * 4);
#define SC_LD5(NK, DD, BE, KP, RF, AR, OFF) do { \
                asm volatile("ds_read_b128 %0, %1 offset:%2" : "=&v"(NK) : "v"(AR), "i"((OFF))); asm volatile("ds_read_b128 %0, %1 offset:%2" : "=&v"(DD) : "v"(AR), "i"((OFF) + 256)); \
                asm volatile("ds_read_b128 %0, %1 offset:%2" : "=&v"(BE) : "v"(AR), "i"((OFF) + 512)); asm volatile("ds_read_b128 %0, %1 offset:%2" : "=&v"(KP) : "v"(AR), "i"((OFF) + 768)); \
                asm volatile("ds_read_b128 %0, %1 offset:%2" : "=&v"(RF) : "v"(AR), "i"((OFF) + 1024)); } while (0)
            f32x4 nk, dd, be, kp, rf, nk1, dd1, be1, kp1, rf1, nk2, dd2, be2, kp2, rf2, vcur, vnxt;
            SC_LD5(nk, dd, be, kp, rf, va0, 0); SC_LD5(nk1, dd1, be1, kp1, rf1, va0, 1280);
            asm volatile("ds_read_b128 %0, %1" : "=&v"(vcur) : "v"(ra0));
            asm volatile("s_waitcnt lgkmcnt(0)" : "+v"(nk), "+v"(dd), "+v"(be), "+v"(kp), "+v"(rf), "+v"(nk1), "+v"(dd1), "+v"(be1), "+v"(kp1), "+v"(rf1), "+v"(vcur));
            vnxt = vcur;
            float sa;
            { f32x2 pa = S01 * (f32x2){nk.x, nk.y}; pa = S23 * (f32x2){nk.z, nk.w} + pa; sa = row16_sum(pa.x + pa.y); }
            float ykeep = 0.f;
#define SC_STEP(J, VSEL, LDV, VOFF, WAITN) do { \
                SC_LD5(nk2, dd2, be2, kp2, rf2, va8, ((J) + 2) * 1280); \
                if (LDV) asm volatile("ds_read_b128 %0, %1 offset:%2" : "=&v"(vnxt) : "v"(ra8), "i"((VOFF))); \
                asm volatile("s_waitcnt lgkmcnt(" #WAITN ")" : "+v"(nk1), "+v"(dd1), "+v"(be1), "+v"(kp1), "+v"(rf1)); \
                const float vv_ = (VSEL); \
                S01 = S01 * (f32x2){dd.x, dd.y} + (f32x2){be.x, be.y} * sa + (f32x2){kp.x, kp.y} * vv_; \
                S23 = S23 * (f32x2){dd.z, dd.w} + (f32x2){be.z, be.w} * sa + (f32x2){kp.z, kp.w} * vv_; \
                f32x2 pa_ = S01 * (f32x2){nk1.x, nk1.y}; pa_ = S23 * (f32x2){nk1.z, nk1.w} + pa_; \
                f32x2 py_ = S01 * (f32x2){rf.x, rf.y}; py_ = S23 * (f32x2){rf.z, rf.w} + py_; \
                float y_ = py_.x + py_.y, a2_ = pa_.x + pa_.y; \
                y_ = DPP_XADD(y_, 0xB1); a2_ = DPP_XADD(a2_, 0xB1); y_ = DPP_XADD(y_, 0x4E); a2_ = DPP_XADD(a2_, 0x4E); \
                y_ = DPP_XADD(y_, 0x141); a2_ = DPP_XADD(a2_, 0x141); y_ = DPP_XADD(y_, 0x140); a2_ = DPP_XADD(a2_, 0x140); \
                sa = a2_; \
                ykeep = __builtin_bit_cast(float, __builtin_amdgcn_update_dpp(__builtin_bit_cast(int, y_), __builtin_bit_cast(int, ykeep), 0x111, 0xF, 0xF, false));   \
                nk = nk1; dd = dd1; be = be1; kp = kp1; rf = rf1; nk1 = nk2; dd1 = dd2; be1 = be2; kp1 = kp2; rf1 = rf2; } while (0)
#pragma unroll 1
            for (int t8 = 0; t8 < TC; t8 += 8) {
                const unsigned va8 = va0 + (unsigned)t8 * 1280u, ra8 = ra0 + (unsigned)t8 * 4u;
                SC_STEP(0, vcur.x, 0, 0, 5); SC_STEP(1, vcur.y, 0, 0, 5); SC_STEP(2, vcur.z, 1, 16, 6); SC_STEP(3, vcur.w, 0, 0, 5);
                asm volatile("" : "+v"(vnxt)); vcur = vnxt;
                SC_STEP(4, vcur.x, 0, 0, 5); SC_STEP(5, vcur.y, 0, 0, 5); SC_STEP(6, vcur.z, 1, 32, 6); SC_STEP(7, vcur.w, 0, 0, 5);
                asm volatile("" : "+v"(vnxt)); vcur = vnxt;
                if (t8 & 8) yrow[(t8 + 7 - cc) * 32] = ykeep;
            }
            asm volatile("s_waitcnt lgkmcnt(0)" ::: "memory");
#undef SC_STEP
#undef SC_LD5
        }
        __syncthreads();
        {
            const int cn = T / TC;
            const LAS float* yb = (const LAS float*)(lds + ((cn - 1) & 1) * SC_BUF + SC_VEC + SC_V + pt * 128) + 2 * pj;
            const size_t m_ = rowbase + (size_t)(cn - 1) * TC + pt;
            *(unsigned*)(Y + m_ * D + h * 64 + half * 32 + 2 * pj) = cvt_pk_bf16(yb[0], yb[1]);
        }
        __syncthreads();
    }
#undef SCAN_LOAD
}
#endif
__device__ __forceinline__ void gn_phase(bf16_t* Y, const bf16_t* R, const bf16_t* Kb, const bf16_t* V, const bf16_t* Z, const bf16_t* WA, const float* k_a, const float* r_k, const float* gn_g, const float* gn_b, int G, int bid, int tid) {
    const int wave = __builtin_amdgcn_readfirstlane(tid >> 6), lane = tid & 63;
    const int gw = bid * NWAVES + wave, NGW = G * NWAVES;
    const int col = lane * 16;
    f32x4 kaq[4], rkq[4], ggq[4], gbq[4];
#pragma unroll
    for (int q = 0; q < 4; ++q) { kaq[q] = *(const f32x4*)(k_a + col + 4 * q); rkq[q] = *(const f32x4*)(r_k + col + 4 * q); ggq[q] = *(const f32x4*)(gn_g + col + 4 * q); gbq[q] = *(const f32x4*)(gn_b + col + 4 * q); }
    u32x4 ry_[2], rr_[2], rk_[2], rv_[2], rz_[2], ra_[2];
#define GN_LOAD(mm) do { const size_t off_ = (size_t)(mm) * D + col; _Pragma("unroll") for (int j = 0; j < 2; ++j) { ry_[j] = *(const u32x4*)(Y + off_ + 8 * j); rr_[j] = *(const u32x4*)(R + off_ + 8 * j); \
        rk_[j] = *(const u32x4*)(Kb + off_ + 8 * j); rv_[j] = *(const u32x4*)(V + off_ + 8 * j); rz_[j] = *(const u32x4*)(Z + off_ + 8 * j); ra_[j] = *(const u32x4*)(WA + (size_t)(mm) * 2048 + 1024 + col + 8 * j); } } while (0)
    if (gw < M) GN_LOAD(gw);
    for (int m = gw; m < M; m += NGW) {
        const size_t off = (size_t)m * D + col;
        f32x4 y[4], r[4], k[4], v[4], z[4], aa[4];
#pragma unroll
        for (int j = 0; j < 2; ++j) { unpack8(ry_[j], y[2 * j], y[2 * j + 1]); unpack8(rr_[j], r[2 * j], r[2 * j + 1]); unpack8(rk_[j], k[2 * j], k[2 * j + 1]);
            unpack8(rv_[j], v[2 * j], v[2 * j + 1]); unpack8(rz_[j], z[2 * j], z[2 * j + 1]); unpack8(ra_[j], aa[2 * j], aa[2 * j + 1]); }
        if (m + NGW < M) GN_LOAD(m + NGW);
        float s = 0.f, bs = 0.f;
#pragma unroll
        for (int q = 0; q < 4; ++q) {
            s += (y[q].x + y[q].y) + (y[q].z + y[q].w);
            const f32x4 kp = k[q] * (1.0f + (aa[q] - 1.0f) * kaq[q]);
            const f32x4 t = r[q] * kp * rkq[q];
            bs += (t.x + t.y) + (t.z + t.w);
        }
        s += __shfl_xor(s, 1); s += __shfl_xor(s, 2); bs += __shfl_xor(bs, 1); bs += __shfl_xor(bs, 2);
        const float mean = s * (1.0f / 64.0f);
        float q2 = 0.f;
#pragma unroll
        for (int q = 0; q < 4; ++q) { const f32x4 dlt = y[q] - mean; q2 += (dlt.x * dlt.x + dlt.y * dlt.y) + (dlt.z * dlt.z + dlt.w * dlt.w); }
        q2 += __shfl_xor(q2, 1); q2 += __shfl_xor(q2, 2);
        const float rstd = 1.0f / sqrtf(q2 * (1.0f / 64.0f) + 64e-5f);
        f32x4 o[4];
#pragma unroll
        for (int q = 0; q < 4; ++q) {
            const f32x4 yn = (y[q] - mean) * rstd * ggq[q] + gbq[q] + bs * v[q];
#pragma unroll
            for (int e = 0; e < 4; ++e) o[q][e] = yn[e] * z[q][e] * fsigmoid(z[q][e]);
        }
        *(u32x4*)(Y + off) = pack8(o[0], o[1]); *(u32x4*)(Y + off + 8) = pack8(o[2], o[3]);
    }
}
__device__ __forceinline__ void final_norm_phase(const bf16_t* H2, float* out, const float* g, int G, int bid, int tid) {
    const int wave = __builtin_amdgcn_readfirstlane(tid >> 6), lane = tid & 63;
    const int gw = bid * NWAVES + wave, NGW = G * NWAVES;
    f32x4 gv[4];
#pragma unroll
    for (int j = 0; j < 2; ++j) { gv[2 * j] = *(const f32x4*)(g + j * 512 + lane * 8); gv[2 * j + 1] = *(const f32x4*)(g + j * 512 + lane * 8 + 4); }
    u32x4 rh_[2];
    if (gw < M) { rh_[0] = *(const u32x4*)(H2 + (size_t)gw * D + lane * 8); rh_[1] = *(const u32x4*)(H2 + (size_t)gw * D + 512 + lane * 8); }
    for (int m = gw; m < M; m += NGW) {
        f32x4 v[4]; float s = 0.f;
        unpack8(rh_[0], v[0], v[1]); unpack8(rh_[1], v[2], v[3]);
        if (m + NGW < M) { rh_[0] = *(const u32x4*)(H2 + (size_t)(m + NGW) * D + lane * 8); rh_[1] = *(const u32x4*)(H2 + (size_t)(m + NGW) * D + 512 + lane * 8); }
#pragma unroll
        for (int q = 0; q < 4; ++q) s += (v[q].x * v[q].x + v[q].y * v[q].y) + (v[q].z * v[q].z + v[q].w * v[q].w);
        const float rstd = 1.0f / sqrtf(wave_sum(s) * (1.0f / D) + 1e-6f);
#pragma unroll
        for (int j = 0; j < 2; ++j) { float* o = out + (size_t)m * D + j * 512 + lane * 8; *(f32x4*)o = v[2 * j] * rstd * gv[2 * j]; *(f32x4*)(o + 4) = v[2 * j + 1] * rstd * gv[2 * j + 1]; }
    }
}
#ifndef MK_PER_PHASE
#define MK_PER_PHASE 0
#endif
constexpr int NPHASE = 15;
#ifndef MK_REP_PHASE
#define MK_REP_PHASE -1
#endif
#ifndef MK_REP_N
#define MK_REP_N 2
#endif
#define REPS(k) ((k) == MK_REP_PHASE ? MK_REP_N : 1)

__global__ void __launch_bounds__(NTHR, 2) hybrid_fwd(Args a) {
    extern __shared__ __attribute__((aligned(16))) unsigned char lds_raw[];
    LAS unsigned char* lds = (LAS unsigned char*)lds_raw;
    cg::grid_group grid = cg::this_grid();
    const int wave_s = __builtin_amdgcn_readfirstlane((int)threadIdx.x >> 6);
    const int bid = blockIdx.x, G = gridDim.x;
#define TID() int lane_v_; asm volatile("v_mbcnt_lo_u32_b32 %0, -1, 0\n\tv_mbcnt_hi_u32_b32 %0, -1, %0" : "=v"(lane_v_)); const int tid = wave_s * 64 + lane_v_
    { TID(); if (tid < 16) ((LAS unsigned*)(lds + LDS_BYTES - 64))[tid] = 0u; __syncthreads();
#if !MK_PER_PHASE
      kptr_t kpb = kargs(); (void)xcd_barrier_post((unsigned*)(kws(kpb) + WS_CTL), (volatile LAS unsigned*)(lds + LDS_BYTES - 64), tid);
#endif
    }
    int lo, hi; { kptr_t kp0 = kargs(); lo = *(const int __attribute__((address_space(4)))*)(kp0 + 8 * 26); hi = *(const int __attribute__((address_space(4)))*)(kp0 + 8 * 26 + 4); }
#ifndef PH_MASK
#define PH_MASK 0x7fff
#endif
#define IN(k) (((PH_MASK >> (k)) & 1) && lo <= (k) && (k) < hi)
#define SEAM(k) do { if (IN(k) && IN((k) + 1)) { if ((k) == 0) grid.sync(); else { TID(); kptr_t kpb = kargs(); XcdBarrier xb_; xb_.bar = (unsigned*)(kws(kpb) + WS_CTL); xb_.x = xb_xcc_id(); xb_.st = (volatile LAS unsigned*)(lds + LDS_BYTES - 64); xcd_barrier(xb_, tid); } } } while (0)
#define PTRS() kptr_t kp = kargs(); unsigned char* ws = kws(kp); (void)ws
#define S1 ((bf16_t*)(ws + WS_S1))
#define S2 ((bf16_t*)(ws + WS_S2))
#define S3 ((bf16_t*)(ws + WS_S3))
#define S4 ((bf16_t*)(ws + WS_S4))
#define QKVZ ((bf16_t*)(ws + WS_QKVZ))
#define XS0 ((bf16_t*)(ws + WS_XS0))
#define XS1 ((bf16_t*)(ws + WS_XS1))
#define WAb ((bf16_t*)(ws + WS_WA))
#define A2 ((bf16_t*)(ws + WS_A2))
#define Lb ((bf16_t*)(ws + WS_L))
#define Kr ((bf16_t*)kout(kp))
#define Vr ((bf16_t*)kout(kp) + (size_t)M * D)
#define WR ((const bf16_t*)(ws + WS_WR))

    if (IN(0)) for (int rep_ = 0; rep_ < REPS(0); ++rep_) { TID(); p0_prologue(lds, G, bid, tid); }
    SEAM(0);
    if (IN(1)) for (int rep_ = 0; rep_ < REPS(1); ++rep_) { TID(); PTRS();
        { pg8::Gemm g{S1, (const bf16_t*)(ws + WS_WQKVZ), M, ATT_IN, D}; pg8::StaticOrder S; S.init(M, ATT_IN, G, bid);
          pg8::EpiQKVZ E{QKVZ, (const float*)(ws + WS_BIAS), (const float*)(ws + WS_COS), (const float*)(ws + WS_SIN)};
          pg8::gemm_phase<pg8::EpiQKVZ, pg8::StaticOrder, true, true>(lds, g, S, E, tid); }
        __syncthreads();
        { pg8::Gemm g{(const bf16_t*)(ws + WS_PB0), (const bf16_t*)(ws + WS_WP0), M, D, PLE}; pg8::StaticOrder S; S.init(M, D, G, bid);
          pg8::EpiStore E{S2, D};
          pg8::gemm_phase<pg8::EpiStore, pg8::StaticOrder, true, true>(lds, g, S, E, tid); }
    }
    SEAM(1);
    if (IN(2)) for (int rep_ = 0; rep_ < REPS(2); ++rep_) { TID(); PTRS(); attn_phase(lds, QKVZ, kin(kp, I_ASINK), S1, G, bid, tid); }
    SEAM(2);
    if (IN(3)) for (int rep_ = 0; rep_ < REPS(3); ++rep_) { TID(); PTRS();
        pg8::Gemm g{S1, (const bf16_t*)(ws + WS_WO0), M, D, D}; pg8::StaticOrder S; S.init(M, D, G, bid);
        pg8::EpiRes<false> E{(const void*)kin(kp, I_X), S3};
        pg8::gemm_phase<pg8::EpiRes<false>, pg8::StaticOrder, true, true>(lds, g, S, E, tid);
    }
    SEAM(3);
    if (IN(4)) for (int rep_ = 0; rep_ < REPS(4); ++rep_) { TID(); PTRS();
        pg8::Gemm g{S3, (const bf16_t*)(ws + WS_WG0), M, D, D}; pg8::StaticOrder S; S.init(M, D, G, bid);
        pg8::EpiGate<false> E{S3, S2, (void*)S4};
        pg8::gemm_phase<pg8::EpiGate<false>, pg8::StaticOrder, true, true>(lds, g, S, E, tid);
    }
    SEAM(4);
    if (IN(5)) for (int rep_ = 0; rep_ < REPS(5); ++rep_) { TID(); PTRS(); lerp_phase<0>(S4, kin(kp, I_NORMG) + D, kin(kp, I_MU), S1, XS0, XS1, G, bid, tid); }
    SEAM(5);
    if (IN(6)) for (int rep_ = 0; rep_ < REPS(6); ++rep_) { TID(); PTRS();
        { pg8::Gemm g{XS0, WR, M, 2 * D, D, XS1, 4}; pg8::StaticOrder S; S.init(M, 2 * D, G, bid); pg8::EpiStore2 E{S3, Kr, 4, D};
          pg8::gemm_phase<pg8::EpiStore2, pg8::StaticOrder, true, true>(lds, g, S, E, tid); }
        __syncthreads();
        { pg8::Gemm g{S1, (const bf16_t*)(ws + WS_WL), M, 256, D}; pg8::StaticOrder S; S.init(M, 256, G, bid); pg8::EpiStore E{Lb, 256};
          pg8::gemm_phase<pg8::EpiStore, pg8::StaticOrder, true, true>(lds, g, S, E, tid); }
    }
    SEAM(6);
    if (IN(7)) for (int rep_ = 0; rep_ < REPS(7); ++rep_) { TID(); PTRS(); lerp_phase<1>(S4, kin(kp, I_NORMG) + D, kin(kp, I_MU), nullptr, XS0, XS1, G, bid, tid); lora_mid_phase(Lb, A2, G, bid, tid); }
    SEAM(7);
    if (IN(8)) for (int rep_ = 0; rep_ < REPS(8); ++rep_) { TID(); PTRS();
        { pg8::Gemm g{XS0, WR + (size_t)2 * D * D, M, 2 * D, D, XS1, 4}; pg8::StaticOrder S; S.init(M, 2 * D, G, bid); pg8::EpiStore2 E{Vr, S2, 4, D};
          pg8::gemm_phase<pg8::EpiStore2, pg8::StaticOrder, true, true>(lds, g, S, E, tid); }
    }
    SEAM(8);
    if (IN(9)) for (int rep_ = 0; rep_ < REPS(9); ++rep_) { TID(); PTRS();
        pg8::Gemm g{A2, (const bf16_t*)(ws + WS_W2), M, 2048, 128}; pg8::StaticOrder S; S.init(M, 2048, G, bid);
        pg8::EpiWA E{WAb, kin(kp, I_W0), kin(kp, I_A0)};
        pg8::gemm_phase<pg8::EpiWA, pg8::StaticOrder, true, true>(lds, g, S, E, tid);
    }
    SEAM(9);
    if (IN(10)) for (int rep_ = 0; rep_ < REPS(10); ++rep_) { TID(); PTRS(); scan_phase(lds, S3, Kr, Vr, WAb, kin(kp, I_KK), kin(kp, I_KA), S1, G, bid, tid); }
    SEAM(10);
    if (IN(11)) for (int rep_ = 0; rep_ < REPS(11); ++rep_) { TID(); PTRS(); gn_phase(S1, S3, Kr, Vr, S2, WAb, kin(kp, I_KA), kin(kp, I_RK), kin(kp, I_GNG), kin(kp, I_GNB), G, bid, tid); }
    SEAM(11);
    if (IN(12)) for (int rep_ = 0; rep_ < REPS(12); ++rep_) { TID(); PTRS();
        { pg8::Gemm g{S1, (const bf16_t*)(ws + WS_WO1), M, D, D}; pg8::StaticOrder S; S.init(M, D, G, bid); pg8::EpiRes<true> E{(const void*)S4, S3};
          pg8::gemm_phase<pg8::EpiRes<true>, pg8::StaticOrder, true, true>(lds, g, S, E, tid); }
        __syncthreads();
        { pg8::Gemm g{(const bf16_t*)(ws + WS_PB1), (const bf16_t*)(ws + WS_WP1), M, D, PLE}; pg8::StaticOrder S; S.init(M, D, G, bid); pg8::EpiStore E{S2, D};
          pg8::gemm_phase<pg8::EpiStore, pg8::StaticOrder, true, true>(lds, g, S, E, tid); }
    }
    SEAM(12);
    if (IN(13)) for (int rep_ = 0; rep_ < REPS(13); ++rep_) { TID(); PTRS();
        pg8::Gemm g{S3, (const bf16_t*)(ws + WS_WG1), M, D, D}; pg8::StaticOrder S; S.init(M, D, G, bid);
        pg8::EpiGate<false> E{S3, S2, (void*)S1};
        pg8::gemm_phase<pg8::EpiGate<false>, pg8::StaticOrder, true, true>(lds, g, S, E, tid);
    }
    SEAM(13);
    if (IN(14)) for (int rep_ = 0; rep_ < REPS(14); ++rep_) { TID(); PTRS(); final_norm_phase(S1, kout(kp), kin(kp, I_FNG), G, bid, tid); }
#undef IN
#undef SEAM
}

extern "C" void kernel_launch(void* const* d_in, const int* in_sizes, int n_in, void* d_out, int out_size, void* d_ws, size_t ws_size, hipStream_t stream) {
    static int grid = 0;
    if (grid == 0) {
        if (n_in != 24 || out_size != M * D || ws_size < WS_END) { fprintf(stderr, "kernel_launch: unexpected shapes (n_in %d, out %d, ws %zu)\n", n_in, out_size, ws_size); grid = -1; return; }
        int dev = 0, cus = 0, per_cu = 0;
        (void)hipGetDevice(&dev); (void)hipDeviceGetAttribute(&cus, hipDeviceAttributeMultiprocessorCount, dev);
        if (hipFuncSetAttribute((const void*)hybrid_fwd, hipFuncAttributeMaxDynamicSharedMemorySize, LDS_BYTES) != hipSuccess) { fprintf(stderr, "kernel_launch: hipFuncSetAttribute failed\n"); grid = -1; return; }
        if (hipOccupancyMaxActiveBlocksPerMultiprocessor(&per_cu, (const void*)hybrid_fwd, NTHR, LDS_BYTES) != hipSuccess || per_cu < 1) { fprintf(stderr, "kernel_launch: occupancy query reports %d\n", per_cu); per_cu = 1; }
        (void)hipGetLastError();
        grid = cus > 0 ? cus : 256;
    }
    if (grid < 0) return;
    Args a{};
    for (int i = 0; i < 24; ++i) a.in[i] = (const float*)d_in[i];
    a.out = (float*)d_out; a.ws = (unsigned char*)d_ws;
#if MK_PER_PHASE
    for (int ph = 0; ph < NPHASE; ++ph) { a.ph_lo = ph; a.ph_hi = ph + 1; hipLaunchKernelGGL(hybrid_fwd, dim3(grid), dim3(NTHR), LDS_BYTES, stream, a); }
#else
    a.ph_lo = 0; a.ph_hi = NPHASE;
    (void)hipMemsetAsync((unsigned char*)d_ws + WS_CTL, 0, 16384, stream);
    void* args[] = {&a};
    hipError_t e = hipLaunchCooperativeKernel((const void*)hybrid_fwd, dim3(grid), dim3(NTHR), args, LDS_BYTES, stream);
    if (e != hipSuccess) fprintf(stderr, "cooperative launch failed: %s (grid %d)\n", hipGetErrorString(e), grid);
#endif
}
```

```cpp
#include <hip/hip_runtime.h>
#include <hip/hip_cooperative_groups.h>
#include <cstdio>
#include <cstdint>
namespace cg = cooperative_groups;
namespace pg8 {
#define PG8_LAS __attribute__((address_space(3)))
typedef unsigned short bf16_t;
typedef short bf16x8 __attribute__((ext_vector_type(8)));
typedef float f32x4 __attribute__((ext_vector_type(4)));
typedef unsigned u32x4 __attribute__((ext_vector_type(4)));
constexpr int BM = 256, BK = 64, HALF = 128, HTB = HALF * BK * 2  , STAGE_BYTES = 8 * HTB, NXCD = 8, WGM = 8;

__host__ __device__ __forceinline__ int lds_byte(int r, int c) { const int st = (r >> 4) * 2 + (c >> 5), rr = r & 15, cc = c & 31, ob = rr * 64 + cc * 2; return st * 1024 + (ob ^ (((ob >> 9) & 1) << 5)); }
__host__ __device__ __forceinline__ void stage_rc(int b, int& R, int& C) { const int st = b / 1024, sb = b % 1024, swz = sb ^ (((sb >> 9) & 1) << 5); R = (st >> 1) * 16 + swz / 64; C = (st & 1) * 32 + (swz % 64) / 2; }
__host__ __device__ __forceinline__ int perm32(int rho) { const int n = rho >> 4, i = rho & 15; return 8 * (i >> 2) + 4 * n + (i & 3); }

struct Unit { int pm, pn; };
struct Gemm { const bf16_t* A; const bf16_t* Bt; int M, N, K; const bf16_t* A2 = nullptr; int nsplit = 1 << 30;
    __host__ __device__ __forceinline__ const bf16_t* asel(int pn) const { return pn < nsplit ? A : A2; } };

struct StaticOrder {
    int nM, nN, nwg, G, c;
    __host__ __device__ void init(int M, int N, int G_, int c_) { nM = M / BM; nN = N / BM; nwg = nM * nN; G = G_; c = c_; }
    __host__ __device__ bool next(int i, Unit& u) const {
        const long L = (long)i * G + c; if (L >= nwg) return false;
        int wgid = (int)L; { const int q = nwg / NXCD, r = nwg % NXCD, xcd = wgid % NXCD, off = wgid / NXCD; wgid = (xcd < r ? xcd * (q + 1) : r * (q + 1) + (xcd - r) * q) + off; }
        const int nig = WGM * nN, gid = wgid / nig, fm = gid * WGM, gsz = (nM - fm) < WGM ? (nM - fm) : WGM;
        u.pm = fm + ((wgid % nig) % gsz); u.pn = (wgid % nig) / gsz; return true;
    }
    __device__ __forceinline__ void a_ready(const Unit&) const {}
    __device__ __forceinline__ void done(const Unit&) const {}
};

__device__ __forceinline__ unsigned cvt_pk_bf16(float lo, float hi) { unsigned r; asm volatile("v_cvt_pk_bf16_f32 %0, %1, %2" : "=v"(r) : "v"(lo), "v"(hi)); return r; }
typedef float f32x2 __attribute__((ext_vector_type(2)));
__device__ __forceinline__ float bf2f(unsigned short b) { return __uint_as_float((unsigned)b << 16); }
__device__ __forceinline__ float bflo(unsigned w) { return __uint_as_float(w << 16); }
__device__ __forceinline__ float bfhi(unsigned w) { return __uint_as_float(w & 0xffff0000u); }
__device__ __forceinline__ float fsigmoid(float x) { return __builtin_amdgcn_rcpf(1.0f + __expf(-x)); }
__device__ __forceinline__ u32x4 pack8(const f32x4 a, const f32x4 b) { u32x4 w; w.x = cvt_pk_bf16(a[0], a[1]); w.y = cvt_pk_bf16(a[2], a[3]); w.z = cvt_pk_bf16(b[0], b[1]); w.w = cvt_pk_bf16(b[2], b[3]); return w; }
__device__ __forceinline__ void unpack8(const u32x4 w, f32x4& a, f32x4& b) { a = (f32x4){bflo(w.x), bfhi(w.x), bflo(w.y), bfhi(w.y)}; b = (f32x4){bflo(w.z), bfhi(w.z), bflo(w.w), bfhi(w.w)}; }

constexpr float QSCALE = 0.125f * 1.4426950408889634f;

struct EpiQKVZ {
    static constexpr bool PERM = true, AFTER_DRAIN = false;
    bf16_t* O; const float* bias; const float* cs; const float* sn;
    __device__ __forceinline__ void operator()(const f32x4 (&acc)[2][2][4][2], const Unit& u, int wr, int wc, int fr, int fq) const {
        const int row0 = u.pm * BM + wr * 64 + fr, col0 = u.pn * BM + wc * 32 + 8 * fq;
        const bool rope = u.pn < 5; const float sc = u.pn < 4 ? QSCALE : 1.0f;
        const int j4 = 4 * (4 * (wc & 1) + fq);
#pragma unroll
        for (int ai = 0; ai < 2; ++ai)
#pragma unroll
            for (int m = 0; m < 4; ++m) {
                const int row = row0 + ai * HALF + m * 16, pos = row & 4095;
                f32x4 c = (f32x4){1.f, 1.f, 1.f, 1.f}, s = (f32x4){0.f, 0.f, 0.f, 0.f};
                if (rope) { c = *(const f32x4*)(cs + pos * 32 + j4); s = *(const f32x4*)(sn + pos * 32 + j4); }
                bf16_t* rowp = O + (size_t)row * 2560 + col0;
#pragma unroll
                for (int bj = 0; bj < 2; ++bj) {
                    const f32x4 v0 = acc[ai][bj][m][0] + *(const f32x4*)(bias + col0 + bj * HALF), v1 = acc[ai][bj][m][1] + *(const f32x4*)(bias + col0 + bj * HALF + 4);
                    f32x4 o0 = v0, o1 = v1;
                    o0 = (v0 * c - v1 * s) * sc; o1 = (v1 * c + v0 * s) * sc;
                    *(u32x4*)(rowp + bj * HALF) = pack8(o0, o1);
                }
            }
    }
};
struct EpiStore {
    static constexpr bool PERM = true, AFTER_DRAIN = false;
    bf16_t* O; int ldc;
    __device__ __forceinline__ void operator()(const f32x4 (&acc)[2][2][4][2], const Unit& u, int wr, int wc, int fr, int fq) const {
        const int row0 = u.pm * BM + wr * 64 + fr, col0 = u.pn * BM + wc * 32 + 8 * fq;
#pragma unroll
        for (int ai = 0; ai < 2; ++ai)
#pragma unroll
            for (int m = 0; m < 4; ++m) { bf16_t* rowp = O + (size_t)(row0 + ai * HALF + m * 16) * ldc + col0;
#pragma unroll
                for (int bj = 0; bj < 2; ++bj) *(u32x4*)(rowp + bj * HALF) = pack8(acc[ai][bj][m][0], acc[ai][bj][m][1]); }
    }
};
struct EpiStore2 {
    static constexpr bool PERM = true, AFTER_DRAIN = false;
    bf16_t* O1; bf16_t* O2; int nsplit; int ldc;
    __device__ __forceinline__ void operator()(const f32x4 (&acc)[2][2][4][2], const Unit& u, int wr, int wc, int fr, int fq) const {
        const bool first = u.pn < nsplit; bf16_t* O = first ? O1 : O2;
        const int row0 = u.pm * BM + wr * 64 + fr, col0 = (first ? u.pn : u.pn - nsplit) * BM + wc * 32 + 8 * fq;
#pragma unroll
        for (int ai = 0; ai < 2; ++ai)
#pragma unroll
            for (int m = 0; m < 4; ++m) { bf16_t* rowp = O + (size_t)(row0 + ai * HALF + m * 16) * ldc + col0;
#pragma unroll
                for (int bj = 0; bj < 2; ++bj) *(u32x4*)(rowp + bj * HALF) = pack8(acc[ai][bj][m][0], acc[ai][bj][m][1]); }
    }
};
template <bool BF> struct EpiRes {
    static constexpr bool PERM = true, AFTER_DRAIN = false;
    const void* base; bf16_t* O;
    __device__ __forceinline__ void operator()(const f32x4 (&acc)[2][2][4][2], const Unit& u, int wr, int wc, int fr, int fq) const {
        const int row0 = u.pm * BM + wr * 64 + fr, col0 = u.pn * BM + wc * 32 + 8 * fq;
#pragma unroll
        for (int ai = 0; ai < 2; ++ai)
#pragma unroll
            for (int m = 0; m < 4; ++m) { const size_t off = (size_t)(row0 + ai * HALF + m * 16) * 1024 + col0;
#pragma unroll
                for (int bj = 0; bj < 2; ++bj) { f32x4 b0, b1;
                    if (BF) { unpack8(*(const u32x4*)((const bf16_t*)base + off + bj * HALF), b0, b1); }
                    else { b0 = *(const f32x4*)((const float*)base + off + bj * HALF); b1 = *(const f32x4*)((const float*)base + off + bj * HALF + 4); }
                    *(u32x4*)(O + off + bj * HALF) = pack8(b0 + acc[ai][bj][m][0], b1 + acc[ai][bj][m][1]); } }
    }
};
template <bool F32OUT> struct EpiGate {
    static constexpr bool PERM = true, AFTER_DRAIN = false;
    const bf16_t* hpre; const bf16_t* pp; void* O;
    __device__ __forceinline__ void operator()(const f32x4 (&acc)[2][2][4][2], const Unit& u, int wr, int wc, int fr, int fq) const {
        const int row0 = u.pm * BM + wr * 64 + fr, col0 = u.pn * BM + wc * 32 + 8 * fq;
#pragma unroll
        for (int ai = 0; ai < 2; ++ai)
#pragma unroll
            for (int m = 0; m < 4; ++m) { const size_t off = (size_t)(row0 + ai * HALF + m * 16) * 1024 + col0;
#pragma unroll
                for (int bj = 0; bj < 2; ++bj) { f32x4 h0, h1, p0, p1;
                    unpack8(*(const u32x4*)(hpre + off + bj * HALF), h0, h1); unpack8(*(const u32x4*)(pp + off + bj * HALF), p0, p1);
                    f32x4 g0, g1;
#pragma unroll
                    for (int e = 0; e < 4; ++e) { g0[e] = fsigmoid(acc[ai][bj][m][0][e]); g1[e] = fsigmoid(acc[ai][bj][m][1][e]); }
                    const f32x4 o0 = h0 + g0 * p0, o1 = h1 + g1 * p1;
                    if (F32OUT) { *(f32x4*)((float*)O + off + bj * HALF) = o0; *(f32x4*)((float*)O + off + bj * HALF + 4) = o1; }
                    else *(u32x4*)((bf16_t*)O + off + bj * HALF) = pack8(o0, o1); } }
    }
};
struct EpiWA {
    static constexpr bool PERM = true, AFTER_DRAIN = false;
    bf16_t* O; const float* w0; const float* a0;
    __device__ __forceinline__ void operator()(const f32x4 (&acc)[2][2][4][2], const Unit& u, int wr, int wc, int fr, int fq) const {
        const int row0 = u.pm * BM + wr * 64 + fr, col0 = u.pn * BM + wc * 32 + 8 * fq;
        const bool isw = u.pn < 4; const float* bvec = isw ? (w0 + col0) : (a0 + col0 - 1024); const float mul = isw ? -0.6065306597126334f : 1.0f;
#pragma unroll
        for (int ai = 0; ai < 2; ++ai)
#pragma unroll
            for (int m = 0; m < 4; ++m) { bf16_t* rowp = O + (size_t)(row0 + ai * HALF + m * 16) * 2048 + col0;
#pragma unroll
                for (int bj = 0; bj < 2; ++bj) { f32x4 o0, o1; const f32x4 b0 = *(const f32x4*)(bvec + bj * HALF), b1 = *(const f32x4*)(bvec + bj * HALF + 4);
#pragma unroll
                    for (int e = 0; e < 4; ++e) { o0[e] = mul * fsigmoid(acc[ai][bj][m][0][e] + b0[e]); o1[e] = mul * fsigmoid(acc[ai][bj][m][1][e] + b1[e]); }
                    *(u32x4*)(rowp + bj * HALF) = pack8(o0, o1); } }
    }
};
template <class Epi, class Sched, bool ALIGN_EPI = false, bool SP2 = false>
__device__ __forceinline__ void gemm_phase(PG8_LAS unsigned char* lds, const Gemm g, const Sched& S, const Epi& E, const int tid_in) {
    const int tid = tid_in, wid = __builtin_amdgcn_readfirstlane(tid >> 6), lane = tid & 63, wr = wid >> 2, wc = wid & 3, fr = lane & 15, fq = lane >> 4;
    const int K = g.K, nt = K / BK;
    unsigned voffA[2], voffB[2];
#pragma unroll
    for (int i = 0; i < 2; ++i) { int R, C; stage_rc(tid * 16 + i * 8192, R, C); const int Rb = Epi::PERM ? ((R & ~31) + perm32(R & 31)) : R;
        voffA[i] = (unsigned)(R * K + C) * 2u; voffB[i] = (unsigned)(Rb * K + C) * 2u; }
    const size_t kstep = (size_t)(BK * 2);
    const size_t hstep = (size_t)HALF * K * 2;
    const size_t tstep = 2 * hstep;
    const unsigned ldsw = (unsigned)wid * 1024u;
    const int aoff = lds_byte(wr * 64 + fr, fq * 8), boff = lds_byte(wc * 32 + fr, fq * 8);
#define PG8_SA(b, h) (((b) * 2 + (h)) * HTB)
#define PG8_SB(b, h) ((4 + (b) * 2 + (h)) * HTB)
#define PG8_STAGE(bufoff, gbase, voff) do { _Pragma("unroll") for (int _i = 0; _i < 2; ++_i) \
        __builtin_amdgcn_global_load_lds((const unsigned*)((const char*)(gbase) + (voff)[_i]), (PG8_LAS unsigned*)(lds + (bufoff) + ldsw + _i * 8192), 16, 0, 0); } while (0)
#define PG8_LDA(dst, b, h) do { _Pragma("unroll") for (int m = 0; m < 4; ++m) _Pragma("unroll") for (int k = 0; k < 2; ++k) dst[m][k] = *(const PG8_LAS bf16x8*)(lds + PG8_SA(b, h) + aoff + m * 2048 + k * 1024); } while (0)
#define PG8_LDB(dst, b, h) do { _Pragma("unroll") for (int n = 0; n < 2; ++n) _Pragma("unroll") for (int k = 0; k < 2; ++k) dst[n][k] = *(const PG8_LAS bf16x8*)(lds + PG8_SB(b, h) + boff + n * 2048 + k * 1024); } while (0)
#define PG8_MMA(ai, bj, At, Bt) do { __builtin_amdgcn_s_setprio(1); _Pragma("unroll") for (int m = 0; m < 4; ++m) _Pragma("unroll") for (int n = 0; n < 2; ++n) _Pragma("unroll") for (int k = 0; k < 2; ++k) \
        acc[ai][bj][m][n] = __builtin_amdgcn_mfma_f32_16x16x32_bf16(Bt[n][k], At[m][k], acc[ai][bj][m][n], 0, 0, 0); __builtin_amdgcn_s_setprio(0); } while (0)
#define PG8_WAIT_V(n) asm volatile("s_waitcnt vmcnt(" #n ")" ::: "memory")
#define PG8_WAIT_L(n) asm volatile("s_waitcnt lgkmcnt(" #n ")" ::: "memory")
#define PG8_BAR __builtin_amdgcn_s_barrier()
#define PG8_SCHED __builtin_amdgcn_sched_barrier(0)
    Unit cur, nxt; int ui = 0;
    if (!S.next(0, cur)) return;
    f32x4 acc[2][2][4][2];
#pragma unroll
    for (int a = 0; a < 2; ++a)
#pragma unroll
        for (int b = 0; b < 2; ++b)
#pragma unroll
            for (int m = 0; m < 4; ++m)
#pragma unroll
                for (int n = 0; n < 2; ++n) acc[a][b][m][n] = (f32x4){0.f, 0.f, 0.f, 0.f};
    bf16x8 At[4][2], B0[2][2], B1[2][2];
    const char* cA = (const char*)g.asel(cur.pn) + (size_t)cur.pm * tstep; const char* cB = (const char*)g.Bt + (size_t)cur.pn * tstep;
    S.a_ready(cur);
    if constexpr (SP2) {
        PG8_STAGE(PG8_SB(0, 0), cB, voffB); PG8_STAGE(PG8_SB(0, 1), cB + hstep, voffB); PG8_STAGE(PG8_SA(0, 0), cA, voffA); PG8_STAGE(PG8_SA(0, 1), cA + hstep, voffA);
        if (wr == 1) PG8_BAR;
        PG8_WAIT_V(2); PG8_BAR;
        PG8_STAGE(PG8_SB(1, 0), cB + kstep, voffB); PG8_STAGE(PG8_SA(1, 0), cA + kstep, voffA); PG8_STAGE(PG8_SB(1, 1), cB + hstep + kstep, voffB);
        PG8_WAIT_V(6); PG8_BAR;
    } else {
        PG8_STAGE(PG8_SB(0, 0), cB, voffB); PG8_STAGE(PG8_SA(0, 0), cA, voffA); PG8_STAGE(PG8_SB(0, 1), cB + hstep, voffB); PG8_STAGE(PG8_SA(0, 1), cA + hstep, voffA);
        if (wr == 1) PG8_BAR;
        PG8_WAIT_V(4); PG8_BAR;
        PG8_STAGE(PG8_SB(1, 0), cB + kstep, voffB); PG8_STAGE(PG8_SA(1, 0), cA + kstep, voffA); PG8_STAGE(PG8_SB(1, 1), cB + hstep + kstep, voffB);
        PG8_WAIT_V(6); PG8_BAR;
    }
    for (;;) {
        const bool has_next = S.next(ui + 1, nxt);
        const char* nA = has_next ? (const char*)g.asel(nxt.pn) + (size_t)nxt.pm * tstep : cA; const char* nB = has_next ? (const char*)g.Bt + (size_t)nxt.pn * tstep : cB;
        for (int t = 0; t < nt; t += 2) {
            const bool last = (t == nt - 2);
            const char* a1 = cA + (size_t)(t + 1) * kstep;
            const char* a2 = last ? nA : cA + (size_t)(t + 2) * kstep; const char* b2 = last ? nB : cB + (size_t)(t + 2) * kstep;
            const char* a3 = a2 + kstep; const char* b3 = b2 + kstep;
            if (last && has_next) S.a_ready(nxt);
            if constexpr (SP2) {
            PG8_LDB(B0, 0, 0); PG8_LDB(B1, 0, 1); PG8_SCHED; PG8_LDA(At, 0, 0); PG8_STAGE(PG8_SA(1, 1), a1 + hstep, voffA);
            PG8_WAIT_V(8); PG8_WAIT_L(0); PG8_BAR; PG8_MMA(0, 0, At, B0); PG8_MMA(0, 1, At, B1); PG8_BAR; PG8_SCHED;
            PG8_LDA(At, 0, 1); PG8_STAGE(PG8_SB(0, 0), b2, voffB); PG8_STAGE(PG8_SB(0, 1), b2 + hstep, voffB); PG8_STAGE(PG8_SA(0, 0), a2, voffA);
            PG8_WAIT_V(8); PG8_WAIT_L(0); PG8_BAR; PG8_MMA(1, 0, At, B0); PG8_MMA(1, 1, At, B1); PG8_BAR; PG8_SCHED;
            PG8_LDB(B0, 1, 0); PG8_LDB(B1, 1, 1); PG8_SCHED; PG8_LDA(At, 1, 0); PG8_STAGE(PG8_SA(0, 1), a2 + hstep, voffA);
            PG8_WAIT_V(8); PG8_WAIT_L(0); PG8_BAR; PG8_MMA(0, 0, At, B0); PG8_MMA(0, 1, At, B1); PG8_BAR; PG8_SCHED;
            PG8_LDA(At, 1, 1); PG8_STAGE(PG8_SB(1, 0), b3, voffB); PG8_STAGE(PG8_SB(1, 1), b3 + hstep, voffB); PG8_STAGE(PG8_SA(1, 0), a3, voffA);
            PG8_WAIT_V(8); PG8_WAIT_L(0); PG8_BAR; PG8_MMA(1, 0, At, B0); PG8_MMA(1, 1, At, B1); PG8_BAR; PG8_SCHED;
            } else {
            PG8_LDB(B0, 0, 0); PG8_SCHED; PG8_LDA(At, 0, 0); PG8_STAGE(PG8_SA(1, 1), a1 + hstep, voffA);
            PG8_WAIT_L(8); PG8_BAR; PG8_WAIT_L(0); PG8_MMA(0, 0, At, B0); PG8_BAR; PG8_SCHED;
            PG8_LDB(B1, 0, 1); PG8_STAGE(PG8_SB(0, 0), b2, voffB);
            PG8_BAR; PG8_WAIT_L(0); PG8_MMA(0, 1, At, B1); PG8_BAR;
            PG8_LDA(At, 0, 1); PG8_STAGE(PG8_SA(0, 0), a2, voffA);
            PG8_BAR; PG8_WAIT_L(0); PG8_MMA(1, 0, At, B0); PG8_BAR; PG8_SCHED;
            PG8_STAGE(PG8_SB(0, 1), b2 + hstep, voffB);
            PG8_WAIT_V(6); PG8_BAR; PG8_MMA(1, 1, At, B1); PG8_BAR;
            PG8_LDB(B0, 1, 0); PG8_SCHED; PG8_LDA(At, 1, 0); PG8_STAGE(PG8_SA(0, 1), a2 + hstep, voffA);
            PG8_WAIT_L(8); PG8_BAR; PG8_WAIT_L(0); PG8_MMA(0, 0, At, B0); PG8_BAR; PG8_SCHED;
            PG8_LDB(B1, 1, 1); PG8_STAGE(PG8_SB(1, 0), b3, voffB);
            PG8_BAR; PG8_WAIT_L(0); PG8_MMA(0, 1, At, B1); PG8_BAR;
            PG8_LDA(At, 1, 1); PG8_STAGE(PG8_SA(1, 0), a3, voffA);
            PG8_BAR; PG8_WAIT_L(0); PG8_MMA(1, 0, At, B0); PG8_BAR; PG8_SCHED;
            PG8_STAGE(PG8_SB(1, 1), b3 + hstep, voffB);
            PG8_WAIT_V(6); PG8_BAR; PG8_MMA(1, 1, At, B1); PG8_BAR;
            }
        }
        if constexpr (ALIGN_EPI) { if (wr == 0) PG8_BAR; }
        if constexpr (!Epi::AFTER_DRAIN) { E(acc, cur, wr, wc, fr, fq); S.done(cur); }
        if (!has_next) break;
#pragma unroll
        for (int a = 0; a < 2; ++a)
#pragma unroll
            for (int b = 0; b < 2; ++b)
#pragma unroll
                for (int m = 0; m < 4; ++m)
#pragma unroll
                    for (int n = 0; n < 2; ++n) acc[a][b][m][n] = (f32x4){0.f, 0.f, 0.f, 0.f};
        cur = nxt; cA = nA; cB = nB; ++ui;
        if constexpr (ALIGN_EPI) { if (wr == 1) PG8_BAR; }
    }
    PG8_WAIT_V(0);
    if constexpr (!ALIGN_EPI) { if (wr == 0) PG8_BAR; }
    PG8_BAR;
    if constexpr (Epi::AFTER_DRAIN) { E.fused(acc, cur, wr, wc, fr, fq, lds, wid, lane); S.done(cur); }
#undef PG8_SA
#undef PG8_SB
#undef PG8_STAGE
#undef PG8_LDA
#undef PG8_LDB
#undef PG8_MMA
#undef PG8_WAIT_V
#undef PG8_WAIT_L
#undef PG8_BAR
#undef PG8_SCHED
}
}
using pg8::bf16_t; using pg8::bf16x8; using pg8::f32x4; using pg8::u32x4; using pg8::cvt_pk_bf16; using pg8::bf2f; using pg8::bflo; using pg8::bfhi; using pg8::fsigmoid; using pg8::pack8; using pg8::unpack8;
#define LAS __attribute__((address_space(3)))
typedef unsigned u32x2 __attribute__((ext_vector_type(2)));
typedef float f32x2 __attribute__((ext_vector_type(2)));

constexpr int NB = 8, T = 4096, D = 1024, M = NB * T, PLE = 256, ATT_IN = 2560;
constexpr int NWAVES = 8, NTHR = 512;
constexpr int LDS_BYTES = 147456;

constexpr size_t MiB = 1u << 20;
constexpr size_t WS_WQKVZ = 0;
constexpr size_t WS_WO0   = 5 * MiB;
constexpr size_t WS_WG0   = 7 * MiB;
constexpr size_t WS_WG1   = 9 * MiB;
constexpr size_t WS_WO1   = 11 * MiB;
constexpr size_t WS_WR    = 13 * MiB;
constexpr size_t WS_WP0   = 21 * MiB;
constexpr size_t WS_WP1   = 21 * MiB + 512 * 1024;
constexpr size_t WS_WL    = 22 * MiB;
constexpr size_t WS_W2    = 22 * MiB + 512 * 1024;
constexpr size_t WS_COS   = 23 * MiB;
constexpr size_t WS_SIN   = 23 * MiB + 512 * 1024;
constexpr size_t WS_BIAS  = 24 * MiB;
constexpr size_t WS_CTL   = 25 * MiB;
constexpr size_t WS_PB0   = 32 * MiB;
constexpr size_t WS_L     = 32 * MiB;
constexpr size_t WS_PB1   = 48 * MiB;
constexpr size_t WS_S1    = 64 * MiB;
constexpr size_t WS_QKVZ  = 128 * MiB;
constexpr size_t WS_XS0   = 128 * MiB, WS_XS1 = 192 * MiB, WS_WA = 128 * MiB, WS_A2 = 256 * MiB;
constexpr size_t WS_S2    = 288 * MiB;
constexpr size_t WS_S3    = 352 * MiB;
constexpr size_t WS_S4    = 416 * MiB;
constexpr size_t WS_END   = 480 * MiB;

__device__ __forceinline__ float wave_sum(float v) {
#pragma unroll
    for (int o = 1; o < 64; o <<= 1) v += __shfl_xor(v, o);
    return v;
}
__device__ __forceinline__ float dpp_add(float x, const int ctrl_dummy) { return x; }
#define DPP_XADD(x, ctrl) ((x) + __builtin_bit_cast(float, __builtin_amdgcn_update_dpp(0, __builtin_bit_cast(int, (x)), (ctrl), 0xF, 0xF, true)))
__device__ __forceinline__ float row16_sum(float x) {
    x = DPP_XADD(x, 0xB1);
    x = DPP_XADD(x, 0x4E);
    x = DPP_XADD(x, 0x141);
    x = DPP_XADD(x, 0x140);
    return x;
}

__device__ __forceinline__ void grid_bar(unsigned* ctr, unsigned target, int tid) {
    asm volatile("s_waitcnt vmcnt(0)" ::: "memory");
    __syncthreads();
    if (tid == 0) {
        __builtin_amdgcn_fence(__ATOMIC_RELEASE, "agent");
        asm volatile("s_waitcnt vmcnt(0)" ::: "memory");
        __hip_atomic_fetch_add(ctr, 1u, __ATOMIC_RELAXED, __HIP_MEMORY_SCOPE_AGENT);
        while (__hip_atomic_load(ctr, __ATOMIC_RELAXED, __HIP_MEMORY_SCOPE_AGENT) < target) __builtin_amdgcn_s_sleep(2);
        __builtin_amdgcn_fence(__ATOMIC_ACQUIRE, "agent");
        asm volatile("s_waitcnt vmcnt(0)" ::: "memory");
    }
    __syncthreads();
}
#define XB_TMO      128
#define XB_XCNT(j)  (256  + 64 * (j))
#define XB_XSUB(j)  (1280 + 64 * (j))
#define XB_XGEN(j)  (2304 + 64 * (j))
#define XB_TOP      3328
#define XB_TOPGEN   3392
#define XCD_BAR_WORDS 3456
#define XB_SPIN_CAP (1u << 18)

__device__ __forceinline__ unsigned xb_ld(unsigned* p)              { return __hip_atomic_load(p, __ATOMIC_RELAXED, __HIP_MEMORY_SCOPE_AGENT); }
__device__ __forceinline__ unsigned xb_add(unsigned* p, unsigned v) { return __hip_atomic_fetch_add(p, v, __ATOMIC_RELAXED, __HIP_MEMORY_SCOPE_AGENT); }
__device__ __forceinline__ unsigned xb_xcc_id() { return (unsigned)__builtin_amdgcn_s_getreg((3 << 11) | 20) & 0xFu; }
#define XB_SPIN(cond, bar) do { unsigned _sp = 0; while (cond) { __builtin_amdgcn_s_sleep(1); \
    if ((++_sp & 255u) == 0u) { if (xb_ld(&(bar)[XB_TMO])) break; if (_sp > XB_SPIN_CAP) { atomicAdd(&(bar)[XB_TMO], 1u); break; } } } } while (0)

struct XcdBarrier {
    unsigned* bar; unsigned x;
    volatile LAS unsigned* st;
};

__device__ __forceinline__ XcdBarrier xcd_barrier_post(unsigned* bar, volatile LAS unsigned* st, const int tid_) {
    XcdBarrier b; b.bar = bar; b.x = xb_xcc_id(); b.st = st;
    if (tid_ == 0) (void)xb_add(&bar[XB_XCNT(b.x)], 1u);
    return b;
}
__device__ __forceinline__ void xcd_barrier_complete(unsigned* bar, unsigned x, unsigned& nloc, unsigned& nx) {
    const unsigned G = gridDim.x * gridDim.y * gridDim.z;
    unsigned sum, cnt, mine, sp = 0u;
    for (;;) {
        sum = 0u; cnt = 0u; mine = 0u;
#pragma unroll
        for (unsigned j = 0; j < 16; ++j) { const unsigned c = xb_ld(&bar[XB_XCNT(j)]); sum += c; cnt += (c > 0u) ? 1u : 0u; mine = (j == x) ? c : mine; }
        if (sum == G) break;
        __builtin_amdgcn_s_sleep(1);
        if ((++sp & 255u) == 0u) { if (xb_ld(&bar[XB_TMO])) break; if (sp > XB_SPIN_CAP) { atomicAdd(&bar[XB_TMO], 1u); break; } }
    }
    nloc = mine > 0u ? mine : 1u; nx = cnt > 0u ? cnt : 1u;
}

__device__ __forceinline__ void xcd_barrier(const XcdBarrier& b, const int tid_) {
    asm volatile("s_waitcnt vmcnt(0)" ::: "memory");
    __syncthreads();
    if (tid_ == 0) {
        unsigned* bar = b.bar;
        __builtin_amdgcn_s_waitcnt(0);
        unsigned nloc = b.st[0], nx = b.st[1];
        if (nloc == 0u) { xcd_barrier_complete(bar, b.x, nloc, nx); b.st[0] = nloc; b.st[1] = nx; }
        const unsigned old = xb_add(&bar[XB_XSUB(b.x)], 1u);
        const unsigned gen = old / nloc;
        if (old + 1u == (gen + 1u) * nloc) {
            __builtin_amdgcn_fence(__ATOMIC_RELEASE, "agent");
            asm volatile("s_waitcnt vmcnt(0)" ::: "memory");
            const unsigned og = xb_add(&bar[XB_TOP], 1u);
            const unsigned tg = og / nx;
            if (og + 1u == (tg + 1u) * nx) xb_add(&bar[XB_TOPGEN], 1u);
            else XB_SPIN(xb_ld(&bar[XB_TOPGEN]) == tg, bar);
            __builtin_amdgcn_fence(__ATOMIC_ACQUIRE, "agent");
            xb_add(&bar[XB_XGEN(b.x)], 1u);
            asm volatile("s_waitcnt vmcnt(0)" ::: "memory");
        } else {
            XB_SPIN(xb_ld(&bar[XB_XGEN(b.x)]) == gen, bar);
            __builtin_amdgcn_fence(__ATOMIC_ACQUIRE, "agent");
            asm volatile("s_waitcnt vmcnt(0)" ::: "memory");
        }
    }
    __syncthreads();
}

__device__ __forceinline__ int qk_perm_row(int n) {
    if (n >= 1280) return n;
    const int hd = n & ~63, d = n & 63, dd = d & 31;
    return hd + 8 * (dd >> 2) + 4 * (d >> 5) + (dd & 3);
}
template <int MODE>
__device__ __forceinline__ void transpose_item(const float* W, int K, int N, bf16_t* WT, int row_off, LAS float* scr, int item, int lane, const float* s) {
    const int nblk = N / 32, kb = item / nblk, nb = item % nblk, k0 = 64 * kb, n0 = 32 * nb;
#pragma unroll 8
    for (int i = 0; i < 32; ++i) { const int kk = 2 * i + (lane >> 5); float v = W[(size_t)(k0 + kk) * N + n0 + (lane & 31)];
        if (MODE == 2) v *= s[k0 + kk]; if (MODE == 3) v *= 1.0f - s[k0 + kk];
        scr[kk * 33 + (lane & 31)] = v; }
    asm volatile("s_waitcnt lgkmcnt(0)" ::: "memory");
    const int c = lane & 7;
#pragma unroll
    for (int j = 0; j < 4; ++j) { const int n = (lane >> 3) + 8 * j; const LAS float* sp = scr + (8 * c) * 33 + n;
        u32x4 o; o.x = cvt_pk_bf16(sp[0 * 33], sp[1 * 33]); o.y = cvt_pk_bf16(sp[2 * 33], sp[3 * 33]); o.z = cvt_pk_bf16(sp[4 * 33], sp[5 * 33]); o.w = cvt_pk_bf16(sp[6 * 33], sp[7 * 33]);
        const int dn = (MODE == 1) ? qk_perm_row(n0 + n) : (n0 + n);
        *(u32x4*)(WT + (size_t)(row_off + dn) * K + k0 + 8 * c) = o; }
    asm volatile("s_waitcnt lgkmcnt(0)" ::: "memory");
}

struct Args { const float* in[24]; float* out; unsigned char* ws; int ph_lo, ph_hi; };
typedef const __attribute__((address_space(4))) unsigned char* kptr_t;
__device__ __forceinline__ kptr_t kargs() { kptr_t p = (kptr_t)__builtin_amdgcn_kernarg_segment_ptr(); asm volatile("" : "+s"(p)); return p; }
#define GAS __attribute__((address_space(1)))
__device__ __forceinline__ const float* kin(kptr_t p, int i) { return (const float*)(const GAS float*)*(const unsigned long long __attribute__((address_space(4)))*)(p + 8 * i); }
__device__ __forceinline__ float* kout(kptr_t p) { return (float*)(GAS float*)*(const unsigned long long __attribute__((address_space(4)))*)(p + 8 * 24); }
__device__ __forceinline__ unsigned char* kws(kptr_t p) { return (unsigned char*)(GAS unsigned char*)*(const unsigned long long __attribute__((address_space(4)))*)(p + 8 * 25); }

enum { I_X = 0, I_P, I_NORMG, I_AWIN, I_ABIN, I_ASINK, I_AWOUT, I_MU, I_RWIN, I_W0, I_W1, I_W2, I_A0, I_A1, I_A2, I_KK, I_KA, I_RK, I_GNG, I_GNB, I_RWOUT, I_PWP, I_PWG, I_FNG };
__device__ __forceinline__ void p0_prologue(LAS unsigned char* lds, int G, int bid, int tid) {
    kptr_t kp = kargs();
    const int wave = __builtin_amdgcn_readfirstlane(tid >> 6), lane = tid & 63;
    LAS float* scr = (LAS float*)(lds + wave * 16384);
    const int gw = bid * NWAVES + wave, NGW = G * NWAVES;
    unsigned char* ws = kws(kp);
    const float* mu = kin(kp, I_MU);
    constexpr int N1 = 1280, N2 = 512, N5 = 2048, N6 = 128, N7 = 32;
    constexpr int NITEMS = N1 + 4 * N2 + N5 + 2 * N6 + 4 * N7;
    for (int it = gw; it < NITEMS; it += NGW) {
        int r = it;
        if (r < N1) { transpose_item<1>(kin(kp, I_AWIN), 1024, 2560, (bf16_t*)(ws + WS_WQKVZ), 0, scr, r, lane, nullptr); continue; } r -= N1;
        if (r < N2) { transpose_item<0>(kin(kp, I_AWOUT), 1024, 1024, (bf16_t*)(ws + WS_WO0), 0, scr, r, lane, nullptr); continue; } r -= N2;
        if (r < N2) { transpose_item<0>(kin(kp, I_PWG), 1024, 1024, (bf16_t*)(ws + WS_WG0), 0, scr, r, lane, nullptr); continue; } r -= N2;
        if (r < N2) { transpose_item<0>(kin(kp, I_PWG) + 1024 * 1024, 1024, 1024, (bf16_t*)(ws + WS_WG1), 0, scr, r, lane, nullptr); continue; } r -= N2;
        if (r < N2) { transpose_item<0>(kin(kp, I_RWOUT), 1024, 1024, (bf16_t*)(ws + WS_WO1), 0, scr, r, lane, nullptr); continue; } r -= N2;
        if (r < N5) { transpose_item<0>(kin(kp, I_RWIN), 1024, 4096, (bf16_t*)(ws + WS_WR), 0, scr, r, lane, nullptr); continue; } r -= N5;
        if (r < N6) { transpose_item<0>(kin(kp, I_PWP), 256, 1024, (bf16_t*)(ws + WS_WP0), 0, scr, r, lane, nullptr); continue; } r -= N6;
        if (r < N6) { transpose_item<0>(kin(kp, I_PWP) + 256 * 1024, 256, 1024, (bf16_t*)(ws + WS_WP1), 0, scr, r, lane, nullptr); continue; } r -= N6;
        if (r < N7) { transpose_item<3>(kin(kp, I_W1), 1024, 64, (bf16_t*)(ws + WS_WL), 0, scr, r, lane, mu + 4 * 1024); continue; } r -= N7;
        if (r < N7) { transpose_item<2>(kin(kp, I_W1), 1024, 64, (bf16_t*)(ws + WS_WL), 64, scr, r, lane, mu + 4 * 1024); continue; } r -= N7;
        if (r < N7) { transpose_item<3>(kin(kp, I_A1), 1024, 64, (bf16_t*)(ws + WS_WL), 128, scr, r, lane, mu + 5 * 1024); continue; } r -= N7;
        transpose_item<2>(kin(kp, I_A1), 1024, 64, (bf16_t*)(ws + WS_WL), 192, scr, r, lane, mu + 5 * 1024);
    }
    {
        const float* g0 = kin(kp, I_NORMG); bf16_t* XN = (bf16_t*)(ws + WS_S1);
        f32x4 gv[4];
#pragma unroll
        for (int j = 0; j < 4; ++j) gv[j] = *((const f32x4*)g0 + lane + 64 * j);
        const float* xin = kin(kp, I_X);
        f32x4 nx[4];
        if (gw < M) {
#pragma unroll
            for (int j = 0; j < 4; ++j) nx[j] = *((const f32x4*)(xin + (size_t)gw * D) + lane + 64 * j); }
        for (int m = gw; m < M; m += NGW) {
            f32x4 v[4]; float s = 0.f;
#pragma unroll
            for (int j = 0; j < 4; ++j) { v[j] = nx[j]; s += (v[j].x * v[j].x + v[j].y * v[j].y) + (v[j].z * v[j].z + v[j].w * v[j].w); }
            if (m + NGW < M) {
#pragma unroll
                for (int j = 0; j < 4; ++j) nx[j] = *((const f32x4*)(xin + (size_t)(m + NGW) * D) + lane + 64 * j); }
            const float rstd = 1.0f / sqrtf(wave_sum(s) * (1.0f / D) + 1e-6f);
            u32x2* o8 = (u32x2*)(XN + (size_t)m * D) + lane;
#pragma unroll
            for (int j = 0; j < 4; ++j) { const f32x4 o = v[j] * rstd * gv[j]; u32x2 w; w.x = cvt_pk_bf16(o.x, o.y); w.y = cvt_pk_bf16(o.z, o.w); o8[64 * j] = w; }
        }
    }
    const int gt = bid * NTHR + tid, NGT = G * NTHR;
    {
        const f32x4* p4 = (const f32x4*)kin(kp, I_P); u32x4* o = (u32x4*)(ws + WS_PB0);
        for (int i = gt; i < 2 * M * PLE / 8; i += NGT) { const f32x4 x0 = p4[2 * i], x1 = p4[2 * i + 1]; o[i] = pack8(x0, x1); }
    }
    {
        float* cs = (float*)(ws + WS_COS); float* sn = (float*)(ws + WS_SIN);
        for (int i = gt; i < T * 32; i += NGT) {
            const int pos = i >> 5, f = i & 31;
            const float inv = (float)exp2(-(double)f * (13.287712379549449 / 32.0));
            const float ang = (float)pos * inv;
            double rev = (double)ang * 0.15915494309189535; rev -= floor(rev);
            sn[i] = __builtin_amdgcn_sinf((float)rev); cs[i] = __builtin_amdgcn_cosf((float)rev);
        }
    }
    {
        float* bp = (float*)(ws + WS_BIAS);
        for (int i = gt; i < ATT_IN; i += NGT) bp[qk_perm_row(i)] = kin(kp, I_ABIN)[i];
    }
    {
        bf16_t* W2T = (bf16_t*)(ws + WS_W2); const float* w2 = kin(kp, I_W2); const float* a2 = kin(kp, I_A2);
        for (int i = gt; i < 2048 * 128; i += NGT) {
            const int k = i >> 11, nn = i & 2047;
            float v;
            if (nn < 1024) v = (k < 64) ? w2[k * 1024 + nn] : 0.f; else v = (k >= 64) ? a2[(k - 64) * 1024 + (nn - 1024)] : 0.f;
            W2T[(size_t)nn * 128 + k] = (bf16_t)(cvt_pk_bf16(v, 0.f) & 0xffffu);
        }
    }
}

__device__ __forceinline__ void attn_phase(LAS unsigned char* lds, const bf16_t* QKVZ, const float* sinks, bf16_t* OG, int G, int bid, int tid) {
    const int wave = __builtin_amdgcn_readfirstlane(tid >> 6), lane = tid & 63, fr = lane & 15, fq = lane >> 4;
    constexpr int KP = 144, VP = 528;
    LAS unsigned char* Kl = lds; LAS unsigned char* Vt = lds + 256 * KP;
    u32x4 pkv[4], pvv[4];
#define ATT_LOAD(uu) do { const int kvh_ = (uu) & 3, n_ = ((uu) >> 2) & 31, b_ = (uu) >> 7; _Pragma("unroll") for (int i = 0; i < 4; ++i) { \
        const int c_ = tid + 512 * i, key_ = c_ >> 3, ch_ = c_ & 7, t_ = 128 * (n_ - 1) + key_; \
        pkv[i] = (u32x4){0u, 0u, 0u, 0u}; pvv[i] = (u32x4){0u, 0u, 0u, 0u}; \
        if (t_ >= 0) { const bf16_t* rp_ = QKVZ + (size_t)(b_ * T + t_) * ATT_IN + kvh_ * 64 + ch_ * 8; pkv[i] = *(const u32x4*)(rp_ + 1024); pvv[i] = *(const u32x4*)(rp_ + 1280); } } } while (0)
    if (bid < 1024) ATT_LOAD(bid);
    for (int unit = bid; unit < 1024; unit += G) {
        const int kvh = unit & 3, n = (unit >> 2) & 31, b = unit >> 7;
        __syncthreads();
#pragma unroll
        for (int i = 0; i < 4; ++i) {
            const int c = tid + 512 * i, key = c >> 3, ch = c & 7;
            const u32x4 kv = pkv[i], vv = pvv[i];
            *(LAS u32x4*)(Kl + key * KP + ch * 16) = kv;
            LAS unsigned short* vp = (LAS unsigned short*)(Vt + (ch * 8) * VP + ((key ^ (ch << 2)) * 2));
            vp[0 * (VP / 2)] = (unsigned short)(vv.x & 0xffffu); vp[1 * (VP / 2)] = (unsigned short)(vv.x >> 16);
            vp[2 * (VP / 2)] = (unsigned short)(vv.y & 0xffffu); vp[3 * (VP / 2)] = (unsigned short)(vv.y >> 16);
            vp[4 * (VP / 2)] = (unsigned short)(vv.z & 0xffffu); vp[5 * (VP / 2)] = (unsigned short)(vv.z >> 16);
            vp[6 * (VP / 2)] = (unsigned short)(vv.w & 0xffffu); vp[7 * (VP / 2)] = (unsigned short)(vv.w >> 16);
        }
        if (unit + G < 1024) ATT_LOAD(unit + G);
        __syncthreads();
        const int g = wave >> 1, qh = wave & 1, h = kvh * 4 + g;
        const float sink2 = sinks[h] * 1.4426950408889634f;
        for (int mt = 0; mt < 4; ++mt) {
            const int qo0 = qh * 64 + mt * 16;
            const size_t row = (size_t)(b * T + n * 128 + qo0 + fr);
            const bf16_t* qp = QKVZ + row * ATT_IN + h * 64 + fq * 8;
            const bf16x8 q0 = *(const bf16x8*)qp, q1 = *(const bf16x8*)(qp + 32);
            const int kt0 = (qh * 4 + mt) < 6 ? (qh * 4 + mt) : 6;
            f32x4 s[10];
#pragma unroll
            for (int kt = 0; kt < 10; ++kt) {
                const LAS unsigned char* kp = Kl + ((kt0 + kt) * 16 + fr) * KP + fq * 16;
                const bf16x8 k0 = *(const LAS bf16x8*)kp, k1 = *(const LAS bf16x8*)(kp + 64);
                f32x4 acc = (f32x4){0.f, 0.f, 0.f, 0.f};
                acc = __builtin_amdgcn_mfma_f32_16x16x32_bf16(k0, q0, acc, 0, 0, 0);
                acc = __builtin_amdgcn_mfma_f32_16x16x32_bf16(k1, q1, acc, 0, 0, 0);
                s[kt] = acc;
            }
            const int qi = 128 + qo0 + fr;
            float mx = sink2;
#pragma unroll
            for (int kt = 0; kt < 10; ++kt)
#pragma unroll
                for (int r = 0; r < 4; ++r) { const int si = (kt0 + kt) * 16 + 4 * fq + r, df = qi - si; const bool ok = (df >= 0) && (df < 128) && (n > 0 || si >= 128);
                    const float v = ok ? s[kt][r] : -1e30f; s[kt][r] = v; mx = fmaxf(mx, v); }
            mx = fmaxf(mx, __shfl_xor(mx, 16)); mx = fmaxf(mx, __shfl_xor(mx, 32));
            float sum = 0.f;
#pragma unroll
            for (int kt = 0; kt < 10; ++kt)
#pragma unroll
                for (int r = 0; r < 4; ++r) { const float p = __builtin_amdgcn_exp2f(s[kt][r] - mx); s[kt][r] = p; sum += p; }
            sum += __shfl_xor(sum, 16); sum += __shfl_xor(sum, 32);
            sum += __builtin_amdgcn_exp2f(sink2 - mx);
            const float inv = 1.0f / sum;
            f32x4 o[4];
#pragma unroll
            for (int dt = 0; dt < 4; ++dt) o[dt] = (f32x4){0.f, 0.f, 0.f, 0.f};
#pragma unroll
            for (int kk = 0; kk < 5; ++kk) {
                const u32x4 pw = pack8(s[2 * kk], s[2 * kk + 1]);
                const bf16x8 pf = __builtin_bit_cast(bf16x8, pw);
#pragma unroll
                for (int dt = 0; dt < 4; ++dt) {
                    const int d = dt * 16 + fr, sw = ((d >> 3) & 7) << 2, keyA = 16 * (kt0 + 2 * kk) + 4 * fq, keyB = keyA + 16;
                    const u32x2 va = *(const LAS u32x2*)(Vt + d * VP + ((keyA ^ sw) * 2)), vb = *(const LAS u32x2*)(Vt + d * VP + ((keyB ^ sw) * 2));
                    const u32x4 vw = (u32x4){va.x, va.y, vb.x, vb.y};
                    o[dt] = __builtin_amdgcn_mfma_f32_16x16x32_bf16(__builtin_bit_cast(bf16x8, vw), pf, o[dt], 0, 0, 0);
                }
            }
            const bf16_t* zp = QKVZ + row * ATT_IN + 1536 + h * 64 + 4 * fq;
            bf16_t* op = OG + row * D + h * 64 + 4 * fq;
#pragma unroll
            for (int dt = 0; dt < 4; ++dt) {
                const u32x2 zw = *(const u32x2*)(zp + dt * 16);
                const float z0 = bflo(zw.x), z1 = bfhi(zw.x), z2 = bflo(zw.y), z3 = bfhi(zw.y);
                const float r0 = o[dt][0] * inv * z0 * fsigmoid(z0), r1 = o[dt][1] * inv * z1 * fsigmoid(z1), r2 = o[dt][2] * inv * z2 * fsigmoid(z2), r3 = o[dt][3] * inv * z3 * fsigmoid(z3);
                u32x2 w; w.x = cvt_pk_bf16(r0, r1); w.y = cvt_pk_bf16(r2, r3);
                *(u32x2*)(op + dt * 16) = w;
            }
        }
    }
}
template <int ROUND>
__device__ __forceinline__ void lerp_phase(const bf16_t* H1, const float* g1, const float* mu, bf16_t* HN, bf16_t* XS0, bf16_t* XS1, int G, int bid, int tid) {
    const int wave = __builtin_amdgcn_readfirstlane(tid >> 6), lane = tid & 63;
    const int gw = bid * NWAVES + wave, NGW = G * NWAVES;
    const float* mu0 = mu + (ROUND == 0 ? 0 : 2) * 1024; const float* mu1 = mu0 + 1024;
    f32x4 gq[4], m0q[4], m1q[4];
#pragma unroll
    for (int q = 0; q < 4; ++q) { const int col = (q >> 1) * 512 + lane * 8 + 4 * (q & 1); gq[q] = *(const f32x4*)(g1 + col); m0q[q] = *(const f32x4*)(mu0 + col); m1q[q] = *(const f32x4*)(mu1 + col); }
    u32x4 rc_[2], rp_[2];
#define LERP_LOAD(mm) do { const bool hp_ = ((mm) & (T - 1)) != 0; _Pragma("unroll") for (int j = 0; j < 2; ++j) { const size_t off_ = (size_t)(mm) * D + j * 512 + lane * 8; \
        rc_[j] = *(const u32x4*)(H1 + off_); rp_[j] = hp_ ? *(const u32x4*)(H1 + off_ - D) : (u32x4){0u, 0u, 0u, 0u}; } } while (0)
    if (gw < M) LERP_LOAD(gw);
    for (int m = gw; m < M; m += NGW) {
        f32x4 c[4], p[4];
        float sc = 0.f, sp = 0.f;
#pragma unroll
        for (int j = 0; j < 2; ++j) { unpack8(rc_[j], c[2 * j], c[2 * j + 1]); unpack8(rp_[j], p[2 * j], p[2 * j + 1]); }
        if (m + NGW < M) LERP_LOAD(m + NGW);
#pragma unroll
        for (int q = 0; q < 4; ++q) { sc += (c[q].x * c[q].x + c[q].y * c[q].y) + (c[q].z * c[q].z + c[q].w * c[q].w); sp += (p[q].x * p[q].x + p[q].y * p[q].y) + (p[q].z * p[q].z + p[q].w * p[q].w); }
        const float rc = 1.0f / sqrtf(wave_sum(sc) * (1.0f / D) + 1e-6f), rp = 1.0f / sqrtf(wave_sum(sp) * (1.0f / D) + 1e-6f);
#pragma unroll
        for (int j = 0; j < 2; ++j) {
            const int col = j * 512 + lane * 8; const size_t off = (size_t)m * D + col;
            f32x4 hn[2], xx[2], o0[2], o1[2];
#pragma unroll
            for (int e = 0; e < 2; ++e) {
                const f32x4 gv = gq[2 * j + e];
                hn[e] = c[2 * j + e] * rc * gv; xx[e] = p[2 * j + e] * rp * gv - hn[e];
                o0[e] = hn[e] + xx[e] * m0q[2 * j + e];
                o1[e] = hn[e] + xx[e] * m1q[2 * j + e];
            }
            if (ROUND == 0) *(u32x4*)(HN + off) = pack8(hn[0], hn[1]);
            *(u32x4*)(XS0 + off) = pack8(o0[0], o0[1]);
            *(u32x4*)(XS1 + off) = pack8(o1[0], o1[1]);
        }
    }
}
__device__ __forceinline__ void lora_mid_phase(const bf16_t* L, bf16_t* A2, int G, int bid, int tid) {
    const int gt = bid * NTHR + tid, NGT = G * NTHR;
    for (int i = gt; i < M * 16; i += NGT) {
        const int m = i >> 4, ch = i & 15, isA = ch >> 3, c8 = (ch & 7) * 8;
        const bool hasprev = (m & (T - 1)) != 0;
        f32x4 u0, u1, v0 = (f32x4){0.f, 0.f, 0.f, 0.f}, v1 = v0;
        unpack8(*(const u32x4*)(L + (size_t)m * 256 + isA * 128 + c8), u0, u1);
        if (hasprev) unpack8(*(const u32x4*)(L + (size_t)(m - 1) * 256 + isA * 128 + 64 + c8), v0, v1);
        u0 += v0; u1 += v1;
        if (!isA) {
#pragma unroll
            for (int e = 0; e < 4; ++e) { u0[e] = tanhf(u0[e]); u1[e] = tanhf(u1[e]); }
        }
        *(u32x4*)(A2 + (size_t)m * 128 + ch * 8) = pack8(u0, u1);
    }
}
#ifndef MK_SCAN_CHUNKED
#define MK_SCAN_CHUNKED 1
#endif
#if MK_SCAN_CHUNKED
typedef __bf16 ck_bf16x2_t __attribute__((ext_vector_type(2)));
__device__ __forceinline__ unsigned ck_cvt(float lo, float hi) { const f32x2 v = {lo, hi}; return __builtin_bit_cast(unsigned, __builtin_convertvector(v, ck_bf16x2_t)); }
constexpr int CK_RP = 144;
constexpr int CK_TP = 40;
constexpr int CK_ABAR = 0, CK_RBAR = 2304, CK_BTIL = 4608, CK_KTIL = 6912;
constexpr int CK_BT_T = 9216, CK_KT_T = 11776;
constexpr int CK_VT = 14336;
constexpr int CK_GAM = 15616;
constexpr int CK_BUF = 15872;
constexpr int CK_LD = 2 * CK_BUF;
constexpr int CK_PRIV = CK_LD + 2 * 4096;
constexpr int CK_PRIV_SZ = 2560;
__device__ __forceinline__ bf16x8 ck_ld2(const LAS unsigned char* p, int off2) {
    const u32x2 a = *(const LAS u32x2*)p, b = *(const LAS u32x2*)(p + off2); return __builtin_bit_cast(bf16x8, (u32x4){a.x, a.y, b.x, b.y}); }
__device__ __forceinline__ bf16x8 ck_ld1(const LAS unsigned char* p) {
    const u32x2 a = *(const LAS u32x2*)p; return __builtin_bit_cast(bf16x8, (u32x4){a.x, a.y, 0u, 0u}); }
__device__ __forceinline__ bf16x8 ck_pk4(const f32x4 x) { return __builtin_bit_cast(bf16x8, (u32x4){ck_cvt(x[0], x[1]), ck_cvt(x[2], x[3]), 0u, 0u}); }
#define CK_MFMA(a, b, c) __builtin_amdgcn_mfma_f32_16x16x32_bf16((a), (b), (c), 0, 0, 0)

__device__ __forceinline__ void scan_phase(LAS unsigned char* lds, const bf16_t* R, const bf16_t* Kb, const bf16_t* V, const bf16_t* WA, const float* k_k, const float* k_a, bf16_t* Y, int G, int bid, int tid) {
    const int wave = __builtin_amdgcn_readfirstlane(tid >> 6), lane = tid & 63, c = lane & 15, g = lane >> 4;
    const int pid = tid - 128, pt = (pid >> 4) & 15, pj = pid & 15;
    const bool producer = (wave >= 2) && (wave < 6), consumer = wave < 2;
    constexpr int NCH = T / 16;
    for (int unit = bid; unit < 256; unit += G) {
        const int b = unit >> 5, h = (unit >> 1) & 15, half = unit & 1;
        const size_t rowbase = (size_t)b * T;
        f32x4 kkw = (f32x4){0.f, 0.f, 0.f, 0.f}, kaw = kkw;
        if (producer) { kkw = *(const f32x4*)(k_k + h * 64 + 4 * pj); kaw = *(const f32x4*)(k_a + h * 64 + 4 * pj); }
        u32x2 rk = (u32x2){0u, 0u}, rr = rk, ra = rk, rl = rk; unsigned rv = 0u, vsave = 0u;
        f32x4 nkk = kkw, be = kkw, kp = kkw, rf = kkw, lf = kkw;
#define CK_LOAD(cn) do { const size_t m_ = rowbase + (size_t)(cn) * 16 + pt; \
            rk = *(const u32x2*)(Kb + m_ * D + h * 64 + 4 * pj); rr = *(const u32x2*)(R + m_ * D + h * 64 + 4 * pj); \
            rl = *(const u32x2*)(WA + m_ * 2048 + h * 64 + 4 * pj); ra = *(const u32x2*)(WA + m_ * 2048 + 1024 + h * 64 + 4 * pj); \
            rv = *(const unsigned*)(V + m_ * D + h * 64 + half * 32 + 2 * pj); } while (0)
#define CK_P1(cn) do { \
            const f32x4 kf_ = (f32x4){bflo(rk.x), bfhi(rk.x), bflo(rk.y), bfhi(rk.y)}, af_ = (f32x4){bflo(ra.x), bfhi(ra.x), bflo(ra.y), bfhi(ra.y)}; \
            lf = (f32x4){bflo(rl.x), bfhi(rl.x), bflo(rl.y), bfhi(rl.y)}; rf = (f32x4){bflo(rr.x), bfhi(rr.x), bflo(rr.y), bfhi(rr.y)}; \
            const f32x4 kv_ = kf_ * kkw; \
            float ss_ = (kv_.x * kv_.x + kv_.y * kv_.y) + (kv_.z * kv_.z + kv_.w * kv_.w); \
            ss_ = row16_sum(ss_); \
            const float invn_ = (ss_ > 1e-24f) ? __builtin_amdgcn_rsqf(ss_) : 1e12f;        \
            const f32x4 kk_ = kv_ * invn_; nkk = -kk_; be = kk_ * af_; \
            kp = kf_ * (1.0f + (af_ - 1.0f) * kaw); vsave = rv; \
            *(LAS f32x4*)(lds + CK_LD + ((cn) & 1) * 4096 + (pt * 64 + 4 * pj) * 4) = lf; } while (0)
        if (producer) { CK_LOAD(0); CK_P1(0); CK_LOAD(1); }
        f32x4 H[4];
#pragma unroll
        for (int kt = 0; kt < 4; ++kt) H[kt] = (f32x4){0.f, 0.f, 0.f, 0.f};
        __syncthreads();
        for (int it = 0; it <= NCH; ++it) {
            if (producer && it < NCH) {
                LAS unsigned char* buf = lds + (it & 1) * CK_BUF;
                const LAS unsigned char* ldp = lds + CK_LD + (it & 1) * 4096 + 16 * pj;
                f32x4 Gc = (f32x4){0.f, 0.f, 0.f, 0.f};
                const int w4 = 4 * (wave - 2);
#pragma unroll
                for (int s4 = 0; s4 < 16; s4 += 4) {
                    if (s4 <= w4) {
                        f32x4 x0 = *(const LAS f32x4*)(ldp + (s4 + 0) * 256), x1 = *(const LAS f32x4*)(ldp + (s4 + 1) * 256), x2 = *(const LAS f32x4*)(ldp + (s4 + 2) * 256), x3 = *(const LAS f32x4*)(ldp + (s4 + 3) * 256);
                        asm volatile("" : "+v"(x0), "+v"(x1), "+v"(x2), "+v"(x3));
                        if (s4 < w4) Gc += (x0 + x1) + (x2 + x3);
                        else { const f32x4 z4 = (f32x4){0.f, 0.f, 0.f, 0.f};
                            Gc += (s4 + 0 <= pt) ? x0 : z4; Gc += (s4 + 1 <= pt) ? x1 : z4; Gc += (s4 + 2 <= pt) ? x2 : z4; Gc += (s4 + 3 <= pt) ? x3 : z4; }
                    }
                }
                const f32x4 Gm = Gc - lf;
                f32x4 eA, eR, eN;
#pragma unroll
                for (int e = 0; e < 4; ++e) { eA[e] = __expf(Gm[e]); eR[e] = __expf(Gc[e]); eN[e] = __expf(-Gc[e]); }
                const f32x4 ab = nkk * eA, rb = rf * eR, bt = be * eN, kt_ = kp * eN;
                const unsigned ab0 = ck_cvt(ab.x, ab.y), ab1 = ck_cvt(ab.z, ab.w), rb0 = ck_cvt(rb.x, rb.y), rb1 = ck_cvt(rb.z, rb.w);
                const unsigned bt0 = ck_cvt(bt.x, bt.y), bt1 = ck_cvt(bt.z, bt.w), kt0 = ck_cvt(kt_.x, kt_.y), kt1 = ck_cvt(kt_.z, kt_.w);
                LAS unsigned char* rowp = buf + pt * CK_RP + pj * 8;
                *(LAS u32x2*)(rowp + CK_ABAR) = (u32x2){ab0, ab1}; *(LAS u32x2*)(rowp + CK_RBAR) = (u32x2){rb0, rb1};
                *(LAS u32x2*)(rowp + CK_BTIL) = (u32x2){bt0, bt1}; *(LAS u32x2*)(rowp + CK_KTIL) = (u32x2){kt0, kt1};
                LAS unsigned short* btT = (LAS unsigned short*)(buf + CK_BT_T + (4 * pj) * CK_TP + pt * 2);
                LAS unsigned short* ktT = (LAS unsigned short*)(buf + CK_KT_T + (4 * pj) * CK_TP + pt * 2);
                constexpr int TS = CK_TP / 2;
                btT[0] = (unsigned short)(bt0 & 0xffffu); btT[TS] = (unsigned short)(bt0 >> 16); btT[2 * TS] = (unsigned short)(bt1 & 0xffffu); btT[3 * TS] = (unsigned short)(bt1 >> 16);
                ktT[0] = (unsigned short)(kt0 & 0xffffu); ktT[TS] = (unsigned short)(kt0 >> 16); ktT[2 * TS] = (unsigned short)(kt1 & 0xffffu); ktT[3 * TS] = (unsigned short)(kt1 >> 16);
                LAS unsigned short* vT = (LAS unsigned short*)(buf + CK_VT + (2 * pj) * CK_TP + pt * 2);
                vT[0] = (unsigned short)(vsave & 0xffffu); vT[TS] = (unsigned short)(vsave >> 16);
                if (pt == 15) *(LAS f32x4*)(buf + CK_GAM + 16 * pj) = eR;
                if (it + 1 < NCH) { CK_P1(it + 1); if (it + 2 < NCH) CK_LOAD(it + 2); }
            }
            if (consumer && it > 0) {
                const int cn = it - 1;
                const LAS unsigned char* buf = lds + (cn & 1) * CK_BUF;
                LAS unsigned char* priv = lds + CK_PRIV + wave * CK_PRIV_SZ;
                LAS float* AabT = (LAS float*)priv; LAS float* Xch = (LAS float*)(priv + 1024); LAS unsigned char* UT = priv + 2048;
                f32x4 xab = (f32x4){0.f, 0.f, 0.f, 0.f}, xak = xab, xrb = xab, xrk = xab;
                bf16x8 pa[2], pr[2];
#pragma unroll
                for (int ks = 0; ks < 2; ++ks) {
                    const LAS unsigned char* rp = buf + c * CK_RP + (32 * ks + 4 * g) * 2;
                    pa[ks] = ck_ld2(rp + CK_ABAR, 32); pr[ks] = ck_ld2(rp + CK_RBAR, 32);
                    const bf16x8 pb = ck_ld2(rp + CK_BTIL, 32), pk = ck_ld2(rp + CK_KTIL, 32);
                    xab = CK_MFMA(pb, pa[ks], xab); xak = CK_MFMA(pk, pa[ks], xak); xrb = CK_MFMA(pb, pr[ks], xrb); xrk = CK_MFMA(pk, pr[ks], xrk);
                }
#pragma unroll
                for (int r = 0; r < 4; ++r) { const int s = 4 * g + r; if (!(s < c)) { xab[r] = 0.f; xak[r] = 0.f; } if (!(s <= c)) { xrb[r] = 0.f; xrk[r] = 0.f; } }
#pragma unroll
                for (int r = 0; r < 4; ++r) AabT[(4 * g + r) * 16 + c] = xab[r];
                const bf16x8 opak = ck_pk4(xak), oprb = ck_pk4(xrb), oprk = ck_pk4(xrk);
                bf16x8 oph[2];
#pragma unroll
                for (int ks = 0; ks < 2; ++ks) oph[ks] = __builtin_bit_cast(bf16x8, (u32x4){ck_cvt(H[2 * ks][0], H[2 * ks][1]), ck_cvt(H[2 * ks][2], H[2 * ks][3]), ck_cvt(H[2 * ks + 1][0], H[2 * ks + 1][1]), ck_cvt(H[2 * ks + 1][2], H[2 * ks + 1][3])});
                const bf16x8 opv = ck_ld1(buf + CK_VT + (wave * 16 + c) * CK_TP + g * 8);
                f32x4 rhs = (f32x4){0.f, 0.f, 0.f, 0.f};
                rhs = CK_MFMA(pa[0], oph[0], rhs); rhs = CK_MFMA(pa[1], oph[1], rhs); rhs = CK_MFMA(opak, opv, rhs);
                *(LAS f32x4*)(Xch + c * 16 + 4 * g) = rhs;
                asm volatile("s_waitcnt lgkmcnt(0)" ::: "memory");
                float u[16];
#pragma unroll
                for (int q = 0; q < 4; ++q) { const f32x4 x = *(const LAS f32x4*)(Xch + c * 16 + 4 * q); u[4 * q] = x[0]; u[4 * q + 1] = x[1]; u[4 * q + 2] = x[2]; u[4 * q + 3] = x[3]; }
                f32x4 cw[15][4];
#define CK_COLLD(ss) do { _Pragma("unroll") for (int q_ = ((ss) + 1) / 4; q_ < 4; ++q_) cw[(ss)][q_] = *(const LAS f32x4*)(AabT + (ss) * 16 + 4 * q_); } while (0)
                CK_COLLD(0); CK_COLLD(1);
#pragma unroll
                for (int s = 0; s < 15; ++s) {
                    if (s + 2 < 15) CK_COLLD(s + 2);
                    __builtin_amdgcn_sched_barrier(0);
#pragma unroll
                    for (int t = s + 1; t < 16; ++t) u[t] += cw[s][t >> 2][t & 3] * u[s];
                }
#undef CK_COLLD
                { u32x4 w0, w1; w0.x = ck_cvt(u[0], u[1]); w0.y = ck_cvt(u[2], u[3]); w0.z = ck_cvt(u[4], u[5]); w0.w = ck_cvt(u[6], u[7]);
                  w1.x = ck_cvt(u[8], u[9]); w1.y = ck_cvt(u[10], u[11]); w1.z = ck_cvt(u[12], u[13]); w1.w = ck_cvt(u[14], u[15]);
                  *(LAS u32x4*)(UT + c * 32) = w0; *(LAS u32x4*)(UT + c * 32 + 16) = w1; }
                asm volatile("s_waitcnt lgkmcnt(0)" ::: "memory");
                const bf16x8 opu = ck_ld1(UT + c * 32 + g * 8);
                f32x4 yy = (f32x4){0.f, 0.f, 0.f, 0.f};
                yy = CK_MFMA(pr[0], oph[0], yy); yy = CK_MFMA(pr[1], oph[1], yy); yy = CK_MFMA(oprb, opu, yy); yy = CK_MFMA(oprk, opv, yy);
                {
                    bf16_t* yp = Y + (rowbase + (size_t)cn * 16 + 4 * g) * D + h * 64 + half * 32 + wave * 16 + c;
#pragma unroll
                    for (int r = 0; r < 4; ++r) yp[(size_t)r * D] = (bf16_t)(ck_cvt(yy[r], 0.f) & 0xffffu);
                }
#pragma unroll
                for (int kt = 0; kt < 4; ++kt) {
                    const bf16x8 opb = ck_ld1(buf + CK_BT_T + (16 * kt + c) * CK_TP + g * 8), opk = ck_ld1(buf + CK_KT_T + (16 * kt + c) * CK_TP + g * 8);
                    f32x4 hh = H[kt];
                    hh = CK_MFMA(opb, opu, hh); hh = CK_MFMA(opk, opv, hh);
                    H[kt] = hh * *(const LAS f32x4*)(buf + CK_GAM + (16 * kt + 4 * g) * 4);
                }
            }
            __syncthreads();
        }
    }
#undef CK_LOAD
#undef CK_P1
}
#else
constexpr int TC = 32;
constexpr int SC_VEC = TC * 5 * 64 * 4;
constexpr int SC_VP = 36;
constexpr int SC_V = 32 * SC_VP * 4;
constexpr int SC_Y = TC * 32 * 4;
constexpr int SC_BUF = SC_VEC + SC_V + SC_Y;
__device__ __forceinline__ void scan_phase(LAS unsigned char* lds, const bf16_t* R, const bf16_t* Kb, const bf16_t* V, const bf16_t* WA, const float* k_k, const float* k_a, bf16_t* Y, int G, int bid, int tid) {
    const int wave = __builtin_amdgcn_readfirstlane(tid >> 6), lane = tid & 63, rg = lane >> 4, cc = lane & 15;
    const int pt = tid >> 4, pj = tid & 15;
    for (int unit = bid; unit < 256; unit += G) {
        const int b = unit >> 5, h = (unit >> 1) & 15, half = unit & 1;
        const size_t rowbase = (size_t)b * T;
        const f32x4 kkw = *(const f32x4*)(k_k + h * 64 + 4 * pj), kaw = *(const f32x4*)(k_a + h * 64 + 4 * pj);
        f32x2 S01 = (f32x2){0.f, 0.f}, S23 = (f32x2){0.f, 0.f};
        u32x2 rk, rr, ra, rl; unsigned rv;
#define SCAN_LOAD(cn) do { const size_t m_ = rowbase + (size_t)(cn) * TC + pt; \
            rk = *(const u32x2*)(Kb + m_ * D + h * 64 + 4 * pj); rr = *(const u32x2*)(R + m_ * D + h * 64 + 4 * pj); \
            rl = *(const u32x2*)(WA + m_ * 2048 + h * 64 + 4 * pj); ra = *(const u32x2*)(WA + m_ * 2048 + 1024 + h * 64 + 4 * pj); \
            rv = *(const unsigned*)(V + m_ * D + h * 64 + half * 32 + 2 * pj); } while (0)
        SCAN_LOAD(0);
        __syncthreads();
        for (int cn = 0; cn < T / TC; ++cn) {
            LAS unsigned char* buf = lds + (cn & 1) * SC_BUF;
            {
                const f32x4 kf = (f32x4){bflo(rk.x), bfhi(rk.x), bflo(rk.y), bfhi(rk.y)}, af = (f32x4){bflo(ra.x), bfhi(ra.x), bflo(ra.y), bfhi(ra.y)};
                const f32x4 lf = (f32x4){bflo(rl.x), bfhi(rl.x), bflo(rl.y), bfhi(rl.y)}, rf = (f32x4){bflo(rr.x), bfhi(rr.x), bflo(rr.y), bfhi(rr.y)};
                const f32x4 kv = kf * kkw;
                float ss = (kv.x * kv.x + kv.y * kv.y) + (kv.z * kv.z + kv.w * kv.w);
                ss = row16_sum(ss);
                const float invn = 1.0f / fmaxf(sqrtf(ss), 1e-12f);
                const f32x4 kk = kv * invn;
                const f32x4 kp = kf * (1.0f + (af - 1.0f) * kaw);
                f32x4 dd; dd.x = __expf(lf.x); dd.y = __expf(lf.y); dd.z = __expf(lf.z); dd.w = __expf(lf.w);
                LAS f32x4* vp = (LAS f32x4*)(buf + pt * 1280) + pj;
                vp[0] = -kk; vp[16] = dd; vp[32] = kk * af; vp[48] = kp; vp[64] = rf;
                LAS float* vv = (LAS float*)(buf + SC_VEC) + (2 * pj) * SC_VP + pt;
                vv[0] = bflo(rv); vv[SC_VP] = bfhi(rv);
            }
            if (cn + 1 < T / TC) SCAN_LOAD(cn + 1);
            __syncthreads();
            if (cn > 0) {
                const LAS float* yb = (const LAS float*)(lds + ((cn - 1) & 1) * SC_BUF + SC_VEC + SC_V + pt * 128) + 2 * pj;
                const size_t m_ = rowbase + (size_t)(cn - 1) * TC + pt;
                *(unsigned*)(Y + m_ * D + h * 64 + half * 32 + 2 * pj) = cvt_pk_bf16(yb[0], yb[1]);
            }
            const int rloc = wave * 4 + rg;
            LAS float* yrow = (LAS float*)(buf + SC_VEC + SC_V) + rloc;
            const unsigned va0 = (unsigned)(size_t)(buf + cc * 16), ra0 = (unsigned)(size_t)(buf + SC_VEC + rloc * SC_VP * 4);
#define SC_LD5(NK, DD, BE, KP, RF, AR, OFF) do { \
                asm volatile("ds_read_b128 %0, %1 offset:%2" : "=&v"(NK) : "v"(AR), "i"((OFF))); asm volatile("ds_read_b128 %0, %1 offset:%2" : "=&v"(DD) : "v"(AR), "i"((OFF) + 256)); \
                asm volatile("ds_read_b128 %0, %1 offset:%2" : "=&v"(BE) : "v"(AR), "i"((OFF) + 512)); asm volatile("ds_read_b128 %0, %1 offset:%2" : "=&v"(KP) : "v"(AR), "i"((OFF) + 768)); \
                asm volatile("ds_read_b128 %0, %1 offset:%2" : "=&v"(RF) : "v"(AR), "i"((OFF) + 1024)); } while (0)
            f32x4 nk, dd, be, kp, rf, nk1, dd1, be1, kp1, rf1, nk2, dd2, be2, kp2, rf2, vcur, vnxt;
            SC_LD5(nk, dd, be, kp, rf, va0, 0); SC_LD5(nk1, dd1, be1, kp1, rf1, va0, 1280);
            asm volatile("ds_read_b128 %0, %1" : "=&v"(vcur) : "v"(ra0));
            asm volatile("s_waitcnt lgkmcnt(0)" : "+v"(nk), "+v"(dd), "+v"(be), "+v"(kp), "+v"(rf), "+v"(nk1), "+v"(dd1), "+v"(be1), "+v"(kp1), "+v"(rf1), "+v"(vcur));
            vnxt = vcur;
            float sa;
            { f32x2 pa = S01 * (f32x2){nk.x, nk.y}; pa = S23 * (f32x2){nk.z, nk.w} + pa; sa = row16_sum(pa.x + pa.y); }
            float ykeep = 0.f;
#define SC_STEP(J, VSEL, LDV, VOFF, WAITN) do { \
                SC_LD5(nk2, dd2, be2, kp2, rf2, va8, ((J) + 2) * 1280); \
                if (LDV) asm volatile("ds_read_b128 %0, %1 offset:%2" : "=&v"(vnxt) : "v"(ra8), "i"((VOFF))); \
                asm volatile("s_waitcnt lgkmcnt(" #WAITN ")" : "+v"(nk1), "+v"(dd1), "+v"(be1), "+v"(kp1), "+v"(rf1)); \
                const float vv_ = (VSEL); \
                S01 = S01 * (f32x2){dd.x, dd.y} + (f32x2){be.x, be.y} * sa + (f32x2){kp.x, kp.y} * vv_; \
                S23 = S23 * (f32x2){dd.z, dd.w} + (f32x2){be.z, be.w} * sa + (f32x2){kp.z, kp.w} * vv_; \
                f32x2 pa_ = S01 * (f32x2){nk1.x, nk1.y}; pa_ = S23 * (f32x2){nk1.z, nk1.w} + pa_; \
                f32x2 py_ = S01 * (f32x2){rf.x, rf.y}; py_ = S23 * (f32x2){rf.z, rf.w} + py_; \
                float y_ = py_.x + py_.y, a2_ = pa_.x + pa_.y; \
                y_ = DPP_XADD(y_, 0xB1); a2_ = DPP_XADD(a2_, 0xB1); y_ = DPP_XADD(y_, 0x4E); a2_ = DPP_XADD(a2_, 0x4E); \
                y_ = DPP_XADD(y_, 0x141); a2_ = DPP_XADD(a2_, 0x141); y_ = DPP_XADD(y_, 0x140); a2_ = DPP_XADD(a2_, 0x140); \
                sa = a2_; \
                ykeep = __builtin_bit_cast(float, __builtin_amdgcn_update_dpp(__builtin_bit_cast(int, y_), __builtin_bit_cast(int, ykeep), 0x111, 0xF, 0xF, false));   \
                nk = nk1; dd = dd1; be = be1; kp = kp1; rf = rf1; nk1 = nk2; dd1 = dd2; be1 = be2; kp1 = kp2; rf1 = rf2; } while (0)
#pragma unroll 1
            for (int t8 = 0; t8 < TC; t8 += 8) {
                const unsigned va8 = va0 + (unsigned)t8 * 1280u, ra8 = ra0 + (unsigned)t8 * 4u;
                SC_STEP(0, vcur.x, 0, 0, 5); SC_STEP(1, vcur.y, 0, 0, 5); SC_STEP(2, vcur.z, 1, 16, 6); SC_STEP(3, vcur.w, 0, 0, 5);
                asm volatile("" : "+v"(vnxt)); vcur = vnxt;
                SC_STEP(4, vcur.x, 0, 0, 5); SC_STEP(5, vcur.y, 0, 0, 5); SC_STEP(6, vcur.z, 1, 32, 6); SC_STEP(7, vcur.w, 0, 0, 5);
                asm volatile("" : "+v"(vnxt)); vcur = vnxt;
                if (t8 & 8) yrow[(t8 + 7 - cc) * 32] = ykeep;
            }
            asm volatile("s_waitcnt lgkmcnt(0)" ::: "memory");
#undef SC_STEP
#undef SC_LD5
        }
        __syncthreads();
        {
            const int cn = T / TC;
            const LAS float* yb = (const LAS float*)(lds + ((cn - 1) & 1) * SC_BUF + SC_VEC + SC_V + pt * 128) + 2 * pj;
            const size_t m_ = rowbase + (size_t)(cn - 1) * TC + pt;
            *(unsigned*)(Y + m_ * D + h * 64 + half * 32 + 2 * pj) = cvt_pk_bf16(yb[0], yb[1]);
        }
        __syncthreads();
    }
#undef SCAN_LOAD
}
#endif
__device__ __forceinline__ void gn_phase(bf16_t* Y, const bf16_t* R, const bf16_t* Kb, const bf16_t* V, const bf16_t* Z, const bf16_t* WA, const float* k_a, const float* r_k, const float* gn_g, const float* gn_b, int G, int bid, int tid) {
    const int wave = __builtin_amdgcn_readfirstlane(tid >> 6), lane = tid & 63;
    const int gw = bid * NWAVES + wave, NGW = G * NWAVES;
    const int col = lane * 16;
    f32x4 kaq[4], rkq[4], ggq[4], gbq[4];
#pragma unroll
    for (int q = 0; q < 4; ++q) { kaq[q] = *(const f32x4*)(k_a + col + 4 * q); rkq[q] = *(const f32x4*)(r_k + col + 4 * q); ggq[q] = *(const f32x4*)(gn_g + col + 4 * q); gbq[q] = *(const f32x4*)(gn_b + col + 4 * q); }
    u32x4 ry_[2], rr_[2], rk_[2], rv_[2], rz_[2], ra_[2];
#define GN_LOAD(mm) do { const size_t off_ = (size_t)(mm) * D + col; _Pragma("unroll") for (int j = 0; j < 2; ++j) { ry_[j] = *(const u32x4*)(Y + off_ + 8 * j); rr_[j] = *(const u32x4*)(R + off_ + 8 * j); \
        rk_[j] = *(const u32x4*)(Kb + off_ + 8 * j); rv_[j] = *(const u32x4*)(V + off_ + 8 * j); rz_[j] = *(const u32x4*)(Z + off_ + 8 * j); ra_[j] = *(const u32x4*)(WA + (size_t)(mm) * 2048 + 1024 + col + 8 * j); } } while (0)
    if (gw < M) GN_LOAD(gw);
    for (int m = gw; m < M; m += NGW) {
        const size_t off = (size_t)m * D + col;
        f32x4 y[4], r[4], k[4], v[4], z[4], aa[4];
#pragma unroll
        for (int j = 0; j < 2; ++j) { unpack8(ry_[j], y[2 * j], y[2 * j + 1]); unpack8(rr_[j], r[2 * j], r[2 * j + 1]); unpack8(rk_[j], k[2 * j], k[2 * j + 1]);
            unpack8(rv_[j], v[2 * j], v[2 * j + 1]); unpack8(rz_[j], z[2 * j], z[2 * j + 1]); unpack8(ra_[j], aa[2 * j], aa[2 * j + 1]); }
        if (m + NGW < M) GN_LOAD(m + NGW);
        float s = 0.f, bs = 0.f;
#pragma unroll
        for (int q = 0; q < 4; ++q) {
            s += (y[q].x + y[q].y) + (y[q].z + y[q].w);
            const f32x4 kp = k[q] * (1.0f + (aa[q] - 1.0f) * kaq[q]);
            const f32x4 t = r[q] * kp * rkq[q];
            bs += (t.x + t.y) + (t.z + t.w);
        }
        s += __shfl_xor(s, 1); s += __shfl_xor(s, 2); bs += __shfl_xor(bs, 1); bs += __shfl_xor(bs, 2);
        const float mean = s * (1.0f / 64.0f);
        float q2 = 0.f;
#pragma unroll
        for (int q = 0; q < 4; ++q) { const f32x4 dlt = y[q] - mean; q2 += (dlt.x * dlt.x + dlt.y * dlt.y) + (dlt.z * dlt.z + dlt.w * dlt.w); }
        q2 += __shfl_xor(q2, 1); q2 += __shfl_xor(q2, 2);
        const float rstd = 1.0f / sqrtf(q2 * (1.0f / 64.0f) + 64e-5f);
        f32x4 o[4];
#pragma unroll
        for (int q = 0; q < 4; ++q) {
            const f32x4 yn = (y[q] - mean) * rstd * ggq[q] + gbq[q] + bs * v[q];
#pragma unroll
            for (int e = 0; e < 4; ++e) o[q][e] = yn[e] * z[q][e] * fsigmoid(z[q][e]);
        }
        *(u32x4*)(Y + off) = pack8(o[0], o[1]); *(u32x4*)(Y + off + 8) = pack8(o[2], o[3]);
    }
}
__device__ __forceinline__ void final_norm_phase(const bf16_t* H2, float* out, const float* g, int G, int bid, int tid) {
    const int wave = __builtin_amdgcn_readfirstlane(tid >> 6), lane = tid & 63;
    const int gw = bid * NWAVES + wave, NGW = G * NWAVES;
    f32x4 gv[4];
#pragma unroll
    for (int j = 0; j < 2; ++j) { gv[2 * j] = *(const f32x4*)(g + j * 512 + lane * 8); gv[2 * j + 1] = *(const f32x4*)(g + j * 512 + lane * 8 + 4); }
    u32x4 rh_[2];
    if (gw < M) { rh_[0] = *(const u32x4*)(H2 + (size_t)gw * D + lane * 8); rh_[1] = *(const u32x4*)(H2 + (size_t)gw * D + 512 + lane * 8); }
    for (int m = gw; m < M; m += NGW) {
        f32x4 v[4]; float s = 0.f;
        unpack8(rh_[0], v[0], v[1]); unpack8(rh_[1], v[2], v[3]);
        if (m + NGW < M) { rh_[0] = *(const u32x4*)(H2 + (size_t)(m + NGW) * D + lane * 8); rh_[1] = *(const u32x4*)(H2 + (size_t)(m + NGW) * D + 512 + lane * 8); }
#pragma unroll
        for (int q = 0; q < 4; ++q) s += (v[q].x * v[q].x + v[q].y * v[q].y) + (v[q].z * v[q].z + v[q].w * v[q].w);
        const float rstd = 1.0f / sqrtf(wave_sum(s) * (1.0f / D) + 1e-6f);
#pragma unroll
        for (int j = 0; j < 2; ++j) { float* o = out + (size_t)m * D + j * 512 + lane * 8; *(f32x4*)o = v[2 * j] * rstd * gv[2 * j]; *(f32x4*)(o + 4) = v[2 * j + 1] * rstd * gv[2 * j + 1]; }
    }
}
#ifndef MK_PER_PHASE
#define MK_PER_PHASE 0
#endif
constexpr int NPHASE = 15;
#ifndef MK_REP_PHASE
#define MK_REP_PHASE -1
#endif
#ifndef MK_REP_N
#define MK_REP_N 2
#endif
#define REPS(k) ((k) == MK_REP_PHASE ? MK_REP_N : 1)

__global__ void __launch_bounds__(NTHR, 2) hybrid_fwd(Args a) {
    extern __shared__ __attribute__((aligned(16))) unsigned char lds_raw[];
    LAS unsigned char* lds = (LAS unsigned char*)lds_raw;
    cg::grid_group grid = cg::this_grid();
    const int wave_s = __builtin_amdgcn_readfirstlane((int)threadIdx.x >> 6);
    const int bid = blockIdx.x, G = gridDim.x;
#define TID() int lane_v_; asm volatile("v_mbcnt_lo_u32_b32 %0, -1, 0\n\tv_mbcnt_hi_u32_b32 %0, -1, %0" : "=v"(lane_v_)); const int tid = wave_s * 64 + lane_v_
    { TID(); if (tid < 16) ((LAS unsigned*)(lds + LDS_BYTES - 64))[tid] = 0u; __syncthreads();
#if !MK_PER_PHASE
      kptr_t kpb = kargs(); (void)xcd_barrier_post((unsigned*)(kws(kpb) + WS_CTL), (volatile LAS unsigned*)(lds + LDS_BYTES - 64), tid);
#endif
    }
    int lo, hi; { kptr_t kp0 = kargs(); lo = *(const int __attribute__((address_space(4)))*)(kp0 + 8 * 26); hi = *(const int __attribute__((address_space(4)))*)(kp0 + 8 * 26 + 4); }
#ifndef PH_MASK
#define PH_MASK 0x7fff
#endif
#define IN(k) (((PH_MASK >> (k)) & 1) && lo <= (k) && (k) < hi)
#define SEAM(k) do { if (IN(k) && IN((k) + 1)) { if ((k) == 0) grid.sync(); else { TID(); kptr_t kpb = kargs(); XcdBarrier xb_; xb_.bar = (unsigned*)(kws(kpb) + WS_CTL); xb_.x = xb_xcc_id(); xb_.st = (volatile LAS unsigned*)(lds + LDS_BYTES - 64); xcd_barrier(xb_, tid); } } } while (0)
#define PTRS() kptr_t kp = kargs(); unsigned char* ws = kws(kp); (void)ws
#define S1 ((bf16_t*)(ws + WS_S1))
#define S2 ((bf16_t*)(ws + WS_S2))
#define S3 ((bf16_t*)(ws + WS_S3))
#define S4 ((bf16_t*)(ws + WS_S4))
#define QKVZ ((bf16_t*)(ws + WS_QKVZ))
#define XS0 ((bf16_t*)(ws + WS_XS0))
#define XS1 ((bf16_t*)(ws + WS_XS1))
#define WAb ((bf16_t*)(ws + WS_WA))
#define A2 ((bf16_t*)(ws + WS_A2))
#define Lb ((bf16_t*)(ws + WS_L))
#define Kr ((bf16_t*)kout(kp))
#define Vr ((bf16_t*)kout(kp) + (size_t)M * D)
#define WR ((const bf16_t*)(ws + WS_WR))

    if (IN(0)) for (int rep_ = 0; rep_ < REPS(0); ++rep_) { TID(); p0_prologue(lds, G, bid, tid); }
    SEAM(0);
    if (IN(1)) for (int rep_ = 0; rep_ < REPS(1); ++rep_) { TID(); PTRS();
        { pg8::Gemm g{S1, (const bf16_t*)(ws + WS_WQKVZ), M, ATT_IN, D}; pg8::StaticOrder S; S.init(M, ATT_IN, G, bid);
          pg8::EpiQKVZ E{QKVZ, (const float*)(ws + WS_BIAS), (const float*)(ws + WS_COS), (const float*)(ws + WS_SIN)};
          pg8::gemm_phase<pg8::EpiQKVZ, pg8::StaticOrder, true, true>(lds, g, S, E, tid); }
        __syncthreads();
        { pg8::Gemm g{(const bf16_t*)(ws + WS_PB0), (const bf16_t*)(ws + WS_WP0), M, D, PLE}; pg8::StaticOrder S; S.init(M, D, G, bid);
          pg8::EpiStore E{S2, D};
          pg8::gemm_phase<pg8::EpiStore, pg8::StaticOrder, true, true>(lds, g, S, E, tid); }
    }
    SEAM(1);
    if (IN(2)) for (int rep_ = 0; rep_ < REPS(2); ++rep_) { TID(); PTRS(); attn_phase(lds, QKVZ, kin(kp, I_ASINK), S1, G, bid, tid); }
    SEAM(2);
    if (IN(3)) for (int rep_ = 0; rep_ < REPS(3); ++rep_) { TID(); PTRS();
        pg8::Gemm g{S1, (const bf16_t*)(ws + WS_WO0), M, D, D}; pg8::StaticOrder S; S.init(M, D, G, bid);
        pg8::EpiRes<false> E{(const void*)kin(kp, I_X), S3};
        pg8::gemm_phase<pg8::EpiRes<false>, pg8::StaticOrder, true, true>(lds, g, S, E, tid);
    }
    SEAM(3);
    if (IN(4)) for (int rep_ = 0; rep_ < REPS(4); ++rep_) { TID(); PTRS();
        pg8::Gemm g{S3, (const bf16_t*)(ws + WS_WG0), M, D, D}; pg8::StaticOrder S; S.init(M, D, G, bid);
        pg8::EpiGate<false> E{S3, S2, (void*)S4};
        pg8::gemm_phase<pg8::EpiGate<false>, pg8::StaticOrder, true, true>(lds, g, S, E, tid);
    }
    SEAM(4);
    if (IN(5)) for (int rep_ = 0; rep_ < REPS(5); ++rep_) { TID(); PTRS(); lerp_phase<0>(S4, kin(kp, I_NORMG) + D, kin(kp, I_MU), S1, XS0, XS1, G, bid, tid); }
    SEAM(5);
    if (IN(6)) for (int rep_ = 0; rep_ < REPS(6); ++rep_) { TID(); PTRS();
        { pg8::Gemm g{XS0, WR, M, 2 * D, D, XS1, 4}; pg8::StaticOrder S; S.init(M, 2 * D, G, bid); pg8::EpiStore2 E{S3, Kr, 4, D};
          pg8::gemm_phase<pg8::EpiStore2, pg8::StaticOrder, true, true>(lds, g, S, E, tid); }
        __syncthreads();
        { pg8::Gemm g{S1, (const bf16_t*)(ws + WS_WL), M, 256, D}; pg8::StaticOrder S; S.init(M, 256, G, bid); pg8::EpiStore E{Lb, 256};
          pg8::gemm_phase<pg8::EpiStore, pg8::StaticOrder, true, true>(lds, g, S, E, tid); }
    }
    SEAM(6);
    if (IN(7)) for (int rep_ = 0; rep_ < REPS(7); ++rep_) { TID(); PTRS(); lerp_phase<1>(S4, kin(kp, I_NORMG) + D, kin(kp, I_MU), nullptr, XS0, XS1, G, bid, tid); lora_mid_phase(Lb, A2, G, bid, tid); }
    SEAM(7);
    if (IN(8)) for (int rep_ = 0; rep_ < REPS(8); ++rep_) { TID(); PTRS();
        { pg8::Gemm g{XS0, WR + (size_t)2 * D * D, M, 2 * D, D, XS1, 4}; pg8::StaticOrder S; S.init(M, 2 * D, G, bid); pg8::EpiStore2 E{Vr, S2, 4, D};
          pg8::gemm_phase<pg8::EpiStore2, pg8::StaticOrder, true, true>(lds, g, S, E, tid); }
    }
    SEAM(8);
    if (IN(9)) for (int rep_ = 0; rep_ < REPS(9); ++rep_) { TID(); PTRS();
        pg8::Gemm g{A2, (const bf16_t*)(ws + WS_W2), M, 2048, 128}; pg8::StaticOrder S; S.init(M, 2048, G, bid);
        pg8::EpiWA E{WAb, kin(kp, I_W0), kin(kp, I_A0)};
        pg8::gemm_phase<pg8::EpiWA, pg8::StaticOrder, true, true>(lds, g, S, E, tid);
    }
    SEAM(9);
    if (IN(10)) for (int rep_ = 0; rep_ < REPS(10); ++rep_) { TID(); PTRS(); scan_phase(lds, S3, Kr, Vr, WAb, kin(kp, I_KK), kin(kp, I_KA), S1, G, bid, tid); }
    SEAM(10);
    if (IN(11)) for (int rep_ = 0; rep_ < REPS(11); ++rep_) { TID(); PTRS(); gn_phase(S1, S3, Kr, Vr, S2, WAb, kin(kp, I_KA), kin(kp, I_RK), kin(kp, I_GNG), kin(kp, I_GNB), G, bid, tid); }
    SEAM(11);
    if (IN(12)) for (int rep_ = 0; rep_ < REPS(12); ++rep_) { TID(); PTRS();
        { pg8::Gemm g{S1, (const bf16_t*)(ws + WS_WO1), M, D, D}; pg8::StaticOrder S; S.init(M, D, G, bid); pg8::EpiRes<true> E{(const void*)S4, S3};
          pg8::gemm_phase<pg8::EpiRes<true>, pg8::StaticOrder, true, true>(lds, g, S, E, tid); }
        __syncthreads();
        { pg8::Gemm g{(const bf16_t*)(ws + WS_PB1), (const bf16_t*)(ws + WS_WP1), M, D, PLE}; pg8::StaticOrder S; S.init(M, D, G, bid); pg8::EpiStore E{S2, D};
          pg8::gemm_phase<pg8::EpiStore, pg8::StaticOrder, true, true>(lds, g, S, E, tid); }
    }
    SEAM(12);
    if (IN(13)) for (int rep_ = 0; rep_ < REPS(13); ++rep_) { TID(); PTRS();
        pg8::Gemm g{S3, (const bf16_t*)(ws + WS_WG1), M, D, D}; pg8::StaticOrder S; S.init(M, D, G, bid);
        pg8::EpiGate<false> E{S3, S2, (void*)S1};
        pg8::gemm_phase<pg8::EpiGate<false>, pg8::StaticOrder, true, true>(lds, g, S, E, tid);
    }
    SEAM(13);
    if (IN(14)) for (int rep_ = 0; rep_ < REPS(14); ++rep_) { TID(); PTRS(); final_norm_phase(S1, kout(kp), kin(kp, I_FNG), G, bid, tid); }
#undef IN
#undef SEAM
}

extern "C" void kernel_launch(void* const* d_in, const int* in_sizes, int n_in, void* d_out, int out_size, void* d_ws, size_t ws_size, hipStream_t stream) {
    static int grid = 0;
    if (grid == 0) {
        if (n_in != 24 || out_size != M * D || ws_size < WS_END) { fprintf(stderr, "kernel_launch: unexpected shapes (n_in %d, out %d, ws %zu)\n", n_in, out_size, ws_size); grid = -1; return; }
        int dev = 0, cus = 0, per_cu = 0;
        (void)hipGetDevice(&dev); (void)hipDeviceGetAttribute(&cus, hipDeviceAttributeMultiprocessorCount, dev);
        if (hipFuncSetAttribute((const void*)hybrid_fwd, hipFuncAttributeMaxDynamicSharedMemorySize, LDS_BYTES) != hipSuccess) { fprintf(stderr, "kernel_launch: hipFuncSetAttribute failed\n"); grid = -1; return; }
        if (hipOccupancyMaxActiveBlocksPerMultiprocessor(&per_cu, (const void*)hybrid_fwd, NTHR, LDS_BYTES) != hipSuccess || per_cu < 1) { fprintf(stderr, "kernel_launch: occupancy query reports %d\n", per_cu); per_cu = 1; }
        (void)hipGetLastError();
        grid = cus > 0 ? cus : 256;
    }
    if (grid < 0) return;
    Args a{};
    for (int i = 0; i < 24; ++i) a.in[i] = (const float*)d_in[i];
    a.out = (float*)d_out; a.ws = (unsigned char*)d_ws;
#if MK_PER_PHASE
    for (int ph = 0; ph < NPHASE; ++ph) { a.ph_lo = ph; a.ph_hi = ph + 1; hipLaunchKernelGGL(hybrid_fwd, dim3(grid), dim3(NTHR), LDS_BYTES, stream, a); }
#else
    a.ph_lo = 0; a.ph_hi = NPHASE;
    (void)hipMemsetAsync((unsigned char*)d_ws + WS_CTL, 0, 16384, stream);
    void* args[] = {&a};
    hipError_t e = hipLaunchCooperativeKernel((const void*)hybrid_fwd, dim3(grid), dim3(NTHR), args, LDS_BYTES, stream);
    if (e != hipSuccess) fprintf(stderr, "cooperative launch failed: %s (grid %d)\n", hipGetErrorString(e), grid);
#endif
}
```

```cpp
#include <hip/hip_runtime.h>
#include <hip/hip_cooperative_groups.h>
#include <cstdio>
#include <cstdint>
namespace cg = cooperative_groups;
namespace pg8 {
#define PG8_LAS __attribute__((address_space(3)))
typedef unsigned short bf16_t;
typedef short bf16x8 __attribute__((ext_vector_type(8)));
typedef float f32x4 __attribute__((ext_vector_type(4)));
typedef unsigned u32x4 __attribute__((ext_vector_type(4)));
constexpr int BM = 256, BK = 64, HALF = 128, HTB = HALF * BK * 2  , STAGE_BYTES = 8 * HTB, NXCD = 8, WGM = 8;

__host__ __device__ __forceinline__ int lds_byte(int r, int c) { const int st = (r >> 4) * 2 + (c >> 5), rr = r & 15, cc = c & 31, ob = rr * 64 + cc * 2; return st * 1024 + (ob ^ (((ob >> 9) & 1) << 5)); }
__host__ __device__ __forceinline__ void stage_rc(int b, int& R, int& C) { const int st = b / 1024, sb = b % 1024, swz = sb ^ (((sb >> 9) & 1) << 5); R = (st >> 1) * 16 + swz / 64; C = (st & 1) * 32 + (swz % 64) / 2; }
__host__ __device__ __forceinline__ int perm32(int rho) { const int n = rho >> 4, i = rho & 15; return 8 * (i >> 2) + 4 * n + (i & 3); }

struct Unit { int pm, pn; };
struct Gemm { const bf16_t* A; const bf16_t* Bt; int M, N, K; const bf16_t* A2 = nullptr; int nsplit = 1 << 30;
    __host__ __device__ __forceinline__ const bf16_t* asel(int pn) const { return pn < nsplit ? A : A2; } };

struct StaticOrder {
    int nM, nN, nwg, G, c;
    __host__ __device__ void init(int M, int N, int G_, int c_) { nM = M / BM; nN = N / BM; nwg = nM * nN; G = G_; c = c_; }
    __host__ __device__ bool next(int i, Unit& u) const {
        const long L = (long)i * G + c; if (L >= nwg) return false;
        int wgid = (int)L; { const int q = nwg / NXCD, r = nwg % NXCD, xcd = wgid % NXCD, off = wgid / NXCD; wgid = (xcd < r ? xcd * (q + 1) : r * (q + 1) + (xcd - r) * q) + off; }
        const int nig = WGM * nN, gid = wgid / nig, fm = gid * WGM, gsz = (nM - fm) < WGM ? (nM - fm) : WGM;
        u.pm = fm + ((wgid % nig) % gsz); u.pn = (wgid % nig) / gsz; return true;
    }
    __device__ __forceinline__ void a_ready(const Unit&) const {}
    __device__ __forceinline__ void done(const Unit&) const {}
};

__device__ __forceinline__ unsigned cvt_pk_bf16(float lo, float hi) { unsigned r; asm volatile("v_cvt_pk_bf16_f32 %0, %1, %2" : "=v"(r) : "v"(lo), "v"(hi)); return r; }
typedef float f32x2 __attribute__((ext_vector_type(2)));
__device__ __forceinline__ float bf2f(unsigned short b) { return __uint_as_float((unsigned)b << 16); }
__device__ __forceinline__ float bflo(unsigned w) { return __uint_as_float(w << 16); }
__device__ __forceinline__ float bfhi(unsigned w) { return __uint_as_float(w & 0xffff0000u); }
__device__ __forceinline__ float fsigmoid(float x) { return __builtin_amdgcn_rcpf(1.0f + __expf(-x)); }
__device__ __forceinline__ u32x4 pack8(const f32x4 a, const f32x4 b) { u32x4 w; w.x = cvt_pk_bf16(a[0], a[1]); w.y = cvt_pk_bf16(a[2], a[3]); w.z = cvt_pk_bf16(b[0], b[1]); w.w = cvt_pk_bf16(b[2], b[3]); return w; }
__device__ __forceinline__ void unpack8(const u32x4 w, f32x4& a, f32x4& b) { a = (f32x4){bflo(w.x), bfhi(w.x), bflo(w.y), bfhi(w.y)}; b = (f32x4){bflo(w.z), bfhi(w.z), bflo(w.w), bfhi(w.w)}; }

constexpr float QSCALE = 0.125f * 1.4426950408889634f;

struct EpiQKVZ {
    static constexpr bool PERM = true, AFTER_DRAIN = false;
    bf16_t* O; const float* bias; const float* cs; const float* sn;
    __device__ __forceinline__ void operator()(const f32x4 (&acc)[2][2][4][2], const Unit& u, int wr, int wc, int fr, int fq) const {
        const int row0 = u.pm * BM + wr * 64 + fr, col0 = u.pn * BM + wc * 32 + 8 * fq;
        const bool rope = u.pn < 5; const float sc = u.pn < 4 ? QSCALE : 1.0f;
        const int j4 = 4 * (4 * (wc & 1) + fq);
#pragma unroll
        for (int ai = 0; ai < 2; ++ai)
#pragma unroll
            for (int m = 0; m < 4; ++m) {
                const int row = row0 + ai * HALF + m * 16, pos = row & 4095;
                f32x4 c = (f32x4){1.f, 1.f, 1.f, 1.f}, s = (f32x4){0.f, 0.f, 0.f, 0.f};
                if (rope) { c = *(const f32x4*)(cs + pos * 32 + j4); s = *(const f32x4*)(sn + pos * 32 + j4); }
                bf16_t* rowp = O + (size_t)row * 2560 + col0;
#pragma unroll
                for (int bj = 0; bj < 2; ++bj) {
                    const f32x4 v0 = acc[ai][bj][m][0] + *(const f32x4*)(bias + col0 + bj * HALF), v1 = acc[ai][bj][m][1] + *(const f32x4*)(bias + col0 + bj * HALF + 4);
                    f32x4 o0 = v0, o1 = v1;
                    o0 = (v0 * c - v1 * s) * sc; o1 = (v1 * c + v0 * s) * sc;
                    *(u32x4*)(rowp + bj * HALF) = pack8(o0, o1);
                }
            }
    }
};
struct EpiStore {
    static constexpr bool PERM = true, AFTER_DRAIN = false;
    bf16_t* O; int ldc;
    __device__ __forceinline__ void operator()(const f32x4 (&acc)[2][2][4][2], const Unit& u, int wr, int wc, int fr, int fq) const {
        const int row0 = u.pm * BM + wr * 64 + fr, col0 = u.pn * BM + wc * 32 + 8 * fq;
#pragma unroll
        for (int ai = 0; ai < 2; ++ai)
#pragma unroll
            for (int m = 0; m < 4; ++m) { bf16_t* rowp = O + (size_t)(row0 + ai * HALF + m * 16) * ldc + col0;
#pragma unroll
                for (int bj = 0; bj < 2; ++bj) *(u32x4*)(rowp + bj * HALF) = pack8(acc[ai][bj][m][0], acc[ai][bj][m][1]); }
    }
};
struct EpiStore2 {
    static constexpr bool PERM = true, AFTER_DRAIN = false;
    bf16_t* O1; bf16_t* O2; int nsplit; int ldc;
    __device__ __forceinline__ void operator()(const f32x4 (&acc)[2][2][4][2], const Unit& u, int wr, int wc, int fr, int fq) const {
        const bool first = u.pn < nsplit; bf16_t* O = first ? O1 : O2;
        const int row0 = u.pm * BM + wr * 64 + fr, col0 = (first ? u.pn : u.pn - nsplit) * BM + wc * 32 + 8 * fq;
#pragma unroll
        for (int ai = 0; ai < 2; ++ai)
#pragma unroll
            for (int m = 0; m < 4; ++m) { bf16_t* rowp = O + (size_t)(row0 + ai * HALF + m * 16) * ldc + col0;
#pragma unroll
                for (int bj = 0; bj < 2; ++bj) *(u32x4*)(rowp + bj * HALF) = pack8(acc[ai][bj][m][0], acc[ai][bj][m][1]); }
    }
};
template <bool BF> struct EpiRes {
    static constexpr bool PERM = true, AFTER_DRAIN = false;
    const void* base; bf16_t* O;
    __device__ __forceinline__ void operator()(const f32x4 (&acc)[2][2][4][2], const Unit& u, int wr, int wc, int fr, int fq) const {
        const int row0 = u.pm * BM + wr * 64 + fr, col0 = u.pn * BM + wc * 32 + 8 * fq;
#pragma unroll
        for (int ai = 0; ai < 2; ++ai)
#pragma unroll
            for (int m = 0; m < 4; ++m) { const size_t off = (size_t)(row0 + ai * HALF + m * 16) * 1024 + col0;
#pragma unroll
                for (int bj = 0; bj < 2; ++bj) { f32x4 b0, b1;
                    if (BF) { unpack8(*(const u32x4*)((const bf16_t*)base + off + bj * HALF), b0, b1); }
                    else { b0 = *(const f32x4*)((const float*)base + off + bj * HALF); b1 = *(const f32x4*)((const float*)base + off + bj * HALF + 4); }
                    *(u32x4*)(O + off + bj * HALF) = pack8(b0 + acc[ai][bj][m][0], b1 + acc[ai][bj][m][1]); } }
    }
};
template <bool F32OUT> struct EpiGate {
    static constexpr bool PERM = true, AFTER_DRAIN = false;
    const bf16_t* hpre; const bf16_t* pp; void* O;
    __device__ __forceinline__ void operator()(const f32x4 (&acc)[2][2][4][2], const Unit& u, int wr, int wc, int fr, int fq) const {
        const int row0 = u.pm * BM + wr * 64 + fr, col0 = u.pn * BM + wc * 32 + 8 * fq;
#pragma unroll
        for (int ai = 0; ai < 2; ++ai)
#pragma unroll
            for (int m = 0; m < 4; ++m) { const size_t off = (size_t)(row0 + ai * HALF + m * 16) * 1024 + col0;
#pragma unroll
                for (int bj = 0; bj < 2; ++bj) { f32x4 h0, h1, p0, p1;
                    unpack8(*(const u32x4*)(hpre + off + bj * HALF), h0, h1); unpack8(*(const u32x4*)(pp + off + bj * HALF), p0, p1);
                    f32x4 g0, g1;
#pragma unroll
                    for (int e = 0; e < 4; ++e) { g0[e] = fsigmoid(acc[ai][bj][m][0][e]); g1[e] = fsigmoid(acc[ai][bj][m][1][e]); }
                    const f32x4 o0 = h0 + g0 * p0, o1 = h1 + g1 * p1;
                    if (F32OUT) { *(f32x4*)((float*)O + off + bj * HALF) = o0; *(f32x4*)((float*)O + off + bj * HALF + 4) = o1; }
                    else *(u32x4*)((bf16_t*)O + off + bj * HALF) = pack8(o0, o1); } }
    }
};
struct EpiWA {
    static constexpr bool PERM = true, AFTER_DRAIN = false;
    bf16_t* O; const float* w0; const float* a0;
    __device__ __forceinline__ void operator()(const f32x4 (&acc)[2][2][4][2], const Unit& u, int wr, int wc, int fr, int fq) const {
        const int row0 = u.pm * BM + wr * 64 + fr, col0 = u.pn * BM + wc * 32 + 8 * fq;
        const bool isw = u.pn < 4; const float* bvec = isw ? (w0 + col0) : (a0 + col0 - 1024); const float mul = isw ? -0.6065306597126334f : 1.0f;
#pragma unroll
        for (int ai = 0; ai < 2; ++ai)
#pragma unroll
            for (int m = 0; m < 4; ++m) { bf16_t* rowp = O + (size_t)(row0 + ai * HALF + m * 16) * 2048 + col0;
#pragma unroll
                for (int bj = 0; bj < 2; ++bj) { f32x4 o0, o1; const f32x4 b0 = *(const f32x4*)(bvec + bj * HALF), b1 = *(const f32x4*)(bvec + bj * HALF + 4);
#pragma unroll
                    for (int e = 0; e < 4; ++e) { o0[e] = mul * fsigmoid(acc[ai][bj][m][0][e] + b0[e]); o1[e] = mul * fsigmoid(acc[ai][bj][m][1][e] + b1[e]); }
                    *(u32x4*)(rowp + bj * HALF) = pack8(o0, o1); } }
    }
};
template <class Epi, class Sched, bool ALIGN_EPI = false, bool SP2 = false>
__device__ __forceinline__ void gemm_phase(PG8_LAS unsigned char* lds, const Gemm g, const Sched& S, const Epi& E, const int tid_in) {
    const int tid = tid_in, wid = __builtin_amdgcn_readfirstlane(tid >> 6), lane = tid & 63, wr = wid >> 2, wc = wid & 3, fr = lane & 15, fq = lane >> 4;
    const int K = g.K, nt = K / BK;
    unsigned voffA[2], voffB[2];
#pragma unroll
    for (int i = 0; i < 2; ++i) { int R, C; stage_rc(tid * 16 + i * 8192, R, C); const int Rb = Epi::PERM ? ((R & ~31) + perm32(R & 31)) : R;
        voffA[i] = (unsigned)(R * K + C) * 2u; voffB[i] = (unsigned)(Rb * K + C) * 2u; }
    const size_t kstep = (size_t)(BK * 2);
    const size_t hstep = (size_t)HALF * K * 2;
    const size_t tstep = 2 * hstep;
    const unsigned ldsw = (unsigned)wid * 1024u;
    const int aoff = lds_byte(wr * 64 + fr, fq * 8), boff = lds_byte(wc * 32 + fr, fq * 8);
#define PG8_SA(b, h) (((b) * 2 + (h)) * HTB)
#define PG8_SB(b, h) ((4 + (b) * 2 + (h)) * HTB)
#define PG8_STAGE(bufoff, gbase, voff) do { _Pragma("unroll") for (int _i = 0; _i < 2; ++_i) \
        __builtin_amdgcn_global_load_lds((const unsigned*)((const char*)(gbase) + (voff)[_i]), (PG8_LAS unsigned*)(lds + (bufoff) + ldsw + _i * 8192), 16, 0, 0); } while (0)
#define PG8_LDA(dst, b, h) do { _Pragma("unroll") for (int m = 0; m < 4; ++m) _Pragma("unroll") for (int k = 0; k < 2; ++k) dst[m][k] = *(const PG8_LAS bf16x8*)(lds + PG8_SA(b, h) + aoff + m * 2048 + k * 1024); } while (0)
#define PG8_LDB(dst, b, h) do { _Pragma("unroll") for (int n = 0; n < 2; ++n) _Pragma("unroll") for (int k = 0; k < 2; ++k) dst[n][k] = *(const PG8_LAS bf16x8*)(lds + PG8_SB(b, h) + boff + n * 2048 + k * 1024); } while (0)
#define PG8_MMA(ai, bj, At, Bt) do { __builtin_amdgcn_s_setprio(1); _Pragma("unroll") for (int m = 0; m < 4; ++m) _Pragma("unroll") for (int n = 0; n < 2; ++n) _Pragma("unroll") for (int k = 0; k < 2; ++k) \
        acc[ai][bj][m][n] = __builtin_amdgcn_mfma_f32_16x16x32_bf16(Bt[n][k], At[m][k], acc[ai][bj][m][n], 0, 0, 0); __builtin_amdgcn_s_setprio(0); } while (0)
#define PG8_WAIT_V(n) asm volatile("s_waitcnt vmcnt(" #n ")" ::: "memory")
#define PG8_WAIT_L(n) asm volatile("s_waitcnt lgkmcnt(" #n ")" ::: "memory")
#define PG8_BAR __builtin_amdgcn_s_barrier()
#define PG8_SCHED __builtin_amdgcn_sched_barrier(0)
    Unit cur, nxt; int ui = 0;
    if (!S.next(0, cur)) return;
    f32x4 acc[2][2][4][2];
#pragma unroll
    for (int a = 0; a < 2; ++a)
#pragma unroll
        for (int b = 0; b < 2; ++b)
#pragma unroll
            for (int m = 0; m < 4; ++m)
#pragma unroll
                for (int n = 0; n < 2; ++n) acc[a][b][m][n] = (f32x4){0.f, 0.f, 0.f, 0.f};
    bf16x8 At[4][2], B0[2][2], B1[2][2];
    const char* cA = (const char*)g.asel(cur.pn) + (size_t)cur.pm * tstep; const char* cB = (const char*)g.Bt + (size_t)cur.pn * tstep;
    S.a_ready(cur);
    if constexpr (SP2) {
        PG8_STAGE(PG8_SB(0, 0), cB, voffB); PG8_STAGE(PG8_SB(0, 1), cB + hstep, voffB); PG8_STAGE(PG8_SA(0, 0), cA, voffA); PG8_STAGE(PG8_SA(0, 1), cA + hstep, voffA);
        if (wr == 1) PG8_BAR;
        PG8_WAIT_V(2); PG8_BAR;
        PG8_STAGE(PG8_SB(1, 0), cB + kstep, voffB); PG8_STAGE(PG8_SA(1, 0), cA + kstep, voffA); PG8_STAGE(PG8_SB(1, 1), cB + hstep + kstep, voffB);
        PG8_WAIT_V(6); PG8_BAR;
    } else {
        PG8_STAGE(PG8_SB(0, 0), cB, voffB); PG8_STAGE(PG8_SA(0, 0), cA, voffA); PG8_STAGE(PG8_SB(0, 1), cB + hstep, voffB); PG8_STAGE(PG8_SA(0, 1), cA + hstep, voffA);
        if (wr == 1) PG8_BAR;
        PG8_WAIT_V(4); PG8_BAR;
        PG8_STAGE(PG8_SB(1, 0), cB + kstep, voffB); PG8_STAGE(PG8_SA(1, 0), cA + kstep, voffA); PG8_STAGE(PG8_SB(1, 1), cB + hstep + kstep, voffB);
        PG8_WAIT_V(6); PG8_BAR;
    }
    for (;;) {
        const bool has_next = S.next(ui + 1, nxt);
        const char* nA = has_next ? (const char*)g.asel(nxt.pn) + (size_t)nxt.pm * tstep : cA; const char* nB = has_next ? (const char*)g.Bt + (size_t)nxt.pn * tstep : cB;
        for (int t = 0; t < nt; t += 2) {
            const bool last = (t == nt - 2);
            const char* a1 = cA + (size_t)(t + 1) * kstep;
            const char* a2 = last ? nA : cA + (size_t)(t + 2) * kstep; const char* b2 = last ? nB : cB + (size_t)(t + 2) * kstep;
            const char* a3 = a2 + kstep; const char* b3 = b2 + kstep;
            if (last && has_next) S.a_ready(nxt);
            if constexpr (SP2) {
            PG8_LDB(B0, 0, 0); PG8_LDB(B1, 0, 1); PG8_SCHED; PG8_LDA(At, 0, 0); PG8_STAGE(PG8_SA(1, 1), a1 + hstep, voffA);
            PG8_WAIT_V(8); PG8_WAIT_L(0); PG8_BAR; PG8_MMA(0, 0, At, B0); PG8_MMA(0, 1, At, B1); PG8_BAR; PG8_SCHED;
            PG8_LDA(At, 0, 1); PG8_STAGE(PG8_SB(0, 0), b2, voffB); PG8_STAGE(PG8_SB(0, 1), b2 + hstep, voffB); PG8_STAGE(PG8_SA(0, 0), a2, voffA);
            PG8_WAIT_V(8); PG8_WAIT_L(0); PG8_BAR; PG8_MMA(1, 0, At, B0); PG8_MMA(1, 1, At, B1); PG8_BAR; PG8_SCHED;
            PG8_LDB(B0, 1, 0); PG8_LDB(B1, 1, 1); PG8_SCHED; PG8_LDA(At, 1, 0); PG8_STAGE(PG8_SA(0, 1), a2 + hstep, voffA);
            PG8_WAIT_V(8); PG8_WAIT_L(0); PG8_BAR; PG8_MMA(0, 0, At, B0); PG8_MMA(0, 1, At, B1); PG8_BAR; PG8_SCHED;
            PG8_LDA(At, 1, 1); PG8_STAGE(PG8_SB(1, 0), b3, voffB); PG8_STAGE(PG8_SB(1, 1), b3 + hstep, voffB); PG8_STAGE(PG8_SA(1, 0), a3, voffA);
            PG8_WAIT_V(8); PG8_WAIT_L(0); PG8_BAR; PG8_MMA(1, 0, At, B0); PG8_MMA(1, 1, At, B1); PG8_BAR; PG8_SCHED;
            } else {
            PG8_LDB(B0, 0, 0); PG8_SCHED; PG8_LDA(At, 0, 0); PG8_STAGE(PG8_SA(1, 1), a1 + hstep, voffA);
            PG8_WAIT_L(8); PG8_BAR; PG8_WAIT_L(0); PG8_MMA(0, 0, At, B0); PG8_BAR; PG8_SCHED;
            PG8_LDB(B1, 0, 1); PG8_STAGE(PG8_SB(0, 0), b2, voffB);
            PG8_BAR; PG8_WAIT_L(0); PG8_MMA(0, 1, At, B1); PG8_BAR;
            PG8_LDA(At, 0, 1); PG8_STAGE(PG8_SA(0, 0), a2, voffA);
            PG8_BAR; PG8_WAIT_L(0); PG8_MMA(1, 0, At, B0); PG8_BAR; PG8_SCHED;
            PG8_STAGE(PG8_SB(0, 1), b2 + hstep, voffB);
            PG8_WAIT_V(6); PG8_BAR; PG8_MMA(1, 1, At, B1); PG8_BAR;
            PG8_LDB(B0, 1, 0); PG8_SCHED; PG8_LDA(At, 1, 0); PG8_STAGE(PG8_SA(0, 1), a2 + hstep, voffA);
            PG8_WAIT_L(8); PG8_BAR; PG8_WAIT_L(0); PG8_MMA(0, 0, At, B0); PG8_BAR; PG8_SCHED;
            PG8_LDB(B1, 1, 1); PG8_STAGE(PG8_SB(1, 0), b3, voffB);
            PG8_BAR; PG8_WAIT_L(0); PG8_MMA(0, 1, At, B1); PG8_BAR;
            PG8_LDA(At, 1, 1); PG8_STAGE(PG8_SA(1, 0), a3, voffA);
            PG8_BAR; PG8_WAIT_L(0); PG8_MMA(1, 0, At, B0); PG8_BAR; PG8_SCHED;
            PG8_STAGE(PG8_SB(1, 1), b3 + hstep, voffB);
            PG8_WAIT_V(6); PG8_BAR; PG8_MMA(1, 1, At, B1); PG8_BAR;
            }
        }
        if constexpr (ALIGN_EPI) { if (wr == 0) PG8_BAR; }
        if constexpr (!Epi::AFTER_DRAIN) { E(acc, cur, wr, wc, fr, fq); S.done(cur); }
        if (!has_next) break;
#pragma unroll
        for (int a = 0; a < 2; ++a)
#pragma unroll
            for (int b = 0; b < 2; ++b)
#pragma unroll
                for (int m = 0; m < 4; ++m)
#pragma unroll
                    for (int n = 0; n < 2; ++n) acc[a][b][m][n] = (f32x4){0.f, 0.f, 0.f, 0.f};
        cur = nxt; cA = nA; cB = nB; ++ui;
        if constexpr (ALIGN_EPI) { if (wr == 1) PG8_BAR; }
    }
    PG8_WAIT_V(0);
    if constexpr (!ALIGN_EPI) { if (wr == 0) PG8_BAR; }
    PG8_BAR;
    if constexpr (Epi::AFTER_DRAIN) { E.fused(acc, cur, wr, wc, fr, fq, lds, wid, lane); S.done(cur); }
#undef PG8_SA
#undef PG8_SB
#undef PG8_STAGE
#undef PG8_LDA
#undef PG8_LDB
#undef PG8_MMA
#undef PG8_WAIT_V
#undef PG8_WAIT_L
#undef PG8_BAR
#undef PG8_SCHED
}
}
using pg8::bf16_t; using pg8::bf16x8; using pg8::f32x4; using pg8::u32x4; using pg8::cvt_pk_bf16; using pg8::bf2f; using pg8::bflo; using pg8::bfhi; using pg8::fsigmoid; using pg8::pack8; using pg8::unpack8;
#define LAS __attribute__((address_space(3)))
typedef unsigned u32x2 __attribute__((ext_vector_type(2)));
typedef float f32x2 __attribute__((ext_vector_type(2)));

constexpr int NB = 8, T = 4096, D = 1024, M = NB * T, PLE = 256, ATT_IN = 2560;
constexpr int NWAVES = 8, NTHR = 512;
constexpr int LDS_BYTES = 147456;

constexpr size_t MiB = 1u << 20;
constexpr size_t WS_WQKVZ = 0;
constexpr size_t WS_WO0   = 5 * MiB;
constexpr size_t WS_WG0   = 7 * MiB;
constexpr size_t WS_WG1   = 9 * MiB;
constexpr size_t WS_WO1   = 11 * MiB;
constexpr size_t WS_WR    = 13 * MiB;
constexpr size_t WS_WP0   = 21 * MiB;
constexpr size_t WS_WP1   = 21 * MiB + 512 * 1024;
constexpr size_t WS_WL    = 22 * MiB;
constexpr size_t WS_W2    = 22 * MiB + 512 * 1024;
constexpr size_t WS_COS   = 23 * MiB;
constexpr size_t WS_SIN   = 23 * MiB + 512 * 1024;
constexpr size_t WS_BIAS  = 24 * MiB;
constexpr size_t WS_CTL   = 25 * MiB;
constexpr size_t WS_PB0   = 32 * MiB;
constexpr size_t WS_L     = 32 * MiB;
constexpr size_t WS_PB1   = 48 * MiB;
constexpr size_t WS_S1    = 64 * MiB;
constexpr size_t WS_QKVZ  = 128 * MiB;
constexpr size_t WS_XS0   = 128 * MiB, WS_XS1 = 192 * MiB, WS_WA = 128 * MiB, WS_A2 = 256 * MiB;
constexpr size_t WS_S2    = 288 * MiB;
constexpr size_t WS_S3    = 352 * MiB;
constexpr size_t WS_S4    = 416 * MiB;
constexpr size_t WS_END   = 480 * MiB;

__device__ __forceinline__ float wave_sum(float v) {
#pragma unroll
    for (int o = 1; o < 64; o <<= 1) v += __shfl_xor(v, o);
    return v;
}
__device__ __forceinline__ float dpp_add(float x, const int ctrl_dummy) { return x; }
#define DPP_XADD(x, ctrl) ((x) + __builtin_bit_cast(float, __builtin_amdgcn_update_dpp(0, __builtin_bit_cast(int, (x)), (ctrl), 0xF, 0xF, true)))
__device__ __forceinline__ float row16_sum(float x) {
    x = DPP_XADD(x, 0xB1);
    x = DPP_XADD(x, 0x4E);
    x = DPP_XADD(x, 0x141);
    x = DPP_XADD(x, 0x140);
    return x;
}

__device__ __forceinline__ void grid_bar(unsigned* ctr, unsigned target, int tid) {
    asm volatile("s_waitcnt vmcnt(0)" ::: "memory");
    __syncthreads();
    if (tid == 0) {
        __builtin_amdgcn_fence(__ATOMIC_RELEASE, "agent");
        asm volatile("s_waitcnt vmcnt(0)" ::: "memory");
        __hip_atomic_fetch_add(ctr, 1u, __ATOMIC_RELAXED, __HIP_MEMORY_SCOPE_AGENT);
        while (__hip_atomic_load(ctr, __ATOMIC_RELAXED, __HIP_MEMORY_SCOPE_AGENT) < target) __builtin_amdgcn_s_sleep(2);
        __builtin_amdgcn_fence(__ATOMIC_ACQUIRE, "agent");
        asm volatile("s_waitcnt vmcnt(0)" ::: "memory");
    }
    __syncthreads();
}
#define XB_TMO      128
#define XB_XCNT(j)  (256  + 64 * (j))
#define XB_XSUB(j)  (1280 + 64 * (j))
#define XB_XGEN(j)  (2304 + 64 * (j))
#define XB_TOP      3328
#define XB_TOPGEN   3392
#define XCD_BAR_WORDS 3456
#define XB_SPIN_CAP (1u << 18)

__device__ __forceinline__ unsigned xb_ld(unsigned* p)              { return __hip_atomic_load(p, __ATOMIC_RELAXED, __HIP_MEMORY_SCOPE_AGENT); }
__device__ __forceinline__ unsigned xb_add(unsigned* p, unsigned v) { return __hip_atomic_fetch_add(p, v, __ATOMIC_RELAXED, __HIP_MEMORY_SCOPE_AGENT); }
__device__ __forceinline__ unsigned xb_xcc_id() { return (unsigned)__builtin_amdgcn_s_getreg((3 << 11) | 20) & 0xFu; }
#define XB_SPIN(cond, bar) do { unsigned _sp = 0; while (cond) { __builtin_amdgcn_s_sleep(1); \
    if ((++_sp & 255u) == 0u) { if (xb_ld(&(bar)[XB_TMO])) break; if (_sp > XB_SPIN_CAP) { atomicAdd(&(bar)[XB_TMO], 1u); break; } } } } while (0)

struct XcdBarrier {
    unsigned* bar; unsigned x;
    volatile LAS unsigned* st;
};

__device__ __forceinline__ XcdBarrier xcd_barrier_post(unsigned* bar, volatile LAS unsigned* st, const int tid_) {
    XcdBarrier b; b.bar = bar; b.x = xb_xcc_id(); b.st = st;
    if (tid_ == 0) (void)xb_add(&bar[XB_XCNT(b.x)], 1u);
    return b;
}
__device__ __forceinline__ void xcd_barrier_complete(unsigned* bar, unsigned x, unsigned& nloc, unsigned& nx) {
    const unsigned G = gridDim.x * gridDim.y * gridDim.z;
    unsigned sum, cnt, mine, sp = 0u;
    for (;;) {
        sum = 0u; cnt = 0u; mine = 0u;
#pragma unroll
        for (unsigned j = 0; j < 16; ++j) { const unsigned c = xb_ld(&bar[XB_XCNT(j)]); sum += c; cnt += (c > 0u) ? 1u : 0u; mine = (j == x) ? c : mine; }
        if (sum == G) break;
        __builtin_amdgcn_s_sleep(1);
        if ((++sp & 255u) == 0u) { if (xb_ld(&bar[XB_TMO])) break; if (sp > XB_SPIN_CAP) { atomicAdd(&bar[XB_TMO], 1u); break; } }
    }
    nloc = mine > 0u ? mine : 1u; nx = cnt > 0u ? cnt : 1u;
}

__device__ __forceinline__ void xcd_barrier(const XcdBarrier& b, const int tid_) {
    asm volatile("s_waitcnt vmcnt(0)" ::: "memory");
    __syncthreads();
    if (tid_ == 0) {
        unsigned* bar = b.bar;
        __builtin_amdgcn_s_waitcnt(0);
        unsigned nloc = b.st[0], nx = b.st[1];
        if (nloc == 0u) { xcd_barrier_complete(bar, b.x, nloc, nx); b.st[0] = nloc; b.st[1] = nx; }
        const unsigned old = xb_add(&bar[XB_XSUB(b.x)], 1u);
        const unsigned gen = old / nloc;
        if (old + 1u == (gen + 1u) * nloc) {
            __builtin_amdgcn_fence(__ATOMIC_RELEASE, "agent");
            asm volatile("s_waitcnt vmcnt(0)" ::: "memory");
            const unsigned og = xb_add(&bar[XB_TOP], 1u);
            const unsigned tg = og / nx;
            if (og + 1u == (tg + 1u) * nx) xb_add(&bar[XB_TOPGEN], 1u);
            else XB_SPIN(xb_ld(&bar[XB_TOPGEN]) == tg, bar);
            __builtin_amdgcn_fence(__ATOMIC_ACQUIRE, "agent");
            xb_add(&bar[XB_XGEN(b.x)], 1u);
            asm volatile("s_waitcnt vmcnt(0)" ::: "memory");
        } else {
            XB_SPIN(xb_ld(&bar[XB_XGEN(b.x)]) == gen, bar);
            __builtin_amdgcn_fence(__ATOMIC_ACQUIRE, "agent");
            asm volatile("s_waitcnt vmcnt(0)" ::: "memory");
        }
    }
    __syncthreads();
}

__device__ __forceinline__ int qk_perm_row(int n) {
    if (n >= 1280) return n;
    const int hd = n & ~63, d = n & 63, dd = d & 31;
    return hd + 8 * (dd >> 2) + 4 * (d >> 5) + (dd & 3);
}
template <int MODE>
__device__ __forceinline__ void transpose_item(const float* W, int K, int N, bf16_t* WT, int row_off, LAS float* scr, int item, int lane, const float* s) {
    const int nblk = N / 32, kb = item / nblk, nb = item % nblk, k0 = 64 * kb, n0 = 32 * nb;
#pragma unroll 8
    for (int i = 0; i < 32; ++i) { const int kk = 2 * i + (lane >> 5); float v = W[(size_t)(k0 + kk) * N + n0 + (lane & 31)];
        if (MODE == 2) v *= s[k0 + kk]; if (MODE == 3) v *= 1.0f - s[k0 + kk];
        scr[kk * 33 + (lane & 31)] = v; }
    asm volatile("s_waitcnt lgkmcnt(0)" ::: "memory");
    const int c = lane & 7;
#pragma unroll
    for (int j = 0; j < 4; ++j) { const int n = (lane >> 3) + 8 * j; const LAS float* sp = scr + (8 * c) * 33 + n;
        u32x4 o; o.x = cvt_pk_bf16(sp[0 * 33], sp[1 * 33]); o.y = cvt_pk_bf16(sp[2 * 33], sp[3 * 33]); o.z = cvt_pk_bf16(sp[4 * 33], sp[5 * 33]); o.w = cvt_pk_bf16(sp[6 * 33], sp[7 * 33]);
        const int dn = (MODE == 1) ? qk_perm_row(n0 + n) : (n0 + n);
        *(u32x4*)(WT + (size_t)(row_off + dn) * K + k0 + 8 * c) = o; }
    asm volatile("s_waitcnt lgkmcnt(0)" ::: "memory");
}

struct Args { const float* in[24]; float* out; unsigned char* ws; int ph_lo, ph_hi; };
typedef const __attribute__((address_space(4))) unsigned char* kptr_t;
__device__ __forceinline__ kptr_t kargs() { kptr_t p = (kptr_t)__builtin_amdgcn_kernarg_segment_ptr(); asm volatile("" : "+s"(p)); return p; }
#define GAS __attribute__((address_space(1)))
__device__ __forceinline__ const float* kin(kptr_t p, int i) { return (const float*)(const GAS float*)*(const unsigned long long __attribute__((address_space(4)))*)(p + 8 * i); }
__device__ __forceinline__ float* kout(kptr_t p) { return (float*)(GAS float*)*(const unsigned long long __attribute__((address_space(4)))*)(p + 8 * 24); }
__device__ __forceinline__ unsigned char* kws(kptr_t p) { return (unsigned char*)(GAS unsigned char*)*(const unsigned long long __attribute__((address_space(4)))*)(p + 8 * 25); }

enum { I_X = 0, I_P, I_NORMG, I_AWIN, I_ABIN, I_ASINK, I_AWOUT, I_MU, I_RWIN, I_W0, I_W1, I_W2, I_A0, I_A1, I_A2, I_KK, I_KA, I_RK, I_GNG, I_GNB, I_RWOUT, I_PWP, I_PWG, I_FNG };
__device__ __forceinline__ void p0_prologue(LAS unsigned char* lds, int G, int bid, int tid) {
    kptr_t kp = kargs();
    const int wave = __builtin_amdgcn_readfirstlane(tid >> 6), lane = tid & 63;
    LAS float* scr = (LAS float*)(lds + wave * 16384);
    const int gw = bid * NWAVES + wave, NGW = G * NWAVES;
    unsigned char* ws = kws(kp);
    const float* mu = kin(kp, I_MU);
    constexpr int N1 = 1280, N2 = 512, N5 = 2048, N6 = 128, N7 = 32;
    constexpr int NITEMS = N1 + 4 * N2 + N5 + 2 * N6 + 4 * N7;
    for (int it = gw; it < NITEMS; it += NGW) {
        int r = it;
        if (r < N1) { transpose_item<1>(kin(kp, I_AWIN), 1024, 2560, (bf16_t*)(ws + WS_WQKVZ), 0, scr, r, lane, nullptr); continue; } r -= N1;
        if (r < N2) { transpose_item<0>(kin(kp, I_AWOUT), 1024, 1024, (bf16_t*)(ws + WS_WO0), 0, scr, r, lane, nullptr); continue; } r -= N2;
        if (r < N2) { transpose_item<0>(kin(kp, I_PWG), 1024, 1024, (bf16_t*)(ws + WS_WG0), 0, scr, r, lane, nullptr); continue; } r -= N2;
        if (r < N2) { transpose_item<0>(kin(kp, I_PWG) + 1024 * 1024, 1024, 1024, (bf16_t*)(ws + WS_WG1), 0, scr, r, lane, nullptr); continue; } r -= N2;
        if (r < N2) { transpose_item<0>(kin(kp, I_RWOUT), 1024, 1024, (bf16_t*)(ws + WS_WO1), 0, scr, r, lane, nullptr); continue; } r -= N2;
        if (r < N5) { transpose_item<0>(kin(kp, I_RWIN), 1024, 4096, (bf16_t*)(ws + WS_WR), 0, scr, r, lane, nullptr); continue; } r -= N5;
        if (r < N6) { transpose_item<0>(kin(kp, I_PWP), 256, 1024, (bf16_t*)(ws + WS_WP0), 0, scr, r, lane, nullptr); continue; } r -= N6;
        if (r < N6) { transpose_item<0>(kin(kp, I_PWP) + 256 * 1024, 256, 1024, (bf16_t*)(ws + WS_WP1), 0, scr, r, lane, nullptr); continue; } r -= N6;
        if (r < N7) { transpose_item<3>(kin(kp, I_W1), 1024, 64, (bf16_t*)(ws + WS_WL), 0, scr, r, lane, mu + 4 * 1024); continue; } r -= N7;
        if (r < N7) { transpose_item<2>(kin(kp, I_W1), 1024, 64, (bf16_t*)(ws + WS_WL), 64, scr, r, lane, mu + 4 * 1024); continue; } r -= N7;
        if (r < N7) { transpose_item<3>(kin(kp, I_A1), 1024, 64, (bf16_t*)(ws + WS_WL), 128, scr, r, lane, mu + 5 * 1024); continue; } r -= N7;
        transpose_item<2>(kin(kp, I_A1), 1024, 64, (bf16_t*)(ws + WS_WL), 192, scr, r, lane, mu + 5 * 1024);
    }
    {
        const float* g0 = kin(kp, I_NORMG); bf16_t* XN = (bf16_t*)(ws + WS_S1);
        f32x4 gv[4];
#pragma unroll
        for (int j = 0; j < 4; ++j) gv[j] = *((const f32x4*)g0 + lane + 64 * j);
        const float* xin = kin(kp, I_X);
        f32x4 nx[4];
        if (gw < M) {
#pragma unroll
            for (int j = 0; j < 4; ++j) nx[j] = *((const f32x4*)(xin + (size_t)gw * D) + lane + 64 * j); }
        for (int m = gw; m < M; m += NGW) {
            f32x4 v[4]; float s = 0.f;
#pragma unroll
            for (int j = 0; j < 4; ++j) { v[j] = nx[j]; s += (v[j].x * v[j].x + v[j].y * v[j].y) + (v[j].z * v[j].z + v[j].w * v[j].w); }
            if (m + NGW < M) {
#pragma unroll
                for (int j = 0; j < 4; ++j) nx[j] = *((const f32x4*)(xin + (size_t)(m + NGW) * D) + lane + 64 * j); }
            const float rstd = 1.0f / sqrtf(wave_sum(s) * (1.0f / D) + 1e-6f);
            u32x2* o8 = (u32x2*)(XN + (size_t)m * D) + lane;
#pragma unroll
            for (int j = 0; j < 4; ++j) { const f32x4 o = v[j] * rstd * gv[j]; u32x2 w; w.x = cvt_pk_bf16(o.x, o.y); w.y = cvt_pk_bf16(o.z, o.w); o8[64 * j] = w; }
        }
    }
    const int gt = bid * NTHR + tid, NGT = G * NTHR;
    {
        const f32x4* p4 = (const f32x4*)kin(kp, I_P); u32x4* o = (u32x4*)(ws + WS_PB0);
        for (int i = gt; i < 2 * M * PLE / 8; i += NGT) { const f32x4 x0 = p4[2 * i], x1 = p4[2 * i + 1]; o[i] = pack8(x0, x1); }
    }
    {
        float* cs = (float*)(ws + WS_COS); float* sn = (float*)(ws + WS_SIN);
        for (int i = gt; i < T * 32; i += NGT) {
            const int pos = i >> 5, f = i & 31;
            const float inv = (float)exp2(-(double)f * (13.287712379549449 / 32.0));
            const float ang = (float)pos * inv;
            double rev = (double)ang * 0.15915494309189535; rev -= floor(rev);
            sn[i] = __builtin_amdgcn_sinf((float)rev); cs[i] = __builtin_amdgcn_cosf((float)rev);
        }
    }
    {
        float* bp = (float*)(ws + WS_BIAS);
        for (int i = gt; i < ATT_IN; i += NGT) bp[qk_perm_row(i)] = kin(kp, I_ABIN)[i];
    }
    {
        bf16_t* W2T = (bf16_t*)(ws + WS_W2); const float* w2 = kin(kp, I_W2); const float* a2 = kin(kp, I_A2);
        for (int i = gt; i < 2048 * 128; i += NGT) {
            const int k = i >> 11, nn = i & 2047;
            float v;
            if (nn < 1024) v = (k < 64) ? w2[k * 1024 + nn] : 0.f; else v = (k >= 64) ? a2[(k - 64) * 1024 + (nn - 1024)] : 0.f;
            W2T[(size_t)nn * 128 + k] = (bf16_t)(cvt_pk_bf16(v, 0.f) & 0xffffu);
        }
    }
}

__device__ __forceinline__ void attn_phase(LAS unsigned char* lds, const bf16_t* QKVZ, const float* sinks, bf16_t* OG, int G, int bid, int tid) {
    const int wave = __builtin_amdgcn_readfirstlane(tid >> 6), lane = tid & 63, fr = lane & 15, fq = lane >> 4;
    constexpr int KP = 144, VP = 528;
    LAS unsigned char* Kl = lds; LAS unsigned char* Vt = lds + 256 * KP;
    u32x4 pkv[4], pvv[4];
#define ATT_LOAD(uu) do { const int kvh_ = (uu) & 3, n_ = ((uu) >> 2) & 31, b_ = (uu) >> 7; _Pragma("unroll") for (int i = 0; i < 4; ++i) { \
        const int c_ = tid + 512 * i, key_ = c_ >> 3, ch_ = c_ & 7, t_ = 128 * (n_ - 1) + key_; \
        pkv[i] = (u32x4){0u, 0u, 0u, 0u}; pvv[i] = (u32x4){0u, 0u, 0u, 0u}; \
        if (t_ >= 0) { const bf16_t* rp_ = QKVZ + (size_t)(b_ * T + t_) * ATT_IN + kvh_ * 64 + ch_ * 8; pkv[i] = *(const u32x4*)(rp_ + 1024); pvv[i] = *(const u32x4*)(rp_ + 1280); } } } while (0)
    if (bid < 1024) ATT_LOAD(bid);
    for (int unit = bid; unit < 1024; unit += G) {
        const int kvh = unit & 3, n = (unit >> 2) & 31, b = unit >> 7;
        __syncthreads();
#pragma unroll
        for (int i = 0; i < 4; ++i) {
            const int c = tid + 512 * i, key = c >> 3, ch = c & 7;
            const u32x4 kv = pkv[i], vv = pvv[i];
            *(LAS u32x4*)(Kl + key * KP + ch * 16) = kv;
            LAS unsigned short* vp = (LAS unsigned short*)(Vt + (ch * 8) * VP + ((key ^ (ch << 2)) * 2));
            vp[0 * (VP / 2)] = (unsigned short)(vv.x & 0xffffu); vp[1 * (VP / 2)] = (unsigned short)(vv.x >> 16);
            vp[2 * (VP / 2)] = (unsigned short)(vv.y & 0xffffu); vp[3 * (VP / 2)] = (unsigned short)(vv.y >> 16);
            vp[4 * (VP / 2)] = (unsigned short)(vv.z & 0xffffu); vp[5 * (VP / 2)] = (unsigned short)(vv.z >> 16);
            vp[6 * (VP / 2)] = (unsigned short)(vv.w & 0xffffu); vp[7 * (VP / 2)] = (unsigned short)(vv.w >> 16);
        }
        if (unit + G < 1024) ATT_LOAD(unit + G);
        __syncthreads();
        const int g = wave >> 1, qh = wave & 1, h = kvh * 4 + g;
        const float sink2 = sinks[h] * 1.4426950408889634f;
        for (int mt = 0; mt < 4; ++mt) {
            const int qo0 = qh * 64 + mt * 16;
            const size_t row = (size_t)(b * T + n * 128 + qo0 + fr);
            const bf16_t* qp = QKVZ + row * ATT_IN + h * 64 + fq * 8;
            const bf16x8 q0 = *(const bf16x8*)qp, q1 = *(const bf16x8*)(qp + 32);
            const int kt0 = (qh * 4 + mt) < 6 ? (qh * 4 + mt) : 6;
            f32x4 s[10];
#pragma unroll
            for (int kt = 0; kt < 10; ++kt) {
                const LAS unsigned char* kp = Kl + ((kt0 + kt) * 16 + fr) * KP + fq * 16;
                const bf16x8 k0 = *(const LAS bf16x8*)kp, k1 = *(const LAS bf16x8*)(kp + 64);
                f32x4 acc = (f32x4){0.f, 0.f, 0.f, 0.f};
                acc = __builtin_amdgcn_mfma_f32_16x16x32_bf16(k0, q0, acc, 0, 0, 0);
                acc = __builtin_amdgcn_mfma_f32_16x16x32_bf16(k1, q1, acc, 0, 0, 0);
                s[kt] = acc;
            }
            const int qi = 128 + qo0 + fr;
            float mx = sink2;
#pragma unroll
            for (int kt = 0; kt < 10; ++kt)
#pragma unroll
                for (int r = 0; r < 4; ++r) { const int si = (kt0 + kt) * 16 + 4 * fq + r, df = qi - si; const bool ok = (df >= 0) && (df < 128) && (n > 0 || si >= 128);
                    const float v = ok ? s[kt][r] : -1e30f; s[kt][r] = v; mx = fmaxf(mx, v); }
            mx = fmaxf(mx, __shfl_xor(mx, 16)); mx = fmaxf(mx, __shfl_xor(mx, 32));
            float sum = 0.f;
#pragma unroll
            for (int kt = 0; kt < 10; ++kt)
#pragma unroll
                for (int r = 0; r < 4; ++r) { const float p = __builtin_amdgcn_exp2f(s[kt][r] - mx); s[kt][r] = p; sum += p; }
            sum += __shfl_xor(sum, 16); sum += __shfl_xor(sum, 32);
            sum += __builtin_amdgcn_exp2f(sink2 - mx);
            const float inv = 1.0f / sum;
            f32x4 o[4];
#pragma unroll
            for (int dt = 0; dt < 4; ++dt) o[dt] = (f32x4){0.f, 0.f, 0.f, 0.f};
#pragma unroll
            for (int kk = 0; kk < 5; ++kk) {
                const u32x4 pw = pack8(s[2 * kk], s[2 * kk + 1]);
                const bf16x8 pf = __builtin_bit_cast(bf16x8, pw);
#pragma unroll
                for (int dt = 0; dt < 4; ++dt) {
                    const int d = dt * 16 + fr, sw = ((d >> 3) & 7) << 2, keyA = 16 * (kt0 + 2 * kk) + 4 * fq, keyB = keyA + 16;
                    const u32x2 va = *(const LAS u32x2*)(Vt + d * VP + ((keyA ^ sw) * 2)), vb = *(const LAS u32x2*)(Vt + d * VP + ((keyB ^ sw) * 2));
                    const u32x4 vw = (u32x4){va.x, va.y, vb.x, vb.y};
                    o[dt] = __builtin_amdgcn_mfma_f32_16x16x32_bf16(__builtin_bit_cast(bf16x8, vw), pf, o[dt], 0, 0, 0);
                }
            }
            const bf16_t* zp = QKVZ + row * ATT_IN + 1536 + h * 64 + 4 * fq;
            bf16_t* op = OG + row * D + h * 64 + 4 * fq;
#pragma unroll
            for (int dt = 0; dt < 4; ++dt) {
                const u32x2 zw = *(const u32x2*)(zp + dt * 16);
                const float z0 = bflo(zw.x), z1 = bfhi(zw.x), z2 = bflo(zw.y), z3 = bfhi(zw.y);
                const float r0 = o[dt][0] * inv * z0 * fsigmoid(z0), r1 = o[dt][1] * inv * z1 * fsigmoid(z1), r2 = o[dt][2] * inv * z2 * fsigmoid(z2), r3 = o[dt][3] * inv * z3 * fsigmoid(z3);
                u32x2 w; w.x = cvt_pk_bf16(r0, r1); w.y = cvt_pk_bf16(r2, r3);
                *(u32x2*)(op + dt * 16) = w;
            }
        }
    }
}
template <int ROUND>
__device__ __forceinline__ void lerp_phase(const bf16_t* H1, const float* g1, const float* mu, bf16_t* HN, bf16_t* XS0, bf16_t* XS1, int G, int bid, int tid) {
    const int wave = __builtin_amdgcn_readfirstlane(tid >> 6), lane = tid & 63;
    const int gw = bid * NWAVES + wave, NGW = G * NWAVES;
    const float* mu0 = mu + (ROUND == 0 ? 0 : 2) * 1024; const float* mu1 = mu0 + 1024;
    f32x4 gq[4], m0q[4], m1q[4];
#pragma unroll
    for (int q = 0; q < 4; ++q) { const int col = (q >> 1) * 512 + lane * 8 + 4 * (q & 1); gq[q] = *(const f32x4*)(g1 + col); m0q[q] = *(const f32x4*)(mu0 + col); m1q[q] = *(const f32x4*)(mu1 + col); }
    u32x4 rc_[2], rp_[2];
#define LERP_LOAD(mm) do { const bool hp_ = ((mm) & (T - 1)) != 0; _Pragma("unroll") for (int j = 0; j < 2; ++j) { const size_t off_ = (size_t)(mm) * D + j * 512 + lane * 8; \
        rc_[j] = *(const u32x4*)(H1 + off_); rp_[j] = hp_ ? *(const u32x4*)(H1 + off_ - D) : (u32x4){0u, 0u, 0u, 0u}; } } while (0)
    if (gw < M) LERP_LOAD(gw);
    for (int m = gw; m < M; m += NGW) {
        f32x4 c[4], p[4];
        float sc = 0.f, sp = 0.f;
#pragma unroll
        for (int j = 0; j < 2; ++j) { unpack8(rc_[j], c[2 * j], c[2 * j + 1]); unpack8(rp_[j], p[2 * j], p[2 * j + 1]); }
        if (m + NGW < M) LERP_LOAD(m + NGW);
#pragma unroll
        for (int q = 0; q < 4; ++q) { sc += (c[q].x * c[q].x + c[q].y * c[q].y) + (c[q].z * c[q].z + c[q].w * c[q].w); sp += (p[q].x * p[q].x + p[q].y * p[q].y) + (p[q].z * p[q].z + p[q].w * p[q].w); }
        const float rc = 1.0f / sqrtf(wave_sum(sc) * (1.0f / D) + 1e-6f), rp = 1.0f / sqrtf(wave_sum(sp) * (1.0f / D) + 1e-6f);
#pragma unroll
        for (int j = 0; j < 2; ++j) {
            const int col = j * 512 + lane * 8; const size_t off = (size_t)m * D + col;
            f32x4 hn[2], xx[2], o0[2], o1[2];
#pragma unroll
            for (int e = 0; e < 2; ++e) {
                const f32x4 gv = gq[2 * j + e];
                hn[e] = c[2 * j + e] * rc * gv; xx[e] = p[2 * j + e] * rp * gv - hn[e];
                o0[e] = hn[e] + xx[e] * m0q[2 * j + e];
                o1[e] = hn[e] + xx[e] * m1q[2 * j + e];
            }
            if (ROUND == 0) *(u32x4*)(HN + off) = pack8(hn[0], hn[1]);
            *(u32x4*)(XS0 + off) = pack8(o0[0], o0[1]);
            *(u32x4*)(XS1 + off) = pack8(o1[0], o1[1]);
        }
    }
}
__device__ __forceinline__ void lora_mid_phase(const bf16_t* L, bf16_t* A2, int G, int bid, int tid) {
    const int gt = bid * NTHR + tid, NGT = G * NTHR;
    for (int i = gt; i < M * 16; i += NGT) {
        const int m = i >> 4, ch = i & 15, isA = ch >> 3, c8 = (ch & 7) * 8;
        const bool hasprev = (m & (T - 1)) != 0;
        f32x4 u0, u1, v0 = (f32x4){0.f, 0.f, 0.f, 0.f}, v1 = v0;
        unpack8(*(const u32x4*)(L + (size_t)m * 256 + isA * 128 + c8), u0, u1);
        if (hasprev) unpack8(*(const u32x4*)(L + (size_t)(m - 1) * 256 + isA * 128 + 64 + c8), v0, v1);
        u0 += v0; u1 += v1;
        if (!isA) {
#pragma unroll
            for (int e = 0; e < 4; ++e) { u0[e] = tanhf(u0[e]); u1[e] = tanhf(u1[e]); }
        }
        *(u32x4*)(A2 + (size_t)m * 128 + ch * 8) = pack8(u0, u1);
    }
}
#ifndef MK_SCAN_CHUNKED
#define MK_SCAN_CHUNKED 1
#endif
#if MK_SCAN_CHUNKED
typedef __bf16 ck_bf16x2_t __attribute__((ext_vector_type(2)));
__device__ __forceinline__ unsigned ck_cvt(float lo, float hi) { const f32x2 v = {lo, hi}; return __builtin_bit_cast(unsigned, __builtin_convertvector(v, ck_bf16x2_t)); }
constexpr int CK_RP = 144;
constexpr int CK_TP = 40;
constexpr int CK_ABAR = 0, CK_RBAR = 2304, CK_BTIL = 4608, CK_KTIL = 6912;
constexpr int CK_BT_T = 9216, CK_KT_T = 11776;
constexpr int CK_VT = 14336;
constexpr int CK_GAM = 15616;
constexpr int CK_BUF = 15872;
constexpr int CK_LD = 2 * CK_BUF;
constexpr int CK_PRIV = CK_LD + 2 * 4096;
constexpr int CK_PRIV_SZ = 2560;
__device__ __forceinline__ bf16x8 ck_ld2(const LAS unsigned char* p, int off2) {
    const u32x2 a = *(const LAS u32x2*)p, b = *(const LAS u32x2*)(p + off2); return __builtin_bit_cast(bf16x8, (u32x4){a.x, a.y, b.x, b.y}); }
__device__ __forceinline__ bf16x8 ck_ld1(const LAS unsigned char* p) {
    const u32x2 a = *(const LAS u32x2*)p; return __builtin_bit_cast(bf16x8, (u32x4){a.x, a.y, 0u, 0u}); }
__device__ __forceinline__ bf16x8 ck_pk4(const f32x4 x) { return __builtin_bit_cast(bf16x8, (u32x4){ck_cvt(x[0], x[1]), ck_cvt(x[2], x[3]), 0u, 0u}); }
#define CK_MFMA(a, b, c) __builtin_amdgcn_mfma_f32_16x16x32_bf16((a), (b), (c), 0, 0, 0)

constexpr int CK_STG = CK_PRIV + 2 * CK_PRIV_SZ;
constexpr int CK_STG_SZ = 4 * 4096 + 1024;
__device__ __forceinline__ void scan_phase(LAS unsigned char* lds, const bf16_t* R, const bf16_t* Kb, const bf16_t* V, const bf16_t* WA, const float* k_k, const float* k_a, bf16_t* Y, int G, int bid, int tid) {
    const int wave = __builtin_amdgcn_readfirstlane(tid >> 6), lane = tid & 63, c = lane & 15, g = lane >> 4;
    const int pid = tid - 128, pt = (pid >> 4) & 15, pj = pid & 15;
    const int pid1 = tid - 384, pta = (pid1 >> 4) & 7, ptb = pta + 8;
    const bool producer = (wave >= 2) && (wave < 6), producer1 = wave >= 6, consumer = wave < 2;
    constexpr int NCH = T / 16;
    for (int unit = bid; unit < 256; unit += G) {
        const int b = unit >> 5, h = (unit >> 1) & 15, half = unit & 1;
        const size_t rowbase = (size_t)b * T;
        f32x4 kkw = (f32x4){0.f, 0.f, 0.f, 0.f}, kaw = kkw;
        if (producer1) { kkw = *(const f32x4*)(k_k + h * 64 + 4 * pj); kaw = *(const f32x4*)(k_a + h * 64 + 4 * pj); }
        u32x2 rkA = (u32x2){0u, 0u}, rrA = rkA, raA = rkA, rlA = rkA, rkB = rkA, rrB = rkA, raB = rkA, rlB = rkA; unsigned rvA = 0u, rvB = 0u;
#define CK_LOAD(X, ptx, cn) do { const size_t m_ = rowbase + (size_t)(cn) * 16 + (ptx); \
            rk##X = *(const u32x2*)(Kb + m_ * D + h * 64 + 4 * pj); rr##X = *(const u32x2*)(R + m_ * D + h * 64 + 4 * pj); \
            rl##X = *(const u32x2*)(WA + m_ * 2048 + h * 64 + 4 * pj); ra##X = *(const u32x2*)(WA + m_ * 2048 + 1024 + h * 64 + 4 * pj); \
            rv##X = *(const unsigned*)(V + m_ * D + h * 64 + half * 32 + 2 * pj); } while (0)
#define CK_P1(X, ptx, cn) do { \
            const f32x4 kf_ = (f32x4){bflo(rk##X.x), bfhi(rk##X.x), bflo(rk##X.y), bfhi(rk##X.y)}, af_ = (f32x4){bflo(ra##X.x), bfhi(ra##X.x), bflo(ra##X.y), bfhi(ra##X.y)}; \
            const f32x4 lf_ = (f32x4){bflo(rl##X.x), bfhi(rl##X.x), bflo(rl##X.y), bfhi(rl##X.y)}, rf_ = (f32x4){bflo(rr##X.x), bfhi(rr##X.x), bflo(rr##X.y), bfhi(rr##X.y)}; \
            const f32x4 kv_ = kf_ * kkw; \
            float ss_ = (kv_.x * kv_.x + kv_.y * kv_.y) + (kv_.z * kv_.z + kv_.w * kv_.w); \
            ss_ = row16_sum(ss_); \
            const float invn_ = (ss_ > 1e-24f) ? __builtin_amdgcn_rsqf(ss_) : 1e12f;        \
            const f32x4 kk_ = kv_ * invn_; \
            LAS unsigned char* st_ = lds + CK_STG + ((cn) & 1) * CK_STG_SZ + ((ptx) * 64 + 4 * pj) * 4; \
            *(LAS f32x4*)(st_) = -kk_; *(LAS f32x4*)(st_ + 4096) = kk_ * af_; *(LAS f32x4*)(st_ + 8192) = kf_ * (1.0f + (af_ - 1.0f) * kaw); *(LAS f32x4*)(st_ + 12288) = rf_; \
            *(LAS unsigned*)(lds + CK_STG + ((cn) & 1) * CK_STG_SZ + 16384 + ((ptx) * 16 + pj) * 4) = rv##X; \
            *(LAS f32x4*)(lds + CK_LD + ((cn) & 1) * 4096 + ((ptx) * 64 + 4 * pj) * 4) = lf_; } while (0)
        if (producer1) { CK_LOAD(A, pta, 0); CK_LOAD(B, ptb, 0); CK_P1(A, pta, 0); CK_P1(B, ptb, 0); CK_LOAD(A, pta, 1); CK_LOAD(B, ptb, 1); }
        f32x4 H[4];
#pragma unroll
        for (int kt = 0; kt < 4; ++kt) H[kt] = (f32x4){0.f, 0.f, 0.f, 0.f};
        __syncthreads();
        for (int it = 0; it <= NCH; ++it) {
            if (producer1 && it + 1 < NCH) { CK_P1(A, pta, it + 1); CK_P1(B, ptb, it + 1); if (it + 2 < NCH) { CK_LOAD(A, pta, it + 2); CK_LOAD(B, ptb, it + 2); } }
            if (producer && it < NCH) {
                LAS unsigned char* buf = lds + (it & 1) * CK_BUF;
                const LAS unsigned char* ldp = lds + CK_LD + (it & 1) * 4096 + 16 * pj;
                const LAS unsigned char* stp = lds + CK_STG + (it & 1) * CK_STG_SZ + (pt * 64 + 4 * pj) * 4;
                f32x4 nkk = *(const LAS f32x4*)(stp), be = *(const LAS f32x4*)(stp + 4096), kp = *(const LAS f32x4*)(stp + 8192), rf = *(const LAS f32x4*)(stp + 12288), lf = *(const LAS f32x4*)(ldp + pt * 256);
                unsigned vsave = *(const LAS unsigned*)(lds + CK_STG + (it & 1) * CK_STG_SZ + 16384 + (pt * 16 + pj) * 4);
                asm volatile("" : "+v"(nkk), "+v"(be), "+v"(kp), "+v"(rf), "+v"(lf), "+v"(vsave));
                f32x4 Gc = (f32x4){0.f, 0.f, 0.f, 0.f};
                const int w4 = 4 * (wave - 2);
#pragma unroll
                for (int s4 = 0; s4 < 16; s4 += 4) {
                    if (s4 <= w4) {
                        f32x4 x0 = *(const LAS f32x4*)(ldp + (s4 + 0) * 256), x1 = *(const LAS f32x4*)(ldp + (s4 + 1) * 256), x2 = *(const LAS f32x4*)(ldp + (s4 + 2) * 256), x3 = *(const LAS f32x4*)(ldp + (s4 + 3) * 256);
                        asm volatile("" : "+v"(x0), "+v"(x1), "+v"(x2), "+v"(x3));
                        if (s4 < w4) Gc += (x0 + x1) + (x2 + x3);
                        else { const f32x4 z4 = (f32x4){0.f, 0.f, 0.f, 0.f};
                            Gc += (s4 + 0 <= pt) ? x0 : z4; Gc += (s4 + 1 <= pt) ? x1 : z4; Gc += (s4 + 2 <= pt) ? x2 : z4; Gc += (s4 + 3 <= pt) ? x3 : z4; }
                    }
                }
                const f32x4 Gm = Gc - lf;
                f32x4 eA, eR, eN;
#pragma unroll
                for (int e = 0; e < 4; ++e) { eA[e] = __expf(Gm[e]); eR[e] = __expf(Gc[e]); eN[e] = __expf(-Gc[e]); }
                const f32x4 ab = nkk * eA, rb = rf * eR, bt = be * eN, kt_ = kp * eN;
                const unsigned ab0 = ck_cvt(ab.x, ab.y), ab1 = ck_cvt(ab.z, ab.w), rb0 = ck_cvt(rb.x, rb.y), rb1 = ck_cvt(rb.z, rb.w);
                const unsigned bt0 = ck_cvt(bt.x, bt.y), bt1 = ck_cvt(bt.z, bt.w), kt0 = ck_cvt(kt_.x, kt_.y), kt1 = ck_cvt(kt_.z, kt_.w);
                LAS unsigned char* rowp = buf + pt * CK_RP + pj * 8;
                *(LAS u32x2*)(rowp + CK_ABAR) = (u32x2){ab0, ab1}; *(LAS u32x2*)(rowp + CK_RBAR) = (u32x2){rb0, rb1};
                *(LAS u32x2*)(rowp + CK_BTIL) = (u32x2){bt0, bt1}; *(LAS u32x2*)(rowp + CK_KTIL) = (u32x2){kt0, kt1};
                LAS unsigned short* btT = (LAS unsigned short*)(buf + CK_BT_T + (4 * pj) * CK_TP + pt * 2);
                LAS unsigned short* ktT = (LAS unsigned short*)(buf + CK_KT_T + (4 * pj) * CK_TP + pt * 2);
                constexpr int TS = CK_TP / 2;
                btT[0] = (unsigned short)(bt0 & 0xffffu); btT[TS] = (unsigned short)(bt0 >> 16); btT[2 * TS] = (unsigned short)(bt1 & 0xffffu); btT[3 * TS] = (unsigned short)(bt1 >> 16);
                ktT[0] = (unsigned short)(kt0 & 0xffffu); ktT[TS] = (unsigned short)(kt0 >> 16); ktT[2 * TS] = (unsigned short)(kt1 & 0xffffu); ktT[3 * TS] = (unsigned short)(kt1 >> 16);
                LAS unsigned short* vT = (LAS unsigned short*)(buf + CK_VT + (2 * pj) * CK_TP + pt * 2);
                vT[0] = (unsigned short)(vsave & 0xffffu); vT[TS] = (unsigned short)(vsave >> 16);
                if (pt == 15) *(LAS f32x4*)(buf + CK_GAM + 16 * pj) = eR;
            }
            if (consumer && it > 0) {
                const int cn = it - 1;
                const LAS unsigned char* buf = lds + (cn & 1) * CK_BUF;
                LAS unsigned char* priv = lds + CK_PRIV + wave * CK_PRIV_SZ;
                LAS float* AabT = (LAS float*)priv; LAS float* Xch = (LAS float*)(priv + 1024); LAS unsigned char* UT = priv + 2048;
                f32x4 xab = (f32x4){0.f, 0.f, 0.f, 0.f}, xak = xab, xrb = xab, xrk = xab;
                bf16x8 pa[2], pr[2];
#pragma unroll
                for (int ks = 0; ks < 2; ++ks) {
                    const LAS unsigned char* rp = buf + c * CK_RP + (32 * ks + 4 * g) * 2;
                    pa[ks] = ck_ld2(rp + CK_ABAR, 32); pr[ks] = ck_ld2(rp + CK_RBAR, 32);
                    const bf16x8 pb = ck_ld2(rp + CK_BTIL, 32), pk = ck_ld2(rp + CK_KTIL, 32);
                    xab = CK_MFMA(pb, pa[ks], xab); xak = CK_MFMA(pk, pa[ks], xak); xrb = CK_MFMA(pb, pr[ks], xrb); xrk = CK_MFMA(pk, pr[ks], xrk);
                }
#pragma unroll
                for (int r = 0; r < 4; ++r) { const int s = 4 * g + r; if (!(s < c)) { xab[r] = 0.f; xak[r] = 0.f; } if (!(s <= c)) { xrb[r] = 0.f; xrk[r] = 0.f; } }
#pragma unroll
                for (int r = 0; r < 4; ++r) AabT[(4 * g + r) * 16 + c] = xab[r];
                const bf16x8 opak = ck_pk4(xak), oprb = ck_pk4(xrb), oprk = ck_pk4(xrk);
                bf16x8 oph[2];
#pragma unroll
                for (int ks = 0; ks < 2; ++ks) oph[ks] = __builtin_bit_cast(bf16x8, (u32x4){ck_cvt(H[2 * ks][0], H[2 * ks][1]), ck_cvt(H[2 * ks][2], H[2 * ks][3]), ck_cvt(H[2 * ks + 1][0], H[2 * ks + 1][1]), ck_cvt(H[2 * ks + 1][2], H[2 * ks + 1][3])});
                const bf16x8 opv = ck_ld1(buf + CK_VT + (wave * 16 + c) * CK_TP + g * 8);
                f32x4 rhs = (f32x4){0.f, 0.f, 0.f, 0.f};
                rhs = CK_MFMA(pa[0], oph[0], rhs); rhs = CK_MFMA(pa[1], oph[1], rhs); rhs = CK_MFMA(opak, opv, rhs);
                *(LAS f32x4*)(Xch + c * 16 + 4 * g) = rhs;
                asm volatile("s_waitcnt lgkmcnt(0)" ::: "memory");
                float u[16];
#pragma unroll
                for (int q = 0; q < 4; ++q) { const f32x4 x = *(const LAS f32x4*)(Xch + c * 16 + 4 * q); u[4 * q] = x[0]; u[4 * q + 1] = x[1]; u[4 * q + 2] = x[2]; u[4 * q + 3] = x[3]; }
                f32x4 cw[15][4];
#define CK_COLLD(ss) do { _Pragma("unroll") for (int q_ = ((ss) + 1) / 4; q_ < 4; ++q_) cw[(ss)][q_] = *(const LAS f32x4*)(AabT + (ss) * 16 + 4 * q_); } while (0)
                CK_COLLD(0); CK_COLLD(1);
#pragma unroll
                for (int s = 0; s < 15; ++s) {
                    if (s + 2 < 15) CK_COLLD(s + 2);
                    __builtin_amdgcn_sched_barrier(0);
#pragma unroll
                    for (int t = s + 1; t < 16; ++t) u[t] += cw[s][t >> 2][t & 3] * u[s];
                }
#undef CK_COLLD
                { u32x4 w0, w1; w0.x = ck_cvt(u[0], u[1]); w0.y = ck_cvt(u[2], u[3]); w0.z = ck_cvt(u[4], u[5]); w0.w = ck_cvt(u[6], u[7]);
                  w1.x = ck_cvt(u[8], u[9]); w1.y = ck_cvt(u[10], u[11]); w1.z = ck_cvt(u[12], u[13]); w1.w = ck_cvt(u[14], u[15]);
                  *(LAS u32x4*)(UT + c * 32) = w0; *(LAS u32x4*)(UT + c * 32 + 16) = w1; }
                asm volatile("s_waitcnt lgkmcnt(0)" ::: "memory");
                const bf16x8 opu = ck_ld1(UT + c * 32 + g * 8);
                f32x4 yy = (f32x4){0.f, 0.f, 0.f, 0.f};
                yy = CK_MFMA(pr[0], oph[0], yy); yy = CK_MFMA(pr[1], oph[1], yy); yy = CK_MFMA(oprb, opu, yy); yy = CK_MFMA(oprk, opv, yy);
                {
                    bf16_t* yp = Y + (rowbase + (size_t)cn * 16 + 4 * g) * D + h * 64 + half * 32 + wave * 16 + c;
#pragma unroll
                    for (int r = 0; r < 4; ++r) yp[(size_t)r * D] = (bf16_t)(ck_cvt(yy[r], 0.f) & 0xffffu);
                }
#pragma unroll
                for (int kt = 0; kt < 4; ++kt) {
                    const bf16x8 opb = ck_ld1(buf + CK_BT_T + (16 * kt + c) * CK_TP + g * 8), opk = ck_ld1(buf + CK_KT_T + (16 * kt + c) * CK_TP + g * 8);
                    f32x4 hh = H[kt];
                    hh = CK_MFMA(opb, opu, hh); hh = CK_MFMA(opk, opv, hh);
                    H[kt] = hh * *(const LAS f32x4*)(buf + CK_GAM + (16 * kt + 4 * g) * 4);
                }
            }
            __syncthreads();
        }
    }
#undef CK_LOAD
#undef CK_P1
}
#else
constexpr int TC = 32;
constexpr int SC_VEC = TC * 5 * 64 * 4;
constexpr int SC_VP = 36;
constexpr int SC_V = 32 * SC_VP * 4;
constexpr int SC_Y = TC * 32 * 4;
constexpr int SC_BUF = SC_VEC + SC_V + SC_Y;
__device__ __forceinline__ void scan_phase(LAS unsigned char* lds, const bf16_t* R, const bf16_t* Kb, const bf16_t* V, const bf16_t* WA, const float* k_k, const float* k_a, bf16_t* Y, int G, int bid, int tid) {
    const int wave = __builtin_amdgcn_readfirstlane(tid >> 6), lane = tid & 63, rg = lane >> 4, cc = lane & 15;
    const int pt = tid >> 4, pj = tid & 15;
    for (int unit = bid; unit < 256; unit += G) {
        const int b = unit >> 5, h = (unit >> 1) & 15, half = unit & 1;
        const size_t rowbase = (size_t)b * T;
        const f32x4 kkw = *(const f32x4*)(k_k + h * 64 + 4 * pj), kaw = *(const f32x4*)(k_a + h * 64 + 4 * pj);
        f32x2 S01 = (f32x2){0.f, 0.f}, S23 = (f32x2){0.f, 0.f};
        u32x2 rk, rr, ra, rl; unsigned rv;
#define SCAN_LOAD(cn) do { const size_t m_ = rowbase + (size_t)(cn) * TC + pt; \
            rk = *(const u32x2*)(Kb + m_ * D + h * 64 + 4 * pj); rr = *(const u32x2*)(R + m_ * D + h * 64 + 4 * pj); \
            rl = *(const u32x2*)(WA + m_ * 2048 + h * 64 + 4 * pj); ra = *(const u32x2*)(WA + m_ * 2048 + 1024 + h * 64 + 4 * pj); \
            rv = *(const unsigned*)(V + m_ * D + h * 64 + half * 32 + 2 * pj); } while (0)
        SCAN_LOAD(0);
        __syncthreads();
        for (int cn = 0; cn < T / TC; ++cn) {
            LAS unsigned char* buf = lds + (cn & 1) * SC_BUF;
            {
                const f32x4 kf = (f32x4){bflo(rk.x), bfhi(rk.x), bflo(rk.y), bfhi(rk.y)}, af = (f32x4){bflo(ra.x), bfhi(ra.x), bflo(ra.y), bfhi(ra.y)};
                const f32x4 lf = (f32x4){bflo(rl.x), bfhi(rl.x), bflo(rl.y), bfhi(rl.y)}, rf = (f32x4){bflo(rr.x), bfhi(rr.x), bflo(rr.y), bfhi(rr.y)};
                const f32x4 kv = kf * kkw;
                float ss = (kv.x * kv.x + kv.y * kv.y) + (kv.z * kv.z + kv.w * kv.w);
                ss = row16_sum(ss);
                const float invn = 1.0f / fmaxf(sqrtf(ss), 1e-12f);
                const f32x4 kk = kv * invn;
                const f32x4 kp = kf * (1.0f + (af - 1.0f) * kaw);
                f32x4 dd; dd.x = __expf(lf.x); dd.y = __expf(lf.y); dd.z = __expf(lf.z); dd.w = __expf(lf.w);
                LAS f32x4* vp = (LAS f32x4*)(buf + pt * 1280) + pj;
                vp[0] = -kk; vp[16] = dd; vp[32] = kk * af; vp[48] = kp; vp[64] = rf;
                LAS float* vv = (LAS float*)(buf + SC_VEC) + (2 * pj) * SC_VP + pt;
                vv[0] = bflo(rv); vv[SC_VP] = bfhi(rv);
            }
            if (cn + 1 < T / TC) SCAN_LOAD(cn + 1);
            __syncthreads();
            if (cn > 0) {
                const LAS float* yb = (const LAS float*)(lds + ((cn - 1) & 1) * SC_BUF + SC_VEC + SC_V + pt * 128) + 2 * pj;
                const size_t m_ = rowbase + (size_t)(cn - 1) * TC + pt;
                *(unsigned*)(Y + m_ * D + h * 64 + half * 32 + 2 * pj) = cvt_pk_bf16(yb[0], yb[1]);
            }
            const int rloc = wave * 4 + rg;
            LAS float* yrow = (LAS float*)(buf + SC_VEC + SC_V) + rloc;
            const unsigned va0 = (unsigned)(size_t)(buf + cc * 16), ra0 = (unsigned)(size_t)(buf + SC_VEC + rloc * SC_VP * 4);
#define SC_LD5(NK, DD, BE, KP, RF, AR, OFF) do { \
                asm volatile("ds_read_b128 %0, %1 offset:%2" : "=&v"(NK) : "v"(AR), "i"((OFF))); asm volatile("ds_read_b128 %0, %1 offset:%2" : "=&v"(DD) : "v"(AR), "i"((OFF) + 256)); \
                asm volatile("ds_read_b128 %0, %1 offset:%2" : "=&v"(BE) : "v"(AR), "i"((OFF) + 512)); asm volatile("ds_read_b128 %0, %1 offset:%2" : "=&v"(KP) : "v"(AR), "i"((OFF) + 768)); \
                asm volatile("ds_read_b128 %0, %1 offset:%2" : "=&v"(RF) : "v"(AR), "i"((OFF) + 1024)); } while (0)
            f32x4 nk, dd, be, kp, rf, nk1, dd1, be1, kp1, rf1, nk2, dd2, be2, kp2, rf2, vcur, vnxt;
            SC_LD5(nk, dd, be, kp, rf, va0, 0); SC_LD5(nk1, dd1, be1, kp1, rf1, va0, 1280);
            asm volatile("ds_read_b128 %0, %1" : "=&v"(vcur) : "v"(ra0));
            asm volatile("s_waitcnt lgkmcnt(0)" : "+v"(nk), "+v"(dd), "+v"(be), "+v"(kp), "+v"(rf), "+v"(nk1), "+v"(dd1), "+v"(be1), "+v"(kp1), "+v"(rf1), "+v"(vcur));
            vnxt = vcur;
            float sa;
            { f32x2 pa = S01 * (f32x2){nk.x, nk.y}; pa = S23 * (f32x2){nk.z, nk.w} + pa; sa = row16_sum(pa.x + pa.y); }
            float ykeep = 0.f;
#define SC_STEP(J, VSEL, LDV, VOFF, WAITN) do { \
                SC_LD5(nk2, dd2, be2, kp2, rf2, va8, ((J) + 2) * 1280); \
                if (LDV) asm volatile("ds_read_b128 %0, %1 offset:%2" : "=&v"(vnxt) : "v"(ra8), "i"((VOFF))); \
                asm volatile("s_waitcnt lgkmcnt(" #WAITN ")" : "+v"(nk1), "+v"(dd1), "+v"(be1), "+v"(kp1), "+v"(rf1)); \
                const float vv_ = (VSEL); \
                S01 = S01 * (f32x2){dd.x, dd.y} + (f32x2){be.x, be.y} * sa + (f32x2){kp.x, kp.y} * vv_; \
                S23 = S23 * (f32x2){dd.z, dd.w} + (f32x2){be.z, be.w} * sa + (f32x2){kp.z, kp.w} * vv_; \
                f32x2 pa_ = S01 * (f32x2){nk1.x, nk1.y}; pa_ = S23 * (f32x2){nk1.z, nk1.w} + pa_; \
                f32x2 py_ = S01 * (f32x2){rf.x, rf.y}; py_ = S23 * (f32x2){rf.z, rf.w} + py_; \
                float y_ = py_.x + py_.y, a2_ = pa_.x + pa_.y; \
                y_ = DPP_XADD(y_, 0xB1); a2_ = DPP_XADD(a2_, 0xB1); y_ = DPP_XADD(y_, 0x4E); a2_ = DPP_XADD(a2_, 0x4E); \
                y_ = DPP_XADD(y_, 0x141); a2_ = DPP_XADD(a2_, 0x141); y_ = DPP_XADD(y_, 0x140); a2_ = DPP_XADD(a2_, 0x140); \
                sa = a2_; \
                ykeep = __builtin_bit_cast(float, __builtin_amdgcn_update_dpp(__builtin_bit_cast(int, y_), __builtin_bit_cast(int, ykeep), 0x111, 0xF, 0xF, false));   \
                nk = nk1; dd = dd1; be = be1; kp = kp1; rf = rf1; nk1 = nk2; dd1 = dd2; be1 = be2; kp1 = kp2; rf1 = rf2; } while (0)
#pragma unroll 1
            for (int t8 = 0; t8 < TC; t8 += 8) {
                const unsigned va8 = va0 + (unsigned)t8 * 1280u, ra8 = ra0 + (unsigned)t8 * 4u;
                SC_STEP(0, vcur.x, 0, 0, 5); SC_STEP(1, vcur.y, 0, 0, 5); SC_STEP(2, vcur.z, 1, 16, 6); SC_STEP(3, vcur.w, 0, 0, 5);
                asm volatile("" : "+v"(vnxt)); vcur = vnxt;
                SC_STEP(4, vcur.x, 0, 0, 5); SC_STEP(5, vcur.y, 0, 0, 5); SC_STEP(6, vcur.z, 1, 32, 6); SC_STEP(7, vcur.w, 0, 0, 5);
                asm volatile("" : "+v"(vnxt)); vcur = vnxt;
                if (t8 & 8) yrow[(t8 + 7 - cc) * 32] = ykeep;
            }
            asm volatile("s_waitcnt lgkmcnt(0)" ::: "memory");
#undef SC_STEP
#undef SC_LD5
        }
        __syncthreads();
        {
            const int cn = T / TC;
            const LAS float* yb = (const LAS float*)(lds + ((cn - 1) & 1) * SC_BUF + SC_VEC + SC_V + pt * 128) + 2 * pj;
            const size_t m_ = rowbase + (size_t)(cn - 1) * TC + pt;
            *(unsigned*)(Y + m_ * D + h * 64 + half * 32 + 2 * pj) = cvt_pk_bf16(yb[0], yb[1]);
        }
        __syncthreads();
    }
#undef SCAN_LOAD
}
#endif
__device__ __forceinline__ void gn_phase(bf16_t* Y, const bf16_t* R, const bf16_t* Kb, const bf16_t* V, const bf16_t* Z, const bf16_t* WA, const float* k_a, const float* r_k, const float* gn_g, const float* gn_b, int G, int bid, int tid) {
    const int wave = __builtin_amdgcn_readfirstlane(tid >> 6), lane = tid & 63;
    const int gw = bid * NWAVES + wave, NGW = G * NWAVES;
    const int col = lane * 16;
    f32x4 kaq[4], rkq[4], ggq[4], gbq[4];
#pragma unroll
    for (int q = 0; q < 4; ++q) { kaq[q] = *(const f32x4*)(k_a + col + 4 * q); rkq[q] = *(const f32x4*)(r_k + col + 4 * q); ggq[q] = *(const f32x4*)(gn_g + col + 4 * q); gbq[q] = *(const f32x4*)(gn_b + col + 4 * q); }
    u32x4 ry_[2], rr_[2], rk_[2], rv_[2], rz_[2], ra_[2];
#define GN_LOAD(mm) do { const size_t off_ = (size_t)(mm) * D + col; _Pragma("unroll") for (int j = 0; j < 2; ++j) { ry_[j] = *(const u32x4*)(Y + off_ + 8 * j); rr_[j] = *(const u32x4*)(R + off_ + 8 * j); \
        rk_[j] = *(const u32x4*)(Kb + off_ + 8 * j); rv_[j] = *(const u32x4*)(V + off_ + 8 * j); rz_[j] = *(const u32x4*)(Z + off_ + 8 * j); ra_[j] = *(const u32x4*)(WA + (size_t)(mm) * 2048 + 1024 + col + 8 * j); } } while (0)
    if (gw < M) GN_LOAD(gw);
    for (int m = gw; m < M; m += NGW) {
        const size_t off = (size_t)m * D + col;
        f32x4 y[4], r[4], k[4], v[4], z[4], aa[4];
#pragma unroll
        for (int j = 0; j < 2; ++j) { unpack8(ry_[j], y[2 * j], y[2 * j + 1]); unpack8(rr_[j], r[2 * j], r[2 * j + 1]); unpack8(rk_[j], k[2 * j], k[2 * j + 1]);
            unpack8(rv_[j], v[2 * j], v[2 * j + 1]); unpack8(rz_[j], z[2 * j], z[2 * j + 1]); unpack8(ra_[j], aa[2 * j], aa[2 * j + 1]); }
        if (m + NGW < M) GN_LOAD(m + NGW);
        float s = 0.f, bs = 0.f;
#pragma unroll
        for (int q = 0; q < 4; ++q) {
            s += (y[q].x + y[q].y) + (y[q].z + y[q].w);
            const f32x4 kp = k[q] * (1.0f + (aa[q] - 1.0f) * kaq[q]);
            const f32x4 t = r[q] * kp * rkq[q];
            bs += (t.x + t.y) + (t.z + t.w);
        }
        s += __shfl_xor(s, 1); s += __shfl_xor(s, 2); bs += __shfl_xor(bs, 1); bs += __shfl_xor(bs, 2);
        const float mean = s * (1.0f / 64.0f);
        float q2 = 0.f;
#pragma unroll
        for (int q = 0; q < 4; ++q) { const f32x4 dlt = y[q] - mean; q2 += (dlt.x * dlt.x + dlt.y * dlt.y) + (dlt.z * dlt.z + dlt.w * dlt.w); }
        q2 += __shfl_xor(q2, 1); q2 += __shfl_xor(q2, 2);
        const float rstd = 1.0f / sqrtf(q2 * (1.0f / 64.0f) + 64e-5f);
        f32x4 o[4];
#pragma unroll
        for (int q = 0; q < 4; ++q) {
            const f32x4 yn = (y[q] - mean) * rstd * ggq[q] + gbq[q] + bs * v[q];
#pragma unroll
            for (int e = 0; e < 4; ++e) o[q][e] = yn[e] * z[q][e] * fsigmoid(z[q][e]);
        }
        *(u32x4*)(Y + off) = pack8(o[0], o[1]); *(u32x4*)(Y + off + 8) = pack8(o[2], o[3]);
    }
}
__device__ __forceinline__ void final_norm_phase(const bf16_t* H2, float* out, const float* g, int G, int bid, int tid) {
    const int wave = __builtin_amdgcn_readfirstlane(tid >> 6), lane = tid & 63;
    const int gw = bid * NWAVES + wave, NGW = G * NWAVES;
    f32x4 gv[4];
#pragma unroll
    for (int j = 0; j < 2; ++j) { gv[2 * j] = *(const f32x4*)(g + j * 512 + lane * 8); gv[2 * j + 1] = *(const f32x4*)(g + j * 512 + lane * 8 + 4); }
    u32x4 rh_[2];
    if (gw < M) { rh_[0] = *(const u32x4*)(H2 + (size_t)gw * D + lane * 8); rh_[1] = *(const u32x4*)(H2 + (size_t)gw * D + 512 + lane * 8); }
    for (int m = gw; m < M; m += NGW) {
        f32x4 v[4]; float s = 0.f;
        unpack8(rh_[0], v[0], v[1]); unpack8(rh_[1], v[2], v[3]);
        if (m + NGW < M) { rh_[0] = *(const u32x4*)(H2 + (size_t)(m + NGW) * D + lane * 8); rh_[1] = *(const u32x4*)(H2 + (size_t)(m + NGW) * D + 512 + lane * 8); }
#pragma unroll
        for (int q = 0; q < 4; ++q) s += (v[q].x * v[q].x + v[q].y * v[q].y) + (v[q].z * v[q].z + v[q].w * v[q].w);
        const float rstd = 1.0f / sqrtf(wave_sum(s) * (1.0f / D) + 1e-6f);
#pragma unroll
        for (int j = 0; j < 2; ++j) { float* o = out + (size_t)m * D + j * 512 + lane * 8; *(f32x4*)o = v[2 * j] * rstd * gv[2 * j]; *(f32x4*)(o + 4) = v[2 * j + 1] * rstd * gv[2 * j + 1]; }
    }
}
#ifndef MK_PER_PHASE
#define MK_PER_PHASE 0
#endif
constexpr int NPHASE = 15;
#ifndef MK_REP_PHASE
#define MK_REP_PHASE -1
#endif
#ifndef MK_REP_N
#define MK_REP_N 2
#endif
#define REPS(k) ((k) == MK_REP_PHASE ? MK_REP_N : 1)

__global__ void __launch_bounds__(NTHR, 2) hybrid_fwd(Args a) {
    extern __shared__ __attribute__((aligned(16))) unsigned char lds_raw[];
    LAS unsigned char* lds = (LAS unsigned char*)lds_raw;
    cg::grid_group grid = cg::this_grid();
    const int wave_s = __builtin_amdgcn_readfirstlane((int)threadIdx.x >> 6);
    const int bid = blockIdx.x, G = gridDim.x;
#define TID() int lane_v_; asm volatile("v_mbcnt_lo_u32_b32 %0, -1, 0\n\tv_mbcnt_hi_u32_b32 %0, -1, %0" : "=v"(lane_v_)); const int tid = wave_s * 64 + lane_v_
    { TID(); if (tid < 16) ((LAS unsigned*)(lds + LDS_BYTES - 64))[tid] = 0u; __syncthreads();
#if !MK_PER_PHASE
      kptr_t kpb = kargs(); (void)xcd_barrier_post((unsigned*)(kws(kpb) + WS_CTL), (volatile LAS unsigned*)(lds + LDS_BYTES - 64), tid);
#endif
    }
    int lo, hi; { kptr_t kp0 = kargs(); lo = *(const int __attribute__((address_space(4)))*)(kp0 + 8 * 26); hi = *(const int __attribute__((address_space(4)))*)(kp0 + 8 * 26 + 4); }
#ifndef PH_MASK
#define PH_MASK 0x7fff
#endif
#define IN(k) (((PH_MASK >> (k)) & 1) && lo <= (k) && (k) < hi)
#define SEAM(k) do { if (IN(k) && IN((k) + 1)) { if ((k) == 0) grid.sync(); else { TID(); kptr_t kpb = kargs(); XcdBarrier xb_; xb_.bar = (unsigned*)(kws(kpb) + WS_CTL); xb_.x = xb_xcc_id(); xb_.st = (volatile LAS unsigned*)(lds + LDS_BYTES - 64); xcd_barrier(xb_, tid); } } } while (0)
#define PTRS() kptr_t kp = kargs(); unsigned char* ws = kws(kp); (void)ws
#define S1 ((bf16_t*)(ws + WS_S1))
#define S2 ((bf16_t*)(ws + WS_S2))
#define S3 ((bf16_t*)(ws + WS_S3))
#define S4 ((bf16_t*)(ws + WS_S4))
#define QKVZ ((bf16_t*)(ws + WS_QKVZ))
#define XS0 ((bf16_t*)(ws + WS_XS0))
#define XS1 ((bf16_t*)(ws + WS_XS1))
#define WAb ((bf16_t*)(ws + WS_WA))
#define A2 ((bf16_t*)(ws + WS_A2))
#define Lb ((bf16_t*)(ws + WS_L))
#define Kr ((bf16_t*)kout(kp))
#define Vr ((bf16_t*)kout(kp) + (size_t)M * D)
#define WR ((const bf16_t*)(ws + WS_WR))

    if (IN(0)) for (int rep_ = 0; rep_ < REPS(0); ++rep_) { TID(); p0_prologue(lds, G, bid, tid); }
    SEAM(0);
    if (IN(1)) for (int rep_ = 0; rep_ < REPS(1); ++rep_) { TID(); PTRS();
        { pg8::Gemm g{S1, (const bf16_t*)(ws + WS_WQKVZ), M, ATT_IN, D}; pg8::StaticOrder S; S.init(M, ATT_IN, G, bid);
          pg8::EpiQKVZ E{QKVZ, (const float*)(ws + WS_BIAS), (const float*)(ws + WS_COS), (const float*)(ws + WS_SIN)};
          pg8::gemm_phase<pg8::EpiQKVZ, pg8::StaticOrder, true, true>(lds, g, S, E, tid); }
        __syncthreads();
        { pg8::Gemm g{(const bf16_t*)(ws + WS_PB0), (const bf16_t*)(ws + WS_WP0), M, D, PLE}; pg8::StaticOrder S; S.init(M, D, G, bid);
          pg8::EpiStore E{S2, D};
          pg8::gemm_phase<pg8::EpiStore, pg8::StaticOrder, true, true>(lds, g, S, E, tid); }
    }
    SEAM(1);
    if (IN(2)) for (int rep_ = 0; rep_ < REPS(2); ++rep_) { TID(); PTRS(); attn_phase(lds, QKVZ, kin(kp, I_ASINK), S1, G, bid, tid); }
    SEAM(2);
    if (IN(3)) for (int rep_ = 0; rep_ < REPS(3); ++rep_) { TID(); PTRS();
        pg8::Gemm g{S1, (const bf16_t*)(ws + WS_WO0), M, D, D}; pg8::StaticOrder S; S.init(M, D, G, bid);
        pg8::EpiRes<false> E{(const void*)kin(kp, I_X), S3};
        pg8::gemm_phase<pg8::EpiRes<false>, pg8::StaticOrder, true, true>(lds, g, S, E, tid);
    }
    SEAM(3);
    if (IN(4)) for (int rep_ = 0; rep_ < REPS(4); ++rep_) { TID(); PTRS();
        pg8::Gemm g{S3, (const bf16_t*)(ws + WS_WG0), M, D, D}; pg8::StaticOrder S; S.init(M, D, G, bid);
        pg8::EpiGate<false> E{S3, S2, (void*)S4};
        pg8::gemm_phase<pg8::EpiGate<false>, pg8::StaticOrder, true, true>(lds, g, S, E, tid);
    }
    SEAM(4);
    if (IN(5)) for (int rep_ = 0; rep_ < REPS(5); ++rep_) { TID(); PTRS(); lerp_phase<0>(S4, kin(kp, I_NORMG) + D, kin(kp, I_MU), S1, XS0, XS1, G, bid, tid); }
    SEAM(5);
    if (IN(6)) for (int rep_ = 0; rep_ < REPS(6); ++rep_) { TID(); PTRS();
        { pg8::Gemm g{XS0, WR, M, 2 * D, D, XS1, 4}; pg8::StaticOrder S; S.init(M, 2 * D, G, bid); pg8::EpiStore2 E{S3, Kr, 4, D};
          pg8::gemm_phase<pg8::EpiStore2, pg8::StaticOrder, true, true>(lds, g, S, E, tid); }
        __syncthreads();
        { pg8::Gemm g{S1, (const bf16_t*)(ws + WS_WL), M, 256, D}; pg8::StaticOrder S; S.init(M, 256, G, bid); pg8::EpiStore E{Lb, 256};
          pg8::gemm_phase<pg8::EpiStore, pg8::StaticOrder, true, true>(lds, g, S, E, tid); }
    }
    SEAM(6);
    if (IN(7)) for (int rep_ = 0; rep_ < REPS(7); ++rep_) { TID(); PTRS(); lerp_phase<1>(S4, kin(kp, I_NORMG) + D, kin(kp, I_MU), nullptr, XS0, XS1, G, bid, tid); lora_mid_phase(Lb, A2, G, bid, tid); }
    SEAM(7);
    if (IN(8)) for (int rep_ = 0; rep_ < REPS(8); ++rep_) { TID(); PTRS();
        { pg8::Gemm g{XS0, WR + (size_t)2 * D * D, M, 2 * D, D, XS1, 4}; pg8::StaticOrder S; S.init(M, 2 * D, G, bid); pg8::EpiStore2 E{Vr, S2, 4, D};
          pg8::gemm_phase<pg8::EpiStore2, pg8::StaticOrder, true, true>(lds, g, S, E, tid); }
    }
    SEAM(8);
    if (IN(9)) for (int rep_ = 0; rep_ < REPS(9); ++rep_) { TID(); PTRS();
        pg8::Gemm g{A2, (const bf16_t*)(ws + WS_W2), M, 2048, 128}; pg8::StaticOrder S; S.init(M, 2048, G, bid);
        pg8::EpiWA E{WAb, kin(kp, I_W0), kin(kp, I_A0)};
        pg8::gemm_phase<pg8::EpiWA, pg8::StaticOrder, true, true>(lds, g, S, E, tid);
    }
    SEAM(9);
    if (IN(10)) for (int rep_ = 0; rep_ < REPS(10); ++rep_) { TID(); PTRS(); scan_phase(lds, S3, Kr, Vr, WAb, kin(kp, I_KK), kin(kp, I_KA), S1, G, bid, tid); }
    SEAM(10);
    if (IN(11)) for (int rep_ = 0; rep_ < REPS(11); ++rep_) { TID(); PTRS(); gn_phase(S1, S3, Kr, Vr, S2, WAb, kin(kp, I_KA), kin(kp, I_RK), kin(kp, I_GNG), kin(kp, I_GNB), G, bid, tid); }
    SEAM(11);
    if (IN(12)) for (int rep_ = 0; rep_ < REPS(12); ++rep_) { TID(); PTRS();
        { pg8::Gemm g{S1, (const bf16_t*)(ws + WS_WO1), M, D, D}; pg8::StaticOrder S; S.init(M, D, G, bid); pg8::EpiRes<true> E{(const void*)S4, S3};
          pg8::gemm_phase<pg8::EpiRes<true>, pg8::StaticOrder, true, true>(lds, g, S, E, tid); }
        __syncthreads();
        { pg8::Gemm g{(const bf16_t*)(ws + WS_PB1), (const bf16_t*)(ws + WS_WP1), M, D, PLE}; pg8::StaticOrder S; S.init(M, D, G, bid); pg8::EpiStore E{S2, D};
          pg8::gemm_phase<pg8::EpiStore, pg8::StaticOrder, true, true>(lds, g, S, E, tid); }
    }
    SEAM(12);
    if (IN(13)) for (int rep_ = 0; rep_ < REPS(13); ++rep_) { TID(); PTRS();
        pg8::Gemm g{S3, (const bf16_t*)(ws + WS_WG1), M, D, D}; pg8::StaticOrder S; S.init(M, D, G, bid);
        pg8::EpiGate<false> E{S3, S2, (void*)S1};
        pg8::gemm_phase<pg8::EpiGate<false>, pg8::StaticOrder, true, true>(lds, g, S, E, tid);
    }
    SEAM(13);
    if (IN(14)) for (int rep_ = 0; rep_ < REPS(14); ++rep_) { TID(); PTRS(); final_norm_phase(S1, kout(kp), kin(kp, I_FNG), G, bid, tid); }
#undef IN
#undef SEAM
}

extern "C" void kernel_launch(void* const* d_in, const int* in_sizes, int n_in, void* d_out, int out_size, void* d_ws, size_t ws_size, hipStream_t stream) {
    static int grid = 0;
    if (grid == 0) {
        if (n_in != 24 || out_size != M * D || ws_size < WS_END) { fprintf(stderr, "kernel_launch: unexpected shapes (n_in %d, out %d, ws %zu)\n", n_in, out_size, ws_size); grid = -1; return; }
        int dev = 0, cus = 0, per_cu = 0;
        (void)hipGetDevice(&dev); (void)hipDeviceGetAttribute(&cus, hipDeviceAttributeMultiprocessorCount, dev);
        if (hipFuncSetAttribute((const void*)hybrid_fwd, hipFuncAttributeMaxDynamicSharedMemorySize, LDS_BYTES) != hipSuccess) { fprintf(stderr, "kernel_launch: hipFuncSetAttribute failed\n"); grid = -1; return; }
        if (hipOccupancyMaxActiveBlocksPerMultiprocessor(&per_cu, (const void*)hybrid_fwd, NTHR, LDS_BYTES) != hipSuccess || per_cu < 1) { fprintf(stderr, "kernel_launch: occupancy query reports %d\n", per_cu); per_cu = 1; }
        (void)hipGetLastError();
        grid = cus > 0 ? cus : 256;
    }
    if (grid < 0) return;
    Args a{};
    for (int i = 0; i < 24; ++i) a.in[i] = (const float*)d_in[i];
    a.out = (float*)d_out; a.ws = (unsigned char*)d_ws;
#if MK_PER_PHASE
    for (int ph = 0; ph < NPHASE; ++ph) { a.ph_lo = ph; a.ph_hi = ph + 1; hipLaunchKernelGGL(hybrid_fwd, dim3(grid), dim3(NTHR), LDS_BYTES, stream, a); }
#else
    a.ph_lo = 0; a.ph_hi = NPHASE;
    (void)hipMemsetAsync((unsigned char*)d_ws + WS_CTL, 0, 16384, stream);
    void* args[] = {&a};
    hipError_t e = hipLaunchCooperativeKernel((const void*)hybrid_fwd, dim3(grid), dim3(NTHR), args, LDS_BYTES, stream);
    if (e != hipSuccess) fprintf(stderr, "cooperative launch failed: %s (grid %d)\n", hipGetErrorString(e), grid);
#endif
}
```

```cpp
#include <hip/hip_runtime.h>
#include <hip/hip_cooperative_groups.h>
#include <cstdio>
#include <cstdint>
namespace cg = cooperative_groups;
namespace pg8 {
#define PG8_LAS __attribute__((address_space(3)))
typedef unsigned short bf16_t;
typedef short bf16x8 __attribute__((ext_vector_type(8)));
typedef float f32x4 __attribute__((ext_vector_type(4)));
typedef unsigned u32x4 __attribute__((ext_vector_type(4)));
constexpr int BM = 256, BK = 64, HALF = 128, HTB = HALF * BK * 2  , STAGE_BYTES = 8 * HTB, NXCD = 8, WGM = 8;

__host__ __device__ __forceinline__ int lds_byte(int r, int c) { const int st = (r >> 4) * 2 + (c >> 5), rr = r & 15, cc = c & 31, ob = rr * 64 + cc * 2; return st * 1024 + (ob ^ (((ob >> 9) & 1) << 5)); }
__host__ __device__ __forceinline__ void stage_rc(int b, int& R, int& C) { const int st = b / 1024, sb = b % 1024, swz = sb ^ (((sb >> 9) & 1) << 5); R = (st >> 1) * 16 + swz / 64; C = (st & 1) * 32 + (swz % 64) / 2; }
__host__ __device__ __forceinline__ int perm32(int rho) { const int n = rho >> 4, i = rho & 15; return 8 * (i >> 2) + 4 * n + (i & 3); }

struct Unit { int pm, pn; };
struct Gemm { const bf16_t* A; const bf16_t* Bt; int M, N, K; const bf16_t* A2 = nullptr; int nsplit = 1 << 30;
    __host__ __device__ __forceinline__ const bf16_t* asel(int pn) const { return pn < nsplit ? A : A2; } };

struct StaticOrder {
    int nM, nN, nwg, G, c;
    __host__ __device__ void init(int M, int N, int G_, int c_) { nM = M / BM; nN = N / BM; nwg = nM * nN; G = G_; c = c_; }
    __host__ __device__ bool next(int i, Unit& u) const {
        const long L = (long)i * G + c; if (L >= nwg) return false;
        int wgid = (int)L; { const int q = nwg / NXCD, r = nwg % NXCD, xcd = wgid % NXCD, off = wgid / NXCD; wgid = (xcd < r ? xcd * (q + 1) : r * (q + 1) + (xcd - r) * q) + off; }
        const int nig = WGM * nN, gid = wgid / nig, fm = gid * WGM, gsz = (nM - fm) < WGM ? (nM - fm) : WGM;
        u.pm = fm + ((wgid % nig) % gsz); u.pn = (wgid % nig) / gsz; return true;
    }
    __device__ __forceinline__ void a_ready(const Unit&) const {}
    __device__ __forceinline__ void done(const Unit&) const {}
};

__device__ __forceinline__ unsigned cvt_pk_bf16(float lo, float hi) { unsigned r; asm volatile("v_cvt_pk_bf16_f32 %0, %1, %2" : "=v"(r) : "v"(lo), "v"(hi)); return r; }
typedef float f32x2 __attribute__((ext_vector_type(2)));
__device__ __forceinline__ float bf2f(unsigned short b) { return __uint_as_float((unsigned)b << 16); }
__device__ __forceinline__ float bflo(unsigned w) { return __uint_as_float(w << 16); }
__device__ __forceinline__ float bfhi(unsigned w) { return __uint_as_float(w & 0xffff0000u); }
__device__ __forceinline__ float fsigmoid(float x) { return __builtin_amdgcn_rcpf(1.0f + __expf(-x)); }
__device__ __forceinline__ u32x4 pack8(const f32x4 a, const f32x4 b) { u32x4 w; w.x = cvt_pk_bf16(a[0], a[1]); w.y = cvt_pk_bf16(a[2], a[3]); w.z = cvt_pk_bf16(b[0], b[1]); w.w = cvt_pk_bf16(b[2], b[3]); return w; }
__device__ __forceinline__ void unpack8(const u32x4 w, f32x4& a, f32x4& b) { a = (f32x4){bflo(w.x), bfhi(w.x), bflo(w.y), bfhi(w.y)}; b = (f32x4){bflo(w.z), bfhi(w.z), bflo(w.w), bfhi(w.w)}; }

constexpr float QSCALE = 0.125f * 1.4426950408889634f;

struct EpiQKVZ {
    static constexpr bool PERM = true, AFTER_DRAIN = false;
    bf16_t* O; const float* bias; const float* cs; const float* sn;
    __device__ __forceinline__ void operator()(const f32x4 (&acc)[2][2][4][2], const Unit& u, int wr, int wc, int fr, int fq) const {
        const int row0 = u.pm * BM + wr * 64 + fr, col0 = u.pn * BM + wc * 32 + 8 * fq;
        const bool rope = u.pn < 5; const float sc = u.pn < 4 ? QSCALE : 1.0f;
        const int j4 = 4 * (4 * (wc & 1) + fq);
#pragma unroll
        for (int ai = 0; ai < 2; ++ai)
#pragma unroll
            for (int m = 0; m < 4; ++m) {
                const int row = row0 + ai * HALF + m * 16, pos = row & 4095;
                f32x4 c = (f32x4){1.f, 1.f, 1.f, 1.f}, s = (f32x4){0.f, 0.f, 0.f, 0.f};
                if (rope) { c = *(const f32x4*)(cs + pos * 32 + j4); s = *(const f32x4*)(sn + pos * 32 + j4); }
                bf16_t* rowp = O + (size_t)row * 2560 + col0;
#pragma unroll
                for (int bj = 0; bj < 2; ++bj) {
                    const f32x4 v0 = acc[ai][bj][m][0] + *(const f32x4*)(bias + col0 + bj * HALF), v1 = acc[ai][bj][m][1] + *(const f32x4*)(bias + col0 + bj * HALF + 4);
                    f32x4 o0 = v0, o1 = v1;
                    o0 = (v0 * c - v1 * s) * sc; o1 = (v1 * c + v0 * s) * sc;
                    *(u32x4*)(rowp + bj * HALF) = pack8(o0, o1);
                }
            }
    }
};
struct EpiStore {
    static constexpr bool PERM = true, AFTER_DRAIN = false;
    bf16_t* O; int ldc;
    __device__ __forceinline__ void operator()(const f32x4 (&acc)[2][2][4][2], const Unit& u, int wr, int wc, int fr, int fq) const {
        const int row0 = u.pm * BM + wr * 64 + fr, col0 = u.pn * BM + wc * 32 + 8 * fq;
#pragma unroll
        for (int ai = 0; ai < 2; ++ai)
#pragma unroll
            for (int m = 0; m < 4; ++m) { bf16_t* rowp = O + (size_t)(row0 + ai * HALF + m * 16) * ldc + col0;
#pragma unroll
                for (int bj = 0; bj < 2; ++bj) *(u32x4*)(rowp + bj * HALF) = pack8(acc[ai][bj][m][0], acc[ai][bj][m][1]); }
    }
};
struct EpiStore2 {
    static constexpr bool PERM = true, AFTER_DRAIN = false;
    bf16_t* O1; bf16_t* O2; int nsplit; int ldc;
    __device__ __forceinline__ void operator()(const f32x4 (&acc)[2][2][4][2], const Unit& u, int wr, int wc, int fr, int fq) const {
        const bool first = u.pn < nsplit; bf16_t* O = first ? O1 : O2;
        const int row0 = u.pm * BM + wr * 64 + fr, col0 = (first ? u.pn : u.pn - nsplit) * BM + wc * 32 + 8 * fq;
#pragma unroll
        for (int ai = 0; ai < 2; ++ai)
#pragma unroll
            for (int m = 0; m < 4; ++m) { bf16_t* rowp = O + (size_t)(row0 + ai * HALF + m * 16) * ldc + col0;
#pragma unroll
                for (int bj = 0; bj < 2; ++bj) *(u32x4*)(rowp + bj * HALF) = pack8(acc[ai][bj][m][0], acc[ai][bj][m][1]); }
    }
};
template <bool BF> struct EpiRes {
    static constexpr bool PERM = true, AFTER_DRAIN = false;
    const void* base; bf16_t* O;
    __device__ __forceinline__ void operator()(const f32x4 (&acc)[2][2][4][2], const Unit& u, int wr, int wc, int fr, int fq) const {
        const int row0 = u.pm * BM + wr * 64 + fr, col0 = u.pn * BM + wc * 32 + 8 * fq;
#pragma unroll
        for (int ai = 0; ai < 2; ++ai)
#pragma unroll
            for (int m = 0; m < 4; ++m) { const size_t off = (size_t)(row0 + ai * HALF + m * 16) * 1024 + col0;
#pragma unroll
                for (int bj = 0; bj < 2; ++bj) { f32x4 b0, b1;
                    if (BF) { unpack8(*(const u32x4*)((const bf16_t*)base + off + bj * HALF), b0, b1); }
                    else { b0 = *(const f32x4*)((const float*)base + off + bj * HALF); b1 = *(const f32x4*)((const float*)base + off + bj * HALF + 4); }
                    *(u32x4*)(O + off + bj * HALF) = pack8(b0 + acc[ai][bj][m][0], b1 + acc[ai][bj][m][1]); } }
    }
};
template <bool F32OUT> struct EpiGate {
    static constexpr bool PERM = true, AFTER_DRAIN = false;
    const bf16_t* hpre; const bf16_t* pp; void* O;
    __device__ __forceinline__ void operator()(const f32x4 (&acc)[2][2][4][2], const Unit& u, int wr, int wc, int fr, int fq) const {
        const int row0 = u.pm * BM + wr * 64 + fr, col0 = u.pn * BM + wc * 32 + 8 * fq;
#pragma unroll
        for (int ai = 0; ai < 2; ++ai)
#pragma unroll
            for (int m = 0; m < 4; ++m) { const size_t off = (size_t)(row0 + ai * HALF + m * 16) * 1024 + col0;
#pragma unroll
                for (int bj = 0; bj < 2; ++bj) { f32x4 h0, h1, p0, p1;
                    unpack8(*(const u32x4*)(hpre + off + bj * HALF), h0, h1); unpack8(*(const u32x4*)(pp + off + bj * HALF), p0, p1);
                    f32x4 g0, g1;
#pragma unroll
                    for (int e = 0; e < 4; ++e) { g0[e] = fsigmoid(acc[ai][bj][m][0][e]); g1[e] = fsigmoid(acc[ai][bj][m][1][e]); }
                    const f32x4 o0 = h0 + g0 * p0, o1 = h1 + g1 * p1;
                    if (F32OUT) { *(f32x4*)((float*)O + off + bj * HALF) = o0; *(f32x4*)((float*)O + off + bj * HALF + 4) = o1; }
                    else *(u32x4*)((bf16_t*)O + off + bj * HALF) = pack8(o0, o1); } }
    }
};
struct EpiWA {
    static constexpr bool PERM = true, AFTER_DRAIN = false;
    bf16_t* O; const float* w0; const float* a0;
    __device__ __forceinline__ void operator()(const f32x4 (&acc)[2][2][4][2], const Unit& u, int wr, int wc, int fr, int fq) const {
        const int row0 = u.pm * BM + wr * 64 + fr, col0 = u.pn * BM + wc * 32 + 8 * fq;
        const bool isw = u.pn < 4; const float* bvec = isw ? (w0 + col0) : (a0 + col0 - 1024); const float mul = isw ? -0.6065306597126334f : 1.0f;
#pragma unroll
        for (int ai = 0; ai < 2; ++ai)
#pragma unroll
            for (int m = 0; m < 4; ++m) { bf16_t* rowp = O + (size_t)(row0 + ai * HALF + m * 16) * 2048 + col0;
#pragma unroll
                for (int bj = 0; bj < 2; ++bj) { f32x4 o0, o1; const f32x4 b0 = *(const f32x4*)(bvec + bj * HALF), b1 = *(const f32x4*)(bvec + bj * HALF + 4);
#pragma unroll
                    for (int e = 0; e < 4; ++e) { o0[e] = mul * fsigmoid(acc[ai][bj][m][0][e] + b0[e]); o1[e] = mul * fsigmoid(acc[ai][bj][m][1][e] + b1[e]); }
                    *(u32x4*)(rowp + bj * HALF) = pack8(o0, o1); } }
    }
};
template <class Epi, class Sched, bool ALIGN_EPI = false, bool SP2 = false>
__device__ __forceinline__ void gemm_phase(PG8_LAS unsigned char* lds, const Gemm g, const Sched& S, const Epi& E, const int tid_in) {
    const int tid = tid_in, wid = __builtin_amdgcn_readfirstlane(tid >> 6), lane = tid & 63, wr = wid >> 2, wc = wid & 3, fr = lane & 15, fq = lane >> 4;
    const int K = g.K, nt = K / BK;
    unsigned voffA[2], voffB[2];
#pragma unroll
    for (int i = 0; i < 2; ++i) { int R, C; stage_rc(tid * 16 + i * 8192, R, C); const int Rb = Epi::PERM ? ((R & ~31) + perm32(R & 31)) : R;
        voffA[i] = (unsigned)(R * K + C) * 2u; voffB[i] = (unsigned)(Rb * K + C) * 2u; }
    const size_t kstep = (size_t)(BK * 2);
    const size_t hstep = (size_t)HALF * K * 2;
    const size_t tstep = 2 * hstep;
    const unsigned ldsw = (unsigned)wid * 1024u;
    const int aoff = lds_byte(wr * 64 + fr, fq * 8), boff = lds_byte(wc * 32 + fr, fq * 8);
#define PG8_SA(b, h) (((b) * 2 + (h)) * HTB)
#define PG8_SB(b, h) ((4 + (b) * 2 + (h)) * HTB)
#define PG8_STAGE(bufoff, gbase, voff) do { _Pragma("unroll") for (int _i = 0; _i < 2; ++_i) \
        __builtin_amdgcn_global_load_lds((const unsigned*)((const char*)(gbase) + (voff)[_i]), (PG8_LAS unsigned*)(lds + (bufoff) + ldsw + _i * 8192), 16, 0, 0); } while (0)
#define PG8_LDA(dst, b, h) do { _Pragma("unroll") for (int m = 0; m < 4; ++m) _Pragma("unroll") for (int k = 0; k < 2; ++k) dst[m][k] = *(const PG8_LAS bf16x8*)(lds + PG8_SA(b, h) + aoff + m * 2048 + k * 1024); } while (0)
#define PG8_LDB(dst, b, h) do { _Pragma("unroll") for (int n = 0; n < 2; ++n) _Pragma("unroll") for (int k = 0; k < 2; ++k) dst[n][k] = *(const PG8_LAS bf16x8*)(lds + PG8_SB(b, h) + boff + n * 2048 + k * 1024); } while (0)
#define PG8_MMA(ai, bj, At, Bt) do { __builtin_amdgcn_s_setprio(1); _Pragma("unroll") for (int m = 0; m < 4; ++m) _Pragma("unroll") for (int n = 0; n < 2; ++n) _Pragma("unroll") for (int k = 0; k < 2; ++k) \
        acc[ai][bj][m][n] = __builtin_amdgcn_mfma_f32_16x16x32_bf16(Bt[n][k], At[m][k], acc[ai][bj][m][n], 0, 0, 0); __builtin_amdgcn_s_setprio(0); } while (0)
#define PG8_WAIT_V(n) asm volatile("s_waitcnt vmcnt(" #n ")" ::: "memory")
#define PG8_WAIT_L(n) asm volatile("s_waitcnt lgkmcnt(" #n ")" ::: "memory")
#define PG8_BAR __builtin_amdgcn_s_barrier()
#define PG8_SCHED __builtin_amdgcn_sched_barrier(0)
    Unit cur, nxt; int ui = 0;
    if (!S.next(0, cur)) return;
    f32x4 acc[2][2][4][2];
#pragma unroll
    for (int a = 0; a < 2; ++a)
#pragma unroll
        for (int b = 0; b < 2; ++b)
#pragma unroll
            for (int m = 0; m < 4; ++m)
#pragma unroll
                for (int n = 0; n < 2; ++n) acc[a][b][m][n] = (f32x4){0.f, 0.f, 0.f, 0.f};
    bf16x8 At[4][2], B0[2][2], B1[2][2];
    const char* cA = (const char*)g.asel(cur.pn) + (size_t)cur.pm * tstep; const char* cB = (const char*)g.Bt + (size_t)cur.pn * tstep;
    S.a_ready(cur);
    if constexpr (SP2) {
        PG8_STAGE(PG8_SB(0, 0), cB, voffB); PG8_STAGE(PG8_SB(0, 1), cB + hstep, voffB); PG8_STAGE(PG8_SA(0, 0), cA, voffA); PG8_STAGE(PG8_SA(0, 1), cA + hstep, voffA);
        if (wr == 1) PG8_BAR;
        PG8_WAIT_V(2); PG8_BAR;
        PG8_STAGE(PG8_SB(1, 0), cB + kstep, voffB); PG8_STAGE(PG8_SA(1, 0), cA + kstep, voffA); PG8_STAGE(PG8_SB(1, 1), cB + hstep + kstep, voffB);
        PG8_WAIT_V(6); PG8_BAR;
    } else {
        PG8_STAGE(PG8_SB(0, 0), cB, voffB); PG8_STAGE(PG8_SA(0, 0), cA, voffA); PG8_STAGE(PG8_SB(0, 1), cB + hstep, voffB); PG8_STAGE(PG8_SA(0, 1), cA + hstep, voffA);
        if (wr == 1) PG8_BAR;
        PG8_WAIT_V(4); PG8_BAR;
        PG8_STAGE(PG8_SB(1, 0), cB + kstep, voffB); PG8_STAGE(PG8_SA(1, 0), cA + kstep, voffA); PG8_STAGE(PG8_SB(1, 1), cB + hstep + kstep, voffB);
        PG8_WAIT_V(6); PG8_BAR;
    }
    for (;;) {
        const bool has_next = S.next(ui + 1, nxt);
        const char* nA = has_next ? (const char*)g.asel(nxt.pn) + (size_t)nxt.pm * tstep : cA; const char* nB = has_next ? (const char*)g.Bt + (size_t)nxt.pn * tstep : cB;
        for (int t = 0; t < nt; t += 2) {
            const bool last = (t == nt - 2);
            const char* a1 = cA + (size_t)(t + 1) * kstep;
            const char* a2 = last ? nA : cA + (size_t)(t + 2) * kstep; const char* b2 = last ? nB : cB + (size_t)(t + 2) * kstep;
            const char* a3 = a2 + kstep; const char* b3 = b2 + kstep;
            if (last && has_next) S.a_ready(nxt);
            if constexpr (SP2) {
            PG8_LDB(B0, 0, 0); PG8_LDB(B1, 0, 1); PG8_SCHED; PG8_LDA(At, 0, 0); PG8_STAGE(PG8_SA(1, 1), a1 + hstep, voffA);
            PG8_WAIT_V(8); PG8_WAIT_L(0); PG8_BAR; PG8_MMA(0, 0, At, B0); PG8_MMA(0, 1, At, B1); PG8_BAR; PG8_SCHED;
            PG8_LDA(At, 0, 1); PG8_STAGE(PG8_SB(0, 0), b2, voffB); PG8_STAGE(PG8_SB(0, 1), b2 + hstep, voffB); PG8_STAGE(PG8_SA(0, 0), a2, voffA);
            PG8_WAIT_V(8); PG8_WAIT_L(0); PG8_BAR; PG8_MMA(1, 0, At, B0); PG8_MMA(1, 1, At, B1); PG8_BAR; PG8_SCHED;
            PG8_LDB(B0, 1, 0); PG8_LDB(B1, 1, 1); PG8_SCHED; PG8_LDA(At, 1, 0); PG8_STAGE(PG8_SA(0, 1), a2 + hstep, voffA);
            PG8_WAIT_V(8); PG8_WAIT_L(0); PG8_BAR; PG8_MMA(0, 0, At, B0); PG8_MMA(0, 1, At, B1); PG8_BAR; PG8_SCHED;
            PG8_LDA(At, 1, 1); PG8_STAGE(PG8_SB(1, 0), b3, voffB); PG8_STAGE(PG8_SB(1, 1), b3 + hstep, voffB); PG8_STAGE(PG8_SA(1, 0), a3, voffA);
            PG8_WAIT_V(8); PG8_WAIT_L(0); PG8_BAR; PG8_MMA(1, 0, At, B0); PG8_MMA(1, 1, At, B1); PG8_BAR; PG8_SCHED;
            } else {
            PG8_LDB(B0, 0, 0); PG8_SCHED; PG8_LDA(At, 0, 0); PG8_STAGE(PG8_SA(1, 1), a1 + hstep, voffA);
            PG8_WAIT_L(8); PG8_BAR; PG8_WAIT_L(0); PG8_MMA(0, 0, At, B0); PG8_BAR; PG8_SCHED;
            PG8_LDB(B1, 0, 1); PG8_STAGE(PG8_SB(0, 0), b2, voffB);
            PG8_BAR; PG8_WAIT_L(0); PG8_MMA(0, 1, At, B1); PG8_BAR;
            PG8_LDA(At, 0, 1); PG8_STAGE(PG8_SA(0, 0), a2, voffA);
            PG8_BAR; PG8_WAIT_L(0); PG8_MMA(1, 0, At, B0); PG8_BAR; PG8_SCHED;
            PG8_STAGE(PG8_SB(0, 1), b2 + hstep, voffB);
            PG8_WAIT_V(6); PG8_BAR; PG8_MMA(1, 1, At, B1); PG8_BAR;
            PG8_LDB(B0, 1, 0); PG8_SCHED; PG8_LDA(At, 1, 0); PG8_STAGE(PG8_SA(0, 1), a2 + hstep, voffA);
            PG8_WAIT_L(8); PG8_BAR; PG8_WAIT_L(0); PG8_MMA(0, 0, At, B0); PG8_BAR; PG8_SCHED;
            PG8_LDB(B1, 1, 1); PG8_STAGE(PG8_SB(1, 0), b3, voffB);
            PG8_BAR; PG8_WAIT_L(0); PG8_MMA(0, 1, At, B1); PG8_BAR;
            PG8_LDA(At, 1, 1); PG8_STAGE(PG8_SA(1, 0), a3, voffA);
            PG8_BAR; PG8_WAIT_L(0); PG8_MMA(1, 0, At, B0); PG8_BAR; PG8_SCHED;
            PG8_STAGE(PG8_SB(1, 1), b3 + hstep, voffB);
            PG8_WAIT_V(6); PG8_BAR; PG8_MMA(1, 1, At, B1); PG8_BAR;
            }
        }
        if constexpr (ALIGN_EPI) { if (wr == 0) PG8_BAR; }
        if constexpr (!Epi::AFTER_DRAIN) { E(acc, cur, wr, wc, fr, fq); S.done(cur); }
        if (!has_next) break;
#pragma unroll
        for (int a = 0; a < 2; ++a)
#pragma unroll
            for (int b = 0; b < 2; ++b)
#pragma unroll
                for (int m = 0; m < 4; ++m)
#pragma unroll
                    for (int n = 0; n < 2; ++n) acc[a][b][m][n] = (f32x4){0.f, 0.f, 0.f, 0.f};
        cur = nxt; cA = nA; cB = nB; ++ui;
        if constexpr (ALIGN_EPI) { if (wr == 1) PG8_BAR; }
    }
    PG8_WAIT_V(0);
    if constexpr (!ALIGN_EPI) { if (wr == 0) PG8_BAR; }
    PG8_BAR;
    if constexpr (Epi::AFTER_DRAIN) { E.fused(acc, cur, wr, wc, fr, fq, lds, wid, lane); S.done(cur); }
#undef PG8_SA
#undef PG8_SB
#undef PG8_STAGE
#undef PG8_LDA
#undef PG8_LDB
#undef PG8_MMA
#undef PG8_WAIT_V
#undef PG8_WAIT_L
#undef PG8_BAR
#undef PG8_SCHED
}
}
using pg8::bf16_t; using pg8::bf16x8; using pg8::f32x4; using pg8::u32x4; using pg8::cvt_pk_bf16; using pg8::bf2f; using pg8::bflo; using pg8::bfhi; using pg8::fsigmoid; using pg8::pack8; using pg8::unpack8;
#define LAS __attribute__((address_space(3)))
typedef unsigned u32x2 __attribute__((ext_vector_type(2)));
typedef float f32x2 __attribute__((ext_vector_type(2)));

constexpr int NB = 8, T = 4096, D = 1024, M = NB * T, PLE = 256, ATT_IN = 2560;
constexpr int NWAVES = 8, NTHR = 512;
constexpr int LDS_BYTES = 147456;

constexpr size_t MiB = 1u << 20;
constexpr size_t WS_WQKVZ = 0;
constexpr size_t WS_WO0   = 5 * MiB;
constexpr size_t WS_WG0   = 7 * MiB;
constexpr size_t WS_WG1   = 9 * MiB;
constexpr size_t WS_WO1   = 11 * MiB;
constexpr size_t WS_WR    = 13 * MiB;
constexpr size_t WS_WP0   = 21 * MiB;
constexpr size_t WS_WP1   = 21 * MiB + 512 * 1024;
constexpr size_t WS_WL    = 22 * MiB;
constexpr size_t WS_W2    = 22 * MiB + 512 * 1024;
constexpr size_t WS_COS   = 23 * MiB;
constexpr size_t WS_SIN   = 23 * MiB + 512 * 1024;
constexpr size_t WS_BIAS  = 24 * MiB;
constexpr size_t WS_CTL   = 25 * MiB;
constexpr size_t WS_PB0   = 32 * MiB;
constexpr size_t WS_L     = 32 * MiB;
constexpr size_t WS_PB1   = 48 * MiB;
constexpr size_t WS_S1    = 64 * MiB;
constexpr size_t WS_QKVZ  = 128 * MiB;
constexpr size_t WS_XS0   = 128 * MiB, WS_XS1 = 192 * MiB, WS_WA = 128 * MiB, WS_A2 = 256 * MiB;
constexpr size_t WS_S2    = 288 * MiB;
constexpr size_t WS_S3    = 352 * MiB;
constexpr size_t WS_S4    = 416 * MiB;
constexpr size_t WS_END   = 480 * MiB;

__device__ __forceinline__ float wave_sum(float v) {
#pragma unroll
    for (int o = 1; o < 64; o <<= 1) v += __shfl_xor(v, o);
    return v;
}
__device__ __forceinline__ float dpp_add(float x, const int ctrl_dummy) { return x; }
#define DPP_XADD(x, ctrl) ((x) + __builtin_bit_cast(float, __builtin_amdgcn_update_dpp(0, __builtin_bit_cast(int, (x)), (ctrl), 0xF, 0xF, true)))
__device__ __forceinline__ float row16_sum(float x) {
    x = DPP_XADD(x, 0xB1);
    x = DPP_XADD(x, 0x4E);
    x = DPP_XADD(x, 0x141);
    x = DPP_XADD(x, 0x140);
    return x;
}

__device__ __forceinline__ void grid_bar(unsigned* ctr, unsigned target, int tid) {
    asm volatile("s_waitcnt vmcnt(0)" ::: "memory");
    __syncthreads();
    if (tid == 0) {
        __builtin_amdgcn_fence(__ATOMIC_RELEASE, "agent");
        asm volatile("s_waitcnt vmcnt(0)" ::: "memory");
        __hip_atomic_fetch_add(ctr, 1u, __ATOMIC_RELAXED, __HIP_MEMORY_SCOPE_AGENT);
        while (__hip_atomic_load(ctr, __ATOMIC_RELAXED, __HIP_MEMORY_SCOPE_AGENT) < target) __builtin_amdgcn_s_sleep(2);
        __builtin_amdgcn_fence(__ATOMIC_ACQUIRE, "agent");
        asm volatile("s_waitcnt vmcnt(0)" ::: "memory");
    }
    __syncthreads();
}
#define XB_TMO      128
#define XB_XCNT(j)  (256  + 64 * (j))
#define XB_XSUB(j)  (1280 + 64 * (j))
#define XB_XGEN(j)  (2304 + 64 * (j))
#define XB_TOP      3328
#define XB_TOPGEN   3392
#define XCD_BAR_WORDS 3456
#define XB_SPIN_CAP (1u << 18)

__device__ __forceinline__ unsigned xb_ld(unsigned* p)              { return __hip_atomic_load(p, __ATOMIC_RELAXED, __HIP_MEMORY_SCOPE_AGENT); }
__device__ __forceinline__ unsigned xb_add(unsigned* p, unsigned v) { return __hip_atomic_fetch_add(p, v, __ATOMIC_RELAXED, __HIP_MEMORY_SCOPE_AGENT); }
__device__ __forceinline__ unsigned xb_xcc_id() { return (unsigned)__builtin_amdgcn_s_getreg((3 << 11) | 20) & 0xFu; }
#define XB_SPIN(cond, bar) do { unsigned _sp = 0; while (cond) { __builtin_amdgcn_s_sleep(1); \
    if ((++_sp & 255u) == 0u) { if (xb_ld(&(bar)[XB_TMO])) break; if (_sp > XB_SPIN_CAP) { atomicAdd(&(bar)[XB_TMO], 1u); break; } } } } while (0)

struct XcdBarrier {
    unsigned* bar; unsigned x;
    volatile LAS unsigned* st;
};

__device__ __forceinline__ XcdBarrier xcd_barrier_post(unsigned* bar, volatile LAS unsigned* st, const int tid_) {
    XcdBarrier b; b.bar = bar; b.x = xb_xcc_id(); b.st = st;
    if (tid_ == 0) (void)xb_add(&bar[XB_XCNT(b.x)], 1u);
    return b;
}
__device__ __forceinline__ void xcd_barrier_complete(unsigned* bar, unsigned x, unsigned& nloc, unsigned& nx) {
    const unsigned G = gridDim.x * gridDim.y * gridDim.z;
    unsigned sum, cnt, mine, sp = 0u;
    for (;;) {
        sum = 0u; cnt = 0u; mine = 0u;
#pragma unroll
        for (unsigned j = 0; j < 16; ++j) { const unsigned c = xb_ld(&bar[XB_XCNT(j)]); sum += c; cnt += (c > 0u) ? 1u : 0u; mine = (j == x) ? c : mine; }
        if (sum == G) break;
        __builtin_amdgcn_s_sleep(1);
        if ((++sp & 255u) == 0u) { if (xb_ld(&bar[XB_TMO])) break; if (sp > XB_SPIN_CAP) { atomicAdd(&bar[XB_TMO], 1u); break; } }
    }
    nloc = mine > 0u ? mine : 1u; nx = cnt > 0u ? cnt : 1u;
}

__device__ __forceinline__ void xcd_barrier(const XcdBarrier& b, const int tid_) {
    asm volatile("s_waitcnt vmcnt(0)" ::: "memory");
    __syncthreads();
    if (tid_ == 0) {
        unsigned* bar = b.bar;
        __builtin_amdgcn_s_waitcnt(0);
        unsigned nloc = b.st[0], nx = b.st[1];
        if (nloc == 0u) { xcd_barrier_complete(bar, b.x, nloc, nx); b.st[0] = nloc; b.st[1] = nx; }
        const unsigned old = xb_add(&bar[XB_XSUB(b.x)], 1u);
        const unsigned gen = old / nloc;
        if (old + 1u == (gen + 1u) * nloc) {
            __builtin_amdgcn_fence(__ATOMIC_RELEASE, "agent");
            asm volatile("s_waitcnt vmcnt(0)" ::: "memory");
            const unsigned og = xb_add(&bar[XB_TOP], 1u);
            const unsigned tg = og / nx;
            if (og + 1u == (tg + 1u) * nx) xb_add(&bar[XB_TOPGEN], 1u);
            else XB_SPIN(xb_ld(&bar[XB_TOPGEN]) == tg, bar);
            __builtin_amdgcn_fence(__ATOMIC_ACQUIRE, "agent");
            xb_add(&bar[XB_XGEN(b.x)], 1u);
            asm volatile("s_waitcnt vmcnt(0)" ::: "memory");
        } else {
            XB_SPIN(xb_ld(&bar[XB_XGEN(b.x)]) == gen, bar);
            __builtin_amdgcn_fence(__ATOMIC_ACQUIRE, "agent");
            asm volatile("s_waitcnt vmcnt(0)" ::: "memory");
        }
    }
    __syncthreads();
}

__device__ __forceinline__ int qk_perm_row(int n) {
    if (n >= 1280) return n;
    const int hd = n & ~63, d = n & 63, dd = d & 31;
    return hd + 8 * (dd >> 2) + 4 * (d >> 5) + (dd & 3);
}
template <int MODE>
__device__ __forceinline__ void transpose_item(const float* W, int K, int N, bf16_t* WT, int row_off, LAS float* scr, int item, int lane, const float* s) {
    const int nblk = N / 32, kb = item / nblk, nb = item % nblk, k0 = 64 * kb, n0 = 32 * nb;
#pragma unroll 8
    for (int i = 0; i < 32; ++i) { const int kk = 2 * i + (lane >> 5); float v = W[(size_t)(k0 + kk) * N + n0 + (lane & 31)];
        if (MODE == 2) v *= s[k0 + kk]; if (MODE == 3) v *= 1.0f - s[k0 + kk];
        scr[kk * 33 + (lane & 31)] = v; }
    asm volatile("s_waitcnt lgkmcnt(0)" ::: "memory");
    const int c = lane & 7;
#pragma unroll
    for (int j = 0; j < 4; ++j) { const int n = (lane >> 3) + 8 * j; const LAS float* sp = scr + (8 * c) * 33 + n;
        u32x4 o; o.x = cvt_pk_bf16(sp[0 * 33], sp[1 * 33]); o.y = cvt_pk_bf16(sp[2 * 33], sp[3 * 33]); o.z = cvt_pk_bf16(sp[4 * 33], sp[5 * 33]); o.w = cvt_pk_bf16(sp[6 * 33], sp[7 * 33]);
        const int dn = (MODE == 1) ? qk_perm_row(n0 + n) : (n0 + n);
        *(u32x4*)(WT + (size_t)(row_off + dn) * K + k0 + 8 * c) = o; }
    asm volatile("s_waitcnt lgkmcnt(0)" ::: "memory");
}

struct Args { const float* in[24]; float* out; unsigned char* ws; int ph_lo, ph_hi; };
typedef const __attribute__((address_space(4))) unsigned char* kptr_t;
__device__ __forceinline__ kptr_t kargs() { kptr_t p = (kptr_t)__builtin_amdgcn_kernarg_segment_ptr(); asm volatile("" : "+s"(p)); return p; }
#define GAS __attribute__((address_space(1)))
__device__ __forceinline__ const float* kin(kptr_t p, int i) { return (const float*)(const GAS float*)*(const unsigned long long __attribute__((address_space(4)))*)(p + 8 * i); }
__device__ __forceinline__ float* kout(kptr_t p) { return (float*)(GAS float*)*(const unsigned long long __attribute__((address_space(4)))*)(p + 8 * 24); }
__device__ __forceinline__ unsigned char* kws(kptr_t p) { return (unsigned char*)(GAS unsigned char*)*(const unsigned long long __attribute__((address_space(4)))*)(p + 8 * 25); }

enum { I_X = 0, I_P, I_NORMG, I_AWIN, I_ABIN, I_ASINK, I_AWOUT, I_MU, I_RWIN, I_W0, I_W1, I_W2, I_A0, I_A1, I_A2, I_KK, I_KA, I_RK, I_GNG, I_GNB, I_RWOUT, I_PWP, I_PWG, I_FNG };
__device__ __forceinline__ void p0_prologue(LAS unsigned char* lds, int G, int bid, int tid) {
    kptr_t kp = kargs();
    const int wave = __builtin_amdgcn_readfirstlane(tid >> 6), lane = tid & 63;
    LAS float* scr = (LAS float*)(lds + wave * 16384);
    const int gw = bid * NWAVES + wave, NGW = G * NWAVES;
    unsigned char* ws = kws(kp);
    const float* mu = kin(kp, I_MU);
    constexpr int N1 = 1280, N2 = 512, N5 = 2048, N6 = 128, N7 = 32;
    constexpr int NITEMS = N1 + 4 * N2 + N5 + 2 * N6 + 4 * N7;
    for (int it = gw; it < NITEMS; it += NGW) {
        int r = it;
        if (r < N1) { transpose_item<1>(kin(kp, I_AWIN), 1024, 2560, (bf16_t*)(ws + WS_WQKVZ), 0, scr, r, lane, nullptr); continue; } r -= N1;
        if (r < N2) { transpose_item<0>(kin(kp, I_AWOUT), 1024, 1024, (bf16_t*)(ws + WS_WO0), 0, scr, r, lane, nullptr); continue; } r -= N2;
        if (r < N2) { transpose_item<0>(kin(kp, I_PWG), 1024, 1024, (bf16_t*)(ws + WS_WG0), 0, scr, r, lane, nullptr); continue; } r -= N2;
        if (r < N2) { transpose_item<0>(kin(kp, I_PWG) + 1024 * 1024, 1024, 1024, (bf16_t*)(ws + WS_WG1), 0, scr, r, lane, nullptr); continue; } r -= N2;
        if (r < N2) { transpose_item<0>(kin(kp, I_RWOUT), 1024, 1024, (bf16_t*)(ws + WS_WO1), 0, scr, r, lane, nullptr); continue; } r -= N2;
        if (r < N5) { transpose_item<0>(kin(kp, I_RWIN), 1024, 4096, (bf16_t*)(ws + WS_WR), 0, scr, r, lane, nullptr); continue; } r -= N5;
        if (r < N6) { transpose_item<0>(kin(kp, I_PWP), 256, 1024, (bf16_t*)(ws + WS_WP0), 0, scr, r, lane, nullptr); continue; } r -= N6;
        if (r < N6) { transpose_item<0>(kin(kp, I_PWP) + 256 * 1024, 256, 1024, (bf16_t*)(ws + WS_WP1), 0, scr, r, lane, nullptr); continue; } r -= N6;
        if (r < N7) { transpose_item<3>(kin(kp, I_W1), 1024, 64, (bf16_t*)(ws + WS_WL), 0, scr, r, lane, mu + 4 * 1024); continue; } r -= N7;
        if (r < N7) { transpose_item<2>(kin(kp, I_W1), 1024, 64, (bf16_t*)(ws + WS_WL), 64, scr, r, lane, mu + 4 * 1024); continue; } r -= N7;
        if (r < N7) { transpose_item<3>(kin(kp, I_A1), 1024, 64, (bf16_t*)(ws + WS_WL), 128, scr, r, lane, mu + 5 * 1024); continue; } r -= N7;
        transpose_item<2>(kin(kp, I_A1), 1024, 64, (bf16_t*)(ws + WS_WL), 192, scr, r, lane, mu + 5 * 1024);
    }
    {
        const float* g0 = kin(kp, I_NORMG); bf16_t* XN = (bf16_t*)(ws + WS_S1);
        f32x4 gv[4];
#pragma unroll
        for (int j = 0; j < 4; ++j) gv[j] = *((const f32x4*)g0 + lane + 64 * j);
        const float* xin = kin(kp, I_X);
        f32x4 nx[4];
        if (gw < M) {
#pragma unroll
            for (int j = 0; j < 4; ++j) nx[j] = *((const f32x4*)(xin + (size_t)gw * D) + lane + 64 * j); }
        for (int m = gw; m < M; m += NGW) {
            f32x4 v[4]; float s = 0.f;
#pragma unroll
            for (int j = 0; j < 4; ++j) { v[j] = nx[j]; s += (v[j].x * v[j].x + v[j].y * v[j].y) + (v[j].z * v[j].z + v[j].w * v[j].w); }
            if (m + NGW < M) {
#pragma unroll
                for (int j = 0; j < 4; ++j) nx[j] = *((const f32x4*)(xin + (size_t)(m + NGW) * D) + lane + 64 * j); }
            const float rstd = 1.0f / sqrtf(wave_sum(s) * (1.0f / D) + 1e-6f);
            u32x2* o8 = (u32x2*)(XN + (size_t)m * D) + lane;
#pragma unroll
            for (int j = 0; j < 4; ++j) { const f32x4 o = v[j] * rstd * gv[j]; u32x2 w; w.x = cvt_pk_bf16(o.x, o.y); w.y = cvt_pk_bf16(o.z, o.w); o8[64 * j] = w; }
        }
    }
    const int gt = bid * NTHR + tid, NGT = G * NTHR;
    {
        const f32x4* p4 = (const f32x4*)kin(kp, I_P); u32x4* o = (u32x4*)(ws + WS_PB0);
        for (int i = gt; i < 2 * M * PLE / 8; i += NGT) { const f32x4 x0 = p4[2 * i], x1 = p4[2 * i + 1]; o[i] = pack8(x0, x1); }
    }
    {
        float* cs = (float*)(ws + WS_COS); float* sn = (float*)(ws + WS_SIN);
        for (int i = gt; i < T * 32; i += NGT) {
            const int pos = i >> 5, f = i & 31;
            const float inv = (float)exp2(-(double)f * (13.287712379549449 / 32.0));
            const float ang = (float)pos * inv;
            double rev = (double)ang * 0.15915494309189535; rev -= floor(rev);
            sn[i] = __builtin_amdgcn_sinf((float)rev); cs[i] = __builtin_amdgcn_cosf((float)rev);
        }
    }
    {
        float* bp = (float*)(ws + WS_BIAS);
        for (int i = gt; i < ATT_IN; i += NGT) bp[qk_perm_row(i)] = kin(kp, I_ABIN)[i];
    }
    {
        bf16_t* W2T = (bf16_t*)(ws + WS_W2); const float* w2 = kin(kp, I_W2); const float* a2 = kin(kp, I_A2);
        for (int i = gt; i < 2048 * 128; i += NGT) {
            const int k = i >> 11, nn = i & 2047;
            float v;
            if (nn < 1024) v = (k < 64) ? w2[k * 1024 + nn] : 0.f; else v = (k >= 64) ? a2[(k - 64) * 1024 + (nn - 1024)] : 0.f;
            W2T[(size_t)nn * 128 + k] = (bf16_t)(cvt_pk_bf16(v, 0.f) & 0xffffu);
        }
    }
}

__device__ __forceinline__ void attn_phase(LAS unsigned char* lds, const bf16_t* QKVZ, const float* sinks, bf16_t* OG, int G, int bid, int tid) {
    const int wave = __builtin_amdgcn_readfirstlane(tid >> 6), lane = tid & 63, fr = lane & 15, fq = lane >> 4;
    constexpr int KP = 144, VP = 528;
    LAS unsigned char* Kl = lds; LAS unsigned char* Vt = lds + 256 * KP;
    u32x4 pkv[4], pvv[4];
#define ATT_LOAD(uu) do { const int kvh_ = (uu) & 3, n_ = ((uu) >> 2) & 31, b_ = (uu) >> 7; _Pragma("unroll") for (int i = 0; i < 4; ++i) { \
        const int c_ = tid + 512 * i, key_ = c_ >> 3, ch_ = c_ & 7, t_ = 128 * (n_ - 1) + key_; \
        pkv[i] = (u32x4){0u, 0u, 0u, 0u}; pvv[i] = (u32x4){0u, 0u, 0u, 0u}; \
        if (t_ >= 0) { const bf16_t* rp_ = QKVZ + (size_t)(b_ * T + t_) * ATT_IN + kvh_ * 64 + ch_ * 8; pkv[i] = *(const u32x4*)(rp_ + 1024); pvv[i] = *(const u32x4*)(rp_ + 1280); } } } while (0)
    if (bid < 1024) ATT_LOAD(bid);
    for (int unit = bid; unit < 1024; unit += G) {
        const int kvh = unit & 3, n = (unit >> 2) & 31, b = unit >> 7;
        __syncthreads();
#pragma unroll
        for (int i = 0; i < 4; ++i) {
            const int c = tid + 512 * i, key = c >> 3, ch = c & 7;
            const u32x4 kv = pkv[i], vv = pvv[i];
            *(LAS u32x4*)(Kl + key * KP + ch * 16) = kv;
            LAS unsigned short* vp = (LAS unsigned short*)(Vt + (ch * 8) * VP + ((key ^ (ch << 2)) * 2));
            vp[0 * (VP / 2)] = (unsigned short)(vv.x & 0xffffu); vp[1 * (VP / 2)] = (unsigned short)(vv.x >> 16);
            vp[2 * (VP / 2)] = (unsigned short)(vv.y & 0xffffu); vp[3 * (VP / 2)] = (unsigned short)(vv.y >> 16);
            vp[4 * (VP / 2)] = (unsigned short)(vv.z & 0xffffu); vp[5 * (VP / 2)] = (unsigned short)(vv.z >> 16);
            vp[6 * (VP / 2)] = (unsigned short)(vv.w & 0xffffu); vp[7 * (VP / 2)] = (unsigned short)(vv.w >> 16);
        }
        if (unit + G < 1024) ATT_LOAD(unit + G);
        __syncthreads();
        const int g = wave >> 1, qh = wave & 1, h = kvh * 4 + g;
        const float sink2 = sinks[h] * 1.4426950408889634f;
        for (int mt = 0; mt < 4; ++mt) {
            const int qo0 = qh * 64 + mt * 16;
            const size_t row = (size_t)(b * T + n * 128 + qo0 + fr);
            const bf16_t* qp = QKVZ + row * ATT_IN + h * 64 + fq * 8;
            const bf16x8 q0 = *(const bf16x8*)qp, q1 = *(const bf16x8*)(qp + 32);
            const int kt0 = (qh * 4 + mt) < 6 ? (qh * 4 + mt) : 6;
            f32x4 s[10];
#pragma unroll
            for (int kt = 0; kt < 10; ++kt) {
                const LAS unsigned char* kp = Kl + ((kt0 + kt) * 16 + fr) * KP + fq * 16;
                const bf16x8 k0 = *(const LAS bf16x8*)kp, k1 = *(const LAS bf16x8*)(kp + 64);
                f32x4 acc = (f32x4){0.f, 0.f, 0.f, 0.f};
                acc = __builtin_amdgcn_mfma_f32_16x16x32_bf16(k0, q0, acc, 0, 0, 0);
                acc = __builtin_amdgcn_mfma_f32_16x16x32_bf16(k1, q1, acc, 0, 0, 0);
                s[kt] = acc;
            }
            const int qi = 128 + qo0 + fr;
            float mx = sink2;
#pragma unroll
            for (int kt = 0; kt < 10; ++kt)
#pragma unroll
                for (int r = 0; r < 4; ++r) { const int si = (kt0 + kt) * 16 + 4 * fq + r, df = qi - si; const bool ok = (df >= 0) && (df < 128) && (n > 0 || si >= 128);
                    const float v = ok ? s[kt][r] : -1e30f; s[kt][r] = v; mx = fmaxf(mx, v); }
            mx = fmaxf(mx, __shfl_xor(mx, 16)); mx = fmaxf(mx, __shfl_xor(mx, 32));
            float sum = 0.f;
#pragma unroll
            for (int kt = 0; kt < 10; ++kt)
#pragma unroll
                for (int r = 0; r < 4; ++r) { const float p = __builtin_amdgcn_exp2f(s[kt][r] - mx); s[kt][r] = p; sum += p; }
            sum += __shfl_xor(sum, 16); sum += __shfl_xor(sum, 32);
            sum += __builtin_amdgcn_exp2f(sink2 - mx);
            const float inv = 1.0f / sum;
            f32x4 o[4];
#pragma unroll
            for (int dt = 0; dt < 4; ++dt) o[dt] = (f32x4){0.f, 0.f, 0.f, 0.f};
#pragma unroll
            for (int kk = 0; kk < 5; ++kk) {
                const u32x4 pw = pack8(s[2 * kk], s[2 * kk + 1]);
                const bf16x8 pf = __builtin_bit_cast(bf16x8, pw);
#pragma unroll
                for (int dt = 0; dt < 4; ++dt) {
                    const int d = dt * 16 + fr, sw = ((d >> 3) & 7) << 2, keyA = 16 * (kt0 + 2 * kk) + 4 * fq, keyB = keyA + 16;
                    const u32x2 va = *(const LAS u32x2*)(Vt + d * VP + ((keyA ^ sw) * 2)), vb = *(const LAS u32x2*)(Vt + d * VP + ((keyB ^ sw) * 2));
                    const u32x4 vw = (u32x4){va.x, va.y, vb.x, vb.y};
                    o[dt] = __builtin_amdgcn_mfma_f32_16x16x32_bf16(__builtin_bit_cast(bf16x8, vw), pf, o[dt], 0, 0, 0);
                }
            }
            const bf16_t* zp = QKVZ + row * ATT_IN + 1536 + h * 64 + 4 * fq;
            bf16_t* op = OG + row * D + h * 64 + 4 * fq;
#pragma unroll
            for (int dt = 0; dt < 4; ++dt) {
                const u32x2 zw = *(const u32x2*)(zp + dt * 16);
                const float z0 = bflo(zw.x), z1 = bfhi(zw.x), z2 = bflo(zw.y), z3 = bfhi(zw.y);
                const float r0 = o[dt][0] * inv * z0 * fsigmoid(z0), r1 = o[dt][1] * inv * z1 * fsigmoid(z1), r2 = o[dt][2] * inv * z2 * fsigmoid(z2), r3 = o[dt][3] * inv * z3 * fsigmoid(z3);
                u32x2 w; w.x = cvt_pk_bf16(r0, r1); w.y = cvt_pk_bf16(r2, r3);
                *(u32x2*)(op + dt * 16) = w;
            }
        }
    }
}
template <int ROUND>
__device__ __forceinline__ void lerp_phase(const bf16_t* H1, const float* g1, const float* mu, bf16_t* HN, bf16_t* XS0, bf16_t* XS1, int G, int bid, int tid) {
    const int wave = __builtin_amdgcn_readfirstlane(tid >> 6), lane = tid & 63;
    const int gw = bid * NWAVES + wave, NGW = G * NWAVES;
    const float* mu0 = mu + (ROUND == 0 ? 0 : 2) * 1024; const float* mu1 = mu0 + 1024;
    f32x4 gq[4], m0q[4], m1q[4];
#pragma unroll
    for (int q = 0; q < 4; ++q) { const int col = (q >> 1) * 512 + lane * 8 + 4 * (q & 1); gq[q] = *(const f32x4*)(g1 + col); m0q[q] = *(const f32x4*)(mu0 + col); m1q[q] = *(const f32x4*)(mu1 + col); }
    u32x4 rc_[2], rp_[2];
#define LERP_LOAD(mm) do { const bool hp_ = ((mm) & (T - 1)) != 0; _Pragma("unroll") for (int j = 0; j < 2; ++j) { const size_t off_ = (size_t)(mm) * D + j * 512 + lane * 8; \
        rc_[j] = *(const u32x4*)(H1 + off_); rp_[j] = hp_ ? *(const u32x4*)(H1 + off_ - D) : (u32x4){0u, 0u, 0u, 0u}; } } while (0)
    if (gw < M) LERP_LOAD(gw);
    for (int m = gw; m < M; m += NGW) {
        f32x4 c[4], p[4];
        float sc = 0.f, sp = 0.f;
#pragma unroll
        for (int j = 0; j < 2; ++j) { unpack8(rc_[j], c[2 * j], c[2 * j + 1]); unpack8(rp_[j], p[2 * j], p[2 * j + 1]); }
        if (m + NGW < M) LERP_LOAD(m + NGW);
#pragma unroll
        for (int q = 0; q < 4; ++q) { sc += (c[q].x * c[q].x + c[q].y * c[q].y) + (c[q].z * c[q].z + c[q].w * c[q].w); sp += (p[q].x * p[q].x + p[q].y * p[q].y) + (p[q].z * p[q].z + p[q].w * p[q].w); }
        const float rc = 1.0f / sqrtf(wave_sum(sc) * (1.0f / D) + 1e-6f), rp = 1.0f / sqrtf(wave_sum(sp) * (1.0f / D) + 1e-6f);
#pragma unroll
        for (int j = 0; j < 2; ++j) {
            const int col = j * 512 + lane * 8; const size_t off = (size_t)m * D + col;
            f32x4 hn[2], xx[2], o0[2], o1[2];
#pragma unroll
            for (int e = 0; e < 2; ++e) {
                const f32x4 gv = gq[2 * j + e];
                hn[e] = c[2 * j + e] * rc * gv; xx[e] = p[2 * j + e] * rp * gv - hn[e];
                o0[e] = hn[e] + xx[e] * m0q[2 * j + e];
                o1[e] = hn[e] + xx[e] * m1q[2 * j + e];
            }
            if (ROUND == 0) *(u32x4*)(HN + off) = pack8(hn[0], hn[1]);
            *(u32x4*)(XS0 + off) = pack8(o0[0], o0[1]);
            *(u32x4*)(XS1 + off) = pack8(o1[0], o1[1]);
        }
    }
}
__device__ __forceinline__ void lora_mid_phase(const bf16_t* L, bf16_t* A2, int G, int bid, int tid) {
    const int gt = bid * NTHR + tid, NGT = G * NTHR;
    for (int i = gt; i < M * 16; i += NGT) {
        const int m = i >> 4, ch = i & 15, isA = ch >> 3, c8 = (ch & 7) * 8;
        const bool hasprev = (m & (T - 1)) != 0;
        f32x4 u0, u1, v0 = (f32x4){0.f, 0.f, 0.f, 0.f}, v1 = v0;
        unpack8(*(const u32x4*)(L + (size_t)m * 256 + isA * 128 + c8), u0, u1);
        if (hasprev) unpack8(*(const u32x4*)(L + (size_t)(m - 1) * 256 + isA * 128 + 64 + c8), v0, v1);
        u0 += v0; u1 += v1;
        if (!isA) {
#pragma unroll
            for (int e = 0; e < 4; ++e) { u0[e] = tanhf(u0[e]); u1[e] = tanhf(u1[e]); }
        }
        *(u32x4*)(A2 + (size_t)m * 128 + ch * 8) = pack8(u0, u1);
    }
}
#ifndef MK_SCAN_CHUNKED
#define MK_SCAN_CHUNKED 1
#endif
#if MK_SCAN_CHUNKED
typedef __bf16 ck_bf16x2_t __attribute__((ext_vector_type(2)));
__device__ __forceinline__ unsigned ck_cvt(float lo, float hi) { const f32x2 v = {lo, hi}; return __builtin_bit_cast(unsigned, __builtin_convertvector(v, ck_bf16x2_t)); }
constexpr int CK_RP = 144;
constexpr int CK_TP = 40;
constexpr int CK_ABAR = 0, CK_RBAR = 2304, CK_BTIL = 4608, CK_KTIL = 6912;
constexpr int CK_BT_T = 9216, CK_KT_T = 11776;
constexpr int CK_VT = 14336;
constexpr int CK_GAM = 15616;
constexpr int CK_BUF = 15872;
constexpr int CK_LD = 2 * CK_BUF;
constexpr int CK_PRIV = CK_LD + 2 * 4096;
constexpr int CK_PRIV_SZ = 2560;
__device__ __forceinline__ bf16x8 ck_ld2(const LAS unsigned char* p, int off2) {
    const u32x2 a = *(const LAS u32x2*)p, b = *(const LAS u32x2*)(p + off2); return __builtin_bit_cast(bf16x8, (u32x4){a.x, a.y, b.x, b.y}); }
__device__ __forceinline__ bf16x8 ck_ld1(const LAS unsigned char* p) {
    const u32x2 a = *(const LAS u32x2*)p; return __builtin_bit_cast(bf16x8, (u32x4){a.x, a.y, 0u, 0u}); }
__device__ __forceinline__ bf16x8 ck_pk4(const f32x4 x) { return __builtin_bit_cast(bf16x8, (u32x4){ck_cvt(x[0], x[1]), ck_cvt(x[2], x[3]), 0u, 0u}); }
#define CK_MFMA(a, b, c) __builtin_amdgcn_mfma_f32_16x16x32_bf16((a), (b), (c), 0, 0, 0)

constexpr int CK_STG = CK_PRIV + 2 * CK_PRIV_SZ;
constexpr int CK_STG_SZ = 4 * 4096 + 1024;
__device__ __forceinline__ void scan_phase(LAS unsigned char* lds, const bf16_t* R, const bf16_t* Kb, const bf16_t* V, const bf16_t* WA, const float* k_k, const float* k_a, bf16_t* Y, int G, int bid, int tid) {
    const int wave = __builtin_amdgcn_readfirstlane(tid >> 6), lane = tid & 63, c = lane & 15, g = lane >> 4;
    const int pid = tid - 128, pt = (pid >> 4) & 15, pj = pid & 15;
    const int pid1 = tid - 384, pta = (pid1 >> 4) & 7, ptb = pta + 8;
    const bool producer = (wave >= 2) && (wave < 6), producer1 = wave >= 6, consumer = wave < 2;
    constexpr int NCH = T / 16;
    for (int unit = bid; unit < 256; unit += G) {
        const int b = unit >> 5, h = (unit >> 1) & 15, half = unit & 1;
        const size_t rowbase = (size_t)b * T;
        f32x4 kkw = (f32x4){0.f, 0.f, 0.f, 0.f}, kaw = kkw;
        if (producer1) { kkw = *(const f32x4*)(k_k + h * 64 + 4 * pj); kaw = *(const f32x4*)(k_a + h * 64 + 4 * pj); }
        u32x2 rkA = (u32x2){0u, 0u}, rrA = rkA, raA = rkA, rlA = rkA, rkB = rkA, rrB = rkA, raB = rkA, rlB = rkA; unsigned rvA = 0u, rvB = 0u;
#define CK_LOAD(X, ptx, cn) do { const size_t m_ = rowbase + (size_t)(cn) * 16 + (ptx); \
            rk##X = *(const u32x2*)(Kb + m_ * D + h * 64 + 4 * pj); rr##X = *(const u32x2*)(R + m_ * D + h * 64 + 4 * pj); \
            rl##X = *(const u32x2*)(WA + m_ * 2048 + h * 64 + 4 * pj); ra##X = *(const u32x2*)(WA + m_ * 2048 + 1024 + h * 64 + 4 * pj); \
            rv##X = *(const unsigned*)(V + m_ * D + h * 64 + half * 32 + 2 * pj); } while (0)
#define CK_P1(X, ptx, cn) do { \
            const f32x4 kf_ = (f32x4){bflo(rk##X.x), bfhi(rk##X.x), bflo(rk##X.y), bfhi(rk##X.y)}, af_ = (f32x4){bflo(ra##X.x), bfhi(ra##X.x), bflo(ra##X.y), bfhi(ra##X.y)}; \
            const f32x4 lf_ = (f32x4){bflo(rl##X.x), bfhi(rl##X.x), bflo(rl##X.y), bfhi(rl##X.y)}, rf_ = (f32x4){bflo(rr##X.x), bfhi(rr##X.x), bflo(rr##X.y), bfhi(rr##X.y)}; \
            const f32x4 kv_ = kf_ * kkw; \
            float ss_ = (kv_.x * kv_.x + kv_.y * kv_.y) + (kv_.z * kv_.z + kv_.w * kv_.w); \
            ss_ = row16_sum(ss_); \
            const float invn_ = (ss_ > 1e-24f) ? __builtin_amdgcn_rsqf(ss_) : 1e12f;        \
            const f32x4 kk_ = kv_ * invn_; \
            LAS unsigned char* st_ = lds + CK_STG + ((cn) & 1) * CK_STG_SZ + ((ptx) * 64 + 4 * pj) * 4; \
            *(LAS f32x4*)(st_) = -kk_; *(LAS f32x4*)(st_ + 4096) = kk_ * af_; *(LAS f32x4*)(st_ + 8192) = kf_ * (1.0f + (af_ - 1.0f) * kaw); *(LAS f32x4*)(st_ + 12288) = rf_; \
            *(LAS unsigned*)(lds + CK_STG + ((cn) & 1) * CK_STG_SZ + 16384 + ((ptx) * 16 + pj) * 4) = rv##X; \
            *(LAS f32x4*)(lds + CK_LD + ((cn) & 1) * 4096 + ((ptx) * 64 + 4 * pj) * 4) = lf_; } while (0)
        if (producer1) { CK_LOAD(A, pta, 0); CK_LOAD(B, ptb, 0); CK_P1(A, pta, 0); CK_P1(B, ptb, 0); CK_LOAD(A, pta, 1); CK_LOAD(B, ptb, 1); }
        f32x4 H[4];
#pragma unroll
        for (int kt = 0; kt < 4; ++kt) H[kt] = (f32x4){0.f, 0.f, 0.f, 0.f};
        __syncthreads();
        for (int it = 0; it <= NCH; ++it) {
            if (producer1 && it + 1 < NCH) { CK_P1(A, pta, it + 1); CK_P1(B, ptb, it + 1); if (it + 2 < NCH) { CK_LOAD(A, pta, it + 2); CK_LOAD(B, ptb, it + 2); } }
            if (producer && it < NCH) {
                LAS unsigned char* buf = lds + (it & 1) * CK_BUF;
                const LAS unsigned char* ldp = lds + CK_LD + (it & 1) * 4096 + 16 * pj;
                const LAS unsigned char* stp = lds + CK_STG + (it & 1) * CK_STG_SZ + (pt * 64 + 4 * pj) * 4;
                f32x4 nkk = *(const LAS f32x4*)(stp), be = *(const LAS f32x4*)(stp + 4096), kp = *(const LAS f32x4*)(stp + 8192), rf = *(const LAS f32x4*)(stp + 12288), lf = *(const LAS f32x4*)(ldp + pt * 256);
                unsigned vsave = *(const LAS unsigned*)(lds + CK_STG + (it & 1) * CK_STG_SZ + 16384 + (pt * 16 + pj) * 4);
                asm volatile("" : "+v"(nkk), "+v"(be), "+v"(kp), "+v"(rf), "+v"(lf), "+v"(vsave));
                f32x4 Gc = (f32x4){0.f, 0.f, 0.f, 0.f};
                const int w4 = 4 * (wave - 2);
#pragma unroll
                for (int s4 = 0; s4 < 16; s4 += 4) {
                    if (s4 <= w4) {
                        f32x4 x0 = *(const LAS f32x4*)(ldp + (s4 + 0) * 256), x1 = *(const LAS f32x4*)(ldp + (s4 + 1) * 256), x2 = *(const LAS f32x4*)(ldp + (s4 + 2) * 256), x3 = *(const LAS f32x4*)(ldp + (s4 + 3) * 256);
                        asm volatile("" : "+v"(x0), "+v"(x1), "+v"(x2), "+v"(x3));
                        if (s4 < w4) Gc += (x0 + x1) + (x2 + x3);
                        else { const f32x4 z4 = (f32x4){0.f, 0.f, 0.f, 0.f};
                            Gc += (s4 + 0 <= pt) ? x0 : z4; Gc += (s4 + 1 <= pt) ? x1 : z4; Gc += (s4 + 2 <= pt) ? x2 : z4; Gc += (s4 + 3 <= pt) ? x3 : z4; }
                    }
                }
                const f32x4 Gm = Gc - lf;
                f32x4 eA, eR, eN;
#pragma unroll
                for (int e = 0; e < 4; ++e) { eA[e] = __expf(Gm[e]); eR[e] = __expf(Gc[e]); eN[e] = __expf(-Gc[e]); }
                const f32x4 ab = nkk * eA, rb = rf * eR, bt = be * eN, kt_ = kp * eN;
                const unsigned ab0 = ck_cvt(ab.x, ab.y), ab1 = ck_cvt(ab.z, ab.w), rb0 = ck_cvt(rb.x, rb.y), rb1 = ck_cvt(rb.z, rb.w);
                const unsigned bt0 = ck_cvt(bt.x, bt.y), bt1 = ck_cvt(bt.z, bt.w), kt0 = ck_cvt(kt_.x, kt_.y), kt1 = ck_cvt(kt_.z, kt_.w);
                LAS unsigned char* rowp = buf + pt * CK_RP + 64 * (pj >> 3) + 16 * (pj & 3) + 8 * ((pj >> 2) & 1);
                *(LAS u32x2*)(rowp + CK_ABAR) = (u32x2){ab0, ab1}; *(LAS u32x2*)(rowp + CK_RBAR) = (u32x2){rb0, rb1};
                *(LAS u32x2*)(rowp + CK_BTIL) = (u32x2){bt0, bt1}; *(LAS u32x2*)(rowp + CK_KTIL) = (u32x2){kt0, kt1};
                constexpr int TS = CK_TP / 2;
                {
                    const int rrow = lane >> 4;
#define CK_T4(x0, x1, x2, x3) do { auto s0_ = __builtin_amdgcn_permlane32_swap(x0, x2, false, false); auto s1_ = __builtin_amdgcn_permlane32_swap(x1, x3, false, false); \
                        auto t0_ = __builtin_amdgcn_permlane16_swap(s0_[0], s1_[0], false, false); auto t1_ = __builtin_amdgcn_permlane16_swap(s0_[1], s1_[1], false, false); \
                        x0 = t0_[0]; x1 = t0_[1]; x2 = t1_[0]; x3 = t1_[1]; } while (0)
                    unsigned b0_ = __float_as_uint(bt.x), b1_ = __float_as_uint(bt.y), b2_ = __float_as_uint(bt.z), b3_ = __float_as_uint(bt.w);
                    unsigned k0_ = __float_as_uint(kt_.x), k1_ = __float_as_uint(kt_.y), k2_ = __float_as_uint(kt_.z), k3_ = __float_as_uint(kt_.w);
                    CK_T4(b0_, b1_, b2_, b3_); CK_T4(k0_, k1_, k2_, k3_);
#undef CK_T4
                    const int toff = (4 * pj + rrow) * CK_TP + 8 * (wave - 2);
                    *(LAS u32x2*)(buf + CK_BT_T + toff) = (u32x2){ck_cvt(__uint_as_float(b0_), __uint_as_float(b1_)), ck_cvt(__uint_as_float(b2_), __uint_as_float(b3_))};
                    *(LAS u32x2*)(buf + CK_KT_T + toff) = (u32x2){ck_cvt(__uint_as_float(k0_), __uint_as_float(k1_)), ck_cvt(__uint_as_float(k2_), __uint_as_float(k3_))};
                }
                LAS unsigned short* vT = (LAS unsigned short*)(buf + CK_VT + (2 * pj) * CK_TP + pt * 2);
                vT[0] = (unsigned short)(vsave & 0xffffu); vT[TS] = (unsigned short)(vsave >> 16);
                if (pt == 15) *(LAS f32x4*)(buf + CK_GAM + 16 * pj) = eR;
            }
            if (consumer && it > 0) {
                const int cn = it - 1;
                const LAS unsigned char* buf = lds + (cn & 1) * CK_BUF;
                LAS unsigned char* priv = lds + CK_PRIV + wave * CK_PRIV_SZ;
                LAS float* AabT = (LAS float*)priv; LAS float* Xch = (LAS float*)(priv + 1024); LAS unsigned char* UT = priv + 2048;
                f32x4 xab = (f32x4){0.f, 0.f, 0.f, 0.f}, xak = xab, xrb = xab, xrk = xab;
                bf16x8 pa[2], pr[2];
#pragma unroll
                for (int ks = 0; ks < 2; ++ks) {
                    const LAS unsigned char* rp = buf + c * CK_RP + 64 * ks + 16 * g;
                    pa[ks] = *(const LAS bf16x8*)(rp + CK_ABAR); pr[ks] = *(const LAS bf16x8*)(rp + CK_RBAR);
                    const bf16x8 pb = *(const LAS bf16x8*)(rp + CK_BTIL), pk = *(const LAS bf16x8*)(rp + CK_KTIL);
                    xab = CK_MFMA(pb, pa[ks], xab); xak = CK_MFMA(pk, pa[ks], xak); xrb = CK_MFMA(pb, pr[ks], xrb); xrk = CK_MFMA(pk, pr[ks], xrk);
                }
#pragma unroll
                for (int r = 0; r < 4; ++r) { const int s = 4 * g + r; if (!(s < c)) { xab[r] = 0.f; xak[r] = 0.f; } if (!(s <= c)) { xrb[r] = 0.f; xrk[r] = 0.f; } }
#pragma unroll
                for (int r = 0; r < 4; ++r) AabT[(4 * g + r) * 16 + c] = xab[r];
                const bf16x8 opak = ck_pk4(xak), oprb = ck_pk4(xrb), oprk = ck_pk4(xrk);
                bf16x8 oph[2];
#pragma unroll
                for (int ks = 0; ks < 2; ++ks) oph[ks] = __builtin_bit_cast(bf16x8, (u32x4){ck_cvt(H[2 * ks][0], H[2 * ks][1]), ck_cvt(H[2 * ks][2], H[2 * ks][3]), ck_cvt(H[2 * ks + 1][0], H[2 * ks + 1][1]), ck_cvt(H[2 * ks + 1][2], H[2 * ks + 1][3])});
                const bf16x8 opv = ck_ld1(buf + CK_VT + (wave * 16 + c) * CK_TP + g * 8);
                f32x4 rhs = (f32x4){0.f, 0.f, 0.f, 0.f};
                rhs = CK_MFMA(pa[0], oph[0], rhs); rhs = CK_MFMA(pa[1], oph[1], rhs); rhs = CK_MFMA(opak, opv, rhs);
                *(LAS f32x4*)(Xch + c * 16 + 4 * g) = rhs;
                asm volatile("s_waitcnt lgkmcnt(0)" ::: "memory");
                float u[16];
#pragma unroll
                for (int q = 0; q < 4; ++q) { const f32x4 x = *(const LAS f32x4*)(Xch + c * 16 + 4 * q); u[4 * q] = x[0]; u[4 * q + 1] = x[1]; u[4 * q + 2] = x[2]; u[4 * q + 3] = x[3]; }
                f32x4 cw[15][4];
#define CK_COLLD(ss) do { _Pragma("unroll") for (int q_ = ((ss) + 1) / 4; q_ < 4; ++q_) cw[(ss)][q_] = *(const LAS f32x4*)(AabT + (ss) * 16 + 4 * q_); } while (0)
                CK_COLLD(0); CK_COLLD(1);
#pragma unroll
                for (int s = 0; s < 15; ++s) {
                    if (s + 2 < 15) CK_COLLD(s + 2);
                    __builtin_amdgcn_sched_barrier(0);
#pragma unroll
                    for (int t = s + 1; t < 16; ++t) u[t] += cw[s][t >> 2][t & 3] * u[s];
                }
#undef CK_COLLD
                { u32x4 w0, w1; w0.x = ck_cvt(u[0], u[1]); w0.y = ck_cvt(u[2], u[3]); w0.z = ck_cvt(u[4], u[5]); w0.w = ck_cvt(u[6], u[7]);
                  w1.x = ck_cvt(u[8], u[9]); w1.y = ck_cvt(u[10], u[11]); w1.z = ck_cvt(u[12], u[13]); w1.w = ck_cvt(u[14], u[15]);
                  *(LAS u32x4*)(UT + c * 32) = w0; *(LAS u32x4*)(UT + c * 32 + 16) = w1; }
                asm volatile("s_waitcnt lgkmcnt(0)" ::: "memory");
                const bf16x8 opu = ck_ld1(UT + c * 32 + g * 8);
                f32x4 yy = (f32x4){0.f, 0.f, 0.f, 0.f};
                yy = CK_MFMA(pr[0], oph[0], yy); yy = CK_MFMA(pr[1], oph[1], yy); yy = CK_MFMA(oprb, opu, yy); yy = CK_MFMA(oprk, opv, yy);
                {
                    bf16_t* yp = Y + (rowbase + (size_t)cn * 16 + 4 * g) * D + h * 64 + half * 32 + wave * 16 + c;
#pragma unroll
                    for (int r = 0; r < 4; ++r) yp[(size_t)r * D] = (bf16_t)(ck_cvt(yy[r], 0.f) & 0xffffu);
                }
#pragma unroll
                for (int kt = 0; kt < 4; ++kt) {
                    const bf16x8 opb = ck_ld1(buf + CK_BT_T + (16 * kt + c) * CK_TP + g * 8), opk = ck_ld1(buf + CK_KT_T + (16 * kt + c) * CK_TP + g * 8);
                    f32x4 hh = H[kt];
                    hh = CK_MFMA(opb, opu, hh); hh = CK_MFMA(opk, opv, hh);
                    H[kt] = hh * *(const LAS f32x4*)(buf + CK_GAM + (16 * kt + 4 * g) * 4);
                }
            }
            __syncthreads();
        }
    }
#undef CK_LOAD
#undef CK_P1
}
#else
constexpr int TC = 32;
constexpr int SC_VEC = TC * 5 * 64 * 4;
constexpr int SC_VP = 36;
constexpr int SC_V = 32 * SC_VP * 4;
constexpr int SC_Y = TC * 32 * 4;
constexpr int SC_BUF = SC_VEC + SC_V + SC_Y;
__device__ __forceinline__ void scan_phase(LAS unsigned char* lds, const bf16_t* R, const bf16_t* Kb, const bf16_t* V, const bf16_t* WA, const float* k_k, const float* k_a, bf16_t* Y, int G, int bid, int tid) {
    const int wave = __builtin_amdgcn_readfirstlane(tid >> 6), lane = tid & 63, rg = lane >> 4, cc = lane & 15;
    const int pt = tid >> 4, pj = tid & 15;
    for (int unit = bid; unit < 256; unit += G) {
        const int b = unit >> 5, h = (unit >> 1) & 15, half = unit & 1;
        const size_t rowbase = (size_t)b * T;
        const f32x4 kkw = *(const f32x4*)(k_k + h * 64 + 4 * pj), kaw = *(const f32x4*)(k_a + h * 64 + 4 * pj);
        f32x2 S01 = (f32x2){0.f, 0.f}, S23 = (f32x2){0.f, 0.f};
        u32x2 rk, rr, ra, rl; unsigned rv;
#define SCAN_LOAD(cn) do { const size_t m_ = rowbase + (size_t)(cn) * TC + pt; \
            rk = *(const u32x2*)(Kb + m_ * D + h * 64 + 4 * pj); rr = *(const u32x2*)(R + m_ * D + h * 64 + 4 * pj); \
            rl = *(const u32x2*)(WA + m_ * 2048 + h * 64 + 4 * pj); ra = *(const u32x2*)(WA + m_ * 2048 + 1024 + h * 64 + 4 * pj); \
            rv = *(const unsigned*)(V + m_ * D + h * 64 + half * 32 + 2 * pj); } while (0)
        SCAN_LOAD(0);
        __syncthreads();
        for (int cn = 0; cn < T / TC; ++cn) {
            LAS unsigned char* buf = lds + (cn & 1) * SC_BUF;
            {
                const f32x4 kf = (f32x4){bflo(rk.x), bfhi(rk.x), bflo(rk.y), bfhi(rk.y)}, af = (f32x4){bflo(ra.x), bfhi(ra.x), bflo(ra.y), bfhi(ra.y)};
                const f32x4 lf = (f32x4){bflo(rl.x), bfhi(rl.x), bflo(rl.y), bfhi(rl.y)}, rf = (f32x4){bflo(rr.x), bfhi(rr.x), bflo(rr.y), bfhi(rr.y)};
                const f32x4 kv = kf * kkw;
                float ss = (kv.x * kv.x + kv.y * kv.y) + (kv.z * kv.z + kv.w * kv.w);
                ss = row16_sum(ss);
                const float invn = 1.0f / fmaxf(sqrtf(ss), 1e-12f);
                const f32x4 kk = kv * invn;
                const f32x4 kp = kf * (1.0f + (af - 1.0f) * kaw);
                f32x4 dd; dd.x = __expf(lf.x); dd.y = __expf(lf.y); dd.z = __expf(lf.z); dd.w = __expf(lf.w);
                LAS f32x4* vp = (LAS f32x4*)(buf + pt * 1280) + pj;
                vp[0] = -kk; vp[16] = dd; vp[32] = kk * af; vp[48] = kp; vp[64] = rf;
                LAS float* vv = (LAS float*)(buf + SC_VEC) + (2 * pj) * SC_VP + pt;
                vv[0] = bflo(rv); vv[SC_VP] = bfhi(rv);
            }
            if (cn + 1 < T / TC) SCAN_LOAD(cn + 1);
            __syncthreads();
            if (cn > 0) {
                const LAS float* yb = (const LAS float*)(lds + ((cn - 1) & 1) * SC_BUF + SC_VEC + SC_V + pt * 128) + 2 * pj;
                const size_t m_ = rowbase + (size_t)(cn - 1) * TC + pt;
                *(unsigned*)(Y + m_ * D + h * 64 + half * 32 + 2 * pj) = cvt_pk_bf16(yb[0], yb[1]);
            }
            const int rloc = wave * 4 + rg;
            LAS float* yrow = (LAS float*)(buf + SC_VEC + SC_V) + rloc;
            const unsigned va0 = (unsigned)(size_t)(buf + cc * 16), ra0 = (unsigned)(size_t)(buf + SC_VEC + rloc * SC_VP * 4);
#define SC_LD5(NK, DD, BE, KP, RF, AR, OFF) do { \
                asm volatile("ds_read_b128 %0, %1 offset:%2" : "=&v"(NK) : "v"(AR), "i"((OFF))); asm volatile("ds_read_b128 %0, %1 offset:%2" : "=&v"(DD) : "v"(AR), "i"((OFF) + 256)); \
                asm volatile("ds_read_b128 %0, %1 offset:%2" : "=&v"(BE) : "v"(AR), "i"((OFF) + 512)); asm volatile("ds_read_b128 %0, %1 offset:%2" : "=&v"(KP) : "v"(AR), "i"((OFF) + 768)); \
                asm volatile("ds_read_b128 %0, %1 offset:%2" : "=&v"(RF) : "v"(AR), "i"((OFF) + 1024)); } while (0)
            f32x4 nk, dd, be, kp, rf, nk1, dd1, be1, kp1, rf1, nk2, dd2, be2, kp2, rf2, vcur, vnxt;
            SC_LD5(nk, dd, be, kp, rf, va0, 0); SC_LD5(nk1, dd1, be1, kp1, rf1, va0, 1280);
            asm volatile("ds_read_b128 %0, %1" : "=&v"(vcur) : "v"(ra0));
            asm volatile("s_waitcnt lgkmcnt(0)" : "+v"(nk), "+v"(dd), "+v"(be), "+v"(kp), "+v"(rf), "+v"(nk1), "+v"(dd1), "+v"(be1), "+v"(kp1), "+v"(rf1), "+v"(vcur));
            vnxt = vcur;
            float sa;
            { f32x2 pa = S01 * (f32x2){nk.x, nk.y}; pa = S23 * (f32x2){nk.z, nk.w} + pa; sa = row16_sum(pa.x + pa.y); }
            float ykeep = 0.f;
#define SC_STEP(J, VSEL, LDV, VOFF, WAITN) do { \
                SC_LD5(nk2, dd2, be2, kp2, rf2, va8, ((J) + 2) * 1280); \
                if (LDV) asm volatile("ds_read_b128 %0, %1 offset:%2" : "=&v"(vnxt) : "v"(ra8), "i"((VOFF))); \
                asm volatile("s_waitcnt lgkmcnt(" #WAITN ")" : "+v"(nk1), "+v"(dd1), "+v"(be1), "+v"(kp1), "+v"(rf1)); \
                const float vv_ = (VSEL); \
                S01 = S01 * (f32x2){dd.x, dd.y} + (f32x2){be.x, be.y} * sa + (f32x2){kp.x, kp.y} * vv_; \
                S23 = S23 * (f32x2){dd.z, dd.w} + (f32x2){be.z, be.w} * sa + (f32x2){kp.z, kp.w} * vv_; \
                f32x2 pa_ = S01 * (f32x2){nk1.x, nk1.y}; pa_ = S23 * (f32x2){nk1.z, nk1.w} + pa_; \
                f32x2 py_ = S01 * (f32x2){rf.x, rf.y}; py_ = S23 * (f32x2){rf.z, rf.w} + py_; \
                float y_ = py_.x + py_.y, a2_ = pa_.x + pa_.y; \
                y_ = DPP_XADD(y_, 0xB1); a2_ = DPP_XADD(a2_, 0xB1); y_ = DPP_XADD(y_, 0x4E); a2_ = DPP_XADD(a2_, 0x4E); \
                y_ = DPP_XADD(y_, 0x141); a2_ = DPP_XADD(a2_, 0x141); y_ = DPP_XADD(y_, 0x140); a2_ = DPP_XADD(a2_, 0x140); \
                sa = a2_; \
                ykeep = __builtin_bit_cast(float, __builtin_amdgcn_update_dpp(__builtin_bit_cast(int, y_), __builtin_bit_cast(int, ykeep), 0x111, 0xF, 0xF, false));   \
                nk = nk1; dd = dd1; be = be1; kp = kp1; rf = rf1; nk1 = nk2; dd1 = dd2; be1 = be2; kp1 = kp2; rf1 = rf2; } while (0)
#pragma unroll 1
            for (int t8 = 0; t8 < TC; t8 += 8) {
                const unsigned va8 = va0 + (unsigned)t8 * 1280u, ra8 = ra0 + (unsigned)t8 * 4u;
                SC_STEP(0, vcur.x, 0, 0, 5); SC_STEP(1, vcur.y, 0, 0, 5); SC_STEP(2, vcur.z, 1, 16, 6); SC_STEP(3, vcur.w, 0, 0, 5);
                asm volatile("" : "+v"(vnxt)); vcur = vnxt;
                SC_STEP(4, vcur.x, 0, 0, 5); SC_STEP(5, vcur.y, 0, 0, 5); SC_STEP(6, vcur.z, 1, 32, 6); SC_STEP(7, vcur.w, 0, 0, 5);
                asm volatile("" : "+v"(vnxt)); vcur = vnxt;
                if (t8 & 8) yrow[(t8 + 7 - cc) * 32] = ykeep;
            }
            asm volatile("s_waitcnt lgkmcnt(0)" ::: "memory");
#undef SC_STEP
#undef SC_LD5
        }
        __syncthreads();
        {
            const int cn = T / TC;
            const LAS float* yb = (const LAS float*)(lds + ((cn - 1) & 1) * SC_BUF + SC_VEC + SC_V + pt * 128) + 2 * pj;
            const size_t m_ = rowbase + (size_t)(cn - 1) * TC + pt;
            *(unsigned*)(Y + m_ * D + h * 64 + half * 32 + 2 * pj) = cvt_pk_bf16(yb[0], yb[1]);
        }
        __syncthreads();
    }
#undef SCAN_LOAD
}
#endif
__device__ __forceinline__ void gn_phase(bf16_t* Y, const bf16_t* R, const bf16_t* Kb, const bf16_t* V, const bf16_t* Z, const bf16_t* WA, const float* k_a, const float* r_k, const float* gn_g, const float* gn_b, int G, int bid, int tid) {
    const int wave = __builtin_amdgcn_readfirstlane(tid >> 6), lane = tid & 63;
    const int gw = bid * NWAVES + wave, NGW = G * NWAVES;
    const int col = lane * 16;
    f32x4 kaq[4], rkq[4], ggq[4], gbq[4];
#pragma unroll
    for (int q = 0; q < 4; ++q) { kaq[q] = *(const f32x4*)(k_a + col + 4 * q); rkq[q] = *(const f32x4*)(r_k + col + 4 * q); ggq[q] = *(const f32x4*)(gn_g + col + 4 * q); gbq[q] = *(const f32x4*)(gn_b + col + 4 * q); }
    u32x4 ry_[2], rr_[2], rk_[2], rv_[2], rz_[2], ra_[2];
#define GN_LOAD(mm) do { const size_t off_ = (size_t)(mm) * D + col; _Pragma("unroll") for (int j = 0; j < 2; ++j) { ry_[j] = *(const u32x4*)(Y + off_ + 8 * j); rr_[j] = *(const u32x4*)(R + off_ + 8 * j); \
        rk_[j] = *(const u32x4*)(Kb + off_ + 8 * j); rv_[j] = *(const u32x4*)(V + off_ + 8 * j); rz_[j] = *(const u32x4*)(Z + off_ + 8 * j); ra_[j] = *(const u32x4*)(WA + (size_t)(mm) * 2048 + 1024 + col + 8 * j); } } while (0)
    if (gw < M) GN_LOAD(gw);
    for (int m = gw; m < M; m += NGW) {
        const size_t off = (size_t)m * D + col;
        f32x4 y[4], r[4], k[4], v[4], z[4], aa[4];
#pragma unroll
        for (int j = 0; j < 2; ++j) { unpack8(ry_[j], y[2 * j], y[2 * j + 1]); unpack8(rr_[j], r[2 * j], r[2 * j + 1]); unpack8(rk_[j], k[2 * j], k[2 * j + 1]);
            unpack8(rv_[j], v[2 * j], v[2 * j + 1]); unpack8(rz_[j], z[2 * j], z[2 * j + 1]); unpack8(ra_[j], aa[2 * j], aa[2 * j + 1]); }
        if (m + NGW < M) GN_LOAD(m + NGW);
        float s = 0.f, bs = 0.f;
#pragma unroll
        for (int q = 0; q < 4; ++q) {
            s += (y[q].x + y[q].y) + (y[q].z + y[q].w);
            const f32x4 kp = k[q] * (1.0f + (aa[q] - 1.0f) * kaq[q]);
            const f32x4 t = r[q] * kp * rkq[q];
            bs += (t.x + t.y) + (t.z + t.w);
        }
        s += __shfl_xor(s, 1); s += __shfl_xor(s, 2); bs += __shfl_xor(bs, 1); bs += __shfl_xor(bs, 2);
        const float mean = s * (1.0f / 64.0f);
        float q2 = 0.f;
#pragma unroll
        for (int q = 0; q < 4; ++q) { const f32x4 dlt = y[q] - mean; q2 += (dlt.x * dlt.x + dlt.y * dlt.y) + (dlt.z * dlt.z + dlt.w * dlt.w); }
        q2 += __shfl_xor(q2, 1); q2 += __shfl_xor(q2, 2);
        const float rstd = 1.0f / sqrtf(q2 * (1.0f / 64.0f) + 64e-5f);
        f32x4 o[4];
#pragma unroll
        for (int q = 0; q < 4; ++q) {
            const f32x4 yn = (y[q] - mean) * rstd * ggq[q] + gbq[q] + bs * v[q];
#pragma unroll
            for (int e = 0; e < 4; ++e) o[q][e] = yn[e] * z[q][e] * fsigmoid(z[q][e]);
        }
        *(u32x4*)(Y + off) = pack8(o[0], o[1]); *(u32x4*)(Y + off + 8) = pack8(o[2], o[3]);
    }
}
__device__ __forceinline__ void final_norm_phase(const bf16_t* H2, float* out, const float* g, int G, int bid, int tid) {
    const int wave = __builtin_amdgcn_readfirstlane(tid >> 6), lane = tid & 63;
    const int gw = bid * NWAVES + wave, NGW = G * NWAVES;
    f32x4 gv[4];
#pragma unroll
    for (int j = 0; j < 2; ++j) { gv[2 * j] = *(const f32x4*)(g + j * 512 + lane * 8); gv[2 * j + 1] = *(const f32x4*)(g + j * 512 + lane * 8 + 4); }
    u32x4 rh_[2];
    if (gw < M) { rh_[0] = *(const u32x4*)(H2 + (size_t)gw * D + lane * 8); rh_[1] = *(const u32x4*)(H2 + (size_t)gw * D + 512 + lane * 8); }
    for (int m = gw; m < M; m += NGW) {
        f32x4 v[4]; float s = 0.f;
        unpack8(rh_[0], v[0], v[1]); unpack8(rh_[1], v[2], v[3]);
        if (m + NGW < M) { rh_[0] = *(const u32x4*)(H2 + (size_t)(m + NGW) * D + lane * 8); rh_[1] = *(const u32x4*)(H2 + (size_t)(m + NGW) * D + 512 + lane * 8); }
#pragma unroll
        for (int q = 0; q < 4; ++q) s += (v[q].x * v[q].x + v[q].y * v[q].y) + (v[q].z * v[q].z + v[q].w * v[q].w);
        const float rstd = 1.0f / sqrtf(wave_sum(s) * (1.0f / D) + 1e-6f);
#pragma unroll
        for (int j = 0; j < 2; ++j) { float* o = out + (size_t)m * D + j * 512 + lane * 8; *(f32x4*)o = v[2 * j] * rstd * gv[2 * j]; *(f32x4*)(o + 4) = v[2 * j + 1] * rstd * gv[2 * j + 1]; }
    }
}
#ifndef MK_PER_PHASE
#define MK_PER_PHASE 0
#endif
constexpr int NPHASE = 15;
#ifndef MK_REP_PHASE
#define MK_REP_PHASE -1
#endif
#ifndef MK_REP_N
#define MK_REP_N 2
#endif
#define REPS(k) ((k) == MK_REP_PHASE ? MK_REP_N : 1)

__global__ void __launch_bounds__(NTHR, 2) hybrid_fwd(Args a) {
    extern __shared__ __attribute__((aligned(16))) unsigned char lds_raw[];
    LAS unsigned char* lds = (LAS unsigned char*)lds_raw;
    cg::grid_group grid = cg::this_grid();
    const int wave_s = __builtin_amdgcn_readfirstlane((int)threadIdx.x >> 6);
    const int bid = blockIdx.x, G = gridDim.x;
#define TID() int lane_v_; asm volatile("v_mbcnt_lo_u32_b32 %0, -1, 0\n\tv_mbcnt_hi_u32_b32 %0, -1, %0" : "=v"(lane_v_)); const int tid = wave_s * 64 + lane_v_
    { TID(); if (tid < 16) ((LAS unsigned*)(lds + LDS_BYTES - 64))[tid] = 0u; __syncthreads();
#if !MK_PER_PHASE
      kptr_t kpb = kargs(); (void)xcd_barrier_post((unsigned*)(kws(kpb) + WS_CTL), (volatile LAS unsigned*)(lds + LDS_BYTES - 64), tid);
#endif
    }
    int lo, hi; { kptr_t kp0 = kargs(); lo = *(const int __attribute__((address_space(4)))*)(kp0 + 8 * 26); hi = *(const int __attribute__((address_space(4)))*)(kp0 + 8 * 26 + 4); }
#ifndef PH_MASK
#define PH_MASK 0x7fff
#endif
#define IN(k) (((PH_MASK >> (k)) & 1) && lo <= (k) && (k) < hi)
#define SEAM(k) do { if (IN(k) && IN((k) + 1)) { if ((k) == 0) grid.sync(); else { TID(); kptr_t kpb = kargs(); XcdBarrier xb_; xb_.bar = (unsigned*)(kws(kpb) + WS_CTL); xb_.x = xb_xcc_id(); xb_.st = (volatile LAS unsigned*)(lds + LDS_BYTES - 64); xcd_barrier(xb_, tid); } } } while (0)
#define PTRS() kptr_t kp = kargs(); unsigned char* ws = kws(kp); (void)ws
#define S1 ((bf16_t*)(ws + WS_S1))
#define S2 ((bf16_t*)(ws + WS_S2))
#define S3 ((bf16_t*)(ws + WS_S3))
#define S4 ((bf16_t*)(ws + WS_S4))
#define QKVZ ((bf16_t*)(ws + WS_QKVZ))
#define XS0 ((bf16_t*)(ws + WS_XS0))
#define XS1 ((bf16_t*)(ws + WS_XS1))
#define WAb ((bf16_t*)(ws + WS_WA))
#define A2 ((bf16_t*)(ws + WS_A2))
#define Lb ((bf16_t*)(ws + WS_L))
#define Kr ((bf16_t*)kout(kp))
#define Vr ((bf16_t*)kout(kp) + (size_t)M * D)
#define WR ((const bf16_t*)(ws + WS_WR))

    if (IN(0)) for (int rep_ = 0; rep_ < REPS(0); ++rep_) { TID(); p0_prologue(lds, G, bid, tid); }
    SEAM(0);
    if (IN(1)) for (int rep_ = 0; rep_ < REPS(1); ++rep_) { TID(); PTRS();
        { pg8::Gemm g{S1, (const bf16_t*)(ws + WS_WQKVZ), M, ATT_IN, D}; pg8::StaticOrder S; S.init(M, ATT_IN, G, bid);
          pg8::EpiQKVZ E{QKVZ, (const float*)(ws + WS_BIAS), (const float*)(ws + WS_COS), (const float*)(ws + WS_SIN)};
          pg8::gemm_phase<pg8::EpiQKVZ, pg8::StaticOrder, true, true>(lds, g, S, E, tid); }
        __syncthreads();
        { pg8::Gemm g{(const bf16_t*)(ws + WS_PB0), (const bf16_t*)(ws + WS_WP0), M, D, PLE}; pg8::StaticOrder S; S.init(M, D, G, bid);
          pg8::EpiStore E{S2, D};
          pg8::gemm_phase<pg8::EpiStore, pg8::StaticOrder, true, true>(lds, g, S, E, tid); }
    }
    SEAM(1);
    if (IN(2)) for (int rep_ = 0; rep_ < REPS(2); ++rep_) { TID(); PTRS(); attn_phase(lds, QKVZ, kin(kp, I_ASINK), S1, G, bid, tid); }
    SEAM(2);
    if (IN(3)) for (int rep_ = 0; rep_ < REPS(3); ++rep_) { TID(); PTRS();
        pg8::Gemm g{S1, (const bf16_t*)(ws + WS_WO0), M, D, D}; pg8::StaticOrder S; S.init(M, D, G, bid);
        pg8::EpiRes<false> E{(const void*)kin(kp, I_X), S3};
        pg8::gemm_phase<pg8::EpiRes<false>, pg8::StaticOrder, true, true>(lds, g, S, E, tid);
    }
    SEAM(3);
    if (IN(4)) for (int rep_ = 0; rep_ < REPS(4); ++rep_) { TID(); PTRS();
        pg8::Gemm g{S3, (const bf16_t*)(ws + WS_WG0), M, D, D}; pg8::StaticOrder S; S.init(M, D, G, bid);
        pg8::EpiGate<false> E{S3, S2, (void*)S4};
        pg8::gemm_phase<pg8::EpiGate<false>, pg8::StaticOrder, true, true>(lds, g, S, E, tid);
    }
    SEAM(4);
    if (IN(5)) for (int rep_ = 0; rep_ < REPS(5); ++rep_) { TID(); PTRS(); lerp_phase<0>(S4, kin(kp, I_NORMG) + D, kin(kp, I_MU), S1, XS0, XS1, G, bid, tid); }
    SEAM(5);
    if (IN(6)) for (int rep_ = 0; rep_ < REPS(6); ++rep_) { TID(); PTRS();
        { pg8::Gemm g{XS0, WR, M, 2 * D, D, XS1, 4}; pg8::StaticOrder S; S.init(M, 2 * D, G, bid); pg8::EpiStore2 E{S3, Kr, 4, D};
          pg8::gemm_phase<pg8::EpiStore2, pg8::StaticOrder, true, true>(lds, g, S, E, tid); }
        __syncthreads();
        { pg8::Gemm g{S1, (const bf16_t*)(ws + WS_WL), M, 256, D}; pg8::StaticOrder S; S.init(M, 256, G, bid); pg8::EpiStore E{Lb, 256};
          pg8::gemm_phase<pg8::EpiStore, pg8::StaticOrder, true, true>(lds, g, S, E, tid); }
    }
    SEAM(6);
    if (IN(7)) for (int rep_ = 0; rep_ < REPS(7); ++rep_) { TID(); PTRS(); lerp_phase<1>(S4, kin(kp, I_NORMG) + D, kin(kp, I_MU), nullptr, XS0, XS1, G, bid, tid); lora_mid_phase(Lb, A2, G, bid, tid); }
    SEAM(7);
    if (IN(8)) for (int rep_ = 0; rep_ < REPS(8); ++rep_) { TID(); PTRS();
        { pg8::Gemm g{XS0, WR + (size_t)2 * D * D, M, 2 * D, D, XS1, 4}; pg8::StaticOrder S; S.init(M, 2 * D, G, bid); pg8::EpiStore2 E{Vr, S2, 4, D};
          pg8::gemm_phase<pg8::EpiStore2, pg8::StaticOrder, true, true>(lds, g, S, E, tid); }
    }
    SEAM(8);
    if (IN(9)) for (int rep_ = 0; rep_ < REPS(9); ++rep_) { TID(); PTRS();
        pg8::Gemm g{A2, (const bf16_t*)(ws + WS_W2), M, 2048, 128}; pg8::StaticOrder S; S.init(M, 2048, G, bid);
        pg8::EpiWA E{WAb, kin(kp, I_W0), kin(kp, I_A0)};
        pg8::gemm_phase<pg8::EpiWA, pg8::StaticOrder, true, true>(lds, g, S, E, tid);
    }
    SEAM(9);
    if (IN(10)) for (int rep_ = 0; rep_ < REPS(10); ++rep_) { TID(); PTRS(); scan_phase(lds, S3, Kr, Vr, WAb, kin(kp, I_KK), kin(kp, I_KA), S1, G, bid, tid); }
    SEAM(10);
    if (IN(11)) for (int rep_ = 0; rep_ < REPS(11); ++rep_) { TID(); PTRS(); gn_phase(S1, S3, Kr, Vr, S2, WAb, kin(kp, I_KA), kin(kp, I_RK), kin(kp, I_GNG), kin(kp, I_GNB), G, bid, tid); }
    SEAM(11);
    if (IN(12)) for (int rep_ = 0; rep_ < REPS(12); ++rep_) { TID(); PTRS();
        { pg8::Gemm g{S1, (const bf16_t*)(ws + WS_WO1), M, D, D}; pg8::StaticOrder S; S.init(M, D, G, bid); pg8::EpiRes<true> E{(const void*)S4, S3};
          pg8::gemm_phase<pg8::EpiRes<true>, pg8::StaticOrder, true, true>(lds, g, S, E, tid); }
        __syncthreads();
        { pg8::Gemm g{(const bf16_t*)(ws + WS_PB1), (const bf16_t*)(ws + WS_WP1), M, D, PLE}; pg8::StaticOrder S; S.init(M, D, G, bid); pg8::EpiStore E{S2, D};
          pg8::gemm_phase<pg8::EpiStore, pg8::StaticOrder, true, true>(lds, g, S, E, tid); }
    }
    SEAM(12);
    if (IN(13)) for (int rep_ = 0; rep_ < REPS(13); ++rep_) { TID(); PTRS();
        pg8::Gemm g{S3, (const bf16_t*)(ws + WS_WG1), M, D, D}; pg8::StaticOrder S; S.init(M, D, G, bid);
        pg8::EpiGate<false> E{S3, S2, (void*)S1};
        pg8::gemm_phase<pg8::EpiGate<false>, pg8::StaticOrder, true, true>(lds, g, S, E, tid);
    }
    SEAM(13);
    if (IN(14)) for (int rep_ = 0; rep_ < REPS(14); ++rep_) { TID(); PTRS(); final_norm_phase(S1, kout(kp), kin(kp, I_FNG), G, bid, tid); }
#undef IN
#undef SEAM
}

extern "C" void kernel_launch(void* const* d_in, const int* in_sizes, int n_in, void* d_out, int out_size, void* d_ws, size_t ws_size, hipStream_t stream) {
    static int grid = 0;
    if (grid == 0) {
        if (n_in != 24 || out_size != M * D || ws_size < WS_END) { fprintf(stderr, "kernel_launch: unexpected shapes (n_in %d, out %d, ws %zu)\n", n_in, out_size, ws_size); grid = -1; return; }
        int dev = 0, cus = 0, per_cu = 0;
        (void)hipGetDevice(&dev); (void)hipDeviceGetAttribute(&cus, hipDeviceAttributeMultiprocessorCount, dev);
        if (hipFuncSetAttribute((const void*)hybrid_fwd, hipFuncAttributeMaxDynamicSharedMemorySize, LDS_BYTES) != hipSuccess) { fprintf(stderr, "kernel_launch: hipFuncSetAttribute failed\n"); grid = -1; return; }
        if (hipOccupancyMaxActiveBlocksPerMultiprocessor(&per_cu, (const void*)hybrid_fwd, NTHR, LDS_BYTES) != hipSuccess || per_cu < 1) { fprintf(stderr, "kernel_launch: occupancy query reports %d\n", per_cu); per_cu = 1; }
        (void)hipGetLastError();
        grid = cus > 0 ? cus : 256;
    }
    if (grid < 0) return;
    Args a{};
    for (int i = 0; i < 24; ++i) a.in[i] = (const float*)d_in[i];
    a.out = (float*)d_out; a.ws = (unsigned char*)d_ws;
#if MK_PER_PHASE
    for (int ph = 0; ph < NPHASE; ++ph) { a.ph_lo = ph; a.ph_hi = ph + 1; hipLaunchKernelGGL(hybrid_fwd, dim3(grid), dim3(NTHR), LDS_BYTES, stream, a); }
#else
    a.ph_lo = 0; a.ph_hi = NPHASE;
    (void)hipMemsetAsync((unsigned char*)d_ws + WS_CTL, 0, 16384, stream);
    void* args[] = {&a};
    hipError_t e = hipLaunchCooperativeKernel((const void*)hybrid_fwd, dim3(grid), dim3(NTHR), args, LDS_BYTES, stream);
    if (e != hipSuccess) fprintf(stderr, "cooperative launch failed: %s (grid %d)\n", hipGetErrorString(e), grid);
#endif
}
```

```cpp
#include <hip/hip_runtime.h>
#include <hip/hip_cooperative_groups.h>
#include <cstdio>
#include <cstdint>
namespace cg = cooperative_groups;
namespace pg8 {
#define PG8_LAS __attribute__((address_space(3)))
typedef unsigned short bf16_t;
typedef short bf16x8 __attribute__((ext_vector_type(8)));
typedef float f32x4 __attribute__((ext_vector_type(4)));
typedef unsigned u32x4 __attribute__((ext_vector_type(4)));
constexpr int BM = 256, BK = 64, HALF = 128, HTB = HALF * BK * 2  , STAGE_BYTES = 8 * HTB, NXCD = 8, WGM = 8;

__host__ __device__ __forceinline__ int lds_byte(int r, int c) { const int st = (r >> 4) * 2 + (c >> 5), rr = r & 15, cc = c & 31, ob = rr * 64 + cc * 2; return st * 1024 + (ob ^ (((ob >> 9) & 1) << 5)); }
__host__ __device__ __forceinline__ void stage_rc(int b, int& R, int& C) { const int st = b / 1024, sb = b % 1024, swz = sb ^ (((sb >> 9) & 1) << 5); R = (st >> 1) * 16 + swz / 64; C = (st & 1) * 32 + (swz % 64) / 2; }
__host__ __device__ __forceinline__ int perm32(int rho) { const int n = rho >> 4, i = rho & 15; return 8 * (i >> 2) + 4 * n + (i & 3); }

struct Unit { int pm, pn; };
struct Gemm { const bf16_t* A; const bf16_t* Bt; int M, N, K; const bf16_t* A2 = nullptr; int nsplit = 1 << 30;
    __host__ __device__ __forceinline__ const bf16_t* asel(int pn) const { return pn < nsplit ? A : A2; } };

struct StaticOrder {
    int nM, nN, nwg, G, c;
    __host__ __device__ void init(int M, int N, int G_, int c_) { nM = M / BM; nN = N / BM; nwg = nM * nN; G = G_; c = c_; }
    __host__ __device__ bool next(int i, Unit& u) const {
        const long L = (long)i * G + c; if (L >= nwg) return false;
        int wgid = (int)L; { const int q = nwg / NXCD, r = nwg % NXCD, xcd = wgid % NXCD, off = wgid / NXCD; wgid = (xcd < r ? xcd * (q + 1) : r * (q + 1) + (xcd - r) * q) + off; }
        const int nig = WGM * nN, gid = wgid / nig, fm = gid * WGM, gsz = (nM - fm) < WGM ? (nM - fm) : WGM;
        u.pm = fm + ((wgid % nig) % gsz); u.pn = (wgid % nig) / gsz; return true;
    }
    __device__ __forceinline__ void a_ready(const Unit&) const {}
    __device__ __forceinline__ void done(const Unit&) const {}
};

__device__ __forceinline__ unsigned cvt_pk_bf16(float lo, float hi) { unsigned r; asm volatile("v_cvt_pk_bf16_f32 %0, %1, %2" : "=v"(r) : "v"(lo), "v"(hi)); return r; }
typedef float f32x2 __attribute__((ext_vector_type(2)));
__device__ __forceinline__ float bf2f(unsigned short b) { return __uint_as_float((unsigned)b << 16); }
__device__ __forceinline__ float bflo(unsigned w) { return __uint_as_float(w << 16); }
__device__ __forceinline__ float bfhi(unsigned w) { return __uint_as_float(w & 0xffff0000u); }
__device__ __forceinline__ float fsigmoid(float x) { return __builtin_amdgcn_rcpf(1.0f + __expf(-x)); }
__device__ __forceinline__ u32x4 pack8(const f32x4 a, const f32x4 b) { u32x4 w; w.x = cvt_pk_bf16(a[0], a[1]); w.y = cvt_pk_bf16(a[2], a[3]); w.z = cvt_pk_bf16(b[0], b[1]); w.w = cvt_pk_bf16(b[2], b[3]); return w; }
__device__ __forceinline__ void unpack8(const u32x4 w, f32x4& a, f32x4& b) { a = (f32x4){bflo(w.x), bfhi(w.x), bflo(w.y), bfhi(w.y)}; b = (f32x4){bflo(w.z), bfhi(w.z), bflo(w.w), bfhi(w.w)}; }

constexpr float QSCALE = 0.125f * 1.4426950408889634f;

struct EpiQKVZ {
    static constexpr bool PERM = true, AFTER_DRAIN = false;
    bf16_t* O; const float* bias; const float* cs; const float* sn;
    __device__ __forceinline__ void operator()(const f32x4 (&acc)[2][2][4][2], const Unit& u, int wr, int wc, int fr, int fq) const {
        const int row0 = u.pm * BM + wr * 64 + fr, col0 = u.pn * BM + wc * 32 + 8 * fq;
        const bool rope = u.pn < 5; const float sc = u.pn < 4 ? QSCALE : 1.0f;
        const int j4 = 4 * (4 * (wc & 1) + fq);
#pragma unroll
        for (int ai = 0; ai < 2; ++ai)
#pragma unroll
            for (int m = 0; m < 4; ++m) {
                const int row = row0 + ai * HALF + m * 16, pos = row & 4095;
                f32x4 c = (f32x4){1.f, 1.f, 1.f, 1.f}, s = (f32x4){0.f, 0.f, 0.f, 0.f};
                if (rope) { c = *(const f32x4*)(cs + pos * 32 + j4); s = *(const f32x4*)(sn + pos * 32 + j4); }
                bf16_t* rowp = O + (size_t)row * 2560 + col0;
#pragma unroll
                for (int bj = 0; bj < 2; ++bj) {
                    const f32x4 v0 = acc[ai][bj][m][0] + *(const f32x4*)(bias + col0 + bj * HALF), v1 = acc[ai][bj][m][1] + *(const f32x4*)(bias + col0 + bj * HALF + 4);
                    f32x4 o0 = v0, o1 = v1;
                    o0 = (v0 * c - v1 * s) * sc; o1 = (v1 * c + v0 * s) * sc;
                    *(u32x4*)(rowp + bj * HALF) = pack8(o0, o1);
                }
            }
    }
};
struct EpiStore {
    static constexpr bool PERM = true, AFTER_DRAIN = false;
    bf16_t* O; int ldc;
    __device__ __forceinline__ void operator()(const f32x4 (&acc)[2][2][4][2], const Unit& u, int wr, int wc, int fr, int fq) const {
        const int row0 = u.pm * BM + wr * 64 + fr, col0 = u.pn * BM + wc * 32 + 8 * fq;
#pragma unroll
        for (int ai = 0; ai < 2; ++ai)
#pragma unroll
            for (int m = 0; m < 4; ++m) { bf16_t* rowp = O + (size_t)(row0 + ai * HALF + m * 16) * ldc + col0;
#pragma unroll
                for (int bj = 0; bj < 2; ++bj) *(u32x4*)(rowp + bj * HALF) = pack8(acc[ai][bj][m][0], acc[ai][bj][m][1]); }
    }
};
struct EpiStore2 {
    static constexpr bool PERM = true, AFTER_DRAIN = false;
    bf16_t* O1; bf16_t* O2; int nsplit; int ldc;
    __device__ __forceinline__ void operator()(const f32x4 (&acc)[2][2][4][2], const Unit& u, int wr, int wc, int fr, int fq) const {
        const bool first = u.pn < nsplit; bf16_t* O = first ? O1 : O2;
        const int row0 = u.pm * BM + wr * 64 + fr, col0 = (first ? u.pn : u.pn - nsplit) * BM + wc * 32 + 8 * fq;
#pragma unroll
        for (int ai = 0; ai < 2; ++ai)
#pragma unroll
            for (int m = 0; m < 4; ++m) { bf16_t* rowp = O + (size_t)(row0 + ai * HALF + m * 16) * ldc + col0;
#pragma unroll
                for (int bj = 0; bj < 2; ++bj) *(u32x4*)(rowp + bj * HALF) = pack8(acc[ai][bj][m][0], acc[ai][bj][m][1]); }
    }
};
template <bool BF> struct EpiRes {
    static constexpr bool PERM = true, AFTER_DRAIN = false;
    const void* base; bf16_t* O;
    __device__ __forceinline__ void operator()(const f32x4 (&acc)[2][2][4][2], const Unit& u, int wr, int wc, int fr, int fq) const {
        const int row0 = u.pm * BM + wr * 64 + fr, col0 = u.pn * BM + wc * 32 + 8 * fq;
#pragma unroll
        for (int ai = 0; ai < 2; ++ai)
#pragma unroll
            for (int m = 0; m < 4; ++m) { const size_t off = (size_t)(row0 + ai * HALF + m * 16) * 1024 + col0;
#pragma unroll
                for (int bj = 0; bj < 2; ++bj) { f32x4 b0, b1;
                    if (BF) { unpack8(*(const u32x4*)((const bf16_t*)base + off + bj * HALF), b0, b1); }
                    else { b0 = *(const f32x4*)((const float*)base + off + bj * HALF); b1 = *(const f32x4*)((const float*)base + off + bj * HALF + 4); }
                    *(u32x4*)(O + off + bj * HALF) = pack8(b0 + acc[ai][bj][m][0], b1 + acc[ai][bj][m][1]); } }
    }
};
template <bool F32OUT> struct EpiGate {
    static constexpr bool PERM = true, AFTER_DRAIN = false;
    const bf16_t* hpre; const bf16_t* pp; void* O;
    __device__ __forceinline__ void operator()(const f32x4 (&acc)[2][2][4][2], const Unit& u, int wr, int wc, int fr, int fq) const {
        const int row0 = u.pm * BM + wr * 64 + fr, col0 = u.pn * BM + wc * 32 + 8 * fq;
#pragma unroll
        for (int ai = 0; ai < 2; ++ai)
#pragma unroll
            for (int m = 0; m < 4; ++m) { const size_t off = (size_t)(row0 + ai * HALF + m * 16) * 1024 + col0;
#pragma unroll
                for (int bj = 0; bj < 2; ++bj) { f32x4 h0, h1, p0, p1;
                    unpack8(*(const u32x4*)(hpre + off + bj * HALF), h0, h1); unpack8(*(const u32x4*)(pp + off + bj * HALF), p0, p1);
                    f32x4 g0, g1;
#pragma unroll
                    for (int e = 0; e < 4; ++e) { g0[e] = fsigmoid(acc[ai][bj][m][0][e]); g1[e] = fsigmoid(acc[ai][bj][m][1][e]); }
                    const f32x4 o0 = h0 + g0 * p0, o1 = h1 + g1 * p1;
                    if (F32OUT) { *(f32x4*)((float*)O + off + bj * HALF) = o0; *(f32x4*)((float*)O + off + bj * HALF + 4) = o1; }
                    else *(u32x4*)((bf16_t*)O + off + bj * HALF) = pack8(o0, o1); } }
    }
};
struct EpiWA {
    static constexpr bool PERM = true, AFTER_DRAIN = false;
    bf16_t* O; const float* w0; const float* a0;
    __device__ __forceinline__ void operator()(const f32x4 (&acc)[2][2][4][2], const Unit& u, int wr, int wc, int fr, int fq) const {
        const int row0 = u.pm * BM + wr * 64 + fr, col0 = u.pn * BM + wc * 32 + 8 * fq;
        const bool isw = u.pn < 4; const float* bvec = isw ? (w0 + col0) : (a0 + col0 - 1024); const float mul = isw ? -0.6065306597126334f : 1.0f;
#pragma unroll
        for (int ai = 0; ai < 2; ++ai)
#pragma unroll
            for (int m = 0; m < 4; ++m) { bf16_t* rowp = O + (size_t)(row0 + ai * HALF + m * 16) * 2048 + col0;
#pragma unroll
                for (int bj = 0; bj < 2; ++bj) { f32x4 o0, o1; const f32x4 b0 = *(const f32x4*)(bvec + bj * HALF), b1 = *(const f32x4*)(bvec + bj * HALF + 4);
#pragma unroll
                    for (int e = 0; e < 4; ++e) { o0[e] = mul * fsigmoid(acc[ai][bj][m][0][e] + b0[e]); o1[e] = mul * fsigmoid(acc[ai][bj][m][1][e] + b1[e]); }
                    *(u32x4*)(rowp + bj * HALF) = pack8(o0, o1); } }
    }
};
template <class Epi, class Sched, bool ALIGN_EPI = false, bool SP2 = false>
__device__ __forceinline__ void gemm_phase(PG8_LAS unsigned char* lds, const Gemm g, const Sched& S, const Epi& E, const int tid_in) {
    const int tid = tid_in, wid = __builtin_amdgcn_readfirstlane(tid >> 6), lane = tid & 63, wr = wid >> 2, wc = wid & 3, fr = lane & 15, fq = lane >> 4;
    const int K = g.K, nt = K / BK;
    unsigned voffA[2], voffB[2];
#pragma unroll
    for (int i = 0; i < 2; ++i) { int R, C; stage_rc(tid * 16 + i * 8192, R, C); const int Rb = Epi::PERM ? ((R & ~31) + perm32(R & 31)) : R;
        voffA[i] = (unsigned)(R * K + C) * 2u; voffB[i] = (unsigned)(Rb * K + C) * 2u; }
    const size_t kstep = (size_t)(BK * 2);
    const size_t hstep = (size_t)HALF * K * 2;
    const size_t tstep = 2 * hstep;
    const unsigned ldsw = (unsigned)wid * 1024u;
    const int aoff = lds_byte(wr * 64 + fr, fq * 8), boff = lds_byte(wc * 32 + fr, fq * 8);
#define PG8_SA(b, h) (((b) * 2 + (h)) * HTB)
#define PG8_SB(b, h) ((4 + (b) * 2 + (h)) * HTB)
#define PG8_STAGE(bufoff, gbase, voff) do { _Pragma("unroll") for (int _i = 0; _i < 2; ++_i) \
        __builtin_amdgcn_global_load_lds((const unsigned*)((const char*)(gbase) + (voff)[_i]), (PG8_LAS unsigned*)(lds + (bufoff) + ldsw + _i * 8192), 16, 0, 0); } while (0)
#define PG8_LDA(dst, b, h) do { _Pragma("unroll") for (int m = 0; m < 4; ++m) _Pragma("unroll") for (int k = 0; k < 2; ++k) dst[m][k] = *(const PG8_LAS bf16x8*)(lds + PG8_SA(b, h) + aoff + m * 2048 + k * 1024); } while (0)
#define PG8_LDB(dst, b, h) do { _Pragma("unroll") for (int n = 0; n < 2; ++n) _Pragma("unroll") for (int k = 0; k < 2; ++k) dst[n][k] = *(const PG8_LAS bf16x8*)(lds + PG8_SB(b, h) + boff + n * 2048 + k * 1024); } while (0)
#define PG8_MMA(ai, bj, At, Bt) do { __builtin_amdgcn_s_setprio(1); _Pragma("unroll") for (int m = 0; m < 4; ++m) _Pragma("unroll") for (int n = 0; n < 2; ++n) _Pragma("unroll") for (int k = 0; k < 2; ++k) \
        acc[ai][bj][m][n] = __builtin_amdgcn_mfma_f32_16x16x32_bf16(Bt[n][k], At[m][k], acc[ai][bj][m][n], 0, 0, 0); __builtin_amdgcn_s_setprio(0); } while (0)
#define PG8_WAIT_V(n) asm volatile("s_waitcnt vmcnt(" #n ")" ::: "memory")
#define PG8_WAIT_L(n) asm volatile("s_waitcnt lgkmcnt(" #n ")" ::: "memory")
#define PG8_BAR __builtin_amdgcn_s_barrier()
#define PG8_SCHED __builtin_amdgcn_sched_barrier(0)
    Unit cur, nxt; int ui = 0;
    if (!S.next(0, cur)) return;
    f32x4 acc[2][2][4][2];
#pragma unroll
    for (int a = 0; a < 2; ++a)
#pragma unroll
        for (int b = 0; b < 2; ++b)
#pragma unroll
            for (int m = 0; m < 4; ++m)
#pragma unroll
                for (int n = 0; n < 2; ++n) acc[a][b][m][n] = (f32x4){0.f, 0.f, 0.f, 0.f};
    bf16x8 At[4][2], B0[2][2], B1[2][2];
    const char* cA = (const char*)g.asel(cur.pn) + (size_t)cur.pm * tstep; const char* cB = (const char*)g.Bt + (size_t)cur.pn * tstep;
    S.a_ready(cur);
    if constexpr (SP2) {
        PG8_STAGE(PG8_SB(0, 0), cB, voffB); PG8_STAGE(PG8_SB(0, 1), cB + hstep, voffB); PG8_STAGE(PG8_SA(0, 0), cA, voffA); PG8_STAGE(PG8_SA(0, 1), cA + hstep, voffA);
        if (wr == 1) PG8_BAR;
        PG8_WAIT_V(2); PG8_BAR;
        PG8_STAGE(PG8_SB(1, 0), cB + kstep, voffB); PG8_STAGE(PG8_SA(1, 0), cA + kstep, voffA); PG8_STAGE(PG8_SB(1, 1), cB + hstep + kstep, voffB);
        PG8_WAIT_V(6); PG8_BAR;
    } else {
        PG8_STAGE(PG8_SB(0, 0), cB, voffB); PG8_STAGE(PG8_SA(0, 0), cA, voffA); PG8_STAGE(PG8_SB(0, 1), cB + hstep, voffB); PG8_STAGE(PG8_SA(0, 1), cA + hstep, voffA);
        if (wr == 1) PG8_BAR;
        PG8_WAIT_V(4); PG8_BAR;
        PG8_STAGE(PG8_SB(1, 0), cB + kstep, voffB); PG8_STAGE(PG8_SA(1, 0), cA + kstep, voffA); PG8_STAGE(PG8_SB(1, 1), cB + hstep + kstep, voffB);
        PG8_WAIT_V(6); PG8_BAR;
    }
    for (;;) {
        const bool has_next = S.next(ui + 1, nxt);
        const char* nA = has_next ? (const char*)g.asel(nxt.pn) + (size_t)nxt.pm * tstep : cA; const char* nB = has_next ? (const char*)g.Bt + (size_t)nxt.pn * tstep : cB;
        for (int t = 0; t < nt; t += 2) {
            const bool last = (t == nt - 2);
            const char* a1 = cA + (size_t)(t + 1) * kstep;
            const char* a2 = last ? nA : cA + (size_t)(t + 2) * kstep; const char* b2 = last ? nB : cB + (size_t)(t + 2) * kstep;
            const char* a3 = a2 + kstep; const char* b3 = b2 + kstep;
            if (last && has_next) S.a_ready(nxt);
            if constexpr (SP2) {
            PG8_LDB(B0, 0, 0); PG8_LDB(B1, 0, 1); PG8_SCHED; PG8_LDA(At, 0, 0); PG8_STAGE(PG8_SA(1, 1), a1 + hstep, voffA);
            PG8_WAIT_V(8); PG8_WAIT_L(0); PG8_BAR; PG8_MMA(0, 0, At, B0); PG8_MMA(0, 1, At, B1); PG8_BAR; PG8_SCHED;
            PG8_LDA(At, 0, 1); PG8_STAGE(PG8_SB(0, 0), b2, voffB); PG8_STAGE(PG8_SB(0, 1), b2 + hstep, voffB); PG8_STAGE(PG8_SA(0, 0), a2, voffA);
            PG8_WAIT_V(8); PG8_WAIT_L(0); PG8_BAR; PG8_MMA(1, 0, At, B0); PG8_MMA(1, 1, At, B1); PG8_BAR; PG8_SCHED;
            PG8_LDB(B0, 1, 0); PG8_LDB(B1, 1, 1); PG8_SCHED; PG8_LDA(At, 1, 0); PG8_STAGE(PG8_SA(0, 1), a2 + hstep, voffA);
            PG8_WAIT_V(8); PG8_WAIT_L(0); PG8_BAR; PG8_MMA(0, 0, At, B0); PG8_MMA(0, 1, At, B1); PG8_BAR; PG8_SCHED;
            PG8_LDA(At, 1, 1); PG8_STAGE(PG8_SB(1, 0), b3, voffB); PG8_STAGE(PG8_SB(1, 1), b3 + hstep, voffB); PG8_STAGE(PG8_SA(1, 0), a3, voffA);
            PG8_WAIT_V(8); PG8_WAIT_L(0); PG8_BAR; PG8_MMA(1, 0, At, B0); PG8_MMA(1, 1, At, B1); PG8_BAR; PG8_SCHED;
            } else {
            PG8_LDB(B0, 0, 0); PG8_SCHED; PG8_LDA(At, 0, 0); PG8_STAGE(PG8_SA(1, 1), a1 + hstep, voffA);
            PG8_WAIT_L(8); PG8_BAR; PG8_WAIT_L(0); PG8_MMA(0, 0, At, B0); PG8_BAR; PG8_SCHED;
            PG8_LDB(B1, 0, 1); PG8_STAGE(PG8_SB(0, 0), b2, voffB);
            PG8_BAR; PG8_WAIT_L(0); PG8_MMA(0, 1, At, B1); PG8_BAR;
            PG8_LDA(At, 0, 1); PG8_STAGE(PG8_SA(0, 0), a2, voffA);
            PG8_BAR; PG8_WAIT_L(0); PG8_MMA(1, 0, At, B0); PG8_BAR; PG8_SCHED;
            PG8_STAGE(PG8_SB(0, 1), b2 + hstep, voffB);
            PG8_WAIT_V(6); PG8_BAR; PG8_MMA(1, 1, At, B1); PG8_BAR;
            PG8_LDB(B0, 1, 0); PG8_SCHED; PG8_LDA(At, 1, 0); PG8_STAGE(PG8_SA(0, 1), a2 + hstep, voffA);
            PG8_WAIT_L(8); PG8_BAR; PG8_WAIT_L(0); PG8_MMA(0, 0, At, B0); PG8_BAR; PG8_SCHED;
            PG8_LDB(B1, 1, 1); PG8_STAGE(PG8_SB(1, 0), b3, voffB);
            PG8_BAR; PG8_WAIT_L(0); PG8_MMA(0, 1, At, B1); PG8_BAR;
            PG8_LDA(At, 1, 1); PG8_STAGE(PG8_SA(1, 0), a3, voffA);
            PG8_BAR; PG8_WAIT_L(0); PG8_MMA(1, 0, At, B0); PG8_BAR; PG8_SCHED;
            PG8_STAGE(PG8_SB(1, 1), b3 + hstep, voffB);
            PG8_WAIT_V(6); PG8_BAR; PG8_MMA(1, 1, At, B1); PG8_BAR;
            }
        }
        if constexpr (ALIGN_EPI) { if (wr == 0) PG8_BAR; }
        if constexpr (!Epi::AFTER_DRAIN) { E(acc, cur, wr, wc, fr, fq); S.done(cur); }
        if (!has_next) break;
#pragma unroll
        for (int a = 0; a < 2; ++a)
#pragma unroll
            for (int b = 0; b < 2; ++b)
#pragma unroll
                for (int m = 0; m < 4; ++m)
#pragma unroll
                    for (int n = 0; n < 2; ++n) acc[a][b][m][n] = (f32x4){0.f, 0.f, 0.f, 0.f};
        cur = nxt; cA = nA; cB = nB; ++ui;
        if constexpr (ALIGN_EPI) { if (wr == 1) PG8_BAR; }
    }
    PG8_WAIT_V(0);
    if constexpr (!ALIGN_EPI) { if (wr == 0) PG8_BAR; }
    PG8_BAR;
    if constexpr (Epi::AFTER_DRAIN) { E.fused(acc, cur, wr, wc, fr, fq, lds, wid, lane); S.done(cur); }
#undef PG8_SA
#undef PG8_SB
#undef PG8_STAGE
#undef PG8_LDA
#undef PG8_LDB
#undef PG8_MMA
#undef PG8_WAIT_V
#undef PG8_WAIT_L
#undef PG8_BAR
#undef PG8_SCHED
}
}
using pg8::bf16_t; using pg8::bf16x8; using pg8::f32x4; using pg8::u32x4; using pg8::cvt_pk_bf16; using pg8::bf2f; using pg8::bflo; using pg8::bfhi; using pg8::fsigmoid; using pg8::pack8; using pg8::unpack8;
#define LAS __attribute__((address_space(3)))
typedef unsigned u32x2 __attribute__((ext_vector_type(2)));
typedef float f32x2 __attribute__((ext_vector_type(2)));

constexpr int NB = 8, T = 4096, D = 1024, M = NB * T, PLE = 256, ATT_IN = 2560;
constexpr int NWAVES = 8, NTHR = 512;
constexpr int LDS_BYTES = 147456;

constexpr size_t MiB = 1u << 20;
constexpr size_t WS_WQKVZ = 0;
constexpr size_t WS_WO0   = 5 * MiB;
constexpr size_t WS_WG0   = 7 * MiB;
constexpr size_t WS_WG1   = 9 * MiB;
constexpr size_t WS_WO1   = 11 * MiB;
constexpr size_t WS_WR    = 13 * MiB;
constexpr size_t WS_WP0   = 21 * MiB;
constexpr size_t WS_WP1   = 21 * MiB + 512 * 1024;
constexpr size_t WS_WL    = 22 * MiB;
constexpr size_t WS_W2    = 22 * MiB + 512 * 1024;
constexpr size_t WS_COS   = 23 * MiB;
constexpr size_t WS_SIN   = 23 * MiB + 512 * 1024;
constexpr size_t WS_BIAS  = 24 * MiB;
constexpr size_t WS_CTL   = 25 * MiB;
constexpr size_t WS_PB0   = 32 * MiB;
constexpr size_t WS_L     = 32 * MiB;
constexpr size_t WS_PB1   = 48 * MiB;
constexpr size_t WS_S1    = 64 * MiB;
constexpr size_t WS_QKVZ  = 128 * MiB;
constexpr size_t WS_XS0   = 128 * MiB, WS_XS1 = 192 * MiB, WS_WA = 128 * MiB, WS_A2 = 256 * MiB;
constexpr size_t WS_S2    = 288 * MiB;
constexpr size_t WS_S3    = 352 * MiB;
constexpr size_t WS_S4    = 416 * MiB;
constexpr size_t WS_END   = 480 * MiB;

__device__ __forceinline__ float wave_sum(float v) {
#pragma unroll
    for (int o = 1; o < 64; o <<= 1) v += __shfl_xor(v, o);
    return v;
}
__device__ __forceinline__ float dpp_add(float x, const int ctrl_dummy) { return x; }
#define DPP_XADD(x, ctrl) ((x) + __builtin_bit_cast(float, __builtin_amdgcn_update_dpp(0, __builtin_bit_cast(int, (x)), (ctrl), 0xF, 0xF, true)))
__device__ __forceinline__ float row16_sum(float x) {
    x = DPP_XADD(x, 0xB1);
    x = DPP_XADD(x, 0x4E);
    x = DPP_XADD(x, 0x141);
    x = DPP_XADD(x, 0x140);
    return x;
}

__device__ __forceinline__ void grid_bar(unsigned* ctr, unsigned target, int tid) {
    asm volatile("s_waitcnt vmcnt(0)" ::: "memory");
    __syncthreads();
    if (tid == 0) {
        __builtin_amdgcn_fence(__ATOMIC_RELEASE, "agent");
        asm volatile("s_waitcnt vmcnt(0)" ::: "memory");
        __hip_atomic_fetch_add(ctr, 1u, __ATOMIC_RELAXED, __HIP_MEMORY_SCOPE_AGENT);
        while (__hip_atomic_load(ctr, __ATOMIC_RELAXED, __HIP_MEMORY_SCOPE_AGENT) < target) __builtin_amdgcn_s_sleep(2);
        __builtin_amdgcn_fence(__ATOMIC_ACQUIRE, "agent");
        asm volatile("s_waitcnt vmcnt(0)" ::: "memory");
    }
    __syncthreads();
}
#define XB_TMO      128
#define XB_XCNT(j)  (256  + 64 * (j))
#define XB_XSUB(j)  (1280 + 64 * (j))
#define XB_XGEN(j)  (2304 + 64 * (j))
#define XB_TOP      3328
#define XB_TOPGEN   3392
#define XCD_BAR_WORDS 3456
#define XB_SPIN_CAP (1u << 18)

__device__ __forceinline__ unsigned xb_ld(unsigned* p)              { return __hip_atomic_load(p, __ATOMIC_RELAXED, __HIP_MEMORY_SCOPE_AGENT); }
__device__ __forceinline__ unsigned xb_add(unsigned* p, unsigned v) { return __hip_atomic_fetch_add(p, v, __ATOMIC_RELAXED, __HIP_MEMORY_SCOPE_AGENT); }
__device__ __forceinline__ unsigned xb_xcc_id() { return (unsigned)__builtin_amdgcn_s_getreg((3 << 11) | 20) & 0xFu; }
#define XB_SPIN(cond, bar) do { unsigned _sp = 0; while (cond) { __builtin_amdgcn_s_sleep(1); \
    if ((++_sp & 255u) == 0u) { if (xb_ld(&(bar)[XB_TMO])) break; if (_sp > XB_SPIN_CAP) { atomicAdd(&(bar)[XB_TMO], 1u); break; } } } } while (0)

struct XcdBarrier {
    unsigned* bar; unsigned x;
    volatile LAS unsigned* st;
};

__device__ __forceinline__ XcdBarrier xcd_barrier_post(unsigned* bar, volatile LAS unsigned* st, const int tid_) {
    XcdBarrier b; b.bar = bar; b.x = xb_xcc_id(); b.st = st;
    if (tid_ == 0) (void)xb_add(&bar[XB_XCNT(b.x)], 1u);
    return b;
}
__device__ __forceinline__ void xcd_barrier_complete(unsigned* bar, unsigned x, unsigned& nloc, unsigned& nx) {
    const unsigned G = gridDim.x * gridDim.y * gridDim.z;
    unsigned sum, cnt, mine, sp = 0u;
    for (;;) {
        sum = 0u; cnt = 0u; mine = 0u;
#pragma unroll
        for (unsigned j = 0; j < 16; ++j) { const unsigned c = xb_ld(&bar[XB_XCNT(j)]); sum += c; cnt += (c > 0u) ? 1u : 0u; mine = (j == x) ? c : mine; }
        if (sum == G) break;
        __builtin_amdgcn_s_sleep(1);
        if ((++sp & 255u) == 0u) { if (xb_ld(&bar[XB_TMO])) break; if (sp > XB_SPIN_CAP) { atomicAdd(&bar[XB_TMO], 1u); break; } }
    }
    nloc = mine > 0u ? mine : 1u; nx = cnt > 0u ? cnt : 1u;
}

__device__ __forceinline__ void xcd_barrier(const XcdBarrier& b, const int tid_) {
    asm volatile("s_waitcnt vmcnt(0)" ::: "memory");
    __syncthreads();
    if (tid_ == 0) {
        unsigned* bar = b.bar;
        __builtin_amdgcn_s_waitcnt(0);
        unsigned nloc = b.st[0], nx = b.st[1];
        if (nloc == 0u) { xcd_barrier_complete(bar, b.x, nloc, nx); b.st[0] = nloc; b.st[1] = nx; }
        const unsigned old = xb_add(&bar[XB_XSUB(b.x)], 1u);
        const unsigned gen = old / nloc;
        if (old + 1u == (gen + 1u) * nloc) {
            __builtin_amdgcn_fence(__ATOMIC_RELEASE, "agent");
            asm volatile("s_waitcnt vmcnt(0)" ::: "memory");
            const unsigned og = xb_add(&bar[XB_TOP], 1u);
            const unsigned tg = og / nx;
            if (og + 1u == (tg + 1u) * nx) xb_add(&bar[XB_TOPGEN], 1u);
            else XB_SPIN(xb_ld(&bar[XB_TOPGEN]) == tg, bar);
            __builtin_amdgcn_fence(__ATOMIC_ACQUIRE, "agent");
            xb_add(&bar[XB_XGEN(b.x)], 1u);
            asm volatile("s_waitcnt vmcnt(0)" ::: "memory");
        } else {
            XB_SPIN(xb_ld(&bar[XB_XGEN(b.x)]) == gen, bar);
            __builtin_amdgcn_fence(__ATOMIC_ACQUIRE, "agent");
            asm volatile("s_waitcnt vmcnt(0)" ::: "memory");
        }
    }
    __syncthreads();
}

__device__ __forceinline__ int qk_perm_row(int n) {
    if (n >= 1280) return n;
    const int hd = n & ~63, d = n & 63, dd = d & 31;
    return hd + 8 * (dd >> 2) + 4 * (d >> 5) + (dd & 3);
}
template <int MODE>
__device__ __forceinline__ void transpose_item(const float* W, int K, int N, bf16_t* WT, int row_off, LAS float* scr, int item, int lane, const float* s) {
    const int nblk = N / 32, kb = item / nblk, nb = item % nblk, k0 = 64 * kb, n0 = 32 * nb;
#pragma unroll 8
    for (int i = 0; i < 32; ++i) { const int kk = 2 * i + (lane >> 5); float v = W[(size_t)(k0 + kk) * N + n0 + (lane & 31)];
        if (MODE == 2) v *= s[k0 + kk]; if (MODE == 3) v *= 1.0f - s[k0 + kk];
        scr[kk * 33 + (lane & 31)] = v; }
    asm volatile("s_waitcnt lgkmcnt(0)" ::: "memory");
    const int c = lane & 7;
#pragma unroll
    for (int j = 0; j < 4; ++j) { const int n = (lane >> 3) + 8 * j; const LAS float* sp = scr + (8 * c) * 33 + n;
        u32x4 o; o.x = cvt_pk_bf16(sp[0 * 33], sp[1 * 33]); o.y = cvt_pk_bf16(sp[2 * 33], sp[3 * 33]); o.z = cvt_pk_bf16(sp[4 * 33], sp[5 * 33]); o.w = cvt_pk_bf16(sp[6 * 33], sp[7 * 33]);
        const int dn = (MODE == 1) ? qk_perm_row(n0 + n) : (n0 + n);
        *(u32x4*)(WT + (size_t)(row_off + dn) * K + k0 + 8 * c) = o; }
    asm volatile("s_waitcnt lgkmcnt(0)" ::: "memory");
}

struct Args { const float* in[24]; float* out; unsigned char* ws; int ph_lo, ph_hi; };
typedef const __attribute__((address_space(4))) unsigned char* kptr_t;
__device__ __forceinline__ kptr_t kargs() { kptr_t p = (kptr_t)__builtin_amdgcn_kernarg_segment_ptr(); asm volatile("" : "+s"(p)); return p; }
#define GAS __attribute__((address_space(1)))
__device__ __forceinline__ const float* kin(kptr_t p, int i) { return (const float*)(const GAS float*)*(const unsigned long long __attribute__((address_space(4)))*)(p + 8 * i); }
__device__ __forceinline__ float* kout(kptr_t p) { return (float*)(GAS float*)*(const unsigned long long __attribute__((address_space(4)))*)(p + 8 * 24); }
__device__ __forceinline__ unsigned char* kws(kptr_t p) { return (unsigned char*)(GAS unsigned char*)*(const unsigned long long __attribute__((address_space(4)))*)(p + 8 * 25); }

enum { I_X = 0, I_P, I_NORMG, I_AWIN, I_ABIN, I_ASINK, I_AWOUT, I_MU, I_RWIN, I_W0, I_W1, I_W2, I_A0, I_A1, I_A2, I_KK, I_KA, I_RK, I_GNG, I_GNB, I_RWOUT, I_PWP, I_PWG, I_FNG };
__device__ __forceinline__ void p0_prologue(LAS unsigned char* lds, int G, int bid, int tid) {
    kptr_t kp = kargs();
    const int wave = __builtin_amdgcn_readfirstlane(tid >> 6), lane = tid & 63;
    LAS float* scr = (LAS float*)(lds + wave * 16384);
    const int gw = bid * NWAVES + wave, NGW = G * NWAVES;
    unsigned char* ws = kws(kp);
    const float* mu = kin(kp, I_MU);
    constexpr int N1 = 1280, N2 = 512, N5 = 2048, N6 = 128, N7 = 32;
    constexpr int NITEMS = N1 + 4 * N2 + N5 + 2 * N6 + 4 * N7;
    for (int it = gw; it < NITEMS; it += NGW) {
        int r = it;
        if (r < N1) { transpose_item<1>(kin(kp, I_AWIN), 1024, 2560, (bf16_t*)(ws + WS_WQKVZ), 0, scr, r, lane, nullptr); continue; } r -= N1;
        if (r < N2) { transpose_item<0>(kin(kp, I_AWOUT), 1024, 1024, (bf16_t*)(ws + WS_WO0), 0, scr, r, lane, nullptr); continue; } r -= N2;
        if (r < N2) { transpose_item<0>(kin(kp, I_PWG), 1024, 1024, (bf16_t*)(ws + WS_WG0), 0, scr, r, lane, nullptr); continue; } r -= N2;
        if (r < N2) { transpose_item<0>(kin(kp, I_PWG) + 1024 * 1024, 1024, 1024, (bf16_t*)(ws + WS_WG1), 0, scr, r, lane, nullptr); continue; } r -= N2;
        if (r < N2) { transpose_item<0>(kin(kp, I_RWOUT), 1024, 1024, (bf16_t*)(ws + WS_WO1), 0, scr, r, lane, nullptr); continue; } r -= N2;
        if (r < N5) { transpose_item<0>(kin(kp, I_RWIN), 1024, 4096, (bf16_t*)(ws + WS_WR), 0, scr, r, lane, nullptr); continue; } r -= N5;
        if (r < N6) { transpose_item<0>(kin(kp, I_PWP), 256, 1024, (bf16_t*)(ws + WS_WP0), 0, scr, r, lane, nullptr); continue; } r -= N6;
        if (r < N6) { transpose_item<0>(kin(kp, I_PWP) + 256 * 1024, 256, 1024, (bf16_t*)(ws + WS_WP1), 0, scr, r, lane, nullptr); continue; } r -= N6;
        if (r < N7) { transpose_item<3>(kin(kp, I_W1), 1024, 64, (bf16_t*)(ws + WS_WL), 0, scr, r, lane, mu + 4 * 1024); continue; } r -= N7;
        if (r < N7) { transpose_item<2>(kin(kp, I_W1), 1024, 64, (bf16_t*)(ws + WS_WL), 64, scr, r, lane, mu + 4 * 1024); continue; } r -= N7;
        if (r < N7) { transpose_item<3>(kin(kp, I_A1), 1024, 64, (bf16_t*)(ws + WS_WL), 128, scr, r, lane, mu + 5 * 1024); continue; } r -= N7;
        transpose_item<2>(kin(kp, I_A1), 1024, 64, (bf16_t*)(ws + WS_WL), 192, scr, r, lane, mu + 5 * 1024);
    }
    {
        const float* g0 = kin(kp, I_NORMG); bf16_t* XN = (bf16_t*)(ws + WS_S1);
        f32x4 gv[4];
#pragma unroll
        for (int j = 0; j < 4; ++j) gv[j] = *((const f32x4*)g0 + lane + 64 * j);
        const float* xin = kin(kp, I_X);
        f32x4 nx[4];
        if (gw < M) {
#pragma unroll
            for (int j = 0; j < 4; ++j) nx[j] = *((const f32x4*)(xin + (size_t)gw * D) + lane + 64 * j); }
        for (int m = gw; m < M; m += NGW) {
            f32x4 v[4]; float s = 0.f;
#pragma unroll
            for (int j = 0; j < 4; ++j) { v[j] = nx[j]; s += (v[j].x * v[j].x + v[j].y * v[j].y) + (v[j].z * v[j].z + v[j].w * v[j].w); }
            if (m + NGW < M) {
#pragma unroll
                for (int j = 0; j < 4; ++j) nx[j] = *((const f32x4*)(xin + (size_t)(m + NGW) * D) + lane + 64 * j); }
            const float rstd = 1.0f / sqrtf(wave_sum(s) * (1.0f / D) + 1e-6f);
            u32x2* o8 = (u32x2*)(XN + (size_t)m * D) + lane;
#pragma unroll
            for (int j = 0; j < 4; ++j) { const f32x4 o = v[j] * rstd * gv[j]; u32x2 w; w.x = cvt_pk_bf16(o.x, o.y); w.y = cvt_pk_bf16(o.z, o.w); o8[64 * j] = w; }
        }
    }
    const int gt = bid * NTHR + tid, NGT = G * NTHR;
    {
        const f32x4* p4 = (const f32x4*)kin(kp, I_P); u32x4* o = (u32x4*)(ws + WS_PB0);
        for (int i = gt; i < 2 * M * PLE / 8; i += NGT) { const f32x4 x0 = p4[2 * i], x1 = p4[2 * i + 1]; o[i] = pack8(x0, x1); }
    }
    {
        float* cs = (float*)(ws + WS_COS); float* sn = (float*)(ws + WS_SIN);
        for (int i = gt; i < T * 32; i += NGT) {
            const int pos = i >> 5, f = i & 31;
            const float inv = (float)exp2(-(double)f * (13.287712379549449 / 32.0));
            const float ang = (float)pos * inv;
            double rev = (double)ang * 0.15915494309189535; rev -= floor(rev);
            sn[i] = __builtin_amdgcn_sinf((float)rev); cs[i] = __builtin_amdgcn_cosf((float)rev);
        }
    }
    {
        float* bp = (float*)(ws + WS_BIAS);
        for (int i = gt; i < ATT_IN; i += NGT) bp[qk_perm_row(i)] = kin(kp, I_ABIN)[i];
    }
    {
        bf16_t* W2T = (bf16_t*)(ws + WS_W2); const float* w2 = kin(kp, I_W2); const float* a2 = kin(kp, I_A2);
        for (int i = gt; i < 2048 * 128; i += NGT) {
            const int k = i >> 11, nn = i & 2047;
            float v;
            if (nn < 1024) v = (k < 64) ? w2[k * 1024 + nn] : 0.f; else v = (k >= 64) ? a2[(k - 64) * 1024 + (nn - 1024)] : 0.f;
            W2T[(size_t)nn * 128 + k] = (bf16_t)(cvt_pk_bf16(v, 0.f) & 0xffffu);
        }
    }
}

__device__ __forceinline__ void attn_phase(LAS unsigned char* lds, const bf16_t* QKVZ, const float* sinks, bf16_t* OG, int G, int bid, int tid) {
    const int wave = __builtin_amdgcn_readfirstlane(tid >> 6), lane = tid & 63, fr = lane & 15, fq = lane >> 4;
    constexpr int KP = 144, VP = 528;
    LAS unsigned char* Kl = lds; LAS unsigned char* Vt = lds + 256 * KP;
    u32x4 pkv[4], pvv[4];
#define ATT_LOAD(uu) do { const int kvh_ = (uu) & 3, n_ = ((uu) >> 2) & 31, b_ = (uu) >> 7; _Pragma("unroll") for (int i = 0; i < 4; ++i) { \
        const int c_ = tid + 512 * i, key_ = c_ >> 3, ch_ = c_ & 7, t_ = 128 * (n_ - 1) + key_; \
        pkv[i] = (u32x4){0u, 0u, 0u, 0u}; pvv[i] = (u32x4){0u, 0u, 0u, 0u}; \
        if (t_ >= 0) { const bf16_t* rp_ = QKVZ + (size_t)(b_ * T + t_) * ATT_IN + kvh_ * 64 + ch_ * 8; pkv[i] = *(const u32x4*)(rp_ + 1024); pvv[i] = *(const u32x4*)(rp_ + 1280); } } } while (0)
    if (bid < 1024) ATT_LOAD(bid);
    for (int unit = bid; unit < 1024; unit += G) {
        const int kvh = unit & 3, n = (unit >> 2) & 31, b = unit >> 7;
        __syncthreads();
#pragma unroll
        for (int i = 0; i < 4; ++i) {
            const int c = tid + 512 * i, key = c >> 3, ch = c & 7;
            const u32x4 kv = pkv[i], vv = pvv[i];
            *(LAS u32x4*)(Kl + key * KP + ch * 16) = kv;
            LAS unsigned short* vp = (LAS unsigned short*)(Vt + (ch * 8) * VP + ((key ^ (ch << 2)) * 2));
            vp[0 * (VP / 2)] = (unsigned short)(vv.x & 0xffffu); vp[1 * (VP / 2)] = (unsigned short)(vv.x >> 16);
            vp[2 * (VP / 2)] = (unsigned short)(vv.y & 0xffffu); vp[3 * (VP / 2)] = (unsigned short)(vv.y >> 16);
            vp[4 * (VP / 2)] = (unsigned short)(vv.z & 0xffffu); vp[5 * (VP / 2)] = (unsigned short)(vv.z >> 16);
            vp[6 * (VP / 2)] = (unsigned short)(vv.w & 0xffffu); vp[7 * (VP / 2)] = (unsigned short)(vv.w >> 16);
        }
        if (unit + G < 1024) ATT_LOAD(unit + G);
        __syncthreads();
        const int g = wave >> 1, qh = wave & 1, h = kvh * 4 + g;
        const float sink2 = sinks[h] * 1.4426950408889634f;
        for (int mt = 0; mt < 4; ++mt) {
            const int qo0 = qh * 64 + mt * 16;
            const size_t row = (size_t)(b * T + n * 128 + qo0 + fr);
            const bf16_t* qp = QKVZ + row * ATT_IN + h * 64 + fq * 8;
            const bf16x8 q0 = *(const bf16x8*)qp, q1 = *(const bf16x8*)(qp + 32);
            const int kt0 = (qh * 4 + mt) < 6 ? (qh * 4 + mt) : 6;
            f32x4 s[10];
#pragma unroll
            for (int kt = 0; kt < 10; ++kt) {
                const LAS unsigned char* kp = Kl + ((kt0 + kt) * 16 + fr) * KP + fq * 16;
                const bf16x8 k0 = *(const LAS bf16x8*)kp, k1 = *(const LAS bf16x8*)(kp + 64);
                f32x4 acc = (f32x4){0.f, 0.f, 0.f, 0.f};
                acc = __builtin_amdgcn_mfma_f32_16x16x32_bf16(k0, q0, acc, 0, 0, 0);
                acc = __builtin_amdgcn_mfma_f32_16x16x32_bf16(k1, q1, acc, 0, 0, 0);
                s[kt] = acc;
            }
            const int qi = 128 + qo0 + fr;
            float mx = sink2;
#pragma unroll
            for (int kt = 0; kt < 10; ++kt)
#pragma unroll
                for (int r = 0; r < 4; ++r) { const int si = (kt0 + kt) * 16 + 4 * fq + r, df = qi - si; const bool ok = (df >= 0) && (df < 128) && (n > 0 || si >= 128);
                    const float v = ok ? s[kt][r] : -1e30f; s[kt][r] = v; mx = fmaxf(mx, v); }
            mx = fmaxf(mx, __shfl_xor(mx, 16)); mx = fmaxf(mx, __shfl_xor(mx, 32));
            float sum = 0.f;
#pragma unroll
            for (int kt = 0; kt < 10; ++kt)
#pragma unroll
                for (int r = 0; r < 4; ++r) { const float p = __builtin_amdgcn_exp2f(s[kt][r] - mx); s[kt][r] = p; sum += p; }
            sum += __shfl_xor(sum, 16); sum += __shfl_xor(sum, 32);
            sum += __builtin_amdgcn_exp2f(sink2 - mx);
            const float inv = 1.0f / sum;
            f32x4 o[4];
#pragma unroll
            for (int dt = 0; dt < 4; ++dt) o[dt] = (f32x4){0.f, 0.f, 0.f, 0.f};
#pragma unroll
            for (int kk = 0; kk < 5; ++kk) {
                const u32x4 pw = pack8(s[2 * kk], s[2 * kk + 1]);
                const bf16x8 pf = __builtin_bit_cast(bf16x8, pw);
#pragma unroll
                for (int dt = 0; dt < 4; ++dt) {
                    const int d = dt * 16 + fr, sw = ((d >> 3) & 7) << 2, keyA = 16 * (kt0 + 2 * kk) + 4 * fq, keyB = keyA + 16;
                    const u32x2 va = *(const LAS u32x2*)(Vt + d * VP + ((keyA ^ sw) * 2)), vb = *(const LAS u32x2*)(Vt + d * VP + ((keyB ^ sw) * 2));
                    const u32x4 vw = (u32x4){va.x, va.y, vb.x, vb.y};
                    o[dt] = __builtin_amdgcn_mfma_f32_16x16x32_bf16(__builtin_bit_cast(bf16x8, vw), pf, o[dt], 0, 0, 0);
                }
            }
            const bf16_t* zp = QKVZ + row * ATT_IN + 1536 + h * 64 + 4 * fq;
            bf16_t* op = OG + row * D + h * 64 + 4 * fq;
#pragma unroll
            for (int dt = 0; dt < 4; ++dt) {
                const u32x2 zw = *(const u32x2*)(zp + dt * 16);
                const float z0 = bflo(zw.x), z1 = bfhi(zw.x), z2 = bflo(zw.y), z3 = bfhi(zw.y);
                const float r0 = o[dt][0] * inv * z0 * fsigmoid(z0), r1 = o[dt][1] * inv * z1 * fsigmoid(z1), r2 = o[dt][2] * inv * z2 * fsigmoid(z2), r3 = o[dt][3] * inv * z3 * fsigmoid(z3);
                u32x2 w; w.x = cvt_pk_bf16(r0, r1); w.y = cvt_pk_bf16(r2, r3);
                *(u32x2*)(op + dt * 16) = w;
            }
        }
    }
}
template <int ROUND>
__device__ __forceinline__ void lerp_phase(const bf16_t* H1, const float* g1, const float* mu, bf16_t* HN, bf16_t* XS0, bf16_t* XS1, int G, int bid, int tid) {
    const int wave = __builtin_amdgcn_readfirstlane(tid >> 6), lane = tid & 63;
    const int gw = bid * NWAVES + wave, NGW = G * NWAVES;
    const float* mu0 = mu + (ROUND == 0 ? 0 : 2) * 1024; const float* mu1 = mu0 + 1024;
    f32x4 gq[4], m0q[4], m1q[4];
#pragma unroll
    for (int q = 0; q < 4; ++q) { const int col = (q >> 1) * 512 + lane * 8 + 4 * (q & 1); gq[q] = *(const f32x4*)(g1 + col); m0q[q] = *(const f32x4*)(mu0 + col); m1q[q] = *(const f32x4*)(mu1 + col); }
    u32x4 rc_[2], rp_[2];
#define LERP_LOAD(mm) do { const bool hp_ = ((mm) & (T - 1)) != 0; _Pragma("unroll") for (int j = 0; j < 2; ++j) { const size_t off_ = (size_t)(mm) * D + j * 512 + lane * 8; \
        rc_[j] = *(const u32x4*)(H1 + off_); rp_[j] = hp_ ? *(const u32x4*)(H1 + off_ - D) : (u32x4){0u, 0u, 0u, 0u}; } } while (0)
    if (gw < M) LERP_LOAD(gw);
    for (int m = gw; m < M; m += NGW) {
        f32x4 c[4], p[4];
        float sc = 0.f, sp = 0.f;
#pragma unroll
        for (int j = 0; j < 2; ++j) { unpack8(rc_[j], c[2 * j], c[2 * j + 1]); unpack8(rp_[j], p[2 * j], p[2 * j + 1]); }
        if (m + NGW < M) LERP_LOAD(m + NGW);
#pragma unroll
        for (int q = 0; q < 4; ++q) { sc += (c[q].x * c[q].x + c[q].y * c[q].y) + (c[q].z * c[q].z + c[q].w * c[q].w); sp += (p[q].x * p[q].x + p[q].y * p[q].y) + (p[q].z * p[q].z + p[q].w * p[q].w); }
        const float rc = 1.0f / sqrtf(wave_sum(sc) * (1.0f / D) + 1e-6f), rp = 1.0f / sqrtf(wave_sum(sp) * (1.0f / D) + 1e-6f);
#pragma unroll
        for (int j = 0; j < 2; ++j) {
            const int col = j * 512 + lane * 8; const size_t off = (size_t)m * D + col;
            f32x4 hn[2], xx[2], o0[2], o1[2];
#pragma unroll
            for (int e = 0; e < 2; ++e) {
                const f32x4 gv = gq[2 * j + e];
                hn[e] = c[2 * j + e] * rc * gv; xx[e] = p[2 * j + e] * rp * gv - hn[e];
                o0[e] = hn[e] + xx[e] * m0q[2 * j + e];
                o1[e] = hn[e] + xx[e] * m1q[2 * j + e];
            }
            if (ROUND == 0) *(u32x4*)(HN + off) = pack8(hn[0], hn[1]);
            *(u32x4*)(XS0 + off) = pack8(o0[0], o0[1]);
            *(u32x4*)(XS1 + off) = pack8(o1[0], o1[1]);
        }
    }
}
__device__ __forceinline__ void lora_mid_phase(const bf16_t* L, bf16_t* A2, int G, int bid, int tid) {
    const int gt = bid * NTHR + tid, NGT = G * NTHR;
    for (int i = gt; i < M * 16; i += NGT) {
        const int m = i >> 4, ch = i & 15, isA = ch >> 3, c8 = (ch & 7) * 8;
        const bool hasprev = (m & (T - 1)) != 0;
        f32x4 u0, u1, v0 = (f32x4){0.f, 0.f, 0.f, 0.f}, v1 = v0;
        unpack8(*(const u32x4*)(L + (size_t)m * 256 + isA * 128 + c8), u0, u1);
        if (hasprev) unpack8(*(const u32x4*)(L + (size_t)(m - 1) * 256 + isA * 128 + 64 + c8), v0, v1);
        u0 += v0; u1 += v1;
        if (!isA) {
#pragma unroll
            for (int e = 0; e < 4; ++e) { u0[e] = tanhf(u0[e]); u1[e] = tanhf(u1[e]); }
        }
        *(u32x4*)(A2 + (size_t)m * 128 + ch * 8) = pack8(u0, u1);
    }
}
#ifndef MK_SCAN_CHUNKED
#define MK_SCAN_CHUNKED 1
#endif
#if MK_SCAN_CHUNKED
typedef __bf16 ck_bf16x2_t __attribute__((ext_vector_type(2)));
__device__ __forceinline__ unsigned ck_cvt(float lo, float hi) { const f32x2 v = {lo, hi}; return __builtin_bit_cast(unsigned, __builtin_convertvector(v, ck_bf16x2_t)); }
constexpr int CK_RP = 144;
constexpr int CK_TP = 40;
constexpr int CK_ABAR = 0, CK_RBAR = 2304, CK_BTIL = 4608, CK_KTIL = 6912;
constexpr int CK_BT_T = 9216, CK_KT_T = 11776;
constexpr int CK_VT = 14336;
constexpr int CK_GAM = 15616;
constexpr int CK_BUF = 15872;
constexpr int CK_LD = 2 * CK_BUF;
constexpr int CK_PRIV = CK_LD + 2 * 4096;
constexpr int CK_PRIV_SZ = 2560;
__device__ __forceinline__ bf16x8 ck_ld2(const LAS unsigned char* p, int off2) {
    const u32x2 a = *(const LAS u32x2*)p, b = *(const LAS u32x2*)(p + off2); return __builtin_bit_cast(bf16x8, (u32x4){a.x, a.y, b.x, b.y}); }
__device__ __forceinline__ bf16x8 ck_ld1(const LAS unsigned char* p) {
    const u32x2 a = *(const LAS u32x2*)p; return __builtin_bit_cast(bf16x8, (u32x4){a.x, a.y, 0u, 0u}); }
__device__ __forceinline__ bf16x8 ck_pk4(const f32x4 x) { return __builtin_bit_cast(bf16x8, (u32x4){ck_cvt(x[0], x[1]), ck_cvt(x[2], x[3]), 0u, 0u}); }
#define CK_MFMA(a, b, c) __builtin_amdgcn_mfma_f32_16x16x32_bf16((a), (b), (c), 0, 0, 0)

constexpr int CK_STG = CK_PRIV + 2 * CK_PRIV_SZ;
constexpr int CK_STG_SZ = 4 * 4096 + 1024;
__device__ __forceinline__ void scan_phase(LAS unsigned char* lds, const bf16_t* R, const bf16_t* Kb, const bf16_t* V, const bf16_t* WA, const float* k_k, const float* k_a, bf16_t* Y, int G, int bid, int tid) {
    const int wave = __builtin_amdgcn_readfirstlane(tid >> 6), lane = tid & 63, c = lane & 15, g = lane >> 4;
    const int pid = tid - 128, pt = (pid >> 4) & 15, pj = pid & 15;
    const int pid1 = tid - 384, pta = (pid1 >> 4) & 7, ptb = pta + 8;
    const bool producer = (wave >= 2) && (wave < 6), producer1 = wave >= 6, consumer = wave < 2;
    constexpr int NCH = T / 16;
    for (int unit = bid; unit < 256; unit += G) {
        const int b = unit >> 5, h = (unit >> 1) & 15, half = unit & 1;
        const size_t rowbase = (size_t)b * T;
        f32x4 kkw = (f32x4){0.f, 0.f, 0.f, 0.f}, kaw = kkw;
        if (producer1) { kkw = *(const f32x4*)(k_k + h * 64 + 4 * pj); kaw = *(const f32x4*)(k_a + h * 64 + 4 * pj); }
        u32x2 rkA = (u32x2){0u, 0u}, rrA = rkA, raA = rkA, rlA = rkA, rkB = rkA, rrB = rkA, raB = rkA, rlB = rkA; unsigned rvA = 0u, rvB = 0u;
#define CK_LOAD(X, ptx, cn) do { const size_t m_ = rowbase + (size_t)(cn) * 16 + (ptx); \
            rk##X = *(const u32x2*)(Kb + m_ * D + h * 64 + 4 * pj); rr##X = *(const u32x2*)(R + m_ * D + h * 64 + 4 * pj); \
            rl##X = *(const u32x2*)(WA + m_ * 2048 + h * 64 + 4 * pj); ra##X = *(const u32x2*)(WA + m_ * 2048 + 1024 + h * 64 + 4 * pj); \
            rv##X = *(const unsigned*)(V + m_ * D + h * 64 + half * 32 + 2 * pj); } while (0)
#define CK_P1(X, ptx, cn) do { \
            const f32x4 kf_ = (f32x4){bflo(rk##X.x), bfhi(rk##X.x), bflo(rk##X.y), bfhi(rk##X.y)}, af_ = (f32x4){bflo(ra##X.x), bfhi(ra##X.x), bflo(ra##X.y), bfhi(ra##X.y)}; \
            const f32x4 lf_ = (f32x4){bflo(rl##X.x), bfhi(rl##X.x), bflo(rl##X.y), bfhi(rl##X.y)}, rf_ = (f32x4){bflo(rr##X.x), bfhi(rr##X.x), bflo(rr##X.y), bfhi(rr##X.y)}; \
            const f32x4 kv_ = kf_ * kkw; \
            float ss_ = (kv_.x * kv_.x + kv_.y * kv_.y) + (kv_.z * kv_.z + kv_.w * kv_.w); \
            ss_ = row16_sum(ss_); \
            const float invn_ = (ss_ > 1e-24f) ? __builtin_amdgcn_rsqf(ss_) : 1e12f;        \
            const f32x4 kk_ = kv_ * invn_; \
            LAS unsigned char* st_ = lds + CK_STG + ((cn) & 1) * CK_STG_SZ + ((ptx) * 64 + 4 * pj) * 4; \
            *(LAS f32x4*)(st_) = -kk_; *(LAS f32x4*)(st_ + 4096) = kk_ * af_; *(LAS f32x4*)(st_ + 8192) = kf_ * (1.0f + (af_ - 1.0f) * kaw); *(LAS f32x4*)(st_ + 12288) = rf_; \
            *(LAS unsigned*)(lds + CK_STG + ((cn) & 1) * CK_STG_SZ + 16384 + ((ptx) * 16 + pj) * 4) = rv##X; \
            *(LAS f32x4*)(lds + CK_LD + ((cn) & 1) * 4096 + ((ptx) * 64 + 4 * pj) * 4) = lf_; } while (0)
        if (producer1) { CK_LOAD(A, pta, 0); CK_LOAD(B, ptb, 0); CK_P1(A, pta, 0); CK_P1(B, ptb, 0); CK_LOAD(A, pta, 1); CK_LOAD(B, ptb, 1); }
        f32x4 H[4];
#pragma unroll
        for (int kt = 0; kt < 4; ++kt) H[kt] = (f32x4){0.f, 0.f, 0.f, 0.f};
        __syncthreads();
        for (int it = 0; it <= NCH; ++it) {
            if (producer1 && it + 1 < NCH) { CK_P1(A, pta, it + 1); CK_P1(B, ptb, it + 1); if (it + 2 < NCH) { CK_LOAD(A, pta, it + 2); CK_LOAD(B, ptb, it + 2); } }
            if (producer && it < NCH) {
                LAS unsigned char* buf = lds + (it & 1) * CK_BUF;
                const LAS unsigned char* ldp = lds + CK_LD + (it & 1) * 4096 + 16 * pj;
                const LAS unsigned char* stp = lds + CK_STG + (it & 1) * CK_STG_SZ + (pt * 64 + 4 * pj) * 4;
                f32x4 nkk = *(const LAS f32x4*)(stp), be = *(const LAS f32x4*)(stp + 4096), kp = *(const LAS f32x4*)(stp + 8192), rf = *(const LAS f32x4*)(stp + 12288), lf = *(const LAS f32x4*)(ldp + pt * 256);
                unsigned vsave = *(const LAS unsigned*)(lds + CK_STG + (it & 1) * CK_STG_SZ + 16384 + (pt * 16 + pj) * 4);
                asm volatile("" : "+v"(nkk), "+v"(be), "+v"(kp), "+v"(rf), "+v"(lf), "+v"(vsave));
                f32x4 Gc = (f32x4){0.f, 0.f, 0.f, 0.f};
                const int w4 = 4 * (wave - 2);
#pragma unroll
                for (int s4 = 0; s4 < 16; s4 += 4) {
                    if (s4 <= w4) {
                        f32x4 x0 = *(const LAS f32x4*)(ldp + (s4 + 0) * 256), x1 = *(const LAS f32x4*)(ldp + (s4 + 1) * 256), x2 = *(const LAS f32x4*)(ldp + (s4 + 2) * 256), x3 = *(const LAS f32x4*)(ldp + (s4 + 3) * 256);
                        asm volatile("" : "+v"(x0), "+v"(x1), "+v"(x2), "+v"(x3));
                        if (s4 < w4) Gc += (x0 + x1) + (x2 + x3);
                        else { const f32x4 z4 = (f32x4){0.f, 0.f, 0.f, 0.f};
                            Gc += (s4 + 0 <= pt) ? x0 : z4; Gc += (s4 + 1 <= pt) ? x1 : z4; Gc += (s4 + 2 <= pt) ? x2 : z4; Gc += (s4 + 3 <= pt) ? x3 : z4; }
                    }
                }
                const f32x4 Gm = Gc - lf;
                f32x4 eA, eR, eN;
#pragma unroll
                for (int e = 0; e < 4; ++e) { eA[e] = __expf(Gm[e]); eR[e] = __expf(Gc[e]); eN[e] = __expf(-Gc[e]); }
                const f32x4 ab = nkk * eA, rb = rf * eR, bt = be * eN, kt_ = kp * eN;
                const unsigned ab0 = ck_cvt(ab.x, ab.y), ab1 = ck_cvt(ab.z, ab.w), rb0 = ck_cvt(rb.x, rb.y), rb1 = ck_cvt(rb.z, rb.w);
                const unsigned bt0 = ck_cvt(bt.x, bt.y), bt1 = ck_cvt(bt.z, bt.w), kt0 = ck_cvt(kt_.x, kt_.y), kt1 = ck_cvt(kt_.z, kt_.w);
                LAS unsigned char* rowp = buf + pt * CK_RP + 64 * (pj >> 3) + 16 * (pj & 3) + 8 * ((pj >> 2) & 1);
                *(LAS u32x2*)(rowp + CK_ABAR) = (u32x2){ab0, ab1}; *(LAS u32x2*)(rowp + CK_RBAR) = (u32x2){rb0, rb1};
                *(LAS u32x2*)(rowp + CK_BTIL) = (u32x2){bt0, bt1}; *(LAS u32x2*)(rowp + CK_KTIL) = (u32x2){kt0, kt1};
                constexpr int TS = CK_TP / 2;
                {
                    const int rrow = lane >> 4;
#define CK_T4(x0, x1, x2, x3) do { auto s0_ = __builtin_amdgcn_permlane32_swap(x0, x2, false, false); auto s1_ = __builtin_amdgcn_permlane32_swap(x1, x3, false, false); \
                        auto t0_ = __builtin_amdgcn_permlane16_swap(s0_[0], s1_[0], false, false); auto t1_ = __builtin_amdgcn_permlane16_swap(s0_[1], s1_[1], false, false); \
                        x0 = t0_[0]; x1 = t0_[1]; x2 = t1_[0]; x3 = t1_[1]; } while (0)
                    unsigned b0_ = __float_as_uint(bt.x), b1_ = __float_as_uint(bt.y), b2_ = __float_as_uint(bt.z), b3_ = __float_as_uint(bt.w);
                    unsigned k0_ = __float_as_uint(kt_.x), k1_ = __float_as_uint(kt_.y), k2_ = __float_as_uint(kt_.z), k3_ = __float_as_uint(kt_.w);
                    CK_T4(b0_, b1_, b2_, b3_); CK_T4(k0_, k1_, k2_, k3_);
#undef CK_T4
                    const int toff = (4 * pj + rrow) * CK_TP + 8 * (wave - 2);
                    *(LAS u32x2*)(buf + CK_BT_T + toff) = (u32x2){ck_cvt(__uint_as_float(b0_), __uint_as_float(b1_)), ck_cvt(__uint_as_float(b2_), __uint_as_float(b3_))};
                    *(LAS u32x2*)(buf + CK_KT_T + toff) = (u32x2){ck_cvt(__uint_as_float(k0_), __uint_as_float(k1_)), ck_cvt(__uint_as_float(k2_), __uint_as_float(k3_))};
                }
                LAS unsigned short* vT = (LAS unsigned short*)(buf + CK_VT + (2 * pj) * CK_TP + pt * 2);
                vT[0] = (unsigned short)(vsave & 0xffffu); vT[TS] = (unsigned short)(vsave >> 16);
                if (pt == 15) *(LAS f32x4*)(buf + CK_GAM + 16 * pj) = eR;
            }
            if (consumer && it > 0) {
                const int cn = it - 1;
                const LAS unsigned char* buf = lds + (cn & 1) * CK_BUF;
                LAS unsigned char* priv = lds + CK_PRIV + wave * CK_PRIV_SZ;
                LAS float* AabT = (LAS float*)priv; LAS float* Xch = (LAS float*)(priv + 1024); LAS unsigned char* UT = priv + 2048;
                f32x4 xab = (f32x4){0.f, 0.f, 0.f, 0.f}, xak = xab, xrb = xab, xrk = xab;
                bf16x8 pa[2], pr[2];
#pragma unroll
                for (int ks = 0; ks < 2; ++ks) {
                    const LAS unsigned char* rp = buf + c * CK_RP + 64 * ks + 16 * g;
                    pa[ks] = *(const LAS bf16x8*)(rp + CK_ABAR); pr[ks] = *(const LAS bf16x8*)(rp + CK_RBAR);
                    const bf16x8 pb = *(const LAS bf16x8*)(rp + CK_BTIL), pk = *(const LAS bf16x8*)(rp + CK_KTIL);
                    xab = CK_MFMA(pb, pa[ks], xab); xak = CK_MFMA(pk, pa[ks], xak); xrb = CK_MFMA(pb, pr[ks], xrb); xrk = CK_MFMA(pk, pr[ks], xrk);
                }
#pragma unroll
                for (int r = 0; r < 4; ++r) { const int s = 4 * g + r; if (!(s < c)) { xab[r] = 0.f; xak[r] = 0.f; } if (!(s <= c)) { xrb[r] = 0.f; xrk[r] = 0.f; } }
#pragma unroll
                for (int r = 0; r < 4; ++r) AabT[(4 * g + r) * 16 + c] = xab[r];
                const bf16x8 opak = ck_pk4(xak), oprb = ck_pk4(xrb), oprk = ck_pk4(xrk);
                bf16x8 oph[2];
#pragma unroll
                for (int ks = 0; ks < 2; ++ks) oph[ks] = __builtin_bit_cast(bf16x8, (u32x4){ck_cvt(H[2 * ks][0], H[2 * ks][1]), ck_cvt(H[2 * ks][2], H[2 * ks][3]), ck_cvt(H[2 * ks + 1][0], H[2 * ks + 1][1]), ck_cvt(H[2 * ks + 1][2], H[2 * ks + 1][3])});
                const bf16x8 opv = ck_ld1(buf + CK_VT + (wave * 16 + c) * CK_TP + g * 8);
                f32x4 rhs = (f32x4){0.f, 0.f, 0.f, 0.f};
                rhs = CK_MFMA(pa[0], oph[0], rhs); rhs = CK_MFMA(pa[1], oph[1], rhs); rhs = CK_MFMA(opak, opv, rhs);
                *(LAS f32x4*)(Xch + c * 16 + 4 * g) = rhs;
                asm volatile("s_waitcnt lgkmcnt(0)" ::: "memory");
                float u[16];
#pragma unroll
                for (int q = 0; q < 4; ++q) { const f32x4 x = *(const LAS f32x4*)(Xch + c * 16 + 4 * q); u[4 * q] = x[0]; u[4 * q + 1] = x[1]; u[4 * q + 2] = x[2]; u[4 * q + 3] = x[3]; }
                f32x4 cw[15][4];
#define CK_COLLD(ss) do { _Pragma("unroll") for (int q_ = ((ss) + 1) / 4; q_ < 4; ++q_) cw[(ss)][q_] = *(const LAS f32x4*)(AabT + (ss) * 16 + 4 * q_); } while (0)
                CK_COLLD(0); CK_COLLD(1);
#pragma unroll
                for (int s = 0; s < 15; ++s) {
                    if (s + 2 < 15) CK_COLLD(s + 2);
                    __builtin_amdgcn_sched_barrier(0);
#pragma unroll
                    for (int t = s + 1; t < 16; ++t) u[t] += cw[s][t >> 2][t & 3] * u[s];
                }
#undef CK_COLLD
                bf16x8 opu;
                { const bool g1 = (g & 1) != 0, g2 = (g & 2) != 0;
                  const float a0 = g1 ? u[4] : u[0], a1 = g1 ? u[5] : u[1], a2 = g1 ? u[6] : u[2], a3 = g1 ? u[7] : u[3];
                  const float b0 = g1 ? u[12] : u[8], b1 = g1 ? u[13] : u[9], b2 = g1 ? u[14] : u[10], b3 = g1 ? u[15] : u[11];
                  opu = __builtin_bit_cast(bf16x8, (u32x4){ck_cvt(g2 ? b0 : a0, g2 ? b1 : a1), ck_cvt(g2 ? b2 : a2, g2 ? b3 : a3), 0u, 0u}); }
                f32x4 yy = (f32x4){0.f, 0.f, 0.f, 0.f};
                yy = CK_MFMA(pr[0], oph[0], yy); yy = CK_MFMA(pr[1], oph[1], yy); yy = CK_MFMA(oprb, opu, yy); yy = CK_MFMA(oprk, opv, yy);
                {
                    bf16_t* yp = Y + (rowbase + (size_t)cn * 16 + 4 * g) * D + h * 64 + half * 32 + wave * 16 + c;
#pragma unroll
                    for (int r = 0; r < 4; ++r) yp[(size_t)r * D] = (bf16_t)(ck_cvt(yy[r], 0.f) & 0xffffu);
                }
#pragma unroll
                for (int kt = 0; kt < 4; ++kt) {
                    const bf16x8 opb = ck_ld1(buf + CK_BT_T + (16 * kt + c) * CK_TP + g * 8), opk = ck_ld1(buf + CK_KT_T + (16 * kt + c) * CK_TP + g * 8);
                    f32x4 hh = H[kt];
                    hh = CK_MFMA(opb, opu, hh); hh = CK_MFMA(opk, opv, hh);
                    H[kt] = hh * *(const LAS f32x4*)(buf + CK_GAM + (16 * kt + 4 * g) * 4);
                }
            }
            __syncthreads();
        }
    }
#undef CK_LOAD
#undef CK_P1
}
#else
constexpr int TC = 32;
constexpr int SC_VEC = TC * 5 * 64 * 4;
constexpr int SC_VP = 36;
constexpr int SC_V = 32 * SC_VP * 4;
constexpr int SC_Y = TC * 32 * 4;
constexpr int SC_BUF = SC_VEC + SC_V + SC_Y;
__device__ __forceinline__ void scan_phase(LAS unsigned char* lds, const bf16_t* R, const bf16_t* Kb, const bf16_t* V, const bf16_t* WA, const float* k_k, const float* k_a, bf16_t* Y, int G, int bid, int tid) {
    const int wave = __builtin_amdgcn_readfirstlane(tid >> 6), lane = tid & 63, rg = lane >> 4, cc = lane & 15;
    const int pt = tid >> 4, pj = tid & 15;
    for (int unit = bid; unit < 256; unit += G) {
        const int b = unit >> 5, h = (unit >> 1) & 15, half = unit & 1;
        const size_t rowbase = (size_t)b * T;
        const f32x4 kkw = *(const f32x4*)(k_k + h * 64 + 4 * pj), kaw = *(const f32x4*)(k_a + h * 64 + 4 * pj);
        f32x2 S01 = (f32x2){0.f, 0.f}, S23 = (f32x2){0.f, 0.f};
        u32x2 rk, rr, ra, rl; unsigned rv;
#define SCAN_LOAD(cn) do { const size_t m_ = rowbase + (size_t)(cn) * TC + pt; \
            rk = *(const u32x2*)(Kb + m_ * D + h * 64 + 4 * pj); rr = *(const u32x2*)(R + m_ * D + h * 64 + 4 * pj); \
            rl = *(const u32x2*)(WA + m_ * 2048 + h * 64 + 4 * pj); ra = *(const u32x2*)(WA + m_ * 2048 + 1024 + h * 64 + 4 * pj); \
            rv = *(const unsigned*)(V + m_ * D + h * 64 + half * 32 + 2 * pj); } while (0)
        SCAN_LOAD(0);
        __syncthreads();
        for (int cn = 0; cn < T / TC; ++cn) {
            LAS unsigned char* buf = lds + (cn & 1) * SC_BUF;
            {
                const f32x4 kf = (f32x4){bflo(rk.x), bfhi(rk.x), bflo(rk.y), bfhi(rk.y)}, af = (f32x4){bflo(ra.x), bfhi(ra.x), bflo(ra.y), bfhi(ra.y)};
                const f32x4 lf = (f32x4){bflo(rl.x), bfhi(rl.x), bflo(rl.y), bfhi(rl.y)}, rf = (f32x4){bflo(rr.x), bfhi(rr.x), bflo(rr.y), bfhi(rr.y)};
                const f32x4 kv = kf * kkw;
                float ss = (kv.x * kv.x + kv.y * kv.y) + (kv.z * kv.z + kv.w * kv.w);
                ss = row16_sum(ss);
                const float invn = 1.0f / fmaxf(sqrtf(ss), 1e-12f);
                const f32x4 kk = kv * invn;
                const f32x4 kp = kf * (1.0f + (af - 1.0f) * kaw);
                f32x4 dd; dd.x = __expf(lf.x); dd.y = __expf(lf.y); dd.z = __expf(lf.z); dd.w = __expf(lf.w);
                LAS f32x4* vp = (LAS f32x4*)(buf + pt * 1280) + pj;
                vp[0] = -kk; vp[16] = dd; vp[32] = kk * af; vp[48] = kp; vp[64] = rf;
                LAS float* vv = (LAS float*)(buf + SC_VEC) + (2 * pj) * SC_VP + pt;
                vv[0] = bflo(rv); vv[SC_VP] = bfhi(rv);
            }
            if (cn + 1 < T / TC) SCAN_LOAD(cn + 1);
            __syncthreads();
            if (cn > 0) {
                const LAS float* yb = (const LAS float*)(lds + ((cn - 1) & 1) * SC_BUF + SC_VEC + SC_V + pt * 128) + 2 * pj;
                const size_t m_ = rowbase + (size_t)(cn - 1) * TC + pt;
                *(unsigned*)(Y + m_ * D + h * 64 + half * 32 + 2 * pj) = cvt_pk_bf16(yb[0], yb[1]);
            }
            const int rloc = wave * 4 + rg;
            LAS float* yrow = (LAS float*)(buf + SC_VEC + SC_V) + rloc;
            const unsigned va0 = (unsigned)(size_t)(buf + cc * 16), ra0 = (unsigned)(size_t)(buf + SC_VEC + rloc * SC_VP * 4);
#define SC_LD5(NK, DD, BE, KP, RF, AR, OFF) do { \
                asm volatile("ds_read_b128 %0, %1 offset:%2" : "=&v"(NK) : "v"(AR), "i"((OFF))); asm volatile("ds_read_b128 %0, %1 offset:%2" : "=&v"(DD) : "v"(AR), "i"((OFF) + 256)); \
                asm volatile("ds_read_b128 %0, %1 offset:%2" : "=&v"(BE) : "v"(AR), "i"((OFF) + 512)); asm volatile("ds_read_b128 %0, %1 offset:%2" : "=&v"(KP) : "v"(AR), "i"((OFF) + 768)); \
                asm volatile("ds_read_b128 %0, %1 offset:%2" : "=&v"(RF) : "v"(AR), "i"((OFF) + 1024)); } while (0)
            f32x4 nk, dd, be, kp, rf, nk1, dd1, be1, kp1, rf1, nk2, dd2, be2, kp2, rf2, vcur, vnxt;
            SC_LD5(nk, dd, be, kp, rf, va0, 0); SC_LD5(nk1, dd1, be1, kp1, rf1, va0, 1280);
            asm volatile("ds_read_b128 %0, %1" : "=&v"(vcur) : "v"(ra0));
            asm volatile("s_waitcnt lgkmcnt(0)" : "+v"(nk), "+v"(dd), "+v"(be), "+v"(kp), "+v"(rf), "+v"(nk1), "+v"(dd1), "+v"(be1), "+v"(kp1), "+v"(rf1), "+v"(vcur));
            vnxt = vcur;
            float sa;
            { f32x2 pa = S01 * (f32x2){nk.x, nk.y}; pa = S23 * (f32x2){nk.z, nk.w} + pa; sa = row16_sum(pa.x + pa.y); }
            float ykeep = 0.f;
#define SC_STEP(J, VSEL, LDV, VOFF, WAITN) do { \
                SC_LD5(nk2, dd2, be2, kp2, rf2, va8, ((J) + 2) * 1280); \
                if (LDV) asm volatile("ds_read_b128 %0, %1 offset:%2" : "=&v"(vnxt) : "v"(ra8), "i"((VOFF))); \
                asm volatile("s_waitcnt lgkmcnt(" #WAITN ")" : "+v"(nk1), "+v"(dd1), "+v"(be1), "+v"(kp1), "+v"(rf1)); \
                const float vv_ = (VSEL); \
                S01 = S01 * (f32x2){dd.x, dd.y} + (f32x2){be.x, be.y} * sa + (f32x2){kp.x, kp.y} * vv_; \
                S23 = S23 * (f32x2){dd.z, dd.w} + (f32x2){be.z, be.w} * sa + (f32x2){kp.z, kp.w} * vv_; \
                f32x2 pa_ = S01 * (f32x2){nk1.x, nk1.y}; pa_ = S23 * (f32x2){nk1.z, nk1.w} + pa_; \
                f32x2 py_ = S01 * (f32x2){rf.x, rf.y}; py_ = S23 * (f32x2){rf.z, rf.w} + py_; \
                float y_ = py_.x + py_.y, a2_ = pa_.x + pa_.y; \
                y_ = DPP_XADD(y_, 0xB1); a2_ = DPP_XADD(a2_, 0xB1); y_ = DPP_XADD(y_, 0x4E); a2_ = DPP_XADD(a2_, 0x4E); \
                y_ = DPP_XADD(y_, 0x141); a2_ = DPP_XADD(a2_, 0x141); y_ = DPP_XADD(y_, 0x140); a2_ = DPP_XADD(a2_, 0x140); \
                sa = a2_; \
                ykeep = __builtin_bit_cast(float, __builtin_amdgcn_update_dpp(__builtin_bit_cast(int, y_), __builtin_bit_cast(int, ykeep), 0x111, 0xF, 0xF, false));   \
                nk = nk1; dd = dd1; be = be1; kp = kp1; rf = rf1; nk1 = nk2; dd1 = dd2; be1 = be2; kp1 = kp2; rf1 = rf2; } while (0)
#pragma unroll 1
            for (int t8 = 0; t8 < TC; t8 += 8) {
                const unsigned va8 = va0 + (unsigned)t8 * 1280u, ra8 = ra0 + (unsigned)t8 * 4u;
                SC_STEP(0, vcur.x, 0, 0, 5); SC_STEP(1, vcur.y, 0, 0, 5); SC_STEP(2, vcur.z, 1, 16, 6); SC_STEP(3, vcur.w, 0, 0, 5);
                asm volatile("" : "+v"(vnxt)); vcur = vnxt;
                SC_STEP(4, vcur.x, 0, 0, 5); SC_STEP(5, vcur.y, 0, 0, 5); SC_STEP(6, vcur.z, 1, 32, 6); SC_STEP(7, vcur.w, 0, 0, 5);
                asm volatile("" : "+v"(vnxt)); vcur = vnxt;
                if (t8 & 8) yrow[(t8 + 7 - cc) * 32] = ykeep;
            }
            asm volatile("s_waitcnt lgkmcnt(0)" ::: "memory");
#undef SC_STEP
#undef SC_LD5
        }
        __syncthreads();
        {
            const int cn = T / TC;
            const LAS float* yb = (const LAS float*)(lds + ((cn - 1) & 1) * SC_BUF + SC_VEC + SC_V + pt * 128) + 2 * pj;
            const size_t m_ = rowbase + (size_t)(cn - 1) * TC + pt;
            *(unsigned*)(Y + m_ * D + h * 64 + half * 32 + 2 * pj) = cvt_pk_bf16(yb[0], yb[1]);
        }
        __syncthreads();
    }
#undef SCAN_LOAD
}
#endif
__device__ __forceinline__ void gn_phase(bf16_t* Y, const bf16_t* R, const bf16_t* Kb, const bf16_t* V, const bf16_t* Z, const bf16_t* WA, const float* k_a, const float* r_k, const float* gn_g, const float* gn_b, int G, int bid, int tid) {
    const int wave = __builtin_amdgcn_readfirstlane(tid >> 6), lane = tid & 63;
    const int gw = bid * NWAVES + wave, NGW = G * NWAVES;
    const int col = lane * 16;
    f32x4 kaq[4], rkq[4], ggq[4], gbq[4];
#pragma unroll
    for (int q = 0; q < 4; ++q) { kaq[q] = *(const f32x4*)(k_a + col + 4 * q); rkq[q] = *(const f32x4*)(r_k + col + 4 * q); ggq[q] = *(const f32x4*)(gn_g + col + 4 * q); gbq[q] = *(const f32x4*)(gn_b + col + 4 * q); }
    u32x4 ry_[2], rr_[2], rk_[2], rv_[2], rz_[2], ra_[2];
#define GN_LOAD(mm) do { const size_t off_ = (size_t)(mm) * D + col; _Pragma("unroll") for (int j = 0; j < 2; ++j) { ry_[j] = *(const u32x4*)(Y + off_ + 8 * j); rr_[j] = *(const u32x4*)(R + off_ + 8 * j); \
        rk_[j] = *(const u32x4*)(Kb + off_ + 8 * j); rv_[j] = *(const u32x4*)(V + off_ + 8 * j); rz_[j] = *(const u32x4*)(Z + off_ + 8 * j); ra_[j] = *(const u32x4*)(WA + (size_t)(mm) * 2048 + 1024 + col + 8 * j); } } while (0)
    if (gw < M) GN_LOAD(gw);
    for (int m = gw; m < M; m += NGW) {
        const size_t off = (size_t)m * D + col;
        f32x4 y[4], r[4], k[4], v[4], z[4], aa[4];
#pragma unroll
        for (int j = 0; j < 2; ++j) { unpack8(ry_[j], y[2 * j], y[2 * j + 1]); unpack8(rr_[j], r[2 * j], r[2 * j + 1]); unpack8(rk_[j], k[2 * j], k[2 * j + 1]);
            unpack8(rv_[j], v[2 * j], v[2 * j + 1]); unpack8(rz_[j], z[2 * j], z[2 * j + 1]); unpack8(ra_[j], aa[2 * j], aa[2 * j + 1]); }
        if (m + NGW < M) GN_LOAD(m + NGW);
        float s = 0.f, bs = 0.f;
#pragma unroll
        for (int q = 0; q < 4; ++q) {
            s += (y[q].x + y[q].y) + (y[q].z + y[q].w);
            const f32x4 kp = k[q] * (1.0f + (aa[q] - 1.0f) * kaq[q]);
            const f32x4 t = r[q] * kp * rkq[q];
            bs += (t.x + t.y) + (t.z + t.w);
        }
        s += __shfl_xor(s, 1); s += __shfl_xor(s, 2); bs += __shfl_xor(bs, 1); bs += __shfl_xor(bs, 2);
        const float mean = s * (1.0f / 64.0f);
        float q2 = 0.f;
#pragma unroll
        for (int q = 0; q < 4; ++q) { const f32x4 dlt = y[q] - mean; q2 += (dlt.x * dlt.x + dlt.y * dlt.y) + (dlt.z * dlt.z + dlt.w * dlt.w); }
        q2 += __shfl_xor(q2, 1); q2 += __shfl_xor(q2, 2);
        const float rstd = 1.0f / sqrtf(q2 * (1.0f / 64.0f) + 64e-5f);
        f32x4 o[4];
#pragma unroll
        for (int q = 0; q < 4; ++q) {
            const f32x4 yn = (y[q] - mean) * rstd * ggq[q] + gbq[q] + bs * v[q];
#pragma unroll
            for (int e = 0; e < 4; ++e) o[q][e] = yn[e] * z[q][e] * fsigmoid(z[q][e]);
        }
        *(u32x4*)(Y + off) = pack8(o[0], o[1]); *(u32x4*)(Y + off + 8) = pack8(o[2], o[3]);
    }
}
__device__ __forceinline__ void final_norm_phase(const bf16_t* H2, float* out, const float* g, int G, int bid, int tid) {
    const int wave = __builtin_amdgcn_readfirstlane(tid >> 6), lane = tid & 63;
    const int gw = bid * NWAVES + wave, NGW = G * NWAVES;
    f32x4 gv[4];
#pragma unroll
    for (int j = 0; j < 2; ++j) { gv[2 * j] = *(const f32x4*)(g + j * 512 + lane * 8); gv[2 * j + 1] = *(const f32x4*)(g + j * 512 + lane * 8 + 4); }
    u32x4 rh_[2];
    if (gw < M) { rh_[0] = *(const u32x4*)(H2 + (size_t)gw * D + lane * 8); rh_[1] = *(const u32x4*)(H2 + (size_t)gw * D + 512 + lane * 8); }
    for (int m = gw; m < M; m += NGW) {
        f32x4 v[4]; float s = 0.f;
        unpack8(rh_[0], v[0], v[1]); unpack8(rh_[1], v[2], v[3]);
        if (m + NGW < M) { rh_[0] = *(const u32x4*)(H2 + (size_t)(m + NGW) * D + lane * 8); rh_[1] = *(const u32x4*)(H2 + (size_t)(m + NGW) * D + 512 + lane * 8); }
#pragma unroll
        for (int q = 0; q < 4; ++q) s += (v[q].x * v[q].x + v[q].y * v[q].y) + (v[q].z * v[q].z + v[q].w * v[q].w);
        const float rstd = 1.0f / sqrtf(wave_sum(s) * (1.0f / D) + 1e-6f);
#pragma unroll
        for (int j = 0; j < 2; ++j) { float* o = out + (size_t)m * D + j * 512 + lane * 8; *(f32x4*)o = v[2 * j] * rstd * gv[2 * j]; *(f32x4*)(o + 4) = v[2 * j + 1] * rstd * gv[2 * j + 1]; }
    }
}
#ifndef MK_PER_PHASE
#define MK_PER_PHASE 0
#endif
constexpr int NPHASE = 15;
#ifndef MK_REP_PHASE
#define MK_REP_PHASE -1
#endif
#ifndef MK_REP_N
#define MK_REP_N 2
#endif
#define REPS(k) ((k) == MK_REP_PHASE ? MK_REP_N : 1)

__global__ void __launch_bounds__(NTHR, 2) hybrid_fwd(Args a) {
    extern __shared__ __attribute__((aligned(16))) unsigned char lds_raw[];
    LAS unsigned char* lds = (LAS unsigned char*)lds_raw;
    cg::grid_group grid = cg::this_grid();
    const int wave_s = __builtin_amdgcn_readfirstlane((int)threadIdx.x >> 6);
    const int bid = blockIdx.x, G = gridDim.x;
#define TID() int lane_v_; asm volatile("v_mbcnt_lo_u32_b32 %0, -1, 0\n\tv_mbcnt_hi_u32_b32 %0, -1, %0" : "=v"(lane_v_)); const int tid = wave_s * 64 + lane_v_
    { TID(); if (tid < 16) ((LAS unsigned*)(lds + LDS_BYTES - 64))[tid] = 0u; __syncthreads();
#if !MK_PER_PHASE
      kptr_t kpb = kargs(); (void)xcd_barrier_post((unsigned*)(kws(kpb) + WS_CTL), (volatile LAS unsigned*)(lds + LDS_BYTES - 64), tid);
#endif
    }
    int lo, hi; { kptr_t kp0 = kargs(); lo = *(const int __attribute__((address_space(4)))*)(kp0 + 8 * 26); hi = *(const int __attribute__((address_space(4)))*)(kp0 + 8 * 26 + 4); }
#ifndef PH_MASK
#define PH_MASK 0x7fff
#endif
#define IN(k) (((PH_MASK >> (k)) & 1) && lo <= (k) && (k) < hi)
#define SEAM(k) do { if (IN(k) && IN((k) + 1)) { if ((k) == 0) grid.sync(); else { TID(); kptr_t kpb = kargs(); XcdBarrier xb_; xb_.bar = (unsigned*)(kws(kpb) + WS_CTL); xb_.x = xb_xcc_id(); xb_.st = (volatile LAS unsigned*)(lds + LDS_BYTES - 64); xcd_barrier(xb_, tid); } } } while (0)
#define PTRS() kptr_t kp = kargs(); unsigned char* ws = kws(kp); (void)ws
#define S1 ((bf16_t*)(ws + WS_S1))
#define S2 ((bf16_t*)(ws + WS_S2))
#define S3 ((bf16_t*)(ws + WS_S3))
#define S4 ((bf16_t*)(ws + WS_S4))
#define QKVZ ((bf16_t*)(ws + WS_QKVZ))
#define XS0 ((bf16_t*)(ws + WS_XS0))
#define XS1 ((bf16_t*)(ws + WS_XS1))
#define WAb ((bf16_t*)(ws + WS_WA))
#define A2 ((bf16_t*)(ws + WS_A2))
#define Lb ((bf16_t*)(ws + WS_L))
#define Kr ((bf16_t*)kout(kp))
#define Vr ((bf16_t*)kout(kp) + (size_t)M * D)
#define WR ((const bf16_t*)(ws + WS_WR))

    if (IN(0)) for (int rep_ = 0; rep_ < REPS(0); ++rep_) { TID(); p0_prologue(lds, G, bid, tid); }
    SEAM(0);
    if (IN(1)) for (int rep_ = 0; rep_ < REPS(1); ++rep_) { TID(); PTRS();
        { pg8::Gemm g{S1, (const bf16_t*)(ws + WS_WQKVZ), M, ATT_IN, D}; pg8::StaticOrder S; S.init(M, ATT_IN, G, bid);
          pg8::EpiQKVZ E{QKVZ, (const float*)(ws + WS_BIAS), (const float*)(ws + WS_COS), (const float*)(ws + WS_SIN)};
          pg8::gemm_phase<pg8::EpiQKVZ, pg8::StaticOrder, true, true>(lds, g, S, E, tid); }
        __syncthreads();
        { pg8::Gemm g{(const bf16_t*)(ws + WS_PB0), (const bf16_t*)(ws + WS_WP0), M, D, PLE}; pg8::StaticOrder S; S.init(M, D, G, bid);
          pg8::EpiStore E{S2, D};
          pg8::gemm_phase<pg8::EpiStore, pg8::StaticOrder, true, true>(lds, g, S, E, tid); }
    }
    SEAM(1);
    if (IN(2)) for (int rep_ = 0; rep_ < REPS(2); ++rep_) { TID(); PTRS(); attn_phase(lds, QKVZ, kin(kp, I_ASINK), S1, G, bid, tid); }
    SEAM(2);
    if (IN(3)) for (int rep_ = 0; rep_ < REPS(3); ++rep_) { TID(); PTRS();
        pg8::Gemm g{S1, (const bf16_t*)(ws + WS_WO0), M, D, D}; pg8::StaticOrder S; S.init(M, D, G, bid);
        pg8::EpiRes<false> E{(const void*)kin(kp, I_X), S3};
        pg8::gemm_phase<pg8::EpiRes<false>, pg8::StaticOrder, true, true>(lds, g, S, E, tid);
    }
    SEAM(3);
    if (IN(4)) for (int rep_ = 0; rep_ < REPS(4); ++rep_) { TID(); PTRS();
        pg8::Gemm g{S3, (const bf16_t*)(ws + WS_WG0), M, D, D}; pg8::StaticOrder S; S.init(M, D, G, bid);
        pg8::EpiGate<false> E{S3, S2, (void*)S4};
        pg8::gemm_phase<pg8::EpiGate<false>, pg8::StaticOrder, true, true>(lds, g, S, E, tid);
    }
    SEAM(4);
    if (IN(5)) for (int rep_ = 0; rep_ < REPS(5); ++rep_) { TID(); PTRS(); lerp_phase<0>(S4, kin(kp, I_NORMG) + D, kin(kp, I_MU), S1, XS0, XS1, G, bid, tid); }
    SEAM(5);
    if (IN(6)) for (int rep_ = 0; rep_ < REPS(6); ++rep_) { TID(); PTRS();
        { pg8::Gemm g{XS0, WR, M, 2 * D, D, XS1, 4}; pg8::StaticOrder S; S.init(M, 2 * D, G, bid); pg8::EpiStore2 E{S3, Kr, 4, D};
          pg8::gemm_phase<pg8::EpiStore2, pg8::StaticOrder, true, true>(lds, g, S, E, tid); }
        __syncthreads();
        { pg8::Gemm g{S1, (const bf16_t*)(ws + WS_WL), M, 256, D}; pg8::StaticOrder S; S.init(M, 256, G, bid); pg8::EpiStore E{Lb, 256};
          pg8::gemm_phase<pg8::EpiStore, pg8::StaticOrder, true, true>(lds, g, S, E, tid); }
    }
    SEAM(6);
    if (IN(7)) for (int rep_ = 0; rep_ < REPS(7); ++rep_) { TID(); PTRS(); lerp_phase<1>(S4, kin(kp, I_NORMG) + D, kin(kp, I_MU), nullptr, XS0, XS1, G, bid, tid); lora_mid_phase(Lb, A2, G, bid, tid); }
    SEAM(7);
    if (IN(8)) for (int rep_ = 0; rep_ < REPS(8); ++rep_) { TID(); PTRS();
        { pg8::Gemm g{XS0, WR + (size_t)2 * D * D, M, 2 * D, D, XS1, 4}; pg8::StaticOrder S; S.init(M, 2 * D, G, bid); pg8::EpiStore2 E{Vr, S2, 4, D};
          pg8::gemm_phase<pg8::EpiStore2, pg8::StaticOrder, true, true>(lds, g, S, E, tid); }
    }
    SEAM(8);
    if (IN(9)) for (int rep_ = 0; rep_ < REPS(9); ++rep_) { TID(); PTRS();
        pg8::Gemm g{A2, (const bf16_t*)(ws + WS_W2), M, 2048, 128}; pg8::StaticOrder S; S.init(M, 2048, G, bid);
        pg8::EpiWA E{WAb, kin(kp, I_W0), kin(kp, I_A0)};
        pg8::gemm_phase<pg8::EpiWA, pg8::StaticOrder, true, true>(lds, g, S, E, tid);
    }
    SEAM(9);
    if (IN(10)) for (int rep_ = 0; rep_ < REPS(10); ++rep_) { TID(); PTRS(); scan_phase(lds, S3, Kr, Vr, WAb, kin(kp, I_KK), kin(kp, I_KA), S1, G, bid, tid); }
    SEAM(10);
    if (IN(11)) for (int rep_ = 0; rep_ < REPS(11); ++rep_) { TID(); PTRS(); gn_phase(S1, S3, Kr, Vr, S2, WAb, kin(kp, I_KA), kin(kp, I_RK), kin(kp, I_GNG), kin(kp, I_GNB), G, bid, tid); }
    SEAM(11);
    if (IN(12)) for (int rep_ = 0; rep_ < REPS(12); ++rep_) { TID(); PTRS();
        { pg8::Gemm g{S1, (const bf16_t*)(ws + WS_WO1), M, D, D}; pg8::StaticOrder S; S.init(M, D, G, bid); pg8::EpiRes<true> E{(const void*)S4, S3};
          pg8::gemm_phase<pg8::EpiRes<true>, pg8::StaticOrder, true, true>(lds, g, S, E, tid); }
        __syncthreads();
        { pg8::Gemm g{(const bf16_t*)(ws + WS_PB1), (const bf16_t*)(ws + WS_WP1), M, D, PLE}; pg8::StaticOrder S; S.init(M, D, G, bid); pg8::EpiStore E{S2, D};
          pg8::gemm_phase<pg8::EpiStore, pg8::StaticOrder, true, true>(lds, g, S, E, tid); }
    }
    SEAM(12);
    if (IN(13)) for (int rep_ = 0; rep_ < REPS(13); ++rep_) { TID(); PTRS();
        pg8::Gemm g{S3, (const bf16_t*)(ws + WS_WG1), M, D, D}; pg8::StaticOrder S; S.init(M, D, G, bid);
        pg8::EpiGate<false> E{S3, S2, (void*)S1};
        pg8::gemm_phase<pg8::EpiGate<false>, pg8::StaticOrder, true, true>(lds, g, S, E, tid);
    }
    SEAM(13);
    if (IN(14)) for (int rep_ = 0; rep_ < REPS(14); ++rep_) { TID(); PTRS(); final_norm_phase(S1, kout(kp), kin(kp, I_FNG), G, bid, tid); }
#undef IN
#undef SEAM
}

extern "C" void kernel_launch(void* const* d_in, const int* in_sizes, int n_in, void* d_out, int out_size, void* d_ws, size_t ws_size, hipStream_t stream) {
    static int grid = 0;
    if (grid == 0) {
        if (n_in != 24 || out_size != M * D || ws_size < WS_END) { fprintf(stderr, "kernel_launch: unexpected shapes (n_in %d, out %d, ws %zu)\n", n_in, out_size, ws_size); grid = -1; return; }
        int dev = 0, cus = 0, per_cu = 0;
        (void)hipGetDevice(&dev); (void)hipDeviceGetAttribute(&cus, hipDeviceAttributeMultiprocessorCount, dev);
        if (hipFuncSetAttribute((const void*)hybrid_fwd, hipFuncAttributeMaxDynamicSharedMemorySize, LDS_BYTES) != hipSuccess) { fprintf(stderr, "kernel_launch: hipFuncSetAttribute failed\n"); grid = -1; return; }
        if (hipOccupancyMaxActiveBlocksPerMultiprocessor(&per_cu, (const void*)hybrid_fwd, NTHR, LDS_BYTES) != hipSuccess || per_cu < 1) { fprintf(stderr, "kernel_launch: occupancy query reports %d\n", per_cu); per_cu = 1; }
        (void)hipGetLastError();
        grid = cus > 0 ? cus : 256;
    }
    if (grid < 0) return;
    Args a{};
    for (int i = 0; i < 24; ++i) a.in[i] = (const float*)d_in[i];
    a.out = (float*)d_out; a.ws = (unsigned char*)d_ws;
#if MK_PER_PHASE
    for (int ph = 0; ph < NPHASE; ++ph) { a.ph_lo = ph; a.ph_hi = ph + 1; hipLaunchKernelGGL(hybrid_fwd, dim3(grid), dim3(NTHR), LDS_BYTES, stream, a); }
#else
    a.ph_lo = 0; a.ph_hi = NPHASE;
    (void)hipMemsetAsync((unsigned char*)d_ws + WS_CTL, 0, 16384, stream);
    void* args[] = {&a};
    hipError_t e = hipLaunchCooperativeKernel((const void*)hybrid_fwd, dim3(grid), dim3(NTHR), args, LDS_BYTES, stream);
    if (e != hipSuccess) fprintf(stderr, "cooperative launch failed: %s (grid %d)\n", hipGetErrorString(e), grid);
#endif
}
```

```cpp
#include <hip/hip_runtime.h>
#include <hip/hip_cooperative_groups.h>
#include <cstdio>
#include <cstdint>
namespace cg = cooperative_groups;
namespace pg8 {
#define PG8_LAS __attribute__((address_space(3)))
typedef unsigned short bf16_t;
typedef short bf16x8 __attribute__((ext_vector_type(8)));
typedef float f32x4 __attribute__((ext_vector_type(4)));
typedef unsigned u32x4 __attribute__((ext_vector_type(4)));
constexpr int BM = 256, BK = 64, HALF = 128, HTB = HALF * BK * 2  , STAGE_BYTES = 8 * HTB, NXCD = 8, WGM = 8;

__host__ __device__ __forceinline__ int lds_byte(int r, int c) { const int st = (r >> 4) * 2 + (c >> 5), rr = r & 15, cc = c & 31, ob = rr * 64 + cc * 2; return st * 1024 + (ob ^ (((ob >> 9) & 1) << 5)); }
__host__ __device__ __forceinline__ void stage_rc(int b, int& R, int& C) { const int st = b / 1024, sb = b % 1024, swz = sb ^ (((sb >> 9) & 1) << 5); R = (st >> 1) * 16 + swz / 64; C = (st & 1) * 32 + (swz % 64) / 2; }
__host__ __device__ __forceinline__ int perm32(int rho) { const int n = rho >> 4, i = rho & 15; return 8 * (i >> 2) + 4 * n + (i & 3); }

struct Unit { int pm, pn; };
struct Gemm { const bf16_t* A; const bf16_t* Bt; int M, N, K; const bf16_t* A2 = nullptr; int nsplit = 1 << 30;
    __host__ __device__ __forceinline__ const bf16_t* asel(int pn) const { return pn < nsplit ? A : A2; } };

struct StaticOrder {
    int nM, nN, nwg, G, c;
    __host__ __device__ void init(int M, int N, int G_, int c_) { nM = M / BM; nN = N / BM; nwg = nM * nN; G = G_; c = c_; }
    __host__ __device__ bool next(int i, Unit& u) const {
        const long L = (long)i * G + c; if (L >= nwg) return false;
        int wgid = (int)L; { const int q = nwg / NXCD, r = nwg % NXCD, xcd = wgid % NXCD, off = wgid / NXCD; wgid = (xcd < r ? xcd * (q + 1) : r * (q + 1) + (xcd - r) * q) + off; }
        const int nig = WGM * nN, gid = wgid / nig, fm = gid * WGM, gsz = (nM - fm) < WGM ? (nM - fm) : WGM;
        u.pm = fm + ((wgid % nig) % gsz); u.pn = (wgid % nig) / gsz; return true;
    }
    __device__ __forceinline__ void a_ready(const Unit&) const {}
    __device__ __forceinline__ void done(const Unit&) const {}
};

__device__ __forceinline__ unsigned cvt_pk_bf16(float lo, float hi) { unsigned r; asm volatile("v_cvt_pk_bf16_f32 %0, %1, %2" : "=v"(r) : "v"(lo), "v"(hi)); return r; }
typedef float f32x2 __attribute__((ext_vector_type(2)));
__device__ __forceinline__ float bf2f(unsigned short b) { return __uint_as_float((unsigned)b << 16); }
__device__ __forceinline__ float bflo(unsigned w) { return __uint_as_float(w << 16); }
__device__ __forceinline__ float bfhi(unsigned w) { return __uint_as_float(w & 0xffff0000u); }
__device__ __forceinline__ float fsigmoid(float x) { return __builtin_amdgcn_rcpf(1.0f + __expf(-x)); }
__device__ __forceinline__ u32x4 pack8(const f32x4 a, const f32x4 b) { u32x4 w; w.x = cvt_pk_bf16(a[0], a[1]); w.y = cvt_pk_bf16(a[2], a[3]); w.z = cvt_pk_bf16(b[0], b[1]); w.w = cvt_pk_bf16(b[2], b[3]); return w; }
__device__ __forceinline__ void unpack8(const u32x4 w, f32x4& a, f32x4& b) { a = (f32x4){bflo(w.x), bfhi(w.x), bflo(w.y), bfhi(w.y)}; b = (f32x4){bflo(w.z), bfhi(w.z), bflo(w.w), bfhi(w.w)}; }

constexpr float QSCALE = 0.125f * 1.4426950408889634f;

struct EpiQKVZ {
    static constexpr bool PERM = true, AFTER_DRAIN = false;
    bf16_t* O; const float* bias; const float* cs; const float* sn;
    __device__ __forceinline__ void operator()(const f32x4 (&acc)[2][2][4][2], const Unit& u, int wr, int wc, int fr, int fq) const {
        const int row0 = u.pm * BM + wr * 64 + fr, col0 = u.pn * BM + wc * 32 + 8 * fq;
        const bool rope = u.pn < 5; const float sc = u.pn < 4 ? QSCALE : 1.0f;
        const int j4 = 4 * (4 * (wc & 1) + fq);
#pragma unroll
        for (int ai = 0; ai < 2; ++ai)
#pragma unroll
            for (int m = 0; m < 4; ++m) {
                const int row = row0 + ai * HALF + m * 16, pos = row & 4095;
                f32x4 c = (f32x4){1.f, 1.f, 1.f, 1.f}, s = (f32x4){0.f, 0.f, 0.f, 0.f};
                if (rope) { c = *(const f32x4*)(cs + pos * 32 + j4); s = *(const f32x4*)(sn + pos * 32 + j4); }
                bf16_t* rowp = O + (size_t)row * 2560 + col0;
#pragma unroll
                for (int bj = 0; bj < 2; ++bj) {
                    const f32x4 v0 = acc[ai][bj][m][0] + *(const f32x4*)(bias + col0 + bj * HALF), v1 = acc[ai][bj][m][1] + *(const f32x4*)(bias + col0 + bj * HALF + 4);
                    f32x4 o0 = v0, o1 = v1;
                    o0 = (v0 * c - v1 * s) * sc; o1 = (v1 * c + v0 * s) * sc;
                    *(u32x4*)(rowp + bj * HALF) = pack8(o0, o1);
                }
            }
    }
};
struct EpiStore {
    static constexpr bool PERM = true, AFTER_DRAIN = false;
    bf16_t* O; int ldc;
    __device__ __forceinline__ void operator()(const f32x4 (&acc)[2][2][4][2], const Unit& u, int wr, int wc, int fr, int fq) const {
        const int row0 = u.pm * BM + wr * 64 + fr, col0 = u.pn * BM + wc * 32 + 8 * fq;
#pragma unroll
        for (int ai = 0; ai < 2; ++ai)
#pragma unroll
            for (int m = 0; m < 4; ++m) { bf16_t* rowp = O + (size_t)(row0 + ai * HALF + m * 16) * ldc + col0;
#pragma unroll
                for (int bj = 0; bj < 2; ++bj) *(u32x4*)(rowp + bj * HALF) = pack8(acc[ai][bj][m][0], acc[ai][bj][m][1]); }
    }
};
struct EpiStore2 {
    static constexpr bool PERM = true, AFTER_DRAIN = false;
    bf16_t* O1; bf16_t* O2; int nsplit; int ldc;
    __device__ __forceinline__ void operator()(const f32x4 (&acc)[2][2][4][2], const Unit& u, int wr, int wc, int fr, int fq) const {
        const bool first = u.pn < nsplit; bf16_t* O = first ? O1 : O2;
        const int row0 = u.pm * BM + wr * 64 + fr, col0 = (first ? u.pn : u.pn - nsplit) * BM + wc * 32 + 8 * fq;
#pragma unroll
        for (int ai = 0; ai < 2; ++ai)
#pragma unroll
            for (int m = 0; m < 4; ++m) { bf16_t* rowp = O + (size_t)(row0 + ai * HALF + m * 16) * ldc + col0;
#pragma unroll
                for (int bj = 0; bj < 2; ++bj) *(u32x4*)(rowp + bj * HALF) = pack8(acc[ai][bj][m][0], acc[ai][bj][m][1]); }
    }
};
template <bool BF> struct EpiRes {
    static constexpr bool PERM = true, AFTER_DRAIN = false;
    const void* base; bf16_t* O;
    __device__ __forceinline__ void operator()(const f32x4 (&acc)[2][2][4][2], const Unit& u, int wr, int wc, int fr, int fq) const {
        const int row0 = u.pm * BM + wr * 64 + fr, col0 = u.pn * BM + wc * 32 + 8 * fq;
#pragma unroll
        for (int ai = 0; ai < 2; ++ai)
#pragma unroll
            for (int m = 0; m < 4; ++m) { const size_t off = (size_t)(row0 + ai * HALF + m * 16) * 1024 + col0;
#pragma unroll
                for (int bj = 0; bj < 2; ++bj) { f32x4 b0, b1;
                    if (BF) { unpack8(*(const u32x4*)((const bf16_t*)base + off + bj * HALF), b0, b1); }
                    else { b0 = *(const f32x4*)((const float*)base + off + bj * HALF); b1 = *(const f32x4*)((const float*)base + off + bj * HALF + 4); }
                    *(u32x4*)(O + off + bj * HALF) = pack8(b0 + acc[ai][bj][m][0], b1 + acc[ai][bj][m][1]); } }
    }
};
template <bool F32OUT> struct EpiGate {
    static constexpr bool PERM = true, AFTER_DRAIN = false;
    const bf16_t* hpre; const bf16_t* pp; void* O;
    __device__ __forceinline__ void operator()(const f32x4 (&acc)[2][2][4][2], const Unit& u, int wr, int wc, int fr, int fq) const {
        const int row0 = u.pm * BM + wr * 64 + fr, col0 = u.pn * BM + wc * 32 + 8 * fq;
#pragma unroll
        for (int ai = 0; ai < 2; ++ai)
#pragma unroll
            for (int m = 0; m < 4; ++m) { const size_t off = (size_t)(row0 + ai * HALF + m * 16) * 1024 + col0;
#pragma unroll
                for (int bj = 0; bj < 2; ++bj) { f32x4 h0, h1, p0, p1;
                    unpack8(*(const u32x4*)(hpre + off + bj * HALF), h0, h1); unpack8(*(const u32x4*)(pp + off + bj * HALF), p0, p1);
                    f32x4 g0, g1;
#pragma unroll
                    for (int e = 0; e < 4; ++e) { g0[e] = fsigmoid(acc[ai][bj][m][0][e]); g1[e] = fsigmoid(acc[ai][bj][m][1][e]); }
                    const f32x4 o0 = h0 + g0 * p0, o1 = h1 + g1 * p1;
                    if (F32OUT) { *(f32x4*)((float*)O + off + bj * HALF) = o0; *(f32x4*)((float*)O + off + bj * HALF + 4) = o1; }
                    else *(u32x4*)((bf16_t*)O + off + bj * HALF) = pack8(o0, o1); } }
    }
};
struct EpiWA {
    static constexpr bool PERM = true, AFTER_DRAIN = false;
    bf16_t* O; const float* w0; const float* a0;
    __device__ __forceinline__ void operator()(const f32x4 (&acc)[2][2][4][2], const Unit& u, int wr, int wc, int fr, int fq) const {
        const int row0 = u.pm * BM + wr * 64 + fr, col0 = u.pn * BM + wc * 32 + 8 * fq;
        const bool isw = u.pn < 4; const float* bvec = isw ? (w0 + col0) : (a0 + col0 - 1024); const float mul = isw ? -0.6065306597126334f : 1.0f;
#pragma unroll
        for (int ai = 0; ai < 2; ++ai)
#pragma unroll
            for (int m = 0; m < 4; ++m) { bf16_t* rowp = O + (size_t)(row0 + ai * HALF + m * 16) * 2048 + col0;
#pragma unroll
                for (int bj = 0; bj < 2; ++bj) { f32x4 o0, o1; const f32x4 b0 = *(const f32x4*)(bvec + bj * HALF), b1 = *(const f32x4*)(bvec + bj * HALF + 4);
#pragma unroll
                    for (int e = 0; e < 4; ++e) { o0[e] = mul * fsigmoid(acc[ai][bj][m][0][e] + b0[e]); o1[e] = mul * fsigmoid(acc[ai][bj][m][1][e] + b1[e]); }
                    *(u32x4*)(rowp + bj * HALF) = pack8(o0, o1); } }
    }
};
template <class Epi, class Sched, bool ALIGN_EPI = false, bool SP2 = false>
__device__ __forceinline__ void gemm_phase(PG8_LAS unsigned char* lds, const Gemm g, const Sched& S, const Epi& E, const int tid_in) {
    const int tid = tid_in, wid = __builtin_amdgcn_readfirstlane(tid >> 6), lane = tid & 63, wr = wid >> 2, wc = wid & 3, fr = lane & 15, fq = lane >> 4;
    const int K = g.K, nt = K / BK;
    unsigned voffA[2], voffB[2];
#pragma unroll
    for (int i = 0; i < 2; ++i) { int R, C; stage_rc(tid * 16 + i * 8192, R, C); const int Rb = Epi::PERM ? ((R & ~31) + perm32(R & 31)) : R;
        voffA[i] = (unsigned)(R * K + C) * 2u; voffB[i] = (unsigned)(Rb * K + C) * 2u; }
    const size_t kstep = (size_t)(BK * 2);
    const size_t hstep = (size_t)HALF * K * 2;
    const size_t tstep = 2 * hstep;
    const unsigned ldsw = (unsigned)wid * 1024u;
    const int aoff = lds_byte(wr * 64 + fr, fq * 8), boff = lds_byte(wc * 32 + fr, fq * 8);
#define PG8_SA(b, h) (((b) * 2 + (h)) * HTB)
#define PG8_SB(b, h) ((4 + (b) * 2 + (h)) * HTB)
#define PG8_STAGE(bufoff, gbase, voff) do { _Pragma("unroll") for (int _i = 0; _i < 2; ++_i) \
        __builtin_amdgcn_global_load_lds((const unsigned*)((const char*)(gbase) + (voff)[_i]), (PG8_LAS unsigned*)(lds + (bufoff) + ldsw + _i * 8192), 16, 0, 0); } while (0)
#define PG8_LDA(dst, b, h) do { _Pragma("unroll") for (int m = 0; m < 4; ++m) _Pragma("unroll") for (int k = 0; k < 2; ++k) dst[m][k] = *(const PG8_LAS bf16x8*)(lds + PG8_SA(b, h) + aoff + m * 2048 + k * 1024); } while (0)
#define PG8_LDB(dst, b, h) do { _Pragma("unroll") for (int n = 0; n < 2; ++n) _Pragma("unroll") for (int k = 0; k < 2; ++k) dst[n][k] = *(const PG8_LAS bf16x8*)(lds + PG8_SB(b, h) + boff + n * 2048 + k * 1024); } while (0)
#define PG8_MMA(ai, bj, At, Bt) do { __builtin_amdgcn_s_setprio(1); _Pragma("unroll") for (int m = 0; m < 4; ++m) _Pragma("unroll") for (int n = 0; n < 2; ++n) _Pragma("unroll") for (int k = 0; k < 2; ++k) \
        acc[ai][bj][m][n] = __builtin_amdgcn_mfma_f32_16x16x32_bf16(Bt[n][k], At[m][k], acc[ai][bj][m][n], 0, 0, 0); __builtin_amdgcn_s_setprio(0); } while (0)
#define PG8_WAIT_V(n) asm volatile("s_waitcnt vmcnt(" #n ")" ::: "memory")
#define PG8_WAIT_L(n) asm volatile("s_waitcnt lgkmcnt(" #n ")" ::: "memory")
#define PG8_BAR __builtin_amdgcn_s_barrier()
#define PG8_SCHED __builtin_amdgcn_sched_barrier(0)
    Unit cur, nxt; int ui = 0;
    if (!S.next(0, cur)) return;
    f32x4 acc[2][2][4][2];
#pragma unroll
    for (int a = 0; a < 2; ++a)
#pragma unroll
        for (int b = 0; b < 2; ++b)
#pragma unroll
            for (int m = 0; m < 4; ++m)
#pragma unroll
                for (int n = 0; n < 2; ++n) acc[a][b][m][n] = (f32x4){0.f, 0.f, 0.f, 0.f};
    bf16x8 At[4][2], B0[2][2], B1[2][2];
    const char* cA = (const char*)g.asel(cur.pn) + (size_t)cur.pm * tstep; const char* cB = (const char*)g.Bt + (size_t)cur.pn * tstep;
    S.a_ready(cur);
    if constexpr (SP2) {
        PG8_STAGE(PG8_SB(0, 0), cB, voffB); PG8_STAGE(PG8_SB(0, 1), cB + hstep, voffB); PG8_STAGE(PG8_SA(0, 0), cA, voffA); PG8_STAGE(PG8_SA(0, 1), cA + hstep, voffA);
        if (wr == 1) PG8_BAR;
        PG8_WAIT_V(2); PG8_BAR;
        PG8_STAGE(PG8_SB(1, 0), cB + kstep, voffB); PG8_STAGE(PG8_SA(1, 0), cA + kstep, voffA); PG8_STAGE(PG8_SB(1, 1), cB + hstep + kstep, voffB);
        PG8_WAIT_V(6); PG8_BAR;
    } else {
        PG8_STAGE(PG8_SB(0, 0), cB, voffB); PG8_STAGE(PG8_SA(0, 0), cA, voffA); PG8_STAGE(PG8_SB(0, 1), cB + hstep, voffB); PG8_STAGE(PG8_SA(0, 1), cA + hstep, voffA);
        if (wr == 1) PG8_BAR;
        PG8_WAIT_V(4); PG8_BAR;
        PG8_STAGE(PG8_SB(1, 0), cB + kstep, voffB); PG8_STAGE(PG8_SA(1, 0), cA + kstep, voffA); PG8_STAGE(PG8_SB(1, 1), cB + hstep + kstep, voffB);
        PG8_WAIT_V(6); PG8_BAR;
    }
    for (;;) {
        const bool has_next = S.next(ui + 1, nxt);
        const char* nA = has_next ? (const char*)g.asel(nxt.pn) + (size_t)nxt.pm * tstep : cA; const char* nB = has_next ? (const char*)g.Bt + (size_t)nxt.pn * tstep : cB;
        for (int t = 0; t < nt; t += 2) {
            const bool last = (t == nt - 2);
            const char* a1 = cA + (size_t)(t + 1) * kstep;
            const char* a2 = last ? nA : cA + (size_t)(t + 2) * kstep; const char* b2 = last ? nB : cB + (size_t)(t + 2) * kstep;
            const char* a3 = a2 + kstep; const char* b3 = b2 + kstep;
            if (last && has_next) S.a_ready(nxt);
            if constexpr (SP2) {
            PG8_LDB(B0, 0, 0); PG8_LDB(B1, 0, 1); PG8_SCHED; PG8_LDA(At, 0, 0); PG8_STAGE(PG8_SA(1, 1), a1 + hstep, voffA);
            PG8_WAIT_V(8); PG8_WAIT_L(0); PG8_BAR; PG8_MMA(0, 0, At, B0); PG8_MMA(0, 1, At, B1); PG8_BAR; PG8_SCHED;
            PG8_LDA(At, 0, 1); PG8_STAGE(PG8_SB(0, 0), b2, voffB); PG8_STAGE(PG8_SB(0, 1), b2 + hstep, voffB); PG8_STAGE(PG8_SA(0, 0), a2, voffA);
            PG8_WAIT_V(8); PG8_WAIT_L(0); PG8_BAR; PG8_MMA(1, 0, At, B0); PG8_MMA(1, 1, At, B1); PG8_BAR; PG8_SCHED;
            PG8_LDB(B0, 1, 0); PG8_LDB(B1, 1, 1); PG8_SCHED; PG8_LDA(At, 1, 0); PG8_STAGE(PG8_SA(0, 1), a2 + hstep, voffA);
            PG8_WAIT_V(8); PG8_WAIT_L(0); PG8_BAR; PG8_MMA(0, 0, At, B0); PG8_MMA(0, 1, At, B1); PG8_BAR; PG8_SCHED;
            PG8_LDA(At, 1, 1); PG8_STAGE(PG8_SB(1, 0), b3, voffB); PG8_STAGE(PG8_SB(1, 1), b3 + hstep, voffB); PG8_STAGE(PG8_SA(1, 0), a3, voffA);
            PG8_WAIT_V(8); PG8_WAIT_L(0); PG8_BAR; PG8_MMA(1, 0, At, B0); PG8_MMA(1, 1, At, B1); PG8_BAR; PG8_SCHED;
            } else {
            PG8_LDB(B0, 0, 0); PG8_SCHED; PG8_LDA(At, 0, 0); PG8_STAGE(PG8_SA(1, 1), a1 + hstep, voffA);
            PG8_WAIT_L(8); PG8_BAR; PG8_WAIT_L(0); PG8_MMA(0, 0, At, B0); PG8_BAR; PG8_SCHED;
            PG8_LDB(B1, 0, 1); PG8_STAGE(PG8_SB(0, 0), b2, voffB);
            PG8_BAR; PG8_WAIT_L(0); PG8_MMA(0, 1, At, B1); PG8_BAR;
            PG8_LDA(At, 0, 1); PG8_STAGE(PG8_SA(0, 0), a2, voffA);
            PG8_BAR; PG8_WAIT_L(0); PG8_MMA(1, 0, At, B0); PG8_BAR; PG8_SCHED;
            PG8_STAGE(PG8_SB(0, 1), b2 + hstep, voffB);
            PG8_WAIT_V(6); PG8_BAR; PG8_MMA(1, 1, At, B1); PG8_BAR;
            PG8_LDB(B0, 1, 0); PG8_SCHED; PG8_LDA(At, 1, 0); PG8_STAGE(PG8_SA(0, 1), a2 + hstep, voffA);
            PG8_WAIT_L(8); PG8_BAR; PG8_WAIT_L(0); PG8_MMA(0, 0, At, B0); PG8_BAR; PG8_SCHED;
            PG8_LDB(B1, 1, 1); PG8_STAGE(PG8_SB(1, 0), b3, voffB);
            PG8_BAR; PG8_WAIT_L(0); PG8_MMA(0, 1, At, B1); PG8_BAR;
            PG8_LDA(At, 1, 1); PG8_STAGE(PG8_SA(1, 0), a3, voffA);
            PG8_BAR; PG8_WAIT_L(0); PG8_MMA(1, 0, At, B0); PG8_BAR; PG8_SCHED;
            PG8_STAGE(PG8_SB(1, 1), b3 + hstep, voffB);
            PG8_WAIT_V(6); PG8_BAR; PG8_MMA(1, 1, At, B1); PG8_BAR;
            }
        }
        if constexpr (ALIGN_EPI) { if (wr == 0) PG8_BAR; }
        if constexpr (!Epi::AFTER_DRAIN) { E(acc, cur, wr, wc, fr, fq); S.done(cur); }
        if (!has_next) break;
#pragma unroll
        for (int a = 0; a < 2; ++a)
#pragma unroll
            for (int b = 0; b < 2; ++b)
#pragma unroll
                for (int m = 0; m < 4; ++m)
#pragma unroll
                    for (int n = 0; n < 2; ++n) acc[a][b][m][n] = (f32x4){0.f, 0.f, 0.f, 0.f};
        cur = nxt; cA = nA; cB = nB; ++ui;
        if constexpr (ALIGN_EPI) { if (wr == 1) PG8_BAR; }
    }
    PG8_WAIT_V(0);
    if constexpr (!ALIGN_EPI) { if (wr == 0) PG8_BAR; }
    PG8_BAR;
    if constexpr (Epi::AFTER_DRAIN) { E.fused(acc, cur, wr, wc, fr, fq, lds, wid, lane); S.done(cur); }
#undef PG8_SA
#undef PG8_SB
#undef PG8_STAGE
#undef PG8_LDA
#undef PG8_LDB
#undef PG8_MMA
#undef PG8_WAIT_V
#undef PG8_WAIT_L
#undef PG8_BAR
#undef PG8_SCHED
}
}
using pg8::bf16_t; using pg8::bf16x8; using pg8::f32x4; using pg8::u32x4; using pg8::cvt_pk_bf16; using pg8::bf2f; using pg8::bflo; using pg8::bfhi; using pg8::fsigmoid; using pg8::pack8; using pg8::unpack8;
#define LAS __attribute__((address_space(3)))
typedef unsigned u32x2 __attribute__((ext_vector_type(2)));
typedef float f32x2 __attribute__((ext_vector_type(2)));

constexpr int NB = 8, T = 4096, D = 1024, M = NB * T, PLE = 256, ATT_IN = 2560;
constexpr int NWAVES = 8, NTHR = 512;
constexpr int LDS_BYTES = 147456;

constexpr size_t MiB = 1u << 20;
constexpr size_t WS_WQKVZ = 0;
constexpr size_t WS_WO0   = 5 * MiB;
constexpr size_t WS_WG0   = 7 * MiB;
constexpr size_t WS_WG1   = 9 * MiB;
constexpr size_t WS_WO1   = 11 * MiB;
constexpr size_t WS_WR    = 13 * MiB;
constexpr size_t WS_WP0   = 21 * MiB;
constexpr size_t WS_WP1   = 21 * MiB + 512 * 1024;
constexpr size_t WS_WL    = 22 * MiB;
constexpr size_t WS_W2    = 22 * MiB + 512 * 1024;
constexpr size_t WS_COS   = 23 * MiB;
constexpr size_t WS_SIN   = 23 * MiB + 512 * 1024;
constexpr size_t WS_BIAS  = 24 * MiB;
constexpr size_t WS_CTL   = 25 * MiB;
constexpr size_t WS_PB0   = 32 * MiB;
constexpr size_t WS_L     = 32 * MiB;
constexpr size_t WS_PB1   = 48 * MiB;
constexpr size_t WS_S1    = 64 * MiB;
constexpr size_t WS_QKVZ  = 128 * MiB;
constexpr size_t WS_XS0   = 128 * MiB, WS_XS1 = 192 * MiB, WS_WA = 128 * MiB, WS_A2 = 256 * MiB;
constexpr size_t WS_S2    = 288 * MiB;
constexpr size_t WS_S3    = 352 * MiB;
constexpr size_t WS_S4    = 416 * MiB;
constexpr size_t WS_END   = 480 * MiB;

__device__ __forceinline__ float wave_sum(float v) {
#pragma unroll
    for (int o = 1; o < 64; o <<= 1) v += __shfl_xor(v, o);
    return v;
}
__device__ __forceinline__ float dpp_add(float x, const int ctrl_dummy) { return x; }
#define DPP_XADD(x, ctrl) ((x) + __builtin_bit_cast(float, __builtin_amdgcn_update_dpp(0, __builtin_bit_cast(int, (x)), (ctrl), 0xF, 0xF, true)))
__device__ __forceinline__ float row16_sum(float x) {
    x = DPP_XADD(x, 0xB1);
    x = DPP_XADD(x, 0x4E);
    x = DPP_XADD(x, 0x141);
    x = DPP_XADD(x, 0x140);
    return x;
}

__device__ __forceinline__ void grid_bar(unsigned* ctr, unsigned target, int tid) {
    asm volatile("s_waitcnt vmcnt(0)" ::: "memory");
    __syncthreads();
    if (tid == 0) {
        __builtin_amdgcn_fence(__ATOMIC_RELEASE, "agent");
        asm volatile("s_waitcnt vmcnt(0)" ::: "memory");
        __hip_atomic_fetch_add(ctr, 1u, __ATOMIC_RELAXED, __HIP_MEMORY_SCOPE_AGENT);
        while (__hip_atomic_load(ctr, __ATOMIC_RELAXED, __HIP_MEMORY_SCOPE_AGENT) < target) __builtin_amdgcn_s_sleep(2);
        __builtin_amdgcn_fence(__ATOMIC_ACQUIRE, "agent");
        asm volatile("s_waitcnt vmcnt(0)" ::: "memory");
    }
    __syncthreads();
}
#define XB_TMO      128
#define XB_XCNT(j)  (256  + 64 * (j))
#define XB_XSUB(j)  (1280 + 64 * (j))
#define XB_XGEN(j)  (2304 + 64 * (j))
#define XB_TOP      3328
#define XB_TOPGEN   3392
#define XCD_BAR_WORDS 3456
#define XB_SPIN_CAP (1u << 18)

__device__ __forceinline__ unsigned xb_ld(unsigned* p)              { return __hip_atomic_load(p, __ATOMIC_RELAXED, __HIP_MEMORY_SCOPE_AGENT); }
__device__ __forceinline__ unsigned xb_add(unsigned* p, unsigned v) { return __hip_atomic_fetch_add(p, v, __ATOMIC_RELAXED, __HIP_MEMORY_SCOPE_AGENT); }
__device__ __forceinline__ unsigned xb_xcc_id() { return (unsigned)__builtin_amdgcn_s_getreg((3 << 11) | 20) & 0xFu; }
#define XB_SPIN(cond, bar) do { unsigned _sp = 0; while (cond) { __builtin_amdgcn_s_sleep(1); \
    if ((++_sp & 255u) == 0u) { if (xb_ld(&(bar)[XB_TMO])) break; if (_sp > XB_SPIN_CAP) { atomicAdd(&(bar)[XB_TMO], 1u); break; } } } } while (0)

struct XcdBarrier {
    unsigned* bar; unsigned x;
    volatile LAS unsigned* st;
};

__device__ __forceinline__ XcdBarrier xcd_barrier_post(unsigned* bar, volatile LAS unsigned* st, const int tid_) {
    XcdBarrier b; b.bar = bar; b.x = xb_xcc_id(); b.st = st;
    if (tid_ == 0) (void)xb_add(&bar[XB_XCNT(b.x)], 1u);
    return b;
}
__device__ __forceinline__ void xcd_barrier_complete(unsigned* bar, unsigned x, unsigned& nloc, unsigned& nx) {
    const unsigned G = gridDim.x * gridDim.y * gridDim.z;
    unsigned sum, cnt, mine, sp = 0u;
    for (;;) {
        sum = 0u; cnt = 0u; mine = 0u;
#pragma unroll
        for (unsigned j = 0; j < 16; ++j) { const unsigned c = xb_ld(&bar[XB_XCNT(j)]); sum += c; cnt += (c > 0u) ? 1u : 0u; mine = (j == x) ? c : mine; }
        if (sum == G) break;
        __builtin_amdgcn_s_sleep(1);
        if ((++sp & 255u) == 0u) { if (xb_ld(&bar[XB_TMO])) break; if (sp > XB_SPIN_CAP) { atomicAdd(&bar[XB_TMO], 1u); break; } }
    }
    nloc = mine > 0u ? mine : 1u; nx = cnt > 0u ? cnt : 1u;
}

__device__ __forceinline__ void xcd_barrier(const XcdBarrier& b, const int tid_) {
    asm volatile("s_waitcnt vmcnt(0)" ::: "memory");
    __syncthreads();
    if (tid_ == 0) {
        unsigned* bar = b.bar;
        __builtin_amdgcn_s_waitcnt(0);
        unsigned nloc = b.st[0], nx = b.st[1];
        if (nloc == 0u) { xcd_barrier_complete(bar, b.x, nloc, nx); b.st[0] = nloc; b.st[1] = nx; }
        const unsigned old = xb_add(&bar[XB_XSUB(b.x)], 1u);
        const unsigned gen = old / nloc;
        if (old + 1u == (gen + 1u) * nloc) {
            __builtin_amdgcn_fence(__ATOMIC_RELEASE, "agent");
            asm volatile("s_waitcnt vmcnt(0)" ::: "memory");
            const unsigned og = xb_add(&bar[XB_TOP], 1u);
            const unsigned tg = og / nx;
            if (og + 1u == (tg + 1u) * nx) xb_add(&bar[XB_TOPGEN], 1u);
            else XB_SPIN(xb_ld(&bar[XB_TOPGEN]) == tg, bar);
            __builtin_amdgcn_fence(__ATOMIC_ACQUIRE, "agent");
            xb_add(&bar[XB_XGEN(b.x)], 1u);
            asm volatile("s_waitcnt vmcnt(0)" ::: "memory");
        } else {
            XB_SPIN(xb_ld(&bar[XB_XGEN(b.x)]) == gen, bar);
            __builtin_amdgcn_fence(__ATOMIC_ACQUIRE, "agent");
            asm volatile("s_waitcnt vmcnt(0)" ::: "memory");
        }
    }
    __syncthreads();
}

__device__ __forceinline__ int qk_perm_row(int n) {
    if (n >= 1280) return n;
    const int hd = n & ~63, d = n & 63, dd = d & 31;
    return hd + 8 * (dd >> 2) + 4 * (d >> 5) + (dd & 3);
}
template <int MODE>
__device__ __forceinline__ void transpose_item(const float* W, int K, int N, bf16_t* WT, int row_off, LAS float* scr, int item, int lane, const float* s) {
    const int nblk = N / 32, kb = item / nblk, nb = item % nblk, k0 = 64 * kb, n0 = 32 * nb;
#pragma unroll 8
    for (int i = 0; i < 32; ++i) { const int kk = 2 * i + (lane >> 5); float v = W[(size_t)(k0 + kk) * N + n0 + (lane & 31)];
        if (MODE == 2) v *= s[k0 + kk]; if (MODE == 3) v *= 1.0f - s[k0 + kk];
        scr[kk * 33 + (lane & 31)] = v; }
    asm volatile("s_waitcnt lgkmcnt(0)" ::: "memory");
    const int c = lane & 7;
#pragma unroll
    for (int j = 0; j < 4; ++j) { const int n = (lane >> 3) + 8 * j; const LAS float* sp = scr + (8 * c) * 33 + n;
        u32x4 o; o.x = cvt_pk_bf16(sp[0 * 33], sp[1 * 33]); o.y = cvt_pk_bf16(sp[2 * 33], sp[3 * 33]); o.z = cvt_pk_bf16(sp[4 * 33], sp[5 * 33]); o.w = cvt_pk_bf16(sp[6 * 33], sp[7 * 33]);
        const int dn = (MODE == 1) ? qk_perm_row(n0 + n) : (n0 + n);
        *(u32x4*)(WT + (size_t)(row_off + dn) * K + k0 + 8 * c) = o; }
    asm volatile("s_waitcnt lgkmcnt(0)" ::: "memory");
}

struct Args { const float* in[24]; float* out; unsigned char* ws; int ph_lo, ph_hi; };
typedef const __attribute__((address_space(4))) unsigned char* kptr_t;
__device__ __forceinline__ kptr_t kargs() { kptr_t p = (kptr_t)__builtin_amdgcn_kernarg_segment_ptr(); asm volatile("" : "+s"(p)); return p; }
#define GAS __attribute__((address_space(1)))
__device__ __forceinline__ const float* kin(kptr_t p, int i) { return (const float*)(const GAS float*)*(const unsigned long long __attribute__((address_space(4)))*)(p + 8 * i); }
__device__ __forceinline__ float* kout(kptr_t p) { return (float*)(GAS float*)*(const unsigned long long __attribute__((address_space(4)))*)(p + 8 * 24); }
__device__ __forceinline__ unsigned char* kws(kptr_t p) { return (unsigned char*)(GAS unsigned char*)*(const unsigned long long __attribute__((address_space(4)))*)(p + 8 * 25); }

enum { I_X = 0, I_P, I_NORMG, I_AWIN, I_ABIN, I_ASINK, I_AWOUT, I_MU, I_RWIN, I_W0, I_W1, I_W2, I_A0, I_A1, I_A2, I_KK, I_KA, I_RK, I_GNG, I_GNB, I_RWOUT, I_PWP, I_PWG, I_FNG };
__device__ __forceinline__ void p0_prologue(LAS unsigned char* lds, int G, int bid, int tid) {
    kptr_t kp = kargs();
    const int wave = __builtin_amdgcn_readfirstlane(tid >> 6), lane = tid & 63;
    LAS float* scr = (LAS float*)(lds + wave * 16384);
    const int gw = bid * NWAVES + wave, NGW = G * NWAVES;
    unsigned char* ws = kws(kp);
    const float* mu = kin(kp, I_MU);
    constexpr int N1 = 1280, N2 = 512, N5 = 2048, N6 = 128, N7 = 32;
    constexpr int NITEMS = N1 + 4 * N2 + N5 + 2 * N6 + 4 * N7;
    for (int it = gw; it < NITEMS; it += NGW) {
        int r = it;
        if (r < N1) { transpose_item<1>(kin(kp, I_AWIN), 1024, 2560, (bf16_t*)(ws + WS_WQKVZ), 0, scr, r, lane, nullptr); continue; } r -= N1;
        if (r < N2) { transpose_item<0>(kin(kp, I_AWOUT), 1024, 1024, (bf16_t*)(ws + WS_WO0), 0, scr, r, lane, nullptr); continue; } r -= N2;
        if (r < N2) { transpose_item<0>(kin(kp, I_PWG), 1024, 1024, (bf16_t*)(ws + WS_WG0), 0, scr, r, lane, nullptr); continue; } r -= N2;
        if (r < N2) { transpose_item<0>(kin(kp, I_PWG) + 1024 * 1024, 1024, 1024, (bf16_t*)(ws + WS_WG1), 0, scr, r, lane, nullptr); continue; } r -= N2;
        if (r < N2) { transpose_item<0>(kin(kp, I_RWOUT), 1024, 1024, (bf16_t*)(ws + WS_WO1), 0, scr, r, lane, nullptr); continue; } r -= N2;
        if (r < N5) { transpose_item<0>(kin(kp, I_RWIN), 1024, 4096, (bf16_t*)(ws + WS_WR), 0, scr, r, lane, nullptr); continue; } r -= N5;
        if (r < N6) { transpose_item<0>(kin(kp, I_PWP), 256, 1024, (bf16_t*)(ws + WS_WP0), 0, scr, r, lane, nullptr); continue; } r -= N6;
        if (r < N6) { transpose_item<0>(kin(kp, I_PWP) + 256 * 1024, 256, 1024, (bf16_t*)(ws + WS_WP1), 0, scr, r, lane, nullptr); continue; } r -= N6;
        if (r < N7) { transpose_item<3>(kin(kp, I_W1), 1024, 64, (bf16_t*)(ws + WS_WL), 0, scr, r, lane, mu + 4 * 1024); continue; } r -= N7;
        if (r < N7) { transpose_item<2>(kin(kp, I_W1), 1024, 64, (bf16_t*)(ws + WS_WL), 64, scr, r, lane, mu + 4 * 1024); continue; } r -= N7;
        if (r < N7) { transpose_item<3>(kin(kp, I_A1), 1024, 64, (bf16_t*)(ws + WS_WL), 128, scr, r, lane, mu + 5 * 1024); continue; } r -= N7;
        transpose_item<2>(kin(kp, I_A1), 1024, 64, (bf16_t*)(ws + WS_WL), 192, scr, r, lane, mu + 5 * 1024);
    }
    {
        const float* g0 = kin(kp, I_NORMG); bf16_t* XN = (bf16_t*)(ws + WS_S1);
        f32x4 gv[4];
#pragma unroll
        for (int j = 0; j < 4; ++j) gv[j] = *((const f32x4*)g0 + lane + 64 * j);
        const float* xin = kin(kp, I_X);
        f32x4 nx[4];
        if (gw < M) {
#pragma unroll
            for (int j = 0; j < 4; ++j) nx[j] = *((const f32x4*)(xin + (size_t)gw * D) + lane + 64 * j); }
        for (int m = gw; m < M; m += NGW) {
            f32x4 v[4]; float s = 0.f;
#pragma unroll
            for (int j = 0; j < 4; ++j) { v[j] = nx[j]; s += (v[j].x * v[j].x + v[j].y * v[j].y) + (v[j].z * v[j].z + v[j].w * v[j].w); }
            if (m + NGW < M) {
#pragma unroll
                for (int j = 0; j < 4; ++j) nx[j] = *((const f32x4*)(xin + (size_t)(m + NGW) * D) + lane + 64 * j); }
            const float rstd = 1.0f / sqrtf(wave_sum(s) * (1.0f / D) + 1e-6f);
            u32x2* o8 = (u32x2*)(XN + (size_t)m * D) + lane;
#pragma unroll
            for (int j = 0; j < 4; ++j) { const f32x4 o = v[j] * rstd * gv[j]; u32x2 w; w.x = cvt_pk_bf16(o.x, o.y); w.y = cvt_pk_bf16(o.z, o.w); o8[64 * j] = w; }
        }
    }
    const int gt = bid * NTHR + tid, NGT = G * NTHR;
    {
        const f32x4* p4 = (const f32x4*)kin(kp, I_P); u32x4* o = (u32x4*)(ws + WS_PB0);
        for (int i = gt; i < 2 * M * PLE / 8; i += NGT) { const f32x4 x0 = p4[2 * i], x1 = p4[2 * i + 1]; o[i] = pack8(x0, x1); }
    }
    {
        float* cs = (float*)(ws + WS_COS); float* sn = (float*)(ws + WS_SIN);
        for (int i = gt; i < T * 32; i += NGT) {
            const int pos = i >> 5, f = i & 31;
            const float inv = (float)exp2(-(double)f * (13.287712379549449 / 32.0));
            const float ang = (float)pos * inv;
            double rev = (double)ang * 0.15915494309189535; rev -= floor(rev);
            sn[i] = __builtin_amdgcn_sinf((float)rev); cs[i] = __builtin_amdgcn_cosf((float)rev);
        }
    }
    {
        float* bp = (float*)(ws + WS_BIAS);
        for (int i = gt; i < ATT_IN; i += NGT) bp[qk_perm_row(i)] = kin(kp, I_ABIN)[i];
    }
    {
        bf16_t* W2T = (bf16_t*)(ws + WS_W2); const float* w2 = kin(kp, I_W2); const float* a2 = kin(kp, I_A2);
        for (int i = gt; i < 2048 * 128; i += NGT) {
            const int k = i >> 11, nn = i & 2047;
            float v;
            if (nn < 1024) v = (k < 64) ? w2[k * 1024 + nn] : 0.f; else v = (k >= 64) ? a2[(k - 64) * 1024 + (nn - 1024)] : 0.f;
            W2T[(size_t)nn * 128 + k] = (bf16_t)(cvt_pk_bf16(v, 0.f) & 0xffffu);
        }
    }
}

__device__ __forceinline__ void attn_phase(LAS unsigned char* lds, const bf16_t* QKVZ, const float* sinks, bf16_t* OG, int G, int bid, int tid) {
    const int wave = __builtin_amdgcn_readfirstlane(tid >> 6), lane = tid & 63, fr = lane & 15, fq = lane >> 4;
    constexpr int KP = 144, VP = 528;
    LAS unsigned char* Kl = lds; LAS unsigned char* Vt = lds + 256 * KP;
    u32x4 pkv[4], pvv[4];
#define ATT_LOAD(uu) do { const int kvh_ = (uu) & 3, n_ = ((uu) >> 2) & 31, b_ = (uu) >> 7; _Pragma("unroll") for (int i = 0; i < 4; ++i) { \
        const int c_ = tid + 512 * i, key_ = c_ >> 3, ch_ = c_ & 7, t_ = 128 * (n_ - 1) + key_; \
        pkv[i] = (u32x4){0u, 0u, 0u, 0u}; pvv[i] = (u32x4){0u, 0u, 0u, 0u}; \
        if (t_ >= 0) { const bf16_t* rp_ = QKVZ + (size_t)(b_ * T + t_) * ATT_IN + kvh_ * 64 + ch_ * 8; pkv[i] = *(const u32x4*)(rp_ + 1024); pvv[i] = *(const u32x4*)(rp_ + 1280); } } } while (0)
    if (bid < 1024) ATT_LOAD(bid);
    for (int unit = bid; unit < 1024; unit += G) {
        const int kvh = unit & 3, n = (unit >> 2) & 31, b = unit >> 7;
        __syncthreads();
#pragma unroll
        for (int i = 0; i < 4; ++i) {
            const int c = tid + 512 * i, key = c >> 3, ch = c & 7;
            const u32x4 kv = pkv[i], vv = pvv[i];
            *(LAS u32x4*)(Kl + key * KP + ch * 16) = kv;
            LAS unsigned short* vp = (LAS unsigned short*)(Vt + (ch * 8) * VP + ((key ^ (ch << 2)) * 2));
            vp[0 * (VP / 2)] = (unsigned short)(vv.x & 0xffffu); vp[1 * (VP / 2)] = (unsigned short)(vv.x >> 16);
            vp[2 * (VP / 2)] = (unsigned short)(vv.y & 0xffffu); vp[3 * (VP / 2)] = (unsigned short)(vv.y >> 16);
            vp[4 * (VP / 2)] = (unsigned short)(vv.z & 0xffffu); vp[5 * (VP / 2)] = (unsigned short)(vv.z >> 16);
            vp[6 * (VP / 2)] = (unsigned short)(vv.w & 0xffffu); vp[7 * (VP / 2)] = (unsigned short)(vv.w >> 16);
        }
        if (unit + G < 1024) ATT_LOAD(unit + G);
        __syncthreads();
        const int g = wave >> 1, qh = wave & 1, h = kvh * 4 + g;
        const float sink2 = sinks[h] * 1.4426950408889634f;
        for (int mt = 0; mt < 4; ++mt) {
            const int qo0 = qh * 64 + mt * 16;
            const size_t row = (size_t)(b * T + n * 128 + qo0 + fr);
            const bf16_t* qp = QKVZ + row * ATT_IN + h * 64 + fq * 8;
            const bf16x8 q0 = *(const bf16x8*)qp, q1 = *(const bf16x8*)(qp + 32);
            const int kt0 = (qh * 4 + mt) < 6 ? (qh * 4 + mt) : 6;
            f32x4 s[10];
#pragma unroll
            for (int kt = 0; kt < 10; ++kt) {
                const LAS unsigned char* kp = Kl + ((kt0 + kt) * 16 + fr) * KP + fq * 16;
                const bf16x8 k0 = *(const LAS bf16x8*)kp, k1 = *(const LAS bf16x8*)(kp + 64);
                f32x4 acc = (f32x4){0.f, 0.f, 0.f, 0.f};
                acc = __builtin_amdgcn_mfma_f32_16x16x32_bf16(k0, q0, acc, 0, 0, 0);
                acc = __builtin_amdgcn_mfma_f32_16x16x32_bf16(k1, q1, acc, 0, 0, 0);
                s[kt] = acc;
            }
            const int qi = 128 + qo0 + fr;
            float mx = sink2;
#pragma unroll
            for (int kt = 0; kt < 10; ++kt)
#pragma unroll
                for (int r = 0; r < 4; ++r) { const int si = (kt0 + kt) * 16 + 4 * fq + r, df = qi - si; const bool ok = (df >= 0) && (df < 128) && (n > 0 || si >= 128);
                    const float v = ok ? s[kt][r] : -1e30f; s[kt][r] = v; mx = fmaxf(mx, v); }
            mx = fmaxf(mx, __shfl_xor(mx, 16)); mx = fmaxf(mx, __shfl_xor(mx, 32));
            float sum = 0.f;
#pragma unroll
            for (int kt = 0; kt < 10; ++kt)
#pragma unroll
                for (int r = 0; r < 4; ++r) { const float p = __builtin_amdgcn_exp2f(s[kt][r] - mx); s[kt][r] = p; sum += p; }
            sum += __shfl_xor(sum, 16); sum += __shfl_xor(sum, 32);
            sum += __builtin_amdgcn_exp2f(sink2 - mx);
            const float inv = 1.0f / sum;
            f32x4 o[4];
#pragma unroll
            for (int dt = 0; dt < 4; ++dt) o[dt] = (f32x4){0.f, 0.f, 0.f, 0.f};
#pragma unroll
            for (int kk = 0; kk < 5; ++kk) {
                const u32x4 pw = pack8(s[2 * kk], s[2 * kk + 1]);
                const bf16x8 pf = __builtin_bit_cast(bf16x8, pw);
#pragma unroll
                for (int dt = 0; dt < 4; ++dt) {
                    const int d = dt * 16 + fr, sw = ((d >> 3) & 7) << 2, keyA = 16 * (kt0 + 2 * kk) + 4 * fq, keyB = keyA + 16;
                    const u32x2 va = *(const LAS u32x2*)(Vt + d * VP + ((keyA ^ sw) * 2)), vb = *(const LAS u32x2*)(Vt + d * VP + ((keyB ^ sw) * 2));
                    const u32x4 vw = (u32x4){va.x, va.y, vb.x, vb.y};
                    o[dt] = __builtin_amdgcn_mfma_f32_16x16x32_bf16(__builtin_bit_cast(bf16x8, vw), pf, o[dt], 0, 0, 0);
                }
            }
            const bf16_t* zp = QKVZ + row * ATT_IN + 1536 + h * 64 + 4 * fq;
            bf16_t* op = OG + row * D + h * 64 + 4 * fq;
#pragma unroll
            for (int dt = 0; dt < 4; ++dt) {
                const u32x2 zw = *(const u32x2*)(zp + dt * 16);
                const float z0 = bflo(zw.x), z1 = bfhi(zw.x), z2 = bflo(zw.y), z3 = bfhi(zw.y);
                const float r0 = o[dt][0] * inv * z0 * fsigmoid(z0), r1 = o[dt][1] * inv * z1 * fsigmoid(z1), r2 = o[dt][2] * inv * z2 * fsigmoid(z2), r3 = o[dt][3] * inv * z3 * fsigmoid(z3);
                u32x2 w; w.x = cvt_pk_bf16(r0, r1); w.y = cvt_pk_bf16(r2, r3);
                *(u32x2*)(op + dt * 16) = w;
            }
        }
    }
}
template <int ROUND>
__device__ __forceinline__ void lerp_phase(const bf16_t* H1, const float* g1, const float* mu, bf16_t* HN, bf16_t* XS0, bf16_t* XS1, int G, int bid, int tid) {
    const int wave = __builtin_amdgcn_readfirstlane(tid >> 6), lane = tid & 63;
    const int gw = bid * NWAVES + wave, NGW = G * NWAVES;
    const float* mu0 = mu + (ROUND == 0 ? 0 : 2) * 1024; const float* mu1 = mu0 + 1024;
    f32x4 gq[4], m0q[4], m1q[4];
#pragma unroll
    for (int q = 0; q < 4; ++q) { const int col = (q >> 1) * 512 + lane * 8 + 4 * (q & 1); gq[q] = *(const f32x4*)(g1 + col); m0q[q] = *(const f32x4*)(mu0 + col); m1q[q] = *(const f32x4*)(mu1 + col); }
    u32x4 rc_[2], rp_[2];
#define LERP_LOAD(mm) do { const bool hp_ = ((mm) & (T - 1)) != 0; _Pragma("unroll") for (int j = 0; j < 2; ++j) { const size_t off_ = (size_t)(mm) * D + j * 512 + lane * 8; \
        rc_[j] = *(const u32x4*)(H1 + off_); rp_[j] = hp_ ? *(const u32x4*)(H1 + off_ - D) : (u32x4){0u, 0u, 0u, 0u}; } } while (0)
    if (gw < M) LERP_LOAD(gw);
    for (int m = gw; m < M; m += NGW) {
        f32x4 c[4], p[4];
        float sc = 0.f, sp = 0.f;
#pragma unroll
        for (int j = 0; j < 2; ++j) { unpack8(rc_[j], c[2 * j], c[2 * j + 1]); unpack8(rp_[j], p[2 * j], p[2 * j + 1]); }
        if (m + NGW < M) LERP_LOAD(m + NGW);
#pragma unroll
        for (int q = 0; q < 4; ++q) { sc += (c[q].x * c[q].x + c[q].y * c[q].y) + (c[q].z * c[q].z + c[q].w * c[q].w); sp += (p[q].x * p[q].x + p[q].y * p[q].y) + (p[q].z * p[q].z + p[q].w * p[q].w); }
        const float rc = 1.0f / sqrtf(wave_sum(sc) * (1.0f / D) + 1e-6f), rp = 1.0f / sqrtf(wave_sum(sp) * (1.0f / D) + 1e-6f);
#pragma unroll
        for (int j = 0; j < 2; ++j) {
            const int col = j * 512 + lane * 8; const size_t off = (size_t)m * D + col;
            f32x4 hn[2], xx[2], o0[2], o1[2];
#pragma unroll
            for (int e = 0; e < 2; ++e) {
                const f32x4 gv = gq[2 * j + e];
                hn[e] = c[2 * j + e] * rc * gv; xx[e] = p[2 * j + e] * rp * gv - hn[e];
                o0[e] = hn[e] + xx[e] * m0q[2 * j + e];
                o1[e] = hn[e] + xx[e] * m1q[2 * j + e];
            }
            if (ROUND == 0) *(u32x4*)(HN + off) = pack8(hn[0], hn[1]);
            *(u32x4*)(XS0 + off) = pack8(o0[0], o0[1]);
            *(u32x4*)(XS1 + off) = pack8(o1[0], o1[1]);
        }
    }
}
__device__ __forceinline__ void lora_mid_phase(const bf16_t* L, bf16_t* A2, int G, int bid, int tid) {
    const int gt = bid * NTHR + tid, NGT = G * NTHR;
    for (int i = gt; i < M * 16; i += NGT) {
        const int m = i >> 4, ch = i & 15, isA = ch >> 3, c8 = (ch & 7) * 8;
        const bool hasprev = (m & (T - 1)) != 0;
        f32x4 u0, u1, v0 = (f32x4){0.f, 0.f, 0.f, 0.f}, v1 = v0;
        unpack8(*(const u32x4*)(L + (size_t)m * 256 + isA * 128 + c8), u0, u1);
        if (hasprev) unpack8(*(const u32x4*)(L + (size_t)(m - 1) * 256 + isA * 128 + 64 + c8), v0, v1);
        u0 += v0; u1 += v1;
        if (!isA) {
#pragma unroll
            for (int e = 0; e < 4; ++e) { u0[e] = tanhf(u0[e]); u1[e] = tanhf(u1[e]); }
        }
        *(u32x4*)(A2 + (size_t)m * 128 + ch * 8) = pack8(u0, u1);
    }
}
#ifndef MK_SCAN_CHUNKED
#define MK_SCAN_CHUNKED 1
#endif
#if MK_SCAN_CHUNKED
typedef __bf16 ck_bf16x2_t __attribute__((ext_vector_type(2)));
__device__ __forceinline__ unsigned ck_cvt(float lo, float hi) { const f32x2 v = {lo, hi}; return __builtin_bit_cast(unsigned, __builtin_convertvector(v, ck_bf16x2_t)); }
constexpr int CK_RP = 144;
constexpr int CK_TP = 40;
constexpr int CK_ABAR = 0, CK_RBAR = 2304, CK_BTIL = 4608, CK_KTIL = 6912;
constexpr int CK_BT_T = 9216, CK_KT_T = 11776;
constexpr int CK_VT = 14336;
constexpr int CK_GAM = 15616;
constexpr int CK_BUF = 15872;
constexpr int CK_LD = 2 * CK_BUF;
constexpr int CK_PRIV = CK_LD + 2 * 4096;
constexpr int CK_PRIV_SZ = 2560;
__device__ __forceinline__ bf16x8 ck_ld2(const LAS unsigned char* p, int off2) {
    const u32x2 a = *(const LAS u32x2*)p, b = *(const LAS u32x2*)(p + off2); return __builtin_bit_cast(bf16x8, (u32x4){a.x, a.y, b.x, b.y}); }
__device__ __forceinline__ bf16x8 ck_ld1(const LAS unsigned char* p) {
    const u32x2 a = *(const LAS u32x2*)p; return __builtin_bit_cast(bf16x8, (u32x4){a.x, a.y, 0u, 0u}); }
__device__ __forceinline__ bf16x8 ck_pk4(const f32x4 x) { return __builtin_bit_cast(bf16x8, (u32x4){ck_cvt(x[0], x[1]), ck_cvt(x[2], x[3]), 0u, 0u}); }
#define CK_MFMA(a, b, c) __builtin_amdgcn_mfma_f32_16x16x32_bf16((a), (b), (c), 0, 0, 0)

constexpr int CK_STG = CK_PRIV + 2 * CK_PRIV_SZ;
constexpr int CK_STG_SZ = 4 * 4096 + 1024;
__device__ __forceinline__ void scan_phase(LAS unsigned char* lds, const bf16_t* R, const bf16_t* Kb, const bf16_t* V, const bf16_t* WA, const float* k_k, const float* k_a, bf16_t* Y, int G, int bid, int tid) {
    const int wave = __builtin_amdgcn_readfirstlane(tid >> 6), lane = tid & 63, c = lane & 15, g = lane >> 4;
    const int wq = (wave & 1) + ((wave >> 2) << 1);
    const int pid = wq * 64 + lane, pt = (pid >> 4) & 15, pj = pid & 15;
    const int pid1 = tid - 256, pta = (pid1 >> 4) & 7, ptb = pta + 8;
    const bool producer = (wave == 2) || (wave == 3) || (wave >= 6), producer1 = (wave == 4) || (wave == 5), consumer = wave < 2;
    constexpr int NCH = T / 16;
    for (int unit = bid; unit < 256; unit += G) {
        const int b = unit >> 5, h = (unit >> 1) & 15, half = unit & 1;
        const size_t rowbase = (size_t)b * T;
        f32x4 kkw = (f32x4){0.f, 0.f, 0.f, 0.f}, kaw = kkw;
        if (producer1) { kkw = *(const f32x4*)(k_k + h * 64 + 4 * pj); kaw = *(const f32x4*)(k_a + h * 64 + 4 * pj); }
        u32x2 rkA = (u32x2){0u, 0u}, rrA = rkA, raA = rkA, rlA = rkA, rkB = rkA, rrB = rkA, raB = rkA, rlB = rkA; unsigned rvA = 0u, rvB = 0u;
#define CK_LOAD(X, ptx, cn) do { const size_t m_ = rowbase + (size_t)(cn) * 16 + (ptx); \
            rk##X = *(const u32x2*)(Kb + m_ * D + h * 64 + 4 * pj); rr##X = *(const u32x2*)(R + m_ * D + h * 64 + 4 * pj); \
            rl##X = *(const u32x2*)(WA + m_ * 2048 + h * 64 + 4 * pj); ra##X = *(const u32x2*)(WA + m_ * 2048 + 1024 + h * 64 + 4 * pj); \
            rv##X = *(const unsigned*)(V + m_ * D + h * 64 + half * 32 + 2 * pj); } while (0)
#define CK_P1(X, ptx, cn) do { \
            const f32x4 kf_ = (f32x4){bflo(rk##X.x), bfhi(rk##X.x), bflo(rk##X.y), bfhi(rk##X.y)}, af_ = (f32x4){bflo(ra##X.x), bfhi(ra##X.x), bflo(ra##X.y), bfhi(ra##X.y)}; \
            const f32x4 lf_ = (f32x4){bflo(rl##X.x), bfhi(rl##X.x), bflo(rl##X.y), bfhi(rl##X.y)}, rf_ = (f32x4){bflo(rr##X.x), bfhi(rr##X.x), bflo(rr##X.y), bfhi(rr##X.y)}; \
            const f32x4 kv_ = kf_ * kkw; \
            float ss_ = (kv_.x * kv_.x + kv_.y * kv_.y) + (kv_.z * kv_.z + kv_.w * kv_.w); \
            ss_ = row16_sum(ss_); \
            const float invn_ = (ss_ > 1e-24f) ? __builtin_amdgcn_rsqf(ss_) : 1e12f;        \
            const f32x4 kk_ = kv_ * invn_; \
            LAS unsigned char* st_ = lds + CK_STG + ((cn) & 1) * CK_STG_SZ + ((ptx) * 64 + 4 * pj) * 4; \
            *(LAS f32x4*)(st_) = -kk_; *(LAS f32x4*)(st_ + 4096) = kk_ * af_; *(LAS f32x4*)(st_ + 8192) = kf_ * (1.0f + (af_ - 1.0f) * kaw); *(LAS f32x4*)(st_ + 12288) = rf_; \
            *(LAS unsigned*)(lds + CK_STG + ((cn) & 1) * CK_STG_SZ + 16384 + ((ptx) * 16 + pj) * 4) = rv##X; \
            *(LAS f32x4*)(lds + CK_LD + ((cn) & 1) * 4096 + ((ptx) * 64 + 4 * pj) * 4) = lf_; } while (0)
        if (producer1) { CK_LOAD(A, pta, 0); CK_LOAD(B, ptb, 0); CK_P1(A, pta, 0); CK_P1(B, ptb, 0); CK_LOAD(A, pta, 1); CK_LOAD(B, ptb, 1); }
        f32x4 H[4];
#pragma unroll
        for (int kt = 0; kt < 4; ++kt) H[kt] = (f32x4){0.f, 0.f, 0.f, 0.f};
        __syncthreads();
        for (int it = 0; it <= NCH; ++it) {
            if (producer1 && it + 1 < NCH) { CK_P1(A, pta, it + 1); CK_P1(B, ptb, it + 1); if (it + 2 < NCH) { CK_LOAD(A, pta, it + 2); CK_LOAD(B, ptb, it + 2); } }
            if (producer && it < NCH) {
                LAS unsigned char* buf = lds + (it & 1) * CK_BUF;
                const LAS unsigned char* ldp = lds + CK_LD + (it & 1) * 4096 + 16 * pj;
                const LAS unsigned char* stp = lds + CK_STG + (it & 1) * CK_STG_SZ + (pt * 64 + 4 * pj) * 4;
                f32x4 nkk = *(const LAS f32x4*)(stp), be = *(const LAS f32x4*)(stp + 4096), kp = *(const LAS f32x4*)(stp + 8192), rf = *(const LAS f32x4*)(stp + 12288), lf = *(const LAS f32x4*)(ldp + pt * 256);
                unsigned vsave = *(const LAS unsigned*)(lds + CK_STG + (it & 1) * CK_STG_SZ + 16384 + (pt * 16 + pj) * 4);
                asm volatile("" : "+v"(nkk), "+v"(be), "+v"(kp), "+v"(rf), "+v"(lf), "+v"(vsave));
                f32x4 Gc = (f32x4){0.f, 0.f, 0.f, 0.f};
                const int w4 = 4 * wq;
#pragma unroll
                for (int s4 = 0; s4 < 16; s4 += 4) {
                    if (s4 <= w4) {
                        f32x4 x0 = *(const LAS f32x4*)(ldp + (s4 + 0) * 256), x1 = *(const LAS f32x4*)(ldp + (s4 + 1) * 256), x2 = *(const LAS f32x4*)(ldp + (s4 + 2) * 256), x3 = *(const LAS f32x4*)(ldp + (s4 + 3) * 256);
                        asm volatile("" : "+v"(x0), "+v"(x1), "+v"(x2), "+v"(x3));
                        if (s4 < w4) Gc += (x0 + x1) + (x2 + x3);
                        else { const f32x4 z4 = (f32x4){0.f, 0.f, 0.f, 0.f};
                            Gc += (s4 + 0 <= pt) ? x0 : z4; Gc += (s4 + 1 <= pt) ? x1 : z4; Gc += (s4 + 2 <= pt) ? x2 : z4; Gc += (s4 + 3 <= pt) ? x3 : z4; }
                    }
                }
                const f32x4 Gm = Gc - lf;
                f32x4 eA, eR, eN;
#pragma unroll
                for (int e = 0; e < 4; ++e) { eA[e] = __expf(Gm[e]); eR[e] = __expf(Gc[e]); eN[e] = __expf(-Gc[e]); }
                const f32x4 ab = nkk * eA, rb = rf * eR, bt = be * eN, kt_ = kp * eN;
                const unsigned ab0 = ck_cvt(ab.x, ab.y), ab1 = ck_cvt(ab.z, ab.w), rb0 = ck_cvt(rb.x, rb.y), rb1 = ck_cvt(rb.z, rb.w);
                const unsigned bt0 = ck_cvt(bt.x, bt.y), bt1 = ck_cvt(bt.z, bt.w), kt0 = ck_cvt(kt_.x, kt_.y), kt1 = ck_cvt(kt_.z, kt_.w);
                LAS unsigned char* rowp = buf + pt * CK_RP + 64 * (pj >> 3) + 16 * (pj & 3) + 8 * ((pj >> 2) & 1);
                *(LAS u32x2*)(rowp + CK_ABAR) = (u32x2){ab0, ab1}; *(LAS u32x2*)(rowp + CK_RBAR) = (u32x2){rb0, rb1};
                *(LAS u32x2*)(rowp + CK_BTIL) = (u32x2){bt0, bt1}; *(LAS u32x2*)(rowp + CK_KTIL) = (u32x2){kt0, kt1};
                constexpr int TS = CK_TP / 2;
                {
                    const int rrow = lane >> 4;
#define CK_T4(x0, x1, x2, x3) do { auto s0_ = __builtin_amdgcn_permlane32_swap(x0, x2, false, false); auto s1_ = __builtin_amdgcn_permlane32_swap(x1, x3, false, false); \
                        auto t0_ = __builtin_amdgcn_permlane16_swap(s0_[0], s1_[0], false, false); auto t1_ = __builtin_amdgcn_permlane16_swap(s0_[1], s1_[1], false, false); \
                        x0 = t0_[0]; x1 = t0_[1]; x2 = t1_[0]; x3 = t1_[1]; } while (0)
                    unsigned b0_ = __float_as_uint(bt.x), b1_ = __float_as_uint(bt.y), b2_ = __float_as_uint(bt.z), b3_ = __float_as_uint(bt.w);
                    unsigned k0_ = __float_as_uint(kt_.x), k1_ = __float_as_uint(kt_.y), k2_ = __float_as_uint(kt_.z), k3_ = __float_as_uint(kt_.w);
                    CK_T4(b0_, b1_, b2_, b3_); CK_T4(k0_, k1_, k2_, k3_);
#undef CK_T4
                    const int toff = (4 * pj + rrow) * CK_TP + 8 * wq;
                    *(LAS u32x2*)(buf + CK_BT_T + toff) = (u32x2){ck_cvt(__uint_as_float(b0_), __uint_as_float(b1_)), ck_cvt(__uint_as_float(b2_), __uint_as_float(b3_))};
                    *(LAS u32x2*)(buf + CK_KT_T + toff) = (u32x2){ck_cvt(__uint_as_float(k0_), __uint_as_float(k1_)), ck_cvt(__uint_as_float(k2_), __uint_as_float(k3_))};
                }
                LAS unsigned short* vT = (LAS unsigned short*)(buf + CK_VT + (2 * pj) * CK_TP + pt * 2);
                vT[0] = (unsigned short)(vsave & 0xffffu); vT[TS] = (unsigned short)(vsave >> 16);
                if (pt == 15) *(LAS f32x4*)(buf + CK_GAM + 16 * pj) = eR;
            }
            if (consumer && it > 0) {
                const int cn = it - 1;
                const LAS unsigned char* buf = lds + (cn & 1) * CK_BUF;
                LAS unsigned char* priv = lds + CK_PRIV + wave * CK_PRIV_SZ;
                LAS float* AabT = (LAS float*)priv; LAS float* Xch = (LAS float*)(priv + 1024); LAS unsigned char* UT = priv + 2048;
                f32x4 xab = (f32x4){0.f, 0.f, 0.f, 0.f}, xak = xab, xrb = xab, xrk = xab;
                bf16x8 pa[2], pr[2];
#pragma unroll
                for (int ks = 0; ks < 2; ++ks) {
                    const LAS unsigned char* rp = buf + c * CK_RP + 64 * ks + 16 * g;
                    pa[ks] = *(const LAS bf16x8*)(rp + CK_ABAR); pr[ks] = *(const LAS bf16x8*)(rp + CK_RBAR);
                    const bf16x8 pb = *(const LAS bf16x8*)(rp + CK_BTIL), pk = *(const LAS bf16x8*)(rp + CK_KTIL);
                    xab = CK_MFMA(pb, pa[ks], xab); xak = CK_MFMA(pk, pa[ks], xak); xrb = CK_MFMA(pb, pr[ks], xrb); xrk = CK_MFMA(pk, pr[ks], xrk);
                }
#pragma unroll
                for (int r = 0; r < 4; ++r) { const int s = 4 * g + r; if (!(s < c)) { xab[r] = 0.f; xak[r] = 0.f; } if (!(s <= c)) { xrb[r] = 0.f; xrk[r] = 0.f; } }
#pragma unroll
                for (int r = 0; r < 4; ++r) AabT[(4 * g + r) * 16 + c] = xab[r];
                const bf16x8 opak = ck_pk4(xak), oprb = ck_pk4(xrb), oprk = ck_pk4(xrk);
                bf16x8 oph[2];
#pragma unroll
                for (int ks = 0; ks < 2; ++ks) oph[ks] = __builtin_bit_cast(bf16x8, (u32x4){ck_cvt(H[2 * ks][0], H[2 * ks][1]), ck_cvt(H[2 * ks][2], H[2 * ks][3]), ck_cvt(H[2 * ks + 1][0], H[2 * ks + 1][1]), ck_cvt(H[2 * ks + 1][2], H[2 * ks + 1][3])});
                const bf16x8 opv = ck_ld1(buf + CK_VT + (wave * 16 + c) * CK_TP + g * 8);
                f32x4 rhs = (f32x4){0.f, 0.f, 0.f, 0.f};
                rhs = CK_MFMA(pa[0], oph[0], rhs); rhs = CK_MFMA(pa[1], oph[1], rhs); rhs = CK_MFMA(opak, opv, rhs);
                float u[16];
#pragma unroll
                for (int r = 0; r < 4; ++r) {
                    const unsigned a_ = __float_as_uint(rhs[r]);
                    const auto h_ = __builtin_amdgcn_permlane32_swap(a_, a_, false, false);
                    const auto lo_ = __builtin_amdgcn_permlane16_swap(h_[0], h_[0], false, false);
                    const auto hi_ = __builtin_amdgcn_permlane16_swap(h_[1], h_[1], false, false);
                    u[r] = __uint_as_float(lo_[0]); u[4 + r] = __uint_as_float(lo_[1]); u[8 + r] = __uint_as_float(hi_[0]); u[12 + r] = __uint_as_float(hi_[1]);
                }
                asm volatile("s_waitcnt lgkmcnt(0)" ::: "memory");
                f32x4 cw[15][4];
#define CK_COLLD(ss) do { _Pragma("unroll") for (int q_ = ((ss) + 1) / 4; q_ < 4; ++q_) cw[(ss)][q_] = *(const LAS f32x4*)(AabT + (ss) * 16 + 4 * q_); } while (0)
                CK_COLLD(0); CK_COLLD(1);
#pragma unroll
                for (int s = 0; s < 15; ++s) {
                    if (s + 2 < 15) CK_COLLD(s + 2);
                    __builtin_amdgcn_sched_barrier(0);
#pragma unroll
                    for (int t = s + 1; t < 16; ++t) u[t] += cw[s][t >> 2][t & 3] * u[s];
                }
#undef CK_COLLD
                bf16x8 opu;
                { const bool g1 = (g & 1) != 0, g2 = (g & 2) != 0;
                  const float a0 = g1 ? u[4] : u[0], a1 = g1 ? u[5] : u[1], a2 = g1 ? u[6] : u[2], a3 = g1 ? u[7] : u[3];
                  const float b0 = g1 ? u[12] : u[8], b1 = g1 ? u[13] : u[9], b2 = g1 ? u[14] : u[10], b3 = g1 ? u[15] : u[11];
                  opu = __builtin_bit_cast(bf16x8, (u32x4){ck_cvt(g2 ? b0 : a0, g2 ? b1 : a1), ck_cvt(g2 ? b2 : a2, g2 ? b3 : a3), 0u, 0u}); }
                f32x4 yy = (f32x4){0.f, 0.f, 0.f, 0.f};
                yy = CK_MFMA(pr[0], oph[0], yy); yy = CK_MFMA(pr[1], oph[1], yy); yy = CK_MFMA(oprb, opu, yy); yy = CK_MFMA(oprk, opv, yy);
                {
                    bf16_t* yp = Y + (rowbase + (size_t)cn * 16 + 4 * g) * D + h * 64 + half * 32 + wave * 16 + c;
#pragma unroll
                    for (int r = 0; r < 4; ++r) yp[(size_t)r * D] = (bf16_t)(ck_cvt(yy[r], 0.f) & 0xffffu);
                }
#pragma unroll
                for (int kt = 0; kt < 4; ++kt) {
                    const bf16x8 opb = ck_ld1(buf + CK_BT_T + (16 * kt + c) * CK_TP + g * 8), opk = ck_ld1(buf + CK_KT_T + (16 * kt + c) * CK_TP + g * 8);
                    f32x4 hh = H[kt];
                    hh = CK_MFMA(opb, opu, hh); hh = CK_MFMA(opk, opv, hh);
                    H[kt] = hh * *(const LAS f32x4*)(buf + CK_GAM + (16 * kt + 4 * g) * 4);
                }
            }
            __syncthreads();
        }
    }
#undef CK_LOAD
#undef CK_P1
}
#else
constexpr int TC = 32;
constexpr int SC_VEC = TC * 5 * 64 * 4;
constexpr int SC_VP = 36;
constexpr int SC_V = 32 * SC_VP * 4;
constexpr int SC_Y = TC * 32 * 4;
constexpr int SC_BUF = SC_VEC + SC_V + SC_Y;
__device__ __forceinline__ void scan_phase(LAS unsigned char* lds, const bf16_t* R, const bf16_t* Kb, const bf16_t* V, const bf16_t* WA, const float* k_k, const float* k_a, bf16_t* Y, int G, int bid, int tid) {
    const int wave = __builtin_amdgcn_readfirstlane(tid >> 6), lane = tid & 63, rg = lane >> 4, cc = lane & 15;
    const int pt = tid >> 4, pj = tid & 15;
    for (int unit = bid; unit < 256; unit += G) {
        const int b = unit >> 5, h = (unit >> 1) & 15, half = unit & 1;
        const size_t rowbase = (size_t)b * T;
        const f32x4 kkw = *(const f32x4*)(k_k + h * 64 + 4 * pj), kaw = *(const f32x4*)(k_a + h * 64 + 4 * pj);
        f32x2 S01 = (f32x2){0.f, 0.f}, S23 = (f32x2){0.f, 0.f};
        u32x2 rk, rr, ra, rl; unsigned rv;
#define SCAN_LOAD(cn) do { const size_t m_ = rowbase + (size_t)(cn) * TC + pt; \
            rk = *(const u32x2*)(Kb + m_ * D + h * 64 + 4 * pj); rr = *(const u32x2*)(R + m_ * D + h * 64 + 4 * pj); \
            rl = *(const u32x2*)(WA + m_ * 2048 + h * 64 + 4 * pj); ra = *(const u32x2*)(WA + m_ * 2048 + 1024 + h * 64 + 4 * pj); \
            rv = *(const unsigned*)(V + m_ * D + h * 64 + half * 32 + 2 * pj); } while (0)
        SCAN_LOAD(0);
        __syncthreads();
        for (int cn = 0; cn < T / TC; ++cn) {
            LAS unsigned char* buf = lds + (cn & 1) * SC_BUF;
            {
                const f32x4 kf = (f32x4){bflo(rk.x), bfhi(rk.x), bflo(rk.y), bfhi(rk.y)}, af = (f32x4){bflo(ra.x), bfhi(ra.x), bflo(ra.y), bfhi(ra.y)};
                const f32x4 lf = (f32x4){bflo(rl.x), bfhi(rl.x), bflo(rl.y), bfhi(rl.y)}, rf = (f32x4){bflo(rr.x), bfhi(rr.x), bflo(rr.y), bfhi(rr.y)};
                const f32x4 kv = kf * kkw;
                float ss = (kv.x * kv.x + kv.y * kv.y) + (kv.z * kv.z + kv.w * kv.w);
                ss = row16_sum(ss);
                const float invn = 1.0f / fmaxf(sqrtf(ss), 1e-12f);
                const f32x4 kk = kv * invn;
                const f32x4 kp = kf * (1.0f + (af - 1.0f) * kaw);
                f32x4 dd; dd.x = __expf(lf.x); dd.y = __expf(lf.y); dd.z = __expf(lf.z); dd.w = __expf(lf.w);
                LAS f32x4* vp = (LAS f32x4*)(buf + pt * 1280) + pj;
                vp[0] = -kk; vp[16] = dd; vp[32] = kk * af; vp[48] = kp; vp[64] = rf;
                LAS float* vv = (LAS float*)(buf + SC_VEC) + (2 * pj) * SC_VP + pt;
                vv[0] = bflo(rv); vv[SC_VP] = bfhi(rv);
            }
            if (cn + 1 < T / TC) SCAN_LOAD(cn + 1);
            __syncthreads();
            if (cn > 0) {
                const LAS float* yb = (const LAS float*)(lds + ((cn - 1) & 1) * SC_BUF + SC_VEC + SC_V + pt * 128) + 2 * pj;
                const size_t m_ = rowbase + (size_t)(cn - 1) * TC + pt;
                *(unsigned*)(Y + m_ * D + h * 64 + half * 32 + 2 * pj) = cvt_pk_bf16(yb[0], yb[1]);
            }
            const int rloc = wave * 4 + rg;
            LAS float* yrow = (LAS float*)(buf + SC_VEC + SC_V) + rloc;
            const unsigned va0 = (unsigned)(size_t)(buf + cc * 16), ra0 = (unsigned)(size_t)(buf + SC_VEC + rloc * SC_VP * 4);
#define SC_LD5(NK, DD, BE, KP, RF, AR, OFF) do { \
                asm volatile("ds_read_b128 %0, %1 offset:%2" : "=&v"(NK) : "v"(AR), "i"((OFF))); asm volatile("ds_read_b128 %0, %1 offset:%2" : "=&v"(DD) : "v"(AR), "i"((OFF) + 256)); \
                asm volatile("ds_read_b128 %0, %1 offset:%2" : "=&v"(BE) : "v"(AR), "i"((OFF) + 512)); asm volatile("ds_read_b128 %0, %1 offset:%2" : "=&v"(KP) : "v"(AR), "i"((OFF) + 768)); \
                asm volatile("ds_read_b128 %0, %1 offset:%2" : "=&v"(RF) : "v"(AR), "i"((OFF) + 1024)); } while (0)
            f32x4 nk, dd, be, kp, rf, nk1, dd1, be1, kp1, rf1, nk2, dd2, be2, kp2, rf2, vcur, vnxt;
            SC_LD5(nk, dd, be, kp, rf, va0, 0); SC_LD5(nk1, dd1, be1, kp1, rf1, va0, 1280);
            asm volatile("ds_read_b128 %0, %1" : "=&v"(vcur) : "v"(ra0));
            asm volatile("s_waitcnt lgkmcnt(0)" : "+v"(nk), "+v"(dd), "+v"(be), "+v"(kp), "+v"(rf), "+v"(nk1), "+v"(dd1), "+v"(be1), "+v"(kp1), "+v"(rf1), "+v"(vcur));
            vnxt = vcur;
            float sa;
            { f32x2 pa = S01 * (f32x2){nk.x, nk.y}; pa = S23 * (f32x2){nk.z, nk.w} + pa; sa = row16_sum(pa.x + pa.y); }
            float ykeep = 0.f;
#define SC_STEP(J, VSEL, LDV, VOFF, WAITN) do { \
                SC_LD5(nk2, dd2, be2, kp2, rf2, va8, ((J) + 2) * 1280); \
                if (LDV) asm volatile("ds_read_b128 %0, %1 offset:%2" : "=&v"(vnxt) : "v"(ra8), "i"((VOFF))); \
                asm volatile("s_waitcnt lgkmcnt(" #WAITN ")" : "+v"(nk1), "+v"(dd1), "+v"(be1), "+v"(kp1), "+v"(rf1)); \
                const float vv_ = (VSEL); \
                S01 = S01 * (f32x2){dd.x, dd.y} + (f32x2){be.x, be.y} * sa + (f32x2){kp.x, kp.y} * vv_; \
                S23 = S23 * (f32x2){dd.z, dd.w} + (f32x2){be.z, be.w} * sa + (f32x2){kp.z, kp.w} * vv_; \
                f32x2 pa_ = S01 * (f32x2){nk1.x, nk1.y}; pa_ = S23 * (f32x2){nk1.z, nk1.w} + pa_; \
                f32x2 py_ = S01 * (f32x2){rf.x, rf.y}; py_ = S23 * (f32x2){rf.z, rf.w} + py_; \
                float y_ = py_.x + py_.y, a2_ = pa_.x + pa_.y; \
                y_ = DPP_XADD(y_, 0xB1); a2_ = DPP_XADD(a2_, 0xB1); y_ = DPP_XADD(y_, 0x4E); a2_ = DPP_XADD(a2_, 0x4E); \
                y_ = DPP_XADD(y_, 0x141); a2_ = DPP_XADD(a2_, 0x141); y_ = DPP_XADD(y_, 0x140); a2_ = DPP_XADD(a2_, 0x140); \
                sa = a2_; \
                ykeep = __builtin_bit_cast(float, __builtin_amdgcn_update_dpp(__builtin_bit_cast(int, y_), __builtin_bit_cast(int, ykeep), 0x111, 0xF, 0xF, false));   \
                nk = nk1; dd = dd1; be = be1; kp = kp1; rf = rf1; nk1 = nk2; dd1 = dd2; be1 = be2; kp1 = kp2; rf1 = rf2; } while (0)
#pragma unroll 1
            for (int t8 = 0; t8 < TC; t8 += 8) {
                const unsigned va8 = va0 + (unsigned)t8 * 1280u, ra8 = ra0 + (unsigned)t8 * 4u;
                SC_STEP(0, vcur.x, 0, 0, 5); SC_STEP(1, vcur.y, 0, 0, 5); SC_STEP(2, vcur.z, 1, 16, 6); SC_STEP(3, vcur.w, 0, 0, 5);
                asm volatile("" : "+v"(vnxt)); vcur = vnxt;
                SC_STEP(4, vcur.x, 0, 0, 5); SC_STEP(5, vcur.y, 0, 0, 5); SC_STEP(6, vcur.z, 1, 32, 6); SC_STEP(7, vcur.w, 0, 0, 5);
                asm volatile("" : "+v"(vnxt)); vcur = vnxt;
                if (t8 & 8) yrow[(t8 + 7 - cc) * 32] = ykeep;
            }
            asm volatile("s_waitcnt lgkmcnt(0)" ::: "memory");
#undef SC_STEP
#undef SC_LD5
        }
        __syncthreads();
        {
            const int cn = T / TC;
            const LAS float* yb = (const LAS float*)(lds + ((cn - 1) & 1) * SC_BUF + SC_VEC + SC_V + pt * 128) + 2 * pj;
            const size_t m_ = rowbase + (size_t)(cn - 1) * TC + pt;
            *(unsigned*)(Y + m_ * D + h * 64 + half * 32 + 2 * pj) = cvt_pk_bf16(yb[0], yb[1]);
        }
        __syncthreads();
    }
#undef SCAN_LOAD
}
#endif
__device__ __forceinline__ void gn_phase(bf16_t* Y, const bf16_t* R, const bf16_t* Kb, const bf16_t* V, const bf16_t* Z, const bf16_t* WA, const float* k_a, const float* r_k, const float* gn_g, const float* gn_b, int G, int bid, int tid) {
    const int wave = __builtin_amdgcn_readfirstlane(tid >> 6), lane = tid & 63;
    const int gw = bid * NWAVES + wave, NGW = G * NWAVES;
    const int col = lane * 16;
    f32x4 kaq[4], rkq[4], ggq[4], gbq[4];
#pragma unroll
    for (int q = 0; q < 4; ++q) { kaq[q] = *(const f32x4*)(k_a + col + 4 * q); rkq[q] = *(const f32x4*)(r_k + col + 4 * q); ggq[q] = *(const f32x4*)(gn_g + col + 4 * q); gbq[q] = *(const f32x4*)(gn_b + col + 4 * q); }
    u32x4 ry_[2], rr_[2], rk_[2], rv_[2], rz_[2], ra_[2];
#define GN_LOAD(mm) do { const size_t off_ = (size_t)(mm) * D + col; _Pragma("unroll") for (int j = 0; j < 2; ++j) { ry_[j] = *(const u32x4*)(Y + off_ + 8 * j); rr_[j] = *(const u32x4*)(R + off_ + 8 * j); \
        rk_[j] = *(const u32x4*)(Kb + off_ + 8 * j); rv_[j] = *(const u32x4*)(V + off_ + 8 * j); rz_[j] = *(const u32x4*)(Z + off_ + 8 * j); ra_[j] = *(const u32x4*)(WA + (size_t)(mm) * 2048 + 1024 + col + 8 * j); } } while (0)
    if (gw < M) GN_LOAD(gw);
    for (int m = gw; m < M; m += NGW) {
        const size_t off = (size_t)m * D + col;
        f32x4 y[4], r[4], k[4], v[4], z[4], aa[4];
#pragma unroll
        for (int j = 0; j < 2; ++j) { unpack8(ry_[j], y[2 * j], y[2 * j + 1]); unpack8(rr_[j], r[2 * j], r[2 * j + 1]); unpack8(rk_[j], k[2 * j], k[2 * j + 1]);
            unpack8(rv_[j], v[2 * j], v[2 * j + 1]); unpack8(rz_[j], z[2 * j], z[2 * j + 1]); unpack8(ra_[j], aa[2 * j], aa[2 * j + 1]); }
        if (m + NGW < M) GN_LOAD(m + NGW);
        float s = 0.f, bs = 0.f;
#pragma unroll
        for (int q = 0; q < 4; ++q) {
            s += (y[q].x + y[q].y) + (y[q].z + y[q].w);
            const f32x4 kp = k[q] * (1.0f + (aa[q] - 1.0f) * kaq[q]);
            const f32x4 t = r[q] * kp * rkq[q];
            bs += (t.x + t.y) + (t.z + t.w);
        }
        s += __shfl_xor(s, 1); s += __shfl_xor(s, 2); bs += __shfl_xor(bs, 1); bs += __shfl_xor(bs, 2);
        const float mean = s * (1.0f / 64.0f);
        float q2 = 0.f;
#pragma unroll
        for (int q = 0; q < 4; ++q) { const f32x4 dlt = y[q] - mean; q2 += (dlt.x * dlt.x + dlt.y * dlt.y) + (dlt.z * dlt.z + dlt.w * dlt.w); }
        q2 += __shfl_xor(q2, 1); q2 += __shfl_xor(q2, 2);
        const float rstd = 1.0f / sqrtf(q2 * (1.0f / 64.0f) + 64e-5f);
        f32x4 o[4];
#pragma unroll
        for (int q = 0; q < 4; ++q) {
            const f32x4 yn = (y[q] - mean) * rstd * ggq[q] + gbq[q] + bs * v[q];
#pragma unroll
            for (int e = 0; e < 4; ++e) o[q][e] = yn[e] * z[q][e] * fsigmoid(z[q][e]);
        }
        *(u32x4*)(Y + off) = pack8(o[0], o[1]); *(u32x4*)(Y + off + 8) = pack8(o[2], o[3]);
    }
}
__device__ __forceinline__ void final_norm_phase(const bf16_t* H2, float* out, const float* g, int G, int bid, int tid) {
    const int wave = __builtin_amdgcn_readfirstlane(tid >> 6), lane = tid & 63;
    const int gw = bid * NWAVES + wave, NGW = G * NWAVES;
    f32x4 gv[4];
#pragma unroll
    for (int j = 0; j < 2; ++j) { gv[2 * j] = *(const f32x4*)(g + j * 512 + lane * 8); gv[2 * j + 1] = *(const f32x4*)(g + j * 512 + lane * 8 + 4); }
    u32x4 rh_[2];
    if (gw < M) { rh_[0] = *(const u32x4*)(H2 + (size_t)gw * D + lane * 8); rh_[1] = *(const u32x4*)(H2 + (size_t)gw * D + 512 + lane * 8); }
    for (int m = gw; m < M; m += NGW) {
        f32x4 v[4]; float s = 0.f;
        unpack8(rh_[0], v[0], v[1]); unpack8(rh_[1], v[2], v[3]);
        if (m + NGW < M) { rh_[0] = *(const u32x4*)(H2 + (size_t)(m + NGW) * D + lane * 8); rh_[1] = *(const u32x4*)(H2 + (size_t)(m + NGW) * D + 512 + lane * 8); }
#pragma unroll
        for (int q = 0; q < 4; ++q) s += (v[q].x * v[q].x + v[q].y * v[q].y) + (v[q].z * v[q].z + v[q].w * v[q].w);
        const float rstd = 1.0f / sqrtf(wave_sum(s) * (1.0f / D) + 1e-6f);
#pragma unroll
        for (int j = 0; j < 2; ++j) { float* o = out + (size_t)m * D + j * 512 + lane * 8; *(f32x4*)o = v[2 * j] * rstd * gv[2 * j]; *(f32x4*)(o + 4) = v[2 * j + 1] * rstd * gv[2 * j + 1]; }
    }
}
#ifndef MK_PER_PHASE
#define MK_PER_PHASE 0
#endif
constexpr int NPHASE = 15;
#ifndef MK_REP_PHASE
#define MK_REP_PHASE -1
#endif
#ifndef MK_REP_N
#define MK_REP_N 2
#endif
#define REPS(k) ((k) == MK_REP_PHASE ? MK_REP_N : 1)

__global__ void __launch_bounds__(NTHR, 2) hybrid_fwd(Args a) {
    extern __shared__ __attribute__((aligned(16))) unsigned char lds_raw[];
    LAS unsigned char* lds = (LAS unsigned char*)lds_raw;
    cg::grid_group grid = cg::this_grid();
    const int wave_s = __builtin_amdgcn_readfirstlane((int)threadIdx.x >> 6);
    const int bid = blockIdx.x, G = gridDim.x;
#define TID() int lane_v_; asm volatile("v_mbcnt_lo_u32_b32 %0, -1, 0\n\tv_mbcnt_hi_u32_b32 %0, -1, %0" : "=v"(lane_v_)); const int tid = wave_s * 64 + lane_v_
    { TID(); if (tid < 16) ((LAS unsigned*)(lds + LDS_BYTES - 64))[tid] = 0u; __syncthreads();
#if !MK_PER_PHASE
      kptr_t kpb = kargs(); (void)xcd_barrier_post((unsigned*)(kws(kpb) + WS_CTL), (volatile LAS unsigned*)(lds + LDS_BYTES - 64), tid);
#endif
    }
    int lo, hi; { kptr_t kp0 = kargs(); lo = *(const int __attribute__((address_space(4)))*)(kp0 + 8 * 26); hi = *(const int __attribute__((address_space(4)))*)(kp0 + 8 * 26 + 4); }
#ifndef PH_MASK
#define PH_MASK 0x7fff
#endif
#define IN(k) (((PH_MASK >> (k)) & 1) && lo <= (k) && (k) < hi)
#define SEAM(k) do { if (IN(k) && IN((k) + 1)) { if ((k) == 0) grid.sync(); else { TID(); kptr_t kpb = kargs(); XcdBarrier xb_; xb_.bar = (unsigned*)(kws(kpb) + WS_CTL); xb_.x = xb_xcc_id(); xb_.st = (volatile LAS unsigned*)(lds + LDS_BYTES - 64); xcd_barrier(xb_, tid); } } } while (0)
#define PTRS() kptr_t kp = kargs(); unsigned char* ws = kws(kp); (void)ws
#define S1 ((bf16_t*)(ws + WS_S1))
#define S2 ((bf16_t*)(ws + WS_S2))
#define S3 ((bf16_t*)(ws + WS_S3))
#define S4 ((bf16_t*)(ws + WS_S4))
#define QKVZ ((bf16_t*)(ws + WS_QKVZ))
#define XS0 ((bf16_t*)(ws + WS_XS0))
#define XS1 ((bf16_t*)(ws + WS_XS1))
#define WAb ((bf16_t*)(ws + WS_WA))
#define A2 ((bf16_t*)(ws + WS_A2))
#define Lb ((bf16_t*)(ws + WS_L))
#define Kr ((bf16_t*)kout(kp))
#define Vr ((bf16_t*)kout(kp) + (size_t)M * D)
#define WR ((const bf16_t*)(ws + WS_WR))

    if (IN(0)) for (int rep_ = 0; rep_ < REPS(0); ++rep_) { TID(); p0_prologue(lds, G, bid, tid); }
    SEAM(0);
    if (IN(1)) for (int rep_ = 0; rep_ < REPS(1); ++rep_) { TID(); PTRS();
        { pg8::Gemm g{S1, (const bf16_t*)(ws + WS_WQKVZ), M, ATT_IN, D}; pg8::StaticOrder S; S.init(M, ATT_IN, G, bid);
          pg8::EpiQKVZ E{QKVZ, (const float*)(ws + WS_BIAS), (const float*)(ws + WS_COS), (const float*)(ws + WS_SIN)};
          pg8::gemm_phase<pg8::EpiQKVZ, pg8::StaticOrder, true, true>(lds, g, S, E, tid); }
        __syncthreads();
        { pg8::Gemm g{(const bf16_t*)(ws + WS_PB0), (const bf16_t*)(ws + WS_WP0), M, D, PLE}; pg8::StaticOrder S; S.init(M, D, G, bid);
          pg8::EpiStore E{S2, D};
          pg8::gemm_phase<pg8::EpiStore, pg8::StaticOrder, true, true>(lds, g, S, E, tid); }
    }
    SEAM(1);
    if (IN(2)) for (int rep_ = 0; rep_ < REPS(2); ++rep_) { TID(); PTRS(); attn_phase(lds, QKVZ, kin(kp, I_ASINK), S1, G, bid, tid); }
    SEAM(2);
    if (IN(3)) for (int rep_ = 0; rep_ < REPS(3); ++rep_) { TID(); PTRS();
        pg8::Gemm g{S1, (const bf16_t*)(ws + WS_WO0), M, D, D}; pg8::StaticOrder S; S.init(M, D, G, bid);
        pg8::EpiRes<false> E{(const void*)kin(kp, I_X), S3};
        pg8::gemm_phase<pg8::EpiRes<false>, pg8::StaticOrder, true, true>(lds, g, S, E, tid);
    }
    SEAM(3);
    if (IN(4)) for (int rep_ = 0; rep_ < REPS(4); ++rep_) { TID(); PTRS();
        pg8::Gemm g{S3, (const bf16_t*)(ws + WS_WG0), M, D, D}; pg8::StaticOrder S; S.init(M, D, G, bid);
        pg8::EpiGate<false> E{S3, S2, (void*)S4};
        pg8::gemm_phase<pg8::EpiGate<false>, pg8::StaticOrder, true, true>(lds, g, S, E, tid);
    }
    SEAM(4);
    if (IN(5)) for (int rep_ = 0; rep_ < REPS(5); ++rep_) { TID(); PTRS(); lerp_phase<0>(S4, kin(kp, I_NORMG) + D, kin(kp, I_MU), S1, XS0, XS1, G, bid, tid); }
    SEAM(5);
    if (IN(6)) for (int rep_ = 0; rep_ < REPS(6); ++rep_) { TID(); PTRS();
        { pg8::Gemm g{XS0, WR, M, 2 * D, D, XS1, 4}; pg8::StaticOrder S; S.init(M, 2 * D, G, bid); pg8::EpiStore2 E{S3, Kr, 4, D};
          pg8::gemm_phase<pg8::EpiStore2, pg8::StaticOrder, true, true>(lds, g, S, E, tid); }
        __syncthreads();
        { pg8::Gemm g{S1, (const bf16_t*)(ws + WS_WL), M, 256, D}; pg8::StaticOrder S; S.init(M, 256, G, bid); pg8::EpiStore E{Lb, 256};
          pg8::gemm_phase<pg8::EpiStore, pg8::StaticOrder, true, true>(lds, g, S, E, tid); }
    }
    SEAM(6);
    if (IN(7)) for (int rep_ = 0; rep_ < REPS(7); ++rep_) { TID(); PTRS(); lerp_phase<1>(S4, kin(kp, I_NORMG) + D, kin(kp, I_MU), nullptr, XS0, XS1, G, bid, tid); lora_mid_phase(Lb, A2, G, bid, tid); }
    SEAM(7);
    if (IN(8)) for (int rep_ = 0; rep_ < REPS(8); ++rep_) { TID(); PTRS();
        { pg8::Gemm g{XS0, WR + (size_t)2 * D * D, M, 2 * D, D, XS1, 4}; pg8::StaticOrder S; S.init(M, 2 * D, G, bid); pg8::EpiStore2 E{Vr, S2, 4, D};
          pg8::gemm_phase<pg8::EpiStore2, pg8::StaticOrder, true, true>(lds, g, S, E, tid); }
    }
    SEAM(8);
    if (IN(9)) for (int rep_ = 0; rep_ < REPS(9); ++rep_) { TID(); PTRS();
        pg8::Gemm g{A2, (const bf16_t*)(ws + WS_W2), M, 2048, 128}; pg8::StaticOrder S; S.init(M, 2048, G, bid);
        pg8::EpiWA E{WAb, kin(kp, I_W0), kin(kp, I_A0)};
        pg8::gemm_phase<pg8::EpiWA, pg8::StaticOrder, true, true>(lds, g, S, E, tid);
    }
    SEAM(9);
    if (IN(10)) for (int rep_ = 0; rep_ < REPS(10); ++rep_) { TID(); PTRS(); scan_phase(lds, S3, Kr, Vr, WAb, kin(kp, I_KK), kin(kp, I_KA), S1, G, bid, tid); }
    SEAM(10);
    if (IN(11)) for (int rep_ = 0; rep_ < REPS(11); ++rep_) { TID(); PTRS(); gn_phase(S1, S3, Kr, Vr, S2, WAb, kin(kp, I_KA), kin(kp, I_RK), kin(kp, I_GNG), kin(kp, I_GNB), G, bid, tid); }
    SEAM(11);
    if (IN(12)) for (int rep_ = 0; rep_ < REPS(12); ++rep_) { TID(); PTRS();
        { pg8::Gemm g{S1, (const bf16_t*)(ws + WS_WO1), M, D, D}; pg8::StaticOrder S; S.init(M, D, G, bid); pg8::EpiRes<true> E{(const void*)S4, S3};
          pg8::gemm_phase<pg8::EpiRes<true>, pg8::StaticOrder, true, true>(lds, g, S, E, tid); }
        __syncthreads();
        { pg8::Gemm g{(const bf16_t*)(ws + WS_PB1), (const bf16_t*)(ws + WS_WP1), M, D, PLE}; pg8::StaticOrder S; S.init(M, D, G, bid); pg8::EpiStore E{S2, D};
          pg8::gemm_phase<pg8::EpiStore, pg8::StaticOrder, true, true>(lds, g, S, E, tid); }
    }
    SEAM(12);
    if (IN(13)) for (int rep_ = 0; rep_ < REPS(13); ++rep_) { TID(); PTRS();
        pg8::Gemm g{S3, (const bf16_t*)(ws + WS_WG1), M, D, D}; pg8::StaticOrder S; S.init(M, D, G, bid);
        pg8::EpiGate<false> E{S3, S2, (void*)S1};
        pg8::gemm_phase<pg8::EpiGate<false>, pg8::StaticOrder, true, true>(lds, g, S, E, tid);
    }
    SEAM(13);
    if (IN(14)) for (int rep_ = 0; rep_ < REPS(14); ++rep_) { TID(); PTRS(); final_norm_phase(S1, kout(kp), kin(kp, I_FNG), G, bid, tid); }
#undef IN
#undef SEAM
}

extern "C" void kernel_launch(void* const* d_in, const int* in_sizes, int n_in, void* d_out, int out_size, void* d_ws, size_t ws_size, hipStream_t stream) {
    static int grid = 0;
    if (grid == 0) {
        if (n_in != 24 || out_size != M * D || ws_size < WS_END) { fprintf(stderr, "kernel_launch: unexpected shapes (n_in %d, out %d, ws %zu)\n", n_in, out_size, ws_size); grid = -1; return; }
        int dev = 0, cus = 0, per_cu = 0;
        (void)hipGetDevice(&dev); (void)hipDeviceGetAttribute(&cus, hipDeviceAttributeMultiprocessorCount, dev);
        if (hipFuncSetAttribute((const void*)hybrid_fwd, hipFuncAttributeMaxDynamicSharedMemorySize, LDS_BYTES) != hipSuccess) { fprintf(stderr, "kernel_launch: hipFuncSetAttribute failed\n"); grid = -1; return; }
        if (hipOccupancyMaxActiveBlocksPerMultiprocessor(&per_cu, (const void*)hybrid_fwd, NTHR, LDS_BYTES) != hipSuccess || per_cu < 1) { fprintf(stderr, "kernel_launch: occupancy query reports %d\n", per_cu); per_cu = 1; }
        (void)hipGetLastError();
        grid = cus > 0 ? cus : 256;
    }
    if (grid < 0) return;
    Args a{};
    for (int i = 0; i < 24; ++i) a.in[i] = (const float*)d_in[i];
    a.out = (float*)d_out; a.ws = (unsigned char*)d_ws;
#if MK_PER_PHASE
    for (int ph = 0; ph < NPHASE; ++ph) { a.ph_lo = ph; a.ph_hi = ph + 1; hipLaunchKernelGGL(hybrid_fwd, dim3(grid), dim3(NTHR), LDS_BYTES, stream, a); }
#else
    a.ph_lo = 0; a.ph_hi = NPHASE;
    (void)hipMemsetAsync((unsigned char*)d_ws + WS_CTL, 0, 16384, stream);
    void* args[] = {&a};
    hipError_t e = hipLaunchCooperativeKernel((const void*)hybrid_fwd, dim3(grid), dim3(NTHR), args, LDS_BYTES, stream);
    if (e != hipSuccess) fprintf(stderr, "cooperative launch failed: %s (grid %d)\n", hipGetErrorString(e), grid);
#endif
}
```

```cpp
#include <hip/hip_runtime.h>
#include <hip/hip_cooperative_groups.h>
#include <cstdio>
#include <cstdint>
namespace cg = cooperative_groups;
namespace pg8 {
#define PG8_LAS __attribute__((address_space(3)))
typedef unsigned short bf16_t;
typedef short bf16x8 __attribute__((ext_vector_type(8)));
typedef float f32x4 __attribute__((ext_vector_type(4)));
typedef unsigned u32x4 __attribute__((ext_vector_type(4)));
constexpr int BM = 256, BK = 64, HALF = 128, HTB = HALF * BK * 2  , STAGE_BYTES = 8 * HTB, NXCD = 8, WGM = 4;

__host__ __device__ __forceinline__ int lds_byte(int r, int c) { const int st = (r >> 4) * 2 + (c >> 5), rr = r & 15, cc = c & 31, ob = rr * 64 + cc * 2; return st * 1024 + (ob ^ (((ob >> 9) & 1) << 5)); }
__host__ __device__ __forceinline__ void stage_rc(int b, int& R, int& C) { const int st = b / 1024, sb = b % 1024, swz = sb ^ (((sb >> 9) & 1) << 5); R = (st >> 1) * 16 + swz / 64; C = (st & 1) * 32 + (swz % 64) / 2; }
__host__ __device__ __forceinline__ int perm32(int rho) { const int n = rho >> 4, i = rho & 15; return 8 * (i >> 2) + 4 * n + (i & 3); }

struct Unit { int pm, pn; };
struct Gemm { const bf16_t* A; const bf16_t* Bt; int M, N, K; const bf16_t* A2 = nullptr; int nsplit = 1 << 30;
    __host__ __device__ __forceinline__ const bf16_t* asel(int pn) const { return pn < nsplit ? A : A2; } };

struct StaticOrder {
    int nM, nN, nwg, G, c;
    __host__ __device__ void init(int M, int N, int G_, int c_) { nM = M / BM; nN = N / BM; nwg = nM * nN; G = G_; c = c_; }
    __host__ __device__ bool next(int i, Unit& u) const {
        const long L = (long)i * G + c; if (L >= nwg) return false;
        int wgid = (int)L; { const int q = nwg / NXCD, r = nwg % NXCD, xcd = wgid % NXCD, off = wgid / NXCD; wgid = (xcd < r ? xcd * (q + 1) : r * (q + 1) + (xcd - r) * q) + off; }
        const int nig = WGM * nN, gid = wgid / nig, fm = gid * WGM, gsz = (nM - fm) < WGM ? (nM - fm) : WGM;
        u.pm = fm + ((wgid % nig) % gsz); u.pn = (wgid % nig) / gsz; return true;
    }
    __device__ __forceinline__ void a_ready(const Unit&) const {}
    __device__ __forceinline__ void done(const Unit&) const {}
};

__device__ __forceinline__ unsigned cvt_pk_bf16(float lo, float hi) { unsigned r; asm volatile("v_cvt_pk_bf16_f32 %0, %1, %2" : "=v"(r) : "v"(lo), "v"(hi)); return r; }
typedef float f32x2 __attribute__((ext_vector_type(2)));
__device__ __forceinline__ float bf2f(unsigned short b) { return __uint_as_float((unsigned)b << 16); }
__device__ __forceinline__ float bflo(unsigned w) { return __uint_as_float(w << 16); }
__device__ __forceinline__ float bfhi(unsigned w) { return __uint_as_float(w & 0xffff0000u); }
__device__ __forceinline__ float fsigmoid(float x) { return __builtin_amdgcn_rcpf(1.0f + __expf(-x)); }
__device__ __forceinline__ u32x4 pack8(const f32x4 a, const f32x4 b) { u32x4 w; w.x = cvt_pk_bf16(a[0], a[1]); w.y = cvt_pk_bf16(a[2], a[3]); w.z = cvt_pk_bf16(b[0], b[1]); w.w = cvt_pk_bf16(b[2], b[3]); return w; }
__device__ __forceinline__ void unpack8(const u32x4 w, f32x4& a, f32x4& b) { a = (f32x4){bflo(w.x), bfhi(w.x), bflo(w.y), bfhi(w.y)}; b = (f32x4){bflo(w.z), bfhi(w.z), bflo(w.w), bfhi(w.w)}; }

constexpr float QSCALE = 0.125f * 1.4426950408889634f;

struct EpiQKVZ {
    static constexpr bool PERM = true, AFTER_DRAIN = false;
    bf16_t* O; const float* bias; const float* cs; const float* sn;
    __device__ __forceinline__ void operator()(const f32x4 (&acc)[2][2][4][2], const Unit& u, int wr, int wc, int fr, int fq) const {
        const int row0 = u.pm * BM + wr * 64 + fr, col0 = u.pn * BM + wc * 32 + 8 * fq;
        const bool rope = u.pn < 5; const float sc = u.pn < 4 ? QSCALE : 1.0f;
        const int j4 = 4 * (4 * (wc & 1) + fq);
#pragma unroll
        for (int ai = 0; ai < 2; ++ai)
#pragma unroll
            for (int m = 0; m < 4; ++m) {
                const int row = row0 + ai * HALF + m * 16, pos = row & 4095;
                f32x4 c = (f32x4){1.f, 1.f, 1.f, 1.f}, s = (f32x4){0.f, 0.f, 0.f, 0.f};
                if (rope) { c = *(const f32x4*)(cs + pos * 32 + j4); s = *(const f32x4*)(sn + pos * 32 + j4); }
                bf16_t* rowp = O + (size_t)row * 2560 + col0;
#pragma unroll
                for (int bj = 0; bj < 2; ++bj) {
                    const f32x4 v0 = acc[ai][bj][m][0] + *(const f32x4*)(bias + col0 + bj * HALF), v1 = acc[ai][bj][m][1] + *(const f32x4*)(bias + col0 + bj * HALF + 4);
                    f32x4 o0 = v0, o1 = v1;
                    o0 = (v0 * c - v1 * s) * sc; o1 = (v1 * c + v0 * s) * sc;
                    *(u32x4*)(rowp + bj * HALF) = pack8(o0, o1);
                }
            }
    }
};
struct EpiStore {
    static constexpr bool PERM = true, AFTER_DRAIN = false;
    bf16_t* O; int ldc;
    __device__ __forceinline__ void operator()(const f32x4 (&acc)[2][2][4][2], const Unit& u, int wr, int wc, int fr, int fq) const {
        const int row0 = u.pm * BM + wr * 64 + fr, col0 = u.pn * BM + wc * 32 + 8 * fq;
#pragma unroll
        for (int ai = 0; ai < 2; ++ai)
#pragma unroll
            for (int m = 0; m < 4; ++m) { bf16_t* rowp = O + (size_t)(row0 + ai * HALF + m * 16) * ldc + col0;
#pragma unroll
                for (int bj = 0; bj < 2; ++bj) *(u32x4*)(rowp + bj * HALF) = pack8(acc[ai][bj][m][0], acc[ai][bj][m][1]); }
    }
};
struct EpiStore2 {
    static constexpr bool PERM = true, AFTER_DRAIN = false;
    bf16_t* O1; bf16_t* O2; int nsplit; int ldc;
    __device__ __forceinline__ void operator()(const f32x4 (&acc)[2][2][4][2], const Unit& u, int wr, int wc, int fr, int fq) const {
        const bool first = u.pn < nsplit; bf16_t* O = first ? O1 : O2;
        const int row0 = u.pm * BM + wr * 64 + fr, col0 = (first ? u.pn : u.pn - nsplit) * BM + wc * 32 + 8 * fq;
#pragma unroll
        for (int ai = 0; ai < 2; ++ai)
#pragma unroll
            for (int m = 0; m < 4; ++m) { bf16_t* rowp = O + (size_t)(row0 + ai * HALF + m * 16) * ldc + col0;
#pragma unroll
                for (int bj = 0; bj < 2; ++bj) *(u32x4*)(rowp + bj * HALF) = pack8(acc[ai][bj][m][0], acc[ai][bj][m][1]); }
    }
};
template <bool BF> struct EpiRes {
    static constexpr bool PERM = true, AFTER_DRAIN = false;
    const void* base; bf16_t* O;
    __device__ __forceinline__ void operator()(const f32x4 (&acc)[2][2][4][2], const Unit& u, int wr, int wc, int fr, int fq) const {
        const int row0 = u.pm * BM + wr * 64 + fr, col0 = u.pn * BM + wc * 32 + 8 * fq;
#pragma unroll
        for (int ai = 0; ai < 2; ++ai)
#pragma unroll
            for (int m = 0; m < 4; ++m) { const size_t off = (size_t)(row0 + ai * HALF + m * 16) * 1024 + col0;
#pragma unroll
                for (int bj = 0; bj < 2; ++bj) { f32x4 b0, b1;
                    if (BF) { unpack8(*(const u32x4*)((const bf16_t*)base + off + bj * HALF), b0, b1); }
                    else { b0 = *(const f32x4*)((const float*)base + off + bj * HALF); b1 = *(const f32x4*)((const float*)base + off + bj * HALF + 4); }
                    *(u32x4*)(O + off + bj * HALF) = pack8(b0 + acc[ai][bj][m][0], b1 + acc[ai][bj][m][1]); } }
    }
};
template <bool F32OUT> struct EpiGate {
    static constexpr bool PERM = true, AFTER_DRAIN = false;
    const bf16_t* hpre; const bf16_t* pp; void* O;
    __device__ __forceinline__ void operator()(const f32x4 (&acc)[2][2][4][2], const Unit& u, int wr, int wc, int fr, int fq) const {
        const int row0 = u.pm * BM + wr * 64 + fr, col0 = u.pn * BM + wc * 32 + 8 * fq;
#pragma unroll
        for (int ai = 0; ai < 2; ++ai)
#pragma unroll
            for (int m = 0; m < 4; ++m) { const size_t off = (size_t)(row0 + ai * HALF + m * 16) * 1024 + col0;
#pragma unroll
                for (int bj = 0; bj < 2; ++bj) { f32x4 h0, h1, p0, p1;
                    unpack8(*(const u32x4*)(hpre + off + bj * HALF), h0, h1); unpack8(*(const u32x4*)(pp + off + bj * HALF), p0, p1);
                    f32x4 g0, g1;
#pragma unroll
                    for (int e = 0; e < 4; ++e) { g0[e] = fsigmoid(acc[ai][bj][m][0][e]); g1[e] = fsigmoid(acc[ai][bj][m][1][e]); }
                    const f32x4 o0 = h0 + g0 * p0, o1 = h1 + g1 * p1;
                    if (F32OUT) { *(f32x4*)((float*)O + off + bj * HALF) = o0; *(f32x4*)((float*)O + off + bj * HALF + 4) = o1; }
                    else *(u32x4*)((bf16_t*)O + off + bj * HALF) = pack8(o0, o1); } }
    }
};
struct EpiWA {
    static constexpr bool PERM = true, AFTER_DRAIN = false;
    bf16_t* O; const float* w0; const float* a0;
    __device__ __forceinline__ void operator()(const f32x4 (&acc)[2][2][4][2], const Unit& u, int wr, int wc, int fr, int fq) const {
        const int row0 = u.pm * BM + wr * 64 + fr, col0 = u.pn * BM + wc * 32 + 8 * fq;
        const bool isw = u.pn < 4; const float* bvec = isw ? (w0 + col0) : (a0 + col0 - 1024); const float mul = isw ? -0.6065306597126334f : 1.0f;
#pragma unroll
        for (int ai = 0; ai < 2; ++ai)
#pragma unroll
            for (int m = 0; m < 4; ++m) { bf16_t* rowp = O + (size_t)(row0 + ai * HALF + m * 16) * 2048 + col0;
#pragma unroll
                for (int bj = 0; bj < 2; ++bj) { f32x4 o0, o1; const f32x4 b0 = *(const f32x4*)(bvec + bj * HALF), b1 = *(const f32x4*)(bvec + bj * HALF + 4);
#pragma unroll
                    for (int e = 0; e < 4; ++e) { o0[e] = mul * fsigmoid(acc[ai][bj][m][0][e] + b0[e]); o1[e] = mul * fsigmoid(acc[ai][bj][m][1][e] + b1[e]); }
                    *(u32x4*)(rowp + bj * HALF) = pack8(o0, o1); } }
    }
};
template <class Epi, class Sched, bool ALIGN_EPI = false, bool SP2 = false>
__device__ __forceinline__ void gemm_phase(PG8_LAS unsigned char* lds, const Gemm g, const Sched& S, const Epi& E, const int tid_in) {
    const int tid = tid_in, wid = __builtin_amdgcn_readfirstlane(tid >> 6), lane = tid & 63, wr = wid >> 2, wc = wid & 3, fr = lane & 15, fq = lane >> 4;
    const int K = g.K, nt = K / BK;
    unsigned voffA[2], voffB[2];
#pragma unroll
    for (int i = 0; i < 2; ++i) { int R, C; stage_rc(tid * 16 + i * 8192, R, C); const int Rb = Epi::PERM ? ((R & ~31) + perm32(R & 31)) : R;
        voffA[i] = (unsigned)(R * K + C) * 2u; voffB[i] = (unsigned)(Rb * K + C) * 2u; }
    const size_t kstep = (size_t)(BK * 2);
    const size_t hstep = (size_t)HALF * K * 2;
    const size_t tstep = 2 * hstep;
    const unsigned ldsw = (unsigned)wid * 1024u;
    const int aoff = lds_byte(wr * 64 + fr, fq * 8), boff = lds_byte(wc * 32 + fr, fq * 8);
#define PG8_SA(b, h) (((b) * 2 + (h)) * HTB)
#define PG8_SB(b, h) ((4 + (b) * 2 + (h)) * HTB)
#define PG8_STAGE(bufoff, gbase, voff) do { _Pragma("unroll") for (int _i = 0; _i < 2; ++_i) \
        __builtin_amdgcn_global_load_lds((const unsigned*)((const char*)(gbase) + (voff)[_i]), (PG8_LAS unsigned*)(lds + (bufoff) + ldsw + _i * 8192), 16, 0, 0); } while (0)
#define PG8_LDA(dst, b, h) do { _Pragma("unroll") for (int m = 0; m < 4; ++m) _Pragma("unroll") for (int k = 0; k < 2; ++k) dst[m][k] = *(const PG8_LAS bf16x8*)(lds + PG8_SA(b, h) + aoff + m * 2048 + k * 1024); } while (0)
#define PG8_LDB(dst, b, h) do { _Pragma("unroll") for (int n = 0; n < 2; ++n) _Pragma("unroll") for (int k = 0; k < 2; ++k) dst[n][k] = *(const PG8_LAS bf16x8*)(lds + PG8_SB(b, h) + boff + n * 2048 + k * 1024); } while (0)
#define PG8_MMA(ai, bj, At, Bt) do { __builtin_amdgcn_s_setprio(1); _Pragma("unroll") for (int m = 0; m < 4; ++m) _Pragma("unroll") for (int n = 0; n < 2; ++n) _Pragma("unroll") for (int k = 0; k < 2; ++k) \
        acc[ai][bj][m][n] = __builtin_amdgcn_mfma_f32_16x16x32_bf16(Bt[n][k], At[m][k], acc[ai][bj][m][n], 0, 0, 0); __builtin_amdgcn_s_setprio(0); } while (0)
#define PG8_WAIT_V(n) asm volatile("s_waitcnt vmcnt(" #n ")" ::: "memory")
#define PG8_WAIT_L(n) asm volatile("s_waitcnt lgkmcnt(" #n ")" ::: "memory")
#define PG8_BAR __builtin_amdgcn_s_barrier()
#define PG8_SCHED __builtin_amdgcn_sched_barrier(0)
    Unit cur, nxt; int ui = 0;
    if (!S.next(0, cur)) return;
    f32x4 acc[2][2][4][2];
#pragma unroll
    for (int a = 0; a < 2; ++a)
#pragma unroll
        for (int b = 0; b < 2; ++b)
#pragma unroll
            for (int m = 0; m < 4; ++m)
#pragma unroll
                for (int n = 0; n < 2; ++n) acc[a][b][m][n] = (f32x4){0.f, 0.f, 0.f, 0.f};
    bf16x8 At[4][2], B0[2][2], B1[2][2];
    const char* cA = (const char*)g.asel(cur.pn) + (size_t)cur.pm * tstep; const char* cB = (const char*)g.Bt + (size_t)cur.pn * tstep;
    S.a_ready(cur);
    if constexpr (SP2) {
        PG8_STAGE(PG8_SB(0, 0), cB, voffB); PG8_STAGE(PG8_SB(0, 1), cB + hstep, voffB); PG8_STAGE(PG8_SA(0, 0), cA, voffA); PG8_STAGE(PG8_SA(0, 1), cA + hstep, voffA);
        if (wr == 1) PG8_BAR;
        PG8_WAIT_V(2); PG8_BAR;
        PG8_STAGE(PG8_SB(1, 0), cB + kstep, voffB); PG8_STAGE(PG8_SA(1, 0), cA + kstep, voffA); PG8_STAGE(PG8_SB(1, 1), cB + hstep + kstep, voffB);
        PG8_WAIT_V(6); PG8_BAR;
    } else {
        PG8_STAGE(PG8_SB(0, 0), cB, voffB); PG8_STAGE(PG8_SA(0, 0), cA, voffA); PG8_STAGE(PG8_SB(0, 1), cB + hstep, voffB); PG8_STAGE(PG8_SA(0, 1), cA + hstep, voffA);
        if (wr == 1) PG8_BAR;
        PG8_WAIT_V(4); PG8_BAR;
        PG8_STAGE(PG8_SB(1, 0), cB + kstep, voffB); PG8_STAGE(PG8_SA(1, 0), cA + kstep, voffA); PG8_STAGE(PG8_SB(1, 1), cB + hstep + kstep, voffB);
        PG8_WAIT_V(6); PG8_BAR;
    }
    for (;;) {
        const bool has_next = S.next(ui + 1, nxt);
        const char* nA = has_next ? (const char*)g.asel(nxt.pn) + (size_t)nxt.pm * tstep : cA; const char* nB = has_next ? (const char*)g.Bt + (size_t)nxt.pn * tstep : cB;
        for (int t = 0; t < nt; t += 2) {
            const bool last = (t == nt - 2);
            const char* a1 = cA + (size_t)(t + 1) * kstep;
            const char* a2 = last ? nA : cA + (size_t)(t + 2) * kstep; const char* b2 = last ? nB : cB + (size_t)(t + 2) * kstep;
            const char* a3 = a2 + kstep; const char* b3 = b2 + kstep;
            if (last && has_next) S.a_ready(nxt);
            if constexpr (SP2) {
            PG8_LDB(B0, 0, 0); PG8_LDB(B1, 0, 1); PG8_SCHED; PG8_LDA(At, 0, 0); PG8_STAGE(PG8_SA(1, 1), a1 + hstep, voffA);
            PG8_WAIT_V(8); PG8_WAIT_L(0); PG8_BAR; PG8_MMA(0, 0, At, B0); PG8_MMA(0, 1, At, B1); PG8_BAR; PG8_SCHED;
            PG8_LDA(At, 0, 1); PG8_STAGE(PG8_SB(0, 0), b2, voffB); PG8_STAGE(PG8_SB(0, 1), b2 + hstep, voffB); PG8_STAGE(PG8_SA(0, 0), a2, voffA);
            PG8_WAIT_V(8); PG8_WAIT_L(0); PG8_BAR; PG8_MMA(1, 0, At, B0); PG8_MMA(1, 1, At, B1); PG8_BAR; PG8_SCHED;
            PG8_LDB(B0, 1, 0); PG8_LDB(B1, 1, 1); PG8_SCHED; PG8_LDA(At, 1, 0); PG8_STAGE(PG8_SA(0, 1), a2 + hstep, voffA);
            PG8_WAIT_V(8); PG8_WAIT_L(0); PG8_BAR; PG8_MMA(0, 0, At, B0); PG8_MMA(0, 1, At, B1); PG8_BAR; PG8_SCHED;
            PG8_LDA(At, 1, 1); PG8_STAGE(PG8_SB(1, 0), b3, voffB); PG8_STAGE(PG8_SB(1, 1), b3 + hstep, voffB); PG8_STAGE(PG8_SA(1, 0), a3, voffA);
            PG8_WAIT_V(8); PG8_WAIT_L(0); PG8_BAR; PG8_MMA(1, 0, At, B0); PG8_MMA(1, 1, At, B1); PG8_BAR; PG8_SCHED;
            } else {
            PG8_LDB(B0, 0, 0); PG8_SCHED; PG8_LDA(At, 0, 0); PG8_STAGE(PG8_SA(1, 1), a1 + hstep, voffA);
            PG8_WAIT_L(8); PG8_BAR; PG8_WAIT_L(0); PG8_MMA(0, 0, At, B0); PG8_BAR; PG8_SCHED;
            PG8_LDB(B1, 0, 1); PG8_STAGE(PG8_SB(0, 0), b2, voffB);
            PG8_BAR; PG8_WAIT_L(0); PG8_MMA(0, 1, At, B1); PG8_BAR;
            PG8_LDA(At, 0, 1); PG8_STAGE(PG8_SA(0, 0), a2, voffA);
            PG8_BAR; PG8_WAIT_L(0); PG8_MMA(1, 0, At, B0); PG8_BAR; PG8_SCHED;
            PG8_STAGE(PG8_SB(0, 1), b2 + hstep, voffB);
            PG8_WAIT_V(6); PG8_BAR; PG8_MMA(1, 1, At, B1); PG8_BAR;
            PG8_LDB(B0, 1, 0); PG8_SCHED; PG8_LDA(At, 1, 0); PG8_STAGE(PG8_SA(0, 1), a2 + hstep, voffA);
            PG8_WAIT_L(8); PG8_BAR; PG8_WAIT_L(0); PG8_MMA(0, 0, At, B0); PG8_BAR; PG8_SCHED;
            PG8_LDB(B1, 1, 1); PG8_STAGE(PG8_SB(1, 0), b3, voffB);
            PG8_BAR; PG8_WAIT_L(0); PG8_MMA(0, 1, At, B1); PG8_BAR;
            PG8_LDA(At, 1, 1); PG8_STAGE(PG8_SA(1, 0), a3, voffA);
            PG8_BAR; PG8_WAIT_L(0); PG8_MMA(1, 0, At, B0); PG8_BAR; PG8_SCHED;
            PG8_STAGE(PG8_SB(1, 1), b3 + hstep, voffB);
            PG8_WAIT_V(6); PG8_BAR; PG8_MMA(1, 1, At, B1); PG8_BAR;
            }
        }
        if constexpr (ALIGN_EPI) { if (wr == 0) PG8_BAR; }
        if constexpr (!Epi::AFTER_DRAIN) { E(acc, cur, wr, wc, fr, fq); S.done(cur); }
        if (!has_next) break;
#pragma unroll
        for (int a = 0; a < 2; ++a)
#pragma unroll
            for (int b = 0; b < 2; ++b)
#pragma unroll
                for (int m = 0; m < 4; ++m)
#pragma unroll
                    for (int n = 0; n < 2; ++n) acc[a][b][m][n] = (f32x4){0.f, 0.f, 0.f, 0.f};
        cur = nxt; cA = nA; cB = nB; ++ui;
        if constexpr (ALIGN_EPI) { if (wr == 1) PG8_BAR; }
    }
    PG8_WAIT_V(0);
    if constexpr (!ALIGN_EPI) { if (wr == 0) PG8_BAR; }
    PG8_BAR;
    if constexpr (Epi::AFTER_DRAIN) { E.fused(acc, cur, wr, wc, fr, fq, lds, wid, lane); S.done(cur); }
#undef PG8_SA
#undef PG8_SB
#undef PG8_STAGE
#undef PG8_LDA
#undef PG8_LDB
#undef PG8_MMA
#undef PG8_WAIT_V
#undef PG8_WAIT_L
#undef PG8_BAR
#undef PG8_SCHED
}
}
using pg8::bf16_t; using pg8::bf16x8; using pg8::f32x4; using pg8::u32x4; using pg8::cvt_pk_bf16; using pg8::bf2f; using pg8::bflo; using pg8::bfhi; using pg8::fsigmoid; using pg8::pack8; using pg8::unpack8;
#define LAS __attribute__((address_space(3)))
typedef unsigned u32x2 __attribute__((ext_vector_type(2)));
typedef float f32x2 __attribute__((ext_vector_type(2)));

constexpr int NB = 8, T = 4096, D = 1024, M = NB * T, PLE = 256, ATT_IN = 2560;
constexpr int NWAVES = 8, NTHR = 512;
constexpr int LDS_BYTES = 147456;

constexpr size_t MiB = 1u << 20;
constexpr size_t WS_WQKVZ = 0;
constexpr size_t WS_WO0   = 5 * MiB;
constexpr size_t WS_WG0   = 7 * MiB;
constexpr size_t WS_WG1   = 9 * MiB;
constexpr size_t WS_WO1   = 11 * MiB;
constexpr size_t WS_WR    = 13 * MiB;
constexpr size_t WS_WP0   = 21 * MiB;
constexpr size_t WS_WP1   = 21 * MiB + 512 * 1024;
constexpr size_t WS_WL    = 22 * MiB;
constexpr size_t WS_W2    = 22 * MiB + 512 * 1024;
constexpr size_t WS_COS   = 23 * MiB;
constexpr size_t WS_SIN   = 23 * MiB + 512 * 1024;
constexpr size_t WS_BIAS  = 24 * MiB;
constexpr size_t WS_CTL   = 25 * MiB;
constexpr size_t WS_PB0   = 32 * MiB;
constexpr size_t WS_L     = 32 * MiB;
constexpr size_t WS_PB1   = 48 * MiB;
constexpr size_t WS_S1    = 64 * MiB;
constexpr size_t WS_QKVZ  = 128 * MiB;
constexpr size_t WS_XS0   = 128 * MiB, WS_XS1 = 192 * MiB, WS_WA = 128 * MiB, WS_A2 = 256 * MiB;
constexpr size_t WS_S2    = 288 * MiB;
constexpr size_t WS_S3    = 352 * MiB;
constexpr size_t WS_S4    = 416 * MiB;
constexpr size_t WS_END   = 480 * MiB;

__device__ __forceinline__ float wave_sum(float v) {
#pragma unroll
    for (int o = 1; o < 64; o <<= 1) v += __shfl_xor(v, o);
    return v;
}
__device__ __forceinline__ float dpp_add(float x, const int ctrl_dummy) { return x; }
#define DPP_XADD(x, ctrl) ((x) + __builtin_bit_cast(float, __builtin_amdgcn_update_dpp(0, __builtin_bit_cast(int, (x)), (ctrl), 0xF, 0xF, true)))
__device__ __forceinline__ float row16_sum(float x) {
    x = DPP_XADD(x, 0xB1);
    x = DPP_XADD(x, 0x4E);
    x = DPP_XADD(x, 0x141);
    x = DPP_XADD(x, 0x140);
    return x;
}

__device__ __forceinline__ void grid_bar(unsigned* ctr, unsigned target, int tid) {
    asm volatile("s_waitcnt vmcnt(0)" ::: "memory");
    __syncthreads();
    if (tid == 0) {
        __builtin_amdgcn_fence(__ATOMIC_RELEASE, "agent");
        asm volatile("s_waitcnt vmcnt(0)" ::: "memory");
        __hip_atomic_fetch_add(ctr, 1u, __ATOMIC_RELAXED, __HIP_MEMORY_SCOPE_AGENT);
        while (__hip_atomic_load(ctr, __ATOMIC_RELAXED, __HIP_MEMORY_SCOPE_AGENT) < target) __builtin_amdgcn_s_sleep(2);
        __builtin_amdgcn_fence(__ATOMIC_ACQUIRE, "agent");
        asm volatile("s_waitcnt vmcnt(0)" ::: "memory");
    }
    __syncthreads();
}
#define XB_TMO      128
#define XB_XCNT(j)  (256  + 64 * (j))
#define XB_XSUB(j)  (1280 + 64 * (j))
#define XB_XGEN(j)  (2304 + 64 * (j))
#define XB_TOP      3328
#define XB_TOPGEN   3392
#define XCD_BAR_WORDS 3456
#define XB_SPIN_CAP (1u << 18)

__device__ __forceinline__ unsigned xb_ld(unsigned* p)              { return __hip_atomic_load(p, __ATOMIC_RELAXED, __HIP_MEMORY_SCOPE_AGENT); }
__device__ __forceinline__ unsigned xb_add(unsigned* p, unsigned v) { return __hip_atomic_fetch_add(p, v, __ATOMIC_RELAXED, __HIP_MEMORY_SCOPE_AGENT); }
__device__ __forceinline__ unsigned xb_xcc_id() { return (unsigned)__builtin_amdgcn_s_getreg((3 << 11) | 20) & 0xFu; }
#define XB_SPIN(cond, bar) do { unsigned _sp = 0; while (cond) { __builtin_amdgcn_s_sleep(1); \
    if ((++_sp & 255u) == 0u) { if (xb_ld(&(bar)[XB_TMO])) break; if (_sp > XB_SPIN_CAP) { atomicAdd(&(bar)[XB_TMO], 1u); break; } } } } while (0)

struct XcdBarrier {
    unsigned* bar; unsigned x;
    volatile LAS unsigned* st;
};

__device__ __forceinline__ XcdBarrier xcd_barrier_post(unsigned* bar, volatile LAS unsigned* st, const int tid_) {
    XcdBarrier b; b.bar = bar; b.x = xb_xcc_id(); b.st = st;
    if (tid_ == 0) (void)xb_add(&bar[XB_XCNT(b.x)], 1u);
    return b;
}
__device__ __forceinline__ void xcd_barrier_complete(unsigned* bar, unsigned x, unsigned& nloc, unsigned& nx) {
    const unsigned G = gridDim.x * gridDim.y * gridDim.z;
    unsigned sum, cnt, mine, sp = 0u;
    for (;;) {
        sum = 0u; cnt = 0u; mine = 0u;
#pragma unroll
        for (unsigned j = 0; j < 16; ++j) { const unsigned c = xb_ld(&bar[XB_XCNT(j)]); sum += c; cnt += (c > 0u) ? 1u : 0u; mine = (j == x) ? c : mine; }
        if (sum == G) break;
        __builtin_amdgcn_s_sleep(1);
        if ((++sp & 255u) == 0u) { if (xb_ld(&bar[XB_TMO])) break; if (sp > XB_SPIN_CAP) { atomicAdd(&bar[XB_TMO], 1u); break; } }
    }
    nloc = mine > 0u ? mine : 1u; nx = cnt > 0u ? cnt : 1u;
}

__device__ __forceinline__ void xcd_barrier(const XcdBarrier& b, const int tid_) {
    asm volatile("s_waitcnt vmcnt(0)" ::: "memory");
    __syncthreads();
    if (tid_ == 0) {
        unsigned* bar = b.bar;
        __builtin_amdgcn_s_waitcnt(0);
        unsigned nloc = b.st[0], nx = b.st[1];
        if (nloc == 0u) { xcd_barrier_complete(bar, b.x, nloc, nx); b.st[0] = nloc; b.st[1] = nx; }
        const unsigned old = xb_add(&bar[XB_XSUB(b.x)], 1u);
        const unsigned gen = old / nloc;
        if (old + 1u == (gen + 1u) * nloc) {
            __builtin_amdgcn_fence(__ATOMIC_RELEASE, "agent");
            asm volatile("s_waitcnt vmcnt(0)" ::: "memory");
            const unsigned og = xb_add(&bar[XB_TOP], 1u);
            const unsigned tg = og / nx;
            if (og + 1u == (tg + 1u) * nx) xb_add(&bar[XB_TOPGEN], 1u);
            else XB_SPIN(xb_ld(&bar[XB_TOPGEN]) == tg, bar);
            __builtin_amdgcn_fence(__ATOMIC_ACQUIRE, "agent");
            xb_add(&bar[XB_XGEN(b.x)], 1u);
            asm volatile("s_waitcnt vmcnt(0)" ::: "memory");
        } else {
            XB_SPIN(xb_ld(&bar[XB_XGEN(b.x)]) == gen, bar);
            __builtin_amdgcn_fence(__ATOMIC_ACQUIRE, "agent");
            asm volatile("s_waitcnt vmcnt(0)" ::: "memory");
        }
    }
    __syncthreads();
}

__device__ __forceinline__ int qk_perm_row(int n) {
    if (n >= 1280) return n;
    const int hd = n & ~63, d = n & 63, dd = d & 31;
    return hd + 8 * (dd >> 2) + 4 * (d >> 5) + (dd & 3);
}
template <int MODE>
__device__ __forceinline__ void transpose_item(const float* W, int K, int N, bf16_t* WT, int row_off, LAS float* scr, int item, int lane, const float* s) {
    const int nblk = N / 32, kb = item / nblk, nb = item % nblk, k0 = 64 * kb, n0 = 32 * nb;
#pragma unroll 8
    for (int i = 0; i < 32; ++i) { const int kk = 2 * i + (lane >> 5); float v = W[(size_t)(k0 + kk) * N + n0 + (lane & 31)];
        if (MODE == 2) v *= s[k0 + kk]; if (MODE == 3) v *= 1.0f - s[k0 + kk];
        scr[kk * 33 + (lane & 31)] = v; }
    asm volatile("s_waitcnt lgkmcnt(0)" ::: "memory");
    const int c = lane & 7;
#pragma unroll
    for (int j = 0; j < 4; ++j) { const int n = (lane >> 3) + 8 * j; const LAS float* sp = scr + (8 * c) * 33 + n;
        u32x4 o; o.x = cvt_pk_bf16(sp[0 * 33], sp[1 * 33]); o.y = cvt_pk_bf16(sp[2 * 33], sp[3 * 33]); o.z = cvt_pk_bf16(sp[4 * 33], sp[5 * 33]); o.w = cvt_pk_bf16(sp[6 * 33], sp[7 * 33]);
        const int dn = (MODE == 1) ? qk_perm_row(n0 + n) : (n0 + n);
        *(u32x4*)(WT + (size_t)(row_off + dn) * K + k0 + 8 * c) = o; }
    asm volatile("s_waitcnt lgkmcnt(0)" ::: "memory");
}

struct Args { const float* in[24]; float* out; unsigned char* ws; int ph_lo, ph_hi; };
typedef const __attribute__((address_space(4))) unsigned char* kptr_t;
__device__ __forceinline__ kptr_t kargs() { kptr_t p = (kptr_t)__builtin_amdgcn_kernarg_segment_ptr(); asm volatile("" : "+s"(p)); return p; }
#define GAS __attribute__((address_space(1)))
__device__ __forceinline__ const float* kin(kptr_t p, int i) { return (const float*)(const GAS float*)*(const unsigned long long __attribute__((address_space(4)))*)(p + 8 * i); }
__device__ __forceinline__ float* kout(kptr_t p) { return (float*)(GAS float*)*(const unsigned long long __attribute__((address_space(4)))*)(p + 8 * 24); }
__device__ __forceinline__ unsigned char* kws(kptr_t p) { return (unsigned char*)(GAS unsigned char*)*(const unsigned long long __attribute__((address_space(4)))*)(p + 8 * 25); }

enum { I_X = 0, I_P, I_NORMG, I_AWIN, I_ABIN, I_ASINK, I_AWOUT, I_MU, I_RWIN, I_W0, I_W1, I_W2, I_A0, I_A1, I_A2, I_KK, I_KA, I_RK, I_GNG, I_GNB, I_RWOUT, I_PWP, I_PWG, I_FNG };
__device__ __forceinline__ void p0_prologue(LAS unsigned char* lds, int G, int bid, int tid) {
    kptr_t kp = kargs();
    const int wave = __builtin_amdgcn_readfirstlane(tid >> 6), lane = tid & 63;
    LAS float* scr = (LAS float*)(lds + wave * 16384);
    const int gw = bid * NWAVES + wave, NGW = G * NWAVES;
    unsigned char* ws = kws(kp);
    const float* mu = kin(kp, I_MU);
    constexpr int N1 = 1280, N2 = 512, N5 = 2048, N6 = 128, N7 = 32;
    constexpr int NITEMS = N1 + 4 * N2 + N5 + 2 * N6 + 4 * N7;
    for (int it = gw; it < NITEMS; it += NGW) {
        int r = it;
        if (r < N1) { transpose_item<1>(kin(kp, I_AWIN), 1024, 2560, (bf16_t*)(ws + WS_WQKVZ), 0, scr, r, lane, nullptr); continue; } r -= N1;
        if (r < N2) { transpose_item<0>(kin(kp, I_AWOUT), 1024, 1024, (bf16_t*)(ws + WS_WO0), 0, scr, r, lane, nullptr); continue; } r -= N2;
        if (r < N2) { transpose_item<0>(kin(kp, I_PWG), 1024, 1024, (bf16_t*)(ws + WS_WG0), 0, scr, r, lane, nullptr); continue; } r -= N2;
        if (r < N2) { transpose_item<0>(kin(kp, I_PWG) + 1024 * 1024, 1024, 1024, (bf16_t*)(ws + WS_WG1), 0, scr, r, lane, nullptr); continue; } r -= N2;
        if (r < N2) { transpose_item<0>(kin(kp, I_RWOUT), 1024, 1024, (bf16_t*)(ws + WS_WO1), 0, scr, r, lane, nullptr); continue; } r -= N2;
        if (r < N5) { transpose_item<0>(kin(kp, I_RWIN), 1024, 4096, (bf16_t*)(ws + WS_WR), 0, scr, r, lane, nullptr); continue; } r -= N5;
        if (r < N6) { transpose_item<0>(kin(kp, I_PWP), 256, 1024, (bf16_t*)(ws + WS_WP0), 0, scr, r, lane, nullptr); continue; } r -= N6;
        if (r < N6) { transpose_item<0>(kin(kp, I_PWP) + 256 * 1024, 256, 1024, (bf16_t*)(ws + WS_WP1), 0, scr, r, lane, nullptr); continue; } r -= N6;
        if (r < N7) { transpose_item<3>(kin(kp, I_W1), 1024, 64, (bf16_t*)(ws + WS_WL), 0, scr, r, lane, mu + 4 * 1024); continue; } r -= N7;
        if (r < N7) { transpose_item<2>(kin(kp, I_W1), 1024, 64, (bf16_t*)(ws + WS_WL), 64, scr, r, lane, mu + 4 * 1024); continue; } r -= N7;
        if (r < N7) { transpose_item<3>(kin(kp, I_A1), 1024, 64, (bf16_t*)(ws + WS_WL), 128, scr, r, lane, mu + 5 * 1024); continue; } r -= N7;
        transpose_item<2>(kin(kp, I_A1), 1024, 64, (bf16_t*)(ws + WS_WL), 192, scr, r, lane, mu + 5 * 1024);
    }
    {
        const float* g0 = kin(kp, I_NORMG); bf16_t* XN = (bf16_t*)(ws + WS_S1);
        f32x4 gv[4];
#pragma unroll
        for (int j = 0; j < 4; ++j) gv[j] = *((const f32x4*)g0 + lane + 64 * j);
        const float* xin = kin(kp, I_X);
        f32x4 nx[4];
        if (gw < M) {
#pragma unroll
            for (int j = 0; j < 4; ++j) nx[j] = *((const f32x4*)(xin + (size_t)gw * D) + lane + 64 * j); }
        for (int m = gw; m < M; m += NGW) {
            f32x4 v[4]; float s = 0.f;
#pragma unroll
            for (int j = 0; j < 4; ++j) { v[j] = nx[j]; s += (v[j].x * v[j].x + v[j].y * v[j].y) + (v[j].z * v[j].z + v[j].w * v[j].w); }
            if (m + NGW < M) {
#pragma unroll
                for (int j = 0; j < 4; ++j) nx[j] = *((const f32x4*)(xin + (size_t)(m + NGW) * D) + lane + 64 * j); }
            const float rstd = 1.0f / sqrtf(wave_sum(s) * (1.0f / D) + 1e-6f);
            u32x2* o8 = (u32x2*)(XN + (size_t)m * D) + lane;
#pragma unroll
            for (int j = 0; j < 4; ++j) { const f32x4 o = v[j] * rstd * gv[j]; u32x2 w; w.x = cvt_pk_bf16(o.x, o.y); w.y = cvt_pk_bf16(o.z, o.w); o8[64 * j] = w; }
        }
    }
    const int gt = bid * NTHR + tid, NGT = G * NTHR;
    {
        const f32x4* p4 = (const f32x4*)kin(kp, I_P); u32x4* o = (u32x4*)(ws + WS_PB0);
        for (int i = gt; i < 2 * M * PLE / 8; i += NGT) { const f32x4 x0 = p4[2 * i], x1 = p4[2 * i + 1]; o[i] = pack8(x0, x1); }
    }
    {
        float* cs = (float*)(ws + WS_COS); float* sn = (float*)(ws + WS_SIN);
        for (int i = gt; i < T * 32; i += NGT) {
            const int pos = i >> 5, f = i & 31;
            const float inv = (float)exp2(-(double)f * (13.287712379549449 / 32.0));
            const float ang = (float)pos * inv;
            double rev = (double)ang * 0.15915494309189535; rev -= floor(rev);
            sn[i] = __builtin_amdgcn_sinf((float)rev); cs[i] = __builtin_amdgcn_cosf((float)rev);
        }
    }
    {
        float* bp = (float*)(ws + WS_BIAS);
        for (int i = gt; i < ATT_IN; i += NGT) bp[qk_perm_row(i)] = kin(kp, I_ABIN)[i];
    }
    {
        bf16_t* W2T = (bf16_t*)(ws + WS_W2); const float* w2 = kin(kp, I_W2); const float* a2 = kin(kp, I_A2);
        for (int i = gt; i < 2048 * 128; i += NGT) {
            const int k = i >> 11, nn = i & 2047;
            float v;
            if (nn < 1024) v = (k < 64) ? w2[k * 1024 + nn] : 0.f; else v = (k >= 64) ? a2[(k - 64) * 1024 + (nn - 1024)] : 0.f;
            W2T[(size_t)nn * 128 + k] = (bf16_t)(cvt_pk_bf16(v, 0.f) & 0xffffu);
        }
    }
}

__device__ __forceinline__ void attn_phase(LAS unsigned char* lds, const bf16_t* QKVZ, const float* sinks, bf16_t* OG, int G, int bid, int tid) {
    const int wave = __builtin_amdgcn_readfirstlane(tid >> 6), lane = tid & 63, fr = lane & 15, fq = lane >> 4;
    constexpr int KP = 144, VP = 528;
    LAS unsigned char* Kl = lds; LAS unsigned char* Vt = lds + 256 * KP;
    u32x4 pkv[4], pvv[4];
#define ATT_LOAD(uu) do { const int kvh_ = (uu) & 3, n_ = ((uu) >> 2) & 31, b_ = (uu) >> 7; _Pragma("unroll") for (int i = 0; i < 4; ++i) { \
        const int c_ = tid + 512 * i, key_ = c_ >> 3, ch_ = c_ & 7, t_ = 128 * (n_ - 1) + key_; \
        pkv[i] = (u32x4){0u, 0u, 0u, 0u}; pvv[i] = (u32x4){0u, 0u, 0u, 0u}; \
        if (t_ >= 0) { const bf16_t* rp_ = QKVZ + (size_t)(b_ * T + t_) * ATT_IN + kvh_ * 64 + ch_ * 8; pkv[i] = *(const u32x4*)(rp_ + 1024); pvv[i] = *(const u32x4*)(rp_ + 1280); } } } while (0)
    if (bid < 1024) ATT_LOAD(bid);
    for (int unit = bid; unit < 1024; unit += G) {
        const int kvh = unit & 3, n = (unit >> 2) & 31, b = unit >> 7;
        __syncthreads();
#pragma unroll
        for (int i = 0; i < 4; ++i) {
            const int c = tid + 512 * i, key = c >> 3, ch = c & 7;
            const u32x4 kv = pkv[i], vv = pvv[i];
            *(LAS u32x4*)(Kl + key * KP + ch * 16) = kv;
            LAS unsigned short* vp = (LAS unsigned short*)(Vt + (ch * 8) * VP + ((key ^ (ch << 2)) * 2));
            vp[0 * (VP / 2)] = (unsigned short)(vv.x & 0xffffu); vp[1 * (VP / 2)] = (unsigned short)(vv.x >> 16);
            vp[2 * (VP / 2)] = (unsigned short)(vv.y & 0xffffu); vp[3 * (VP / 2)] = (unsigned short)(vv.y >> 16);
            vp[4 * (VP / 2)] = (unsigned short)(vv.z & 0xffffu); vp[5 * (VP / 2)] = (unsigned short)(vv.z >> 16);
            vp[6 * (VP / 2)] = (unsigned short)(vv.w & 0xffffu); vp[7 * (VP / 2)] = (unsigned short)(vv.w >> 16);
        }
        if (unit + G < 1024) ATT_LOAD(unit + G);
        __syncthreads();
        const int g = wave >> 1, qh = wave & 1, h = kvh * 4 + g;
        const float sink2 = sinks[h] * 1.4426950408889634f;
        for (int mt = 0; mt < 4; ++mt) {
            const int qo0 = qh * 64 + mt * 16;
            const size_t row = (size_t)(b * T + n * 128 + qo0 + fr);
            const bf16_t* qp = QKVZ + row * ATT_IN + h * 64 + fq * 8;
            const bf16x8 q0 = *(const bf16x8*)qp, q1 = *(const bf16x8*)(qp + 32);
            const int kt0 = (qh * 4 + mt) < 6 ? (qh * 4 + mt) : 6;
            f32x4 s[10];
#pragma unroll
            for (int kt = 0; kt < 10; ++kt) {
                const LAS unsigned char* kp = Kl + ((kt0 + kt) * 16 + fr) * KP + fq * 16;
                const bf16x8 k0 = *(const LAS bf16x8*)kp, k1 = *(const LAS bf16x8*)(kp + 64);
                f32x4 acc = (f32x4){0.f, 0.f, 0.f, 0.f};
                acc = __builtin_amdgcn_mfma_f32_16x16x32_bf16(k0, q0, acc, 0, 0, 0);
                acc = __builtin_amdgcn_mfma_f32_16x16x32_bf16(k1, q1, acc, 0, 0, 0);
                s[kt] = acc;
            }
            const int qi = 128 + qo0 + fr;
            float mx = sink2;
#pragma unroll
            for (int kt = 0; kt < 10; ++kt)
#pragma unroll
                for (int r = 0; r < 4; ++r) { const int si = (kt0 + kt) * 16 + 4 * fq + r, df = qi - si; const bool ok = (df >= 0) && (df < 128) && (n > 0 || si >= 128);
                    const float v = ok ? s[kt][r] : -1e30f; s[kt][r] = v; mx = fmaxf(mx, v); }
            mx = fmaxf(mx, __shfl_xor(mx, 16)); mx = fmaxf(mx, __shfl_xor(mx, 32));
            float sum = 0.f;
#pragma unroll
            for (int kt = 0; kt < 10; ++kt)
#pragma unroll
                for (int r = 0; r < 4; ++r) { const float p = __builtin_amdgcn_exp2f(s[kt][r] - mx); s[kt][r] = p; sum += p; }
            sum += __shfl_xor(sum, 16); sum += __shfl_xor(sum, 32);
            sum += __builtin_amdgcn_exp2f(sink2 - mx);
            const float inv = 1.0f / sum;
            f32x4 o[4];
#pragma unroll
            for (int dt = 0; dt < 4; ++dt) o[dt] = (f32x4){0.f, 0.f, 0.f, 0.f};
#pragma unroll
            for (int kk = 0; kk < 5; ++kk) {
                const u32x4 pw = pack8(s[2 * kk], s[2 * kk + 1]);
                const bf16x8 pf = __builtin_bit_cast(bf16x8, pw);
#pragma unroll
                for (int dt = 0; dt < 4; ++dt) {
                    const int d = dt * 16 + fr, sw = ((d >> 3) & 7) << 2, keyA = 16 * (kt0 + 2 * kk) + 4 * fq, keyB = keyA + 16;
                    const u32x2 va = *(const LAS u32x2*)(Vt + d * VP + ((keyA ^ sw) * 2)), vb = *(const LAS u32x2*)(Vt + d * VP + ((keyB ^ sw) * 2));
                    const u32x4 vw = (u32x4){va.x, va.y, vb.x, vb.y};
                    o[dt] = __builtin_amdgcn_mfma_f32_16x16x32_bf16(__builtin_bit_cast(bf16x8, vw), pf, o[dt], 0, 0, 0);
                }
            }
            const bf16_t* zp = QKVZ + row * ATT_IN + 1536 + h * 64 + 4 * fq;
            bf16_t* op = OG + row * D + h * 64 + 4 * fq;
#pragma unroll
            for (int dt = 0; dt < 4; ++dt) {
                const u32x2 zw = *(const u32x2*)(zp + dt * 16);
                const float z0 = bflo(zw.x), z1 = bfhi(zw.x), z2 = bflo(zw.y), z3 = bfhi(zw.y);
                const float r0 = o[dt][0] * inv * z0 * fsigmoid(z0), r1 = o[dt][1] * inv * z1 * fsigmoid(z1), r2 = o[dt][2] * inv * z2 * fsigmoid(z2), r3 = o[dt][3] * inv * z3 * fsigmoid(z3);
                u32x2 w; w.x = cvt_pk_bf16(r0, r1); w.y = cvt_pk_bf16(r2, r3);
                *(u32x2*)(op + dt * 16) = w;
            }
        }
    }
}
template <int ROUND>
__device__ __forceinline__ void lerp_phase(const bf16_t* H1, const float* g1, const float* mu, bf16_t* HN, bf16_t* XS0, bf16_t* XS1, int G, int bid, int tid) {
    const int wave = __builtin_amdgcn_readfirstlane(tid >> 6), lane = tid & 63;
    const int gw = bid * NWAVES + wave, NGW = G * NWAVES;
    const float* mu0 = mu + (ROUND == 0 ? 0 : 2) * 1024; const float* mu1 = mu0 + 1024;
    f32x4 gq[4], m0q[4], m1q[4];
#pragma unroll
    for (int q = 0; q < 4; ++q) { const int col = (q >> 1) * 512 + lane * 8 + 4 * (q & 1); gq[q] = *(const f32x4*)(g1 + col); m0q[q] = *(const f32x4*)(mu0 + col); m1q[q] = *(const f32x4*)(mu1 + col); }
    u32x4 rc_[2], rp_[2];
#define LERP_LOAD(mm) do { const bool hp_ = ((mm) & (T - 1)) != 0; _Pragma("unroll") for (int j = 0; j < 2; ++j) { const size_t off_ = (size_t)(mm) * D + j * 512 + lane * 8; \
        rc_[j] = *(const u32x4*)(H1 + off_); rp_[j] = hp_ ? *(const u32x4*)(H1 + off_ - D) : (u32x4){0u, 0u, 0u, 0u}; } } while (0)
    if (gw < M) LERP_LOAD(gw);
    for (int m = gw; m < M; m += NGW) {
        f32x4 c[4], p[4];
        float sc = 0.f, sp = 0.f;
#pragma unroll
        for (int j = 0; j < 2; ++j) { unpack8(rc_[j], c[2 * j], c[2 * j + 1]); unpack8(rp_[j], p[2 * j], p[2 * j + 1]); }
        if (m + NGW < M) LERP_LOAD(m + NGW);
#pragma unroll
        for (int q = 0; q < 4; ++q) { sc += (c[q].x * c[q].x + c[q].y * c[q].y) + (c[q].z * c[q].z + c[q].w * c[q].w); sp += (p[q].x * p[q].x + p[q].y * p[q].y) + (p[q].z * p[q].z + p[q].w * p[q].w); }
        const float rc = 1.0f / sqrtf(wave_sum(sc) * (1.0f / D) + 1e-6f), rp = 1.0f / sqrtf(wave_sum(sp) * (1.0f / D) + 1e-6f);
#pragma unroll
        for (int j = 0; j < 2; ++j) {
            const int col = j * 512 + lane * 8; const size_t off = (size_t)m * D + col;
            f32x4 hn[2], xx[2], o0[2], o1[2];
#pragma unroll
            for (int e = 0; e < 2; ++e) {
                const f32x4 gv = gq[2 * j + e];
                hn[e] = c[2 * j + e] * rc * gv; xx[e] = p[2 * j + e] * rp * gv - hn[e];
                o0[e] = hn[e] + xx[e] * m0q[2 * j + e];
                o1[e] = hn[e] + xx[e] * m1q[2 * j + e];
            }
            if (ROUND == 0) *(u32x4*)(HN + off) = pack8(hn[0], hn[1]);
            *(u32x4*)(XS0 + off) = pack8(o0[0], o0[1]);
            *(u32x4*)(XS1 + off) = pack8(o1[0], o1[1]);
        }
    }
}
__device__ __forceinline__ void lora_mid_phase(const bf16_t* L, bf16_t* A2, int G, int bid, int tid) {
    const int gt = bid * NTHR + tid, NGT = G * NTHR;
    for (int i = gt; i < M * 16; i += NGT) {
        const int m = i >> 4, ch = i & 15, isA = ch >> 3, c8 = (ch & 7) * 8;
        const bool hasprev = (m & (T - 1)) != 0;
        f32x4 u0, u1, v0 = (f32x4){0.f, 0.f, 0.f, 0.f}, v1 = v0;
        unpack8(*(const u32x4*)(L + (size_t)m * 256 + isA * 128 + c8), u0, u1);
        if (hasprev) unpack8(*(const u32x4*)(L + (size_t)(m - 1) * 256 + isA * 128 + 64 + c8), v0, v1);
        u0 += v0; u1 += v1;
        if (!isA) {
#pragma unroll
            for (int e = 0; e < 4; ++e) { u0[e] = tanhf(u0[e]); u1[e] = tanhf(u1[e]); }
        }
        *(u32x4*)(A2 + (size_t)m * 128 + ch * 8) = pack8(u0, u1);
    }
}
#ifndef MK_SCAN_CHUNKED
#define MK_SCAN_CHUNKED 1
#endif
#if MK_SCAN_CHUNKED
typedef __bf16 ck_bf16x2_t __attribute__((ext_vector_type(2)));
__device__ __forceinline__ unsigned ck_cvt(float lo, float hi) { const f32x2 v = {lo, hi}; return __builtin_bit_cast(unsigned, __builtin_convertvector(v, ck_bf16x2_t)); }
constexpr int CK_RP = 144;
constexpr int CK_TP = 40;
constexpr int CK_ABAR = 0, CK_RBAR = 2304, CK_BTIL = 4608, CK_KTIL = 6912;
constexpr int CK_BT_T = 9216, CK_KT_T = 11776;
constexpr int CK_VT = 14336;
constexpr int CK_GAM = 15616;
constexpr int CK_BUF = 15872;
constexpr int CK_LD = 2 * CK_BUF;
constexpr int CK_PRIV = CK_LD + 2 * 4096;
constexpr int CK_PRIV_SZ = 2560;
__device__ __forceinline__ bf16x8 ck_ld2(const LAS unsigned char* p, int off2) {
    const u32x2 a = *(const LAS u32x2*)p, b = *(const LAS u32x2*)(p + off2); return __builtin_bit_cast(bf16x8, (u32x4){a.x, a.y, b.x, b.y}); }
__device__ __forceinline__ bf16x8 ck_ld1(const LAS unsigned char* p) {
    const u32x2 a = *(const LAS u32x2*)p; return __builtin_bit_cast(bf16x8, (u32x4){a.x, a.y, 0u, 0u}); }
__device__ __forceinline__ bf16x8 ck_pk4(const f32x4 x) { return __builtin_bit_cast(bf16x8, (u32x4){ck_cvt(x[0], x[1]), ck_cvt(x[2], x[3]), 0u, 0u}); }
#define CK_MFMA(a, b, c) __builtin_amdgcn_mfma_f32_16x16x32_bf16((a), (b), (c), 0, 0, 0)

constexpr int CK_STG = CK_PRIV + 2 * CK_PRIV_SZ;
constexpr int CK_STG_SZ = 4 * 4096 + 1024;
__device__ __forceinline__ void scan_phase(LAS unsigned char* lds, const bf16_t* R, const bf16_t* Kb, const bf16_t* V, const bf16_t* WA, const float* k_k, const float* k_a, bf16_t* Y, int G, int bid, int tid) {
    const int wave = __builtin_amdgcn_readfirstlane(tid >> 6), lane = tid & 63, c = lane & 15, g = lane >> 4;
    const int wq = (wave & 1) + ((wave >> 2) << 1);
    const int pid = wq * 64 + lane, pt = (pid >> 4) & 15, pj = pid & 15;
    const int pid1 = tid - 256, pta = (pid1 >> 4) & 7, ptb = pta + 8;
    const bool producer = (wave == 2) || (wave == 3) || (wave >= 6), producer1 = (wave == 4) || (wave == 5), consumer = wave < 2;
    constexpr int NCH = T / 16;
    for (int unit = bid; unit < 256; unit += G) {
        const int b = unit >> 5, h = (unit >> 1) & 15, half = unit & 1;
        const size_t rowbase = (size_t)b * T;
        f32x4 kkw = (f32x4){0.f, 0.f, 0.f, 0.f}, kaw = kkw;
        if (producer1) { kkw = *(const f32x4*)(k_k + h * 64 + 4 * pj); kaw = *(const f32x4*)(k_a + h * 64 + 4 * pj); }
        u32x2 rkA = (u32x2){0u, 0u}, rrA = rkA, raA = rkA, rlA = rkA, rkB = rkA, rrB = rkA, raB = rkA, rlB = rkA; unsigned rvA = 0u, rvB = 0u;
#define CK_LOAD(X, ptx, cn) do { const size_t m_ = rowbase + (size_t)(cn) * 16 + (ptx); \
            rk##X = *(const u32x2*)(Kb + m_ * D + h * 64 + 4 * pj); rr##X = *(const u32x2*)(R + m_ * D + h * 64 + 4 * pj); \
            rl##X = *(const u32x2*)(WA + m_ * 2048 + h * 64 + 4 * pj); ra##X = *(const u32x2*)(WA + m_ * 2048 + 1024 + h * 64 + 4 * pj); \
            rv##X = *(const unsigned*)(V + m_ * D + h * 64 + half * 32 + 2 * pj); } while (0)
#define CK_P1(X, ptx, cn) do { \
            const f32x4 kf_ = (f32x4){bflo(rk##X.x), bfhi(rk##X.x), bflo(rk##X.y), bfhi(rk##X.y)}, af_ = (f32x4){bflo(ra##X.x), bfhi(ra##X.x), bflo(ra##X.y), bfhi(ra##X.y)}; \
            const f32x4 lf_ = (f32x4){bflo(rl##X.x), bfhi(rl##X.x), bflo(rl##X.y), bfhi(rl##X.y)}, rf_ = (f32x4){bflo(rr##X.x), bfhi(rr##X.x), bflo(rr##X.y), bfhi(rr##X.y)}; \
            const f32x4 kv_ = kf_ * kkw; \
            float ss_ = (kv_.x * kv_.x + kv_.y * kv_.y) + (kv_.z * kv_.z + kv_.w * kv_.w); \
            ss_ = row16_sum(ss_); \
            const float invn_ = (ss_ > 1e-24f) ? __builtin_amdgcn_rsqf(ss_) : 1e12f;        \
            const f32x4 kk_ = kv_ * invn_; \
            LAS unsigned char* st_ = lds + CK_STG + ((cn) & 1) * CK_STG_SZ + ((ptx) * 64 + 4 * pj) * 4; \
            *(LAS f32x4*)(st_) = -kk_; *(LAS f32x4*)(st_ + 4096) = kk_ * af_; *(LAS f32x4*)(st_ + 8192) = kf_ * (1.0f + (af_ - 1.0f) * kaw); *(LAS f32x4*)(st_ + 12288) = rf_; \
            *(LAS unsigned*)(lds + CK_STG + ((cn) & 1) * CK_STG_SZ + 16384 + ((ptx) * 16 + pj) * 4) = rv##X; \
            *(LAS f32x4*)(lds + CK_LD + ((cn) & 1) * 4096 + ((ptx) * 64 + 4 * pj) * 4) = lf_; } while (0)
        if (producer1) { CK_LOAD(A, pta, 0); CK_LOAD(B, ptb, 0); CK_P1(A, pta, 0); CK_P1(B, ptb, 0); CK_LOAD(A, pta, 1); CK_LOAD(B, ptb, 1); }
        f32x4 H[4];
#pragma unroll
        for (int kt = 0; kt < 4; ++kt) H[kt] = (f32x4){0.f, 0.f, 0.f, 0.f};
        __syncthreads();
        for (int it = 0; it <= NCH; ++it) {
            if (producer1 && it + 1 < NCH) { CK_P1(A, pta, it + 1); CK_P1(B, ptb, it + 1); if (it + 2 < NCH) { CK_LOAD(A, pta, it + 2); CK_LOAD(B, ptb, it + 2); } }
            if (producer && it < NCH) {
                LAS unsigned char* buf = lds + (it & 1) * CK_BUF;
                const LAS unsigned char* ldp = lds + CK_LD + (it & 1) * 4096 + 16 * pj;
                const LAS unsigned char* stp = lds + CK_STG + (it & 1) * CK_STG_SZ + (pt * 64 + 4 * pj) * 4;
                f32x4 nkk = *(const LAS f32x4*)(stp), be = *(const LAS f32x4*)(stp + 4096), kp = *(const LAS f32x4*)(stp + 8192), rf = *(const LAS f32x4*)(stp + 12288), lf = *(const LAS f32x4*)(ldp + pt * 256);
                unsigned vsave = *(const LAS unsigned*)(lds + CK_STG + (it & 1) * CK_STG_SZ + 16384 + (pt * 16 + pj) * 4);
                asm volatile("" : "+v"(nkk), "+v"(be), "+v"(kp), "+v"(rf), "+v"(lf), "+v"(vsave));
                f32x4 Gc = (f32x4){0.f, 0.f, 0.f, 0.f};
                const int w4 = 4 * wq;
#pragma unroll
                for (int s4 = 0; s4 < 16; s4 += 4) {
                    if (s4 <= w4) {
                        f32x4 x0 = *(const LAS f32x4*)(ldp + (s4 + 0) * 256), x1 = *(const LAS f32x4*)(ldp + (s4 + 1) * 256), x2 = *(const LAS f32x4*)(ldp + (s4 + 2) * 256), x3 = *(const LAS f32x4*)(ldp + (s4 + 3) * 256);
                        asm volatile("" : "+v"(x0), "+v"(x1), "+v"(x2), "+v"(x3));
                        if (s4 < w4) Gc += (x0 + x1) + (x2 + x3);
                        else { const f32x4 z4 = (f32x4){0.f, 0.f, 0.f, 0.f};
                            Gc += (s4 + 0 <= pt) ? x0 : z4; Gc += (s4 + 1 <= pt) ? x1 : z4; Gc += (s4 + 2 <= pt) ? x2 : z4; Gc += (s4 + 3 <= pt) ? x3 : z4; }
                    }
                }
                const f32x4 Gm = Gc - lf;
                f32x4 eA, eR, eN;
#pragma unroll
                for (int e = 0; e < 4; ++e) { eA[e] = __expf(Gm[e]); eR[e] = __expf(Gc[e]); eN[e] = __expf(-Gc[e]); }
                const f32x4 ab = nkk * eA, rb = rf * eR, bt = be * eN, kt_ = kp * eN;
                const unsigned ab0 = ck_cvt(ab.x, ab.y), ab1 = ck_cvt(ab.z, ab.w), rb0 = ck_cvt(rb.x, rb.y), rb1 = ck_cvt(rb.z, rb.w);
                const unsigned bt0 = ck_cvt(bt.x, bt.y), bt1 = ck_cvt(bt.z, bt.w), kt0 = ck_cvt(kt_.x, kt_.y), kt1 = ck_cvt(kt_.z, kt_.w);
                LAS unsigned char* rowp = buf + pt * CK_RP + 64 * (pj >> 3) + 16 * (pj & 3) + 8 * ((pj >> 2) & 1);
                *(LAS u32x2*)(rowp + CK_ABAR) = (u32x2){ab0, ab1}; *(LAS u32x2*)(rowp + CK_RBAR) = (u32x2){rb0, rb1};
                *(LAS u32x2*)(rowp + CK_BTIL) = (u32x2){bt0, bt1}; *(LAS u32x2*)(rowp + CK_KTIL) = (u32x2){kt0, kt1};
                constexpr int TS = CK_TP / 2;
                {
                    const int rrow = lane >> 4;
#define CK_T4(x0, x1, x2, x3) do { auto s0_ = __builtin_amdgcn_permlane32_swap(x0, x2, false, false); auto s1_ = __builtin_amdgcn_permlane32_swap(x1, x3, false, false); \
                        auto t0_ = __builtin_amdgcn_permlane16_swap(s0_[0], s1_[0], false, false); auto t1_ = __builtin_amdgcn_permlane16_swap(s0_[1], s1_[1], false, false); \
                        x0 = t0_[0]; x1 = t0_[1]; x2 = t1_[0]; x3 = t1_[1]; } while (0)
                    unsigned b0_ = __float_as_uint(bt.x), b1_ = __float_as_uint(bt.y), b2_ = __float_as_uint(bt.z), b3_ = __float_as_uint(bt.w);
                    unsigned k0_ = __float_as_uint(kt_.x), k1_ = __float_as_uint(kt_.y), k2_ = __float_as_uint(kt_.z), k3_ = __float_as_uint(kt_.w);
                    CK_T4(b0_, b1_, b2_, b3_); CK_T4(k0_, k1_, k2_, k3_);
#undef CK_T4
                    const int toff = (4 * pj + rrow) * CK_TP + 8 * wq;
                    *(LAS u32x2*)(buf + CK_BT_T + toff) = (u32x2){ck_cvt(__uint_as_float(b0_), __uint_as_float(b1_)), ck_cvt(__uint_as_float(b2_), __uint_as_float(b3_))};
                    *(LAS u32x2*)(buf + CK_KT_T + toff) = (u32x2){ck_cvt(__uint_as_float(k0_), __uint_as_float(k1_)), ck_cvt(__uint_as_float(k2_), __uint_as_float(k3_))};
                }
                LAS unsigned short* vT = (LAS unsigned short*)(buf + CK_VT + (2 * pj) * CK_TP + pt * 2);
                vT[0] = (unsigned short)(vsave & 0xffffu); vT[TS] = (unsigned short)(vsave >> 16);
                if (pt == 15) *(LAS f32x4*)(buf + CK_GAM + 16 * pj) = eR;
            }
            if (consumer && it > 0) {
                const int cn = it - 1;
                const LAS unsigned char* buf = lds + (cn & 1) * CK_BUF;
                LAS unsigned char* priv = lds + CK_PRIV + wave * CK_PRIV_SZ;
                LAS float* AabT = (LAS float*)priv; LAS float* Xch = (LAS float*)(priv + 1024); LAS unsigned char* UT = priv + 2048;
                f32x4 xab = (f32x4){0.f, 0.f, 0.f, 0.f}, xak = xab, xrb = xab, xrk = xab;
                bf16x8 pa[2], pr[2];
#pragma unroll
                for (int ks = 0; ks < 2; ++ks) {
                    const LAS unsigned char* rp = buf + c * CK_RP + 64 * ks + 16 * g;
                    pa[ks] = *(const LAS bf16x8*)(rp + CK_ABAR); pr[ks] = *(const LAS bf16x8*)(rp + CK_RBAR);
                    const bf16x8 pb = *(const LAS bf16x8*)(rp + CK_BTIL), pk = *(const LAS bf16x8*)(rp + CK_KTIL);
                    xab = CK_MFMA(pb, pa[ks], xab); xak = CK_MFMA(pk, pa[ks], xak); xrb = CK_MFMA(pb, pr[ks], xrb); xrk = CK_MFMA(pk, pr[ks], xrk);
                }
#pragma unroll
                for (int r = 0; r < 4; ++r) { const int s = 4 * g + r; if (!(s < c)) { xab[r] = 0.f; xak[r] = 0.f; } if (!(s <= c)) { xrb[r] = 0.f; xrk[r] = 0.f; } }
#pragma unroll
                for (int r = 0; r < 4; ++r) AabT[(4 * g + r) * 16 + c] = xab[r];
                const bf16x8 opak = ck_pk4(xak), oprb = ck_pk4(xrb), oprk = ck_pk4(xrk);
                bf16x8 oph[2];
#pragma unroll
                for (int ks = 0; ks < 2; ++ks) oph[ks] = __builtin_bit_cast(bf16x8, (u32x4){ck_cvt(H[2 * ks][0], H[2 * ks][1]), ck_cvt(H[2 * ks][2], H[2 * ks][3]), ck_cvt(H[2 * ks + 1][0], H[2 * ks + 1][1]), ck_cvt(H[2 * ks + 1][2], H[2 * ks + 1][3])});
                const bf16x8 opv = ck_ld1(buf + CK_VT + (wave * 16 + c) * CK_TP + g * 8);
                f32x4 rhs = (f32x4){0.f, 0.f, 0.f, 0.f};
                rhs = CK_MFMA(pa[0], oph[0], rhs); rhs = CK_MFMA(pa[1], oph[1], rhs); rhs = CK_MFMA(opak, opv, rhs);
                float u[16];
#pragma unroll
                for (int r = 0; r < 4; ++r) {
                    const unsigned a_ = __float_as_uint(rhs[r]);
                    const auto h_ = __builtin_amdgcn_permlane32_swap(a_, a_, false, false);
                    const auto lo_ = __builtin_amdgcn_permlane16_swap(h_[0], h_[0], false, false);
                    const auto hi_ = __builtin_amdgcn_permlane16_swap(h_[1], h_[1], false, false);
                    u[r] = __uint_as_float(lo_[0]); u[4 + r] = __uint_as_float(lo_[1]); u[8 + r] = __uint_as_float(hi_[0]); u[12 + r] = __uint_as_float(hi_[1]);
                }
                asm volatile("s_waitcnt lgkmcnt(0)" ::: "memory");
                f32x4 cw[15][4];
#define CK_COLLD(ss) do { _Pragma("unroll") for (int q_ = ((ss) + 1) / 4; q_ < 4; ++q_) cw[(ss)][q_] = *(const LAS f32x4*)(AabT + (ss) * 16 + 4 * q_); } while (0)
                CK_COLLD(0); CK_COLLD(1);
#pragma unroll
                for (int s = 0; s < 15; ++s) {
                    if (s + 2 < 15) CK_COLLD(s + 2);
                    __builtin_amdgcn_sched_barrier(0);
#pragma unroll
                    for (int t = s + 1; t < 16; ++t) u[t] += cw[s][t >> 2][t & 3] * u[s];
                }
#undef CK_COLLD
                bf16x8 opu;
                { const bool g1 = (g & 1) != 0, g2 = (g & 2) != 0;
                  const float a0 = g1 ? u[4] : u[0], a1 = g1 ? u[5] : u[1], a2 = g1 ? u[6] : u[2], a3 = g1 ? u[7] : u[3];
                  const float b0 = g1 ? u[12] : u[8], b1 = g1 ? u[13] : u[9], b2 = g1 ? u[14] : u[10], b3 = g1 ? u[15] : u[11];
                  opu = __builtin_bit_cast(bf16x8, (u32x4){ck_cvt(g2 ? b0 : a0, g2 ? b1 : a1), ck_cvt(g2 ? b2 : a2, g2 ? b3 : a3), 0u, 0u}); }
                f32x4 yy = (f32x4){0.f, 0.f, 0.f, 0.f};
                yy = CK_MFMA(pr[0], oph[0], yy); yy = CK_MFMA(pr[1], oph[1], yy); yy = CK_MFMA(oprb, opu, yy); yy = CK_MFMA(oprk, opv, yy);
                {
                    bf16_t* yp = Y + (rowbase + (size_t)cn * 16 + 4 * g) * D + h * 64 + half * 32 + wave * 16 + c;
#pragma unroll
                    for (int r = 0; r < 4; ++r) yp[(size_t)r * D] = (bf16_t)(ck_cvt(yy[r], 0.f) & 0xffffu);
                }
#pragma unroll
                for (int kt = 0; kt < 4; ++kt) {
                    const bf16x8 opb = ck_ld1(buf + CK_BT_T + (16 * kt + c) * CK_TP + g * 8), opk = ck_ld1(buf + CK_KT_T + (16 * kt + c) * CK_TP + g * 8);
                    f32x4 hh = H[kt];
                    hh = CK_MFMA(opb, opu, hh); hh = CK_MFMA(opk, opv, hh);
                    H[kt] = hh * *(const LAS f32x4*)(buf + CK_GAM + (16 * kt + 4 * g) * 4);
                }
            }
            __syncthreads();
        }
    }
#undef CK_LOAD
#undef CK_P1
}
#else
constexpr int TC = 32;
constexpr int SC_VEC = TC * 5 * 64 * 4;
constexpr int SC_VP = 36;
constexpr int SC_V = 32 * SC_VP * 4;
constexpr int SC_Y = TC * 32 * 4;
constexpr int SC_BUF = SC_VEC + SC_V + SC_Y;
__device__ __forceinline__ void scan_phase(LAS unsigned char* lds, const bf16_t* R, const bf16_t* Kb, const bf16_t* V, const bf16_t* WA, const float* k_k, const float* k_a, bf16_t* Y, int G, int bid, int tid) {
    const int wave = __builtin_amdgcn_readfirstlane(tid >> 6), lane = tid & 63, rg = lane >> 4, cc = lane & 15;
    const int pt = tid >> 4, pj = tid & 15;
    for (int unit = bid; unit < 256; unit += G) {
        const int b = unit >> 5, h = (unit >> 1) & 15, half = unit & 1;
        const size_t rowbase = (size_t)b * T;
        const f32x4 kkw = *(const f32x4*)(k_k + h * 64 + 4 * pj), kaw = *(const f32x4*)(k_a + h * 64 + 4 * pj);
        f32x2 S01 = (f32x2){0.f, 0.f}, S23 = (f32x2){0.f, 0.f};
        u32x2 rk, rr, ra, rl; unsigned rv;
#define SCAN_LOAD(cn) do { const size_t m_ = rowbase + (size_t)(cn) * TC + pt; \
            rk = *(const u32x2*)(Kb + m_ * D + h * 64 + 4 * pj); rr = *(const u32x2*)(R + m_ * D + h * 64 + 4 * pj); \
            rl = *(const u32x2*)(WA + m_ * 2048 + h * 64 + 4 * pj); ra = *(const u32x2*)(WA + m_ * 2048 + 1024 + h * 64 + 4 * pj); \
            rv = *(const unsigned*)(V + m_ * D + h * 64 + half * 32 + 2 * pj); } while (0)
        SCAN_LOAD(0);
        __syncthreads();
        for (int cn = 0; cn < T / TC; ++cn) {
            LAS unsigned char* buf = lds + (cn & 1) * SC_BUF;
            {
                const f32x4 kf = (f32x4){bflo(rk.x), bfhi(rk.x), bflo(rk.y), bfhi(rk.y)}, af = (f32x4){bflo(ra.x), bfhi(ra.x), bflo(ra.y), bfhi(ra.y)};
                const f32x4 lf = (f32x4){bflo(rl.x), bfhi(rl.x), bflo(rl.y), bfhi(rl.y)}, rf = (f32x4){bflo(rr.x), bfhi(rr.x), bflo(rr.y), bfhi(rr.y)};
                const f32x4 kv = kf * kkw;
                float ss = (kv.x * kv.x + kv.y * kv.y) + (kv.z * kv.z + kv.w * kv.w);
                ss = row16_sum(ss);
                const float invn = 1.0f / fmaxf(sqrtf(ss), 1e-12f);
                const f32x4 kk = kv * invn;
                const f32x4 kp = kf * (1.0f + (af - 1.0f) * kaw);
                f32x4 dd; dd.x = __expf(lf.x); dd.y = __expf(lf.y); dd.z = __expf(lf.z); dd.w = __expf(lf.w);
                LAS f32x4* vp = (LAS f32x4*)(buf + pt * 1280) + pj;
                vp[0] = -kk; vp[16] = dd; vp[32] = kk * af; vp[48] = kp; vp[64] = rf;
                LAS float* vv = (LAS float*)(buf + SC_VEC) + (2 * pj) * SC_VP + pt;
                vv[0] = bflo(rv); vv[SC_VP] = bfhi(rv);
            }
            if (cn + 1 < T / TC) SCAN_LOAD(cn + 1);
            __syncthreads();
            if (cn > 0) {
                const LAS float* yb = (const LAS float*)(lds + ((cn - 1) & 1) * SC_BUF + SC_VEC + SC_V + pt * 128) + 2 * pj;
                const size_t m_ = rowbase + (size_t)(cn - 1) * TC + pt;
                *(unsigned*)(Y + m_ * D + h * 64 + half * 32 + 2 * pj) = cvt_pk_bf16(yb[0], yb[1]);
            }
            const int rloc = wave * 4 + rg;
            LAS float* yrow = (LAS float*)(buf + SC_VEC + SC_V) + rloc;
            const unsigned va0 = (unsigned)(size_t)(buf + cc * 16), ra0 = (unsigned)(size_t)(buf + SC_VEC + rloc * SC_VP * 4);
#define SC_LD5(NK, DD, BE, KP, RF, AR, OFF) do { \
                asm volatile("ds_read_b128 %0, %1 offset:%2" : "=&v"(NK) : "v"(AR), "i"((OFF))); asm volatile("ds_read_b128 %0, %1 offset:%2" : "=&v"(DD) : "v"(AR), "i"((OFF) + 256)); \
                asm volatile("ds_read_b128 %0, %1 offset:%2" : "=&v"(BE) : "v"(AR), "i"((OFF) + 512)); asm volatile("ds_read_b128 %0, %1 offset:%2" : "=&v"(KP) : "v"(AR), "i"((OFF) + 768)); \
                asm volatile("ds_read_b128 %0, %1 offset:%2" : "=&v"(RF) : "v"(AR), "i"((OFF) + 1024)); } while (0)
            f32x4 nk, dd, be, kp, rf, nk1, dd1, be1, kp1, rf1, nk2, dd2, be2, kp2, rf2, vcur, vnxt;
            SC_LD5(nk, dd, be, kp, rf, va0, 0); SC_LD5(nk1, dd1, be1, kp1, rf1, va0, 1280);
            asm volatile("ds_read_b128 %0, %1" : "=&v"(vcur) : "v"(ra0));
            asm volatile("s_waitcnt lgkmcnt(0)" : "+v"(nk), "+v"(dd), "+v"(be), "+v"(kp), "+v"(rf), "+v"(nk1), "+v"(dd1), "+v"(be1), "+v"(kp1), "+v"(rf1), "+v"(vcur));
            vnxt = vcur;
            float sa;
            { f32x2 pa = S01 * (f32x2){nk.x, nk.y}; pa = S23 * (f32x2){nk.z, nk.w} + pa; sa = row16_sum(pa.x + pa.y); }
            float ykeep = 0.f;
#define SC_STEP(J, VSEL, LDV, VOFF, WAITN) do { \
                SC_LD5(nk2, dd2, be2, kp2, rf2, va8, ((J) + 2) * 1280); \
                if (LDV) asm volatile("ds_read_b128 %0, %1 offset:%2" : "=&v"(vnxt) : "v"(ra8), "i"((VOFF))); \
                asm volatile("s_waitcnt lgkmcnt(" #WAITN ")" : "+v"(nk1), "+v"(dd1), "+v"(be1), "+v"(kp1), "+v"(rf1)); \
                const float vv_ = (VSEL); \
                S01 = S01 * (f32x2){dd.x, dd.y} + (f32x2){be.x, be.y} * sa + (f32x2){kp.x, kp.y} * vv_; \
                S23 = S23 * (f32x2){dd.z, dd.w} + (f32x2){be.z, be.w} * sa + (f32x2){kp.z, kp.w} * vv_; \
                f32x2 pa_ = S01 * (f32x2){nk1.x, nk1.y}; pa_ = S23 * (f32x2){nk1.z, nk1.w} + pa_; \
                f32x2 py_ = S01 * (f32x2){rf.x, rf.y}; py_ = S23 * (f32x2){rf.z, rf.w} + py_; \
                float y_ = py_.x + py_.y, a2_ = pa_.x + pa_.y; \
                y_ = DPP_XADD(y_, 0xB1); a2_ = DPP_XADD(a2_, 0xB1); y_ = DPP_XADD(y_, 0x4E); a2_ = DPP_XADD(a2_, 0x4E); \
                y_ = DPP_XADD(y_, 0x141); a2_ = DPP_XADD(a2_, 0x141); y_ = DPP_XADD(y_, 0x140); a2_ = DPP_XADD(a2_, 0x140); \
                sa = a2_; \
                ykeep = __builtin_bit_cast(float, __builtin_amdgcn_update_dpp(__builtin_bit_cast(int, y_), __builtin_bit_cast(int, ykeep), 0x111, 0xF, 0xF, false));   \
                nk = nk1; dd = dd1; be = be1; kp = kp1; rf = rf1; nk1 = nk2; dd1 = dd2; be1 = be2; kp1 = kp2; rf1 = rf2; } while (0)
#pragma unroll 1
            for (int t8 = 0; t8 < TC; t8 += 8) {
                const unsigned va8 = va0 + (unsigned)t8 * 1280u, ra8 = ra0 + (unsigned)t8 * 4u;
                SC_STEP(0, vcur.x, 0, 0, 5); SC_STEP(1, vcur.y, 0, 0, 5); SC_STEP(2, vcur.z, 1, 16, 6); SC_STEP(3, vcur.w, 0, 0, 5);
                asm volatile("" : "+v"(vnxt)); vcur = vnxt;
                SC_STEP(4, vcur.x, 0, 0, 5); SC_STEP(5, vcur.y, 0, 0, 5); SC_STEP(6, vcur.z, 1, 32, 6); SC_STEP(7, vcur.w, 0, 0, 5);
                asm volatile("" : "+v"(vnxt)); vcur = vnxt;
                if (t8 & 8) yrow[(t8 + 7 - cc) * 32] = ykeep;
            }
            asm volatile("s_waitcnt lgkmcnt(0)" ::: "memory");
#undef SC_STEP
#undef SC_LD5
        }
        __syncthreads();
        {
            const int cn = T / TC;
            const LAS float* yb = (const LAS float*)(lds + ((cn - 1) & 1) * SC_BUF + SC_VEC + SC_V + pt * 128) + 2 * pj;
            const size_t m_ = rowbase + (size_t)(cn - 1) * TC + pt;
            *(unsigned*)(Y + m_ * D + h * 64 + half * 32 + 2 * pj) = cvt_pk_bf16(yb[0], yb[1]);
        }
        __syncthreads();
    }
#undef SCAN_LOAD
}
#endif
__device__ __forceinline__ void gn_phase(bf16_t* Y, const bf16_t* R, const bf16_t* Kb, const bf16_t* V, const bf16_t* Z, const bf16_t* WA, const float* k_a, const float* r_k, const float* gn_g, const float* gn_b, int G, int bid, int tid) {
    const int wave = __builtin_amdgcn_readfirstlane(tid >> 6), lane = tid & 63;
    const int gw = bid * NWAVES + wave, NGW = G * NWAVES;
    const int col = lane * 16;
    f32x4 kaq[4], rkq[4], ggq[4], gbq[4];
#pragma unroll
    for (int q = 0; q < 4; ++q) { kaq[q] = *(const f32x4*)(k_a + col + 4 * q); rkq[q] = *(const f32x4*)(r_k + col + 4 * q); ggq[q] = *(const f32x4*)(gn_g + col + 4 * q); gbq[q] = *(const f32x4*)(gn_b + col + 4 * q); }
    u32x4 ry_[2], rr_[2], rk_[2], rv_[2], rz_[2], ra_[2];
#define GN_LOAD(mm) do { const size_t off_ = (size_t)(mm) * D + col; _Pragma("unroll") for (int j = 0; j < 2; ++j) { ry_[j] = *(const u32x4*)(Y + off_ + 8 * j); rr_[j] = *(const u32x4*)(R + off_ + 8 * j); \
        rk_[j] = *(const u32x4*)(Kb + off_ + 8 * j); rv_[j] = *(const u32x4*)(V + off_ + 8 * j); rz_[j] = *(const u32x4*)(Z + off_ + 8 * j); ra_[j] = *(const u32x4*)(WA + (size_t)(mm) * 2048 + 1024 + col + 8 * j); } } while (0)
    if (gw < M) GN_LOAD(gw);
    for (int m = gw; m < M; m += NGW) {
        const size_t off = (size_t)m * D + col;
        f32x4 y[4], r[4], k[4], v[4], z[4], aa[4];
#pragma unroll
        for (int j = 0; j < 2; ++j) { unpack8(ry_[j], y[2 * j], y[2 * j + 1]); unpack8(rr_[j], r[2 * j], r[2 * j + 1]); unpack8(rk_[j], k[2 * j], k[2 * j + 1]);
            unpack8(rv_[j], v[2 * j], v[2 * j + 1]); unpack8(rz_[j], z[2 * j], z[2 * j + 1]); unpack8(ra_[j], aa[2 * j], aa[2 * j + 1]); }
        if (m + NGW < M) GN_LOAD(m + NGW);
        float s = 0.f, bs = 0.f;
#pragma unroll
        for (int q = 0; q < 4; ++q) {
            s += (y[q].x + y[q].y) + (y[q].z + y[q].w);
            const f32x4 kp = k[q] * (1.0f + (aa[q] - 1.0f) * kaq[q]);
            const f32x4 t = r[q] * kp * rkq[q];
            bs += (t.x + t.y) + (t.z + t.w);
        }
        s += __shfl_xor(s, 1); s += __shfl_xor(s, 2); bs += __shfl_xor(bs, 1); bs += __shfl_xor(bs, 2);
        const float mean = s * (1.0f / 64.0f);
        float q2 = 0.f;
#pragma unroll
        for (int q = 0; q < 4; ++q) { const f32x4 dlt = y[q] - mean; q2 += (dlt.x * dlt.x + dlt.y * dlt.y) + (dlt.z * dlt.z + dlt.w * dlt.w); }
        q2 += __shfl_xor(q2, 1); q2 += __shfl_xor(q2, 2);
        const float rstd = 1.0f / sqrtf(q2 * (1.0f / 64.0f) + 64e-5f);
        f32x4 o[4];
#pragma unroll
        for (int q = 0; q < 4; ++q) {
            const f32x4 yn = (y[q] - mean) * rstd * ggq[q] + gbq[q] + bs * v[q];
#pragma unroll
            for (int e = 0; e < 4; ++e) o[q][e] = yn[e] * z[q][e] * fsigmoid(z[q][e]);
        }
        *(u32x4*)(Y + off) = pack8(o[0], o[1]); *(u32x4*)(Y + off + 8) = pack8(o[2], o[3]);
    }
}
__device__ __forceinline__ void final_norm_phase(const bf16_t* H2, float* out, const float* g, int G, int bid, int tid) {
    const int wave = __builtin_amdgcn_readfirstlane(tid >> 6), lane = tid & 63;
    const int gw = bid * NWAVES + wave, NGW = G * NWAVES;
    f32x4 gv[4];
#pragma unroll
    for (int j = 0; j < 2; ++j) { gv[2 * j] = *(const f32x4*)(g + j * 512 + lane * 8); gv[2 * j + 1] = *(const f32x4*)(g + j * 512 + lane * 8 + 4); }
    u32x4 rh_[2];
    if (gw < M) { rh_[0] = *(const u32x4*)(H2 + (size_t)gw * D + lane * 8); rh_[1] = *(const u32x4*)(H2 + (size_t)gw * D + 512 + lane * 8); }
    for (int m = gw; m < M; m += NGW) {
        f32x4 v[4]; float s = 0.f;
        unpack8(rh_[0], v[0], v[1]); unpack8(rh_[1], v[2], v[3]);
        if (m + NGW < M) { rh_[0] = *(const u32x4*)(H2 + (size_t)(m + NGW) * D + lane * 8); rh_[1] = *(const u32x4*)(H2 + (size_t)(m + NGW) * D + 512 + lane * 8); }
#pragma unroll
        for (int q = 0; q < 4; ++q) s += (v[q].x * v[q].x + v[q].y * v[q].y) + (v[q].z * v[q].z + v[q].w * v[q].w);
        const float rstd = 1.0f / sqrtf(wave_sum(s) * (1.0f / D) + 1e-6f);
#pragma unroll
        for (int j = 0; j < 2; ++j) { float* o = out + (size_t)m * D + j * 512 + lane * 8; *(f32x4*)o = v[2 * j] * rstd * gv[2 * j]; *(f32x4*)(o + 4) = v[2 * j + 1] * rstd * gv[2 * j + 1]; }
    }
}
#ifndef MK_PER_PHASE
#define MK_PER_PHASE 0
#endif
constexpr int NPHASE = 15;
#ifndef MK_REP_PHASE
#define MK_REP_PHASE -1
#endif
#ifndef MK_REP_N
#define MK_REP_N 2
#endif
#define REPS(k) ((k) == MK_REP_PHASE ? MK_REP_N : 1)

__global__ void __launch_bounds__(NTHR, 2) hybrid_fwd(Args a) {
    extern __shared__ __attribute__((aligned(16))) unsigned char lds_raw[];
    LAS unsigned char* lds = (LAS unsigned char*)lds_raw;
    cg::grid_group grid = cg::this_grid();
    const int wave_s = __builtin_amdgcn_readfirstlane((int)threadIdx.x >> 6);
    const int bid = blockIdx.x, G = gridDim.x;
#define TID() int lane_v_; asm volatile("v_mbcnt_lo_u32_b32 %0, -1, 0\n\tv_mbcnt_hi_u32_b32 %0, -1, %0" : "=v"(lane_v_)); const int tid = wave_s * 64 + lane_v_
    { TID(); if (tid < 16) ((LAS unsigned*)(lds + LDS_BYTES - 64))[tid] = 0u; __syncthreads();
#if !MK_PER_PHASE
      kptr_t kpb = kargs(); (void)xcd_barrier_post((unsigned*)(kws(kpb) + WS_CTL), (volatile LAS unsigned*)(lds + LDS_BYTES - 64), tid);
#endif
    }
    int lo, hi; { kptr_t kp0 = kargs(); lo = *(const int __attribute__((address_space(4)))*)(kp0 + 8 * 26); hi = *(const int __attribute__((address_space(4)))*)(kp0 + 8 * 26 + 4); }
#ifndef PH_MASK
#define PH_MASK 0x7fff
#endif
#define IN(k) (((PH_MASK >> (k)) & 1) && lo <= (k) && (k) < hi)
#define SEAM(k) do { if (IN(k) && IN((k) + 1)) { if ((k) == 0) grid.sync(); else { TID(); kptr_t kpb = kargs(); XcdBarrier xb_; xb_.bar = (unsigned*)(kws(kpb) + WS_CTL); xb_.x = xb_xcc_id(); xb_.st = (volatile LAS unsigned*)(lds + LDS_BYTES - 64); xcd_barrier(xb_, tid); } } } while (0)
#define PTRS() kptr_t kp = kargs(); unsigned char* ws = kws(kp); (void)ws
#define S1 ((bf16_t*)(ws + WS_S1))
#define S2 ((bf16_t*)(ws + WS_S2))
#define S3 ((bf16_t*)(ws + WS_S3))
#define S4 ((bf16_t*)(ws + WS_S4))
#define QKVZ ((bf16_t*)(ws + WS_QKVZ))
#define XS0 ((bf16_t*)(ws + WS_XS0))
#define XS1 ((bf16_t*)(ws + WS_XS1))
#define WAb ((bf16_t*)(ws + WS_WA))
#define A2 ((bf16_t*)(ws + WS_A2))
#define Lb ((bf16_t*)(ws + WS_L))
#define Kr ((bf16_t*)kout(kp))
#define Vr ((bf16_t*)kout(kp) + (size_t)M * D)
#define WR ((const bf16_t*)(ws + WS_WR))

    if (IN(0)) for (int rep_ = 0; rep_ < REPS(0); ++rep_) { TID(); p0_prologue(lds, G, bid, tid); }
    SEAM(0);
    if (IN(1)) for (int rep_ = 0; rep_ < REPS(1); ++rep_) { TID(); PTRS();
        { pg8::Gemm g{S1, (const bf16_t*)(ws + WS_WQKVZ), M, ATT_IN, D}; pg8::StaticOrder S; S.init(M, ATT_IN, G, bid);
          pg8::EpiQKVZ E{QKVZ, (const float*)(ws + WS_BIAS), (const float*)(ws + WS_COS), (const float*)(ws + WS_SIN)};
          pg8::gemm_phase<pg8::EpiQKVZ, pg8::StaticOrder, true, true>(lds, g, S, E, tid); }
        __syncthreads();
        { pg8::Gemm g{(const bf16_t*)(ws + WS_PB0), (const bf16_t*)(ws + WS_WP0), M, D, PLE}; pg8::StaticOrder S; S.init(M, D, G, bid);
          pg8::EpiStore E{S2, D};
          pg8::gemm_phase<pg8::EpiStore, pg8::StaticOrder, true, true>(lds, g, S, E, tid); }
    }
    SEAM(1);
    if (IN(2)) for (int rep_ = 0; rep_ < REPS(2); ++rep_) { TID(); PTRS(); attn_phase(lds, QKVZ, kin(kp, I_ASINK), S1, G, bid, tid); }
    SEAM(2);
    if (IN(3)) for (int rep_ = 0; rep_ < REPS(3); ++rep_) { TID(); PTRS();
        pg8::Gemm g{S1, (const bf16_t*)(ws + WS_WO0), M, D, D}; pg8::StaticOrder S; S.init(M, D, G, bid);
        pg8::EpiRes<false> E{(const void*)kin(kp, I_X), S3};
        pg8::gemm_phase<pg8::EpiRes<false>, pg8::StaticOrder, true, true>(lds, g, S, E, tid);
    }
    SEAM(3);
    if (IN(4)) for (int rep_ = 0; rep_ < REPS(4); ++rep_) { TID(); PTRS();
        pg8::Gemm g{S3, (const bf16_t*)(ws + WS_WG0), M, D, D}; pg8::StaticOrder S; S.init(M, D, G, bid);
        pg8::EpiGate<false> E{S3, S2, (void*)S4};
        pg8::gemm_phase<pg8::EpiGate<false>, pg8::StaticOrder, true, true>(lds, g, S, E, tid);
    }
    SEAM(4);
    if (IN(5)) for (int rep_ = 0; rep_ < REPS(5); ++rep_) { TID(); PTRS(); lerp_phase<0>(S4, kin(kp, I_NORMG) + D, kin(kp, I_MU), S1, XS0, XS1, G, bid, tid); }
    SEAM(5);
    if (IN(6)) for (int rep_ = 0; rep_ < REPS(6); ++rep_) { TID(); PTRS();
        { pg8::Gemm g{XS0, WR, M, 2 * D, D, XS1, 4}; pg8::StaticOrder S; S.init(M, 2 * D, G, bid); pg8::EpiStore2 E{S3, Kr, 4, D};
          pg8::gemm_phase<pg8::EpiStore2, pg8::StaticOrder, true, true>(lds, g, S, E, tid); }
        __syncthreads();
        { pg8::Gemm g{S1, (const bf16_t*)(ws + WS_WL), M, 256, D}; pg8::StaticOrder S; S.init(M, 256, G, bid); pg8::EpiStore E{Lb, 256};
          pg8::gemm_phase<pg8::EpiStore, pg8::StaticOrder, true, true>(lds, g, S, E, tid); }
    }
    SEAM(6);
    if (IN(7)) for (int rep_ = 0; rep_ < REPS(7); ++rep_) { TID(); PTRS(); lerp_phase<1>(S4, kin(kp, I_NORMG) + D, kin(kp, I_MU), nullptr, XS0, XS1, G, bid, tid); lora_mid_phase(Lb, A2, G, bid, tid); }
    SEAM(7);
    if (IN(8)) for (int rep_ = 0; rep_ < REPS(8); ++rep_) { TID(); PTRS();
        { pg8::Gemm g{XS0, WR + (size_t)2 * D * D, M, 2 * D, D, XS1, 4}; pg8::StaticOrder S; S.init(M, 2 * D, G, bid); pg8::EpiStore2 E{Vr, S2, 4, D};
          pg8::gemm_phase<pg8::EpiStore2, pg8::StaticOrder, true, true>(lds, g, S, E, tid); }
    }
    SEAM(8);
    if (IN(9)) for (int rep_ = 0; rep_ < REPS(9); ++rep_) { TID(); PTRS();
        pg8::Gemm g{A2, (const bf16_t*)(ws + WS_W2), M, 2048, 128}; pg8::StaticOrder S; S.init(M, 2048, G, bid);
        pg8::EpiWA E{WAb, kin(kp, I_W0), kin(kp, I_A0)};
        pg8::gemm_phase<pg8::EpiWA, pg8::StaticOrder, true, true>(lds, g, S, E, tid);
    }
    SEAM(9);
    if (IN(10)) for (int rep_ = 0; rep_ < REPS(10); ++rep_) { TID(); PTRS(); scan_phase(lds, S3, Kr, Vr, WAb, kin(kp, I_KK), kin(kp, I_KA), S1, G, bid, tid); }
    SEAM(10);
    if (IN(11)) for (int rep_ = 0; rep_ < REPS(11); ++rep_) { TID(); PTRS(); gn_phase(S1, S3, Kr, Vr, S2, WAb, kin(kp, I_KA), kin(kp, I_RK), kin(kp, I_GNG), kin(kp, I_GNB), G, bid, tid); }
    SEAM(11);
    if (IN(12)) for (int rep_ = 0; rep_ < REPS(12); ++rep_) { TID(); PTRS();
        { pg8::Gemm g{S1, (const bf16_t*)(ws + WS_WO1), M, D, D}; pg8::StaticOrder S; S.init(M, D, G, bid); pg8::EpiRes<true> E{(const void*)S4, S3};
          pg8::gemm_phase<pg8::EpiRes<true>, pg8::StaticOrder, true, true>(lds, g, S, E, tid); }
        __syncthreads();
        { pg8::Gemm g{(const bf16_t*)(ws + WS_PB1), (const bf16_t*)(ws + WS_WP1), M, D, PLE}; pg8::StaticOrder S; S.init(M, D, G, bid); pg8::EpiStore E{S2, D};
          pg8::gemm_phase<pg8::EpiStore, pg8::StaticOrder, true, true>(lds, g, S, E, tid); }
    }
    SEAM(12);
    if (IN(13)) for (int rep_ = 0; rep_ < REPS(13); ++rep_) { TID(); PTRS();
        pg8::Gemm g{S3, (const bf16_t*)(ws + WS_WG1), M, D, D}; pg8::StaticOrder S; S.init(M, D, G, bid);
        pg8::EpiGate<false> E{S3, S2, (void*)S1};
        pg8::gemm_phase<pg8::EpiGate<false>, pg8::StaticOrder, true, true>(lds, g, S, E, tid);
    }
    SEAM(13);
    if (IN(14)) for (int rep_ = 0; rep_ < REPS(14); ++rep_) { TID(); PTRS(); final_norm_phase(S1, kout(kp), kin(kp, I_FNG), G, bid, tid); }
#undef IN
#undef SEAM
}

extern "C" void kernel_launch(void* const* d_in, const int* in_sizes, int n_in, void* d_out, int out_size, void* d_ws, size_t ws_size, hipStream_t stream) {
    static int grid = 0;
    if (grid == 0) {
        if (n_in != 24 || out_size != M * D || ws_size < WS_END) { fprintf(stderr, "kernel_launch: unexpected shapes (n_in %d, out %d, ws %zu)\n", n_in, out_size, ws_size); grid = -1; return; }
        int dev = 0, cus = 0, per_cu = 0;
        (void)hipGetDevice(&dev); (void)hipDeviceGetAttribute(&cus, hipDeviceAttributeMultiprocessorCount, dev);
        if (hipFuncSetAttribute((const void*)hybrid_fwd, hipFuncAttributeMaxDynamicSharedMemorySize, LDS_BYTES) != hipSuccess) { fprintf(stderr, "kernel_launch: hipFuncSetAttribute failed\n"); grid = -1; return; }
        if (hipOccupancyMaxActiveBlocksPerMultiprocessor(&per_cu, (const void*)hybrid_fwd, NTHR, LDS_BYTES) != hipSuccess || per_cu < 1) { fprintf(stderr, "kernel_launch: occupancy query reports %d\n", per_cu); per_cu = 1; }
        (void)hipGetLastError();
        grid = cus > 0 ? cus : 256;
    }
    if (grid < 0) return;
    Args a{};
    for (int i = 0; i < 24; ++i) a.in[i] = (const float*)d_in[i];
    a.out = (float*)d_out; a.ws = (unsigned char*)d_ws;
#if MK_PER_PHASE
    for (int ph = 0; ph < NPHASE; ++ph) { a.ph_lo = ph; a.ph_hi = ph + 1; hipLaunchKernelGGL(hybrid_fwd, dim3(grid), dim3(NTHR), LDS_BYTES, stream, a); }
#else
    a.ph_lo = 0; a.ph_hi = NPHASE;
    (void)hipMemsetAsync((unsigned char*)d_ws + WS_CTL, 0, 16384, stream);
    void* args[] = {&a};
    hipError_t e = hipLaunchCooperativeKernel((const void*)hybrid_fwd, dim3(grid), dim3(NTHR), args, LDS_BYTES, stream);
    if (e != hipSuccess) fprintf(stderr, "cooperative launch failed: %s (grid %d)\n", hipGetErrorString(e), grid);
#endif
}
```

```cpp
#include <hip/hip_runtime.h>
#include <hip/hip_cooperative_groups.h>
#include <cstdio>
#include <cstdint>
namespace cg = cooperative_groups;
namespace pg8 {
#define PG8_LAS __attribute__((address_space(3)))
typedef unsigned short bf16_t;
typedef short bf16x8 __attribute__((ext_vector_type(8)));
typedef float f32x4 __attribute__((ext_vector_type(4)));
typedef unsigned u32x4 __attribute__((ext_vector_type(4)));
constexpr int BM = 256, BK = 64, HALF = 128, HTB = HALF * BK * 2  , STAGE_BYTES = 8 * HTB, NXCD = 8, WGM = 6;

__host__ __device__ __forceinline__ int lds_byte(int r, int c) { const int st = (r >> 4) * 2 + (c >> 5), rr = r & 15, cc = c & 31, ob = rr * 64 + cc * 2; return st * 1024 + (ob ^ (((ob >> 9) & 1) << 5)); }
__host__ __device__ __forceinline__ void stage_rc(int b, int& R, int& C) { const int st = b / 1024, sb = b % 1024, swz = sb ^ (((sb >> 9) & 1) << 5); R = (st >> 1) * 16 + swz / 64; C = (st & 1) * 32 + (swz % 64) / 2; }
__host__ __device__ __forceinline__ int perm32(int rho) { const int n = rho >> 4, i = rho & 15; return 8 * (i >> 2) + 4 * n + (i & 3); }

struct Unit { int pm, pn; };
struct Gemm { const bf16_t* A; const bf16_t* Bt; int M, N, K; const bf16_t* A2 = nullptr; int nsplit = 1 << 30;
    __host__ __device__ __forceinline__ const bf16_t* asel(int pn) const { return pn < nsplit ? A : A2; } };

struct StaticOrder {
    int nM, nN, nwg, G, c;
    __host__ __device__ void init(int M, int N, int G_, int c_) { nM = M / BM; nN = N / BM; nwg = nM * nN; G = G_; c = c_; }
    __host__ __device__ bool next(int i, Unit& u) const {
        const long L = (long)i * G + c; if (L >= nwg) return false;
        int wgid = (int)L; { const int q = nwg / NXCD, r = nwg % NXCD, xcd = wgid % NXCD, off = wgid / NXCD; wgid = (xcd < r ? xcd * (q + 1) : r * (q + 1) + (xcd - r) * q) + off; }
        const int nig = WGM * nN, gid = wgid / nig, fm = gid * WGM, gsz = (nM - fm) < WGM ? (nM - fm) : WGM;
        u.pm = fm + ((wgid % nig) % gsz); u.pn = (wgid % nig) / gsz; return true;
    }
    __device__ __forceinline__ void a_ready(const Unit&) const {}
    __device__ __forceinline__ void done(const Unit&) const {}
};

__device__ __forceinline__ unsigned cvt_pk_bf16(float lo, float hi) { unsigned r; asm volatile("v_cvt_pk_bf16_f32 %0, %1, %2" : "=v"(r) : "v"(lo), "v"(hi)); return r; }
typedef float f32x2 __attribute__((ext_vector_type(2)));
__device__ __forceinline__ float bf2f(unsigned short b) { return __uint_as_float((unsigned)b << 16); }
__device__ __forceinline__ float bflo(unsigned w) { return __uint_as_float(w << 16); }
__device__ __forceinline__ float bfhi(unsigned w) { return __uint_as_float(w & 0xffff0000u); }
__device__ __forceinline__ float fsigmoid(float x) { return __builtin_amdgcn_rcpf(1.0f + __expf(-x)); }
__device__ __forceinline__ u32x4 pack8(const f32x4 a, const f32x4 b) { u32x4 w; w.x = cvt_pk_bf16(a[0], a[1]); w.y = cvt_pk_bf16(a[2], a[3]); w.z = cvt_pk_bf16(b[0], b[1]); w.w = cvt_pk_bf16(b[2], b[3]); return w; }
__device__ __forceinline__ void unpack8(const u32x4 w, f32x4& a, f32x4& b) { a = (f32x4){bflo(w.x), bfhi(w.x), bflo(w.y), bfhi(w.y)}; b = (f32x4){bflo(w.z), bfhi(w.z), bflo(w.w), bfhi(w.w)}; }

constexpr float QSCALE = 0.125f * 1.4426950408889634f;

struct EpiQKVZ {
    static constexpr bool PERM = true, AFTER_DRAIN = false;
    bf16_t* O; const float* bias; const float* cs; const float* sn;
    __device__ __forceinline__ void operator()(const f32x4 (&acc)[2][2][4][2], const Unit& u, int wr, int wc, int fr, int fq) const {
        const int row0 = u.pm * BM + wr * 64 + fr, col0 = u.pn * BM + wc * 32 + 8 * fq;
        const bool rope = u.pn < 5; const float sc = u.pn < 4 ? QSCALE : 1.0f;
        const int j4 = 4 * (4 * (wc & 1) + fq);
#pragma unroll
        for (int ai = 0; ai < 2; ++ai)
#pragma unroll
            for (int m = 0; m < 4; ++m) {
                const int row = row0 + ai * HALF + m * 16, pos = row & 4095;
                f32x4 c = (f32x4){1.f, 1.f, 1.f, 1.f}, s = (f32x4){0.f, 0.f, 0.f, 0.f};
                if (rope) { c = *(const f32x4*)(cs + pos * 32 + j4); s = *(const f32x4*)(sn + pos * 32 + j4); }
                bf16_t* rowp = O + (size_t)row * 2560 + col0;
#pragma unroll
                for (int bj = 0; bj < 2; ++bj) {
                    const f32x4 v0 = acc[ai][bj][m][0] + *(const f32x4*)(bias + col0 + bj * HALF), v1 = acc[ai][bj][m][1] + *(const f32x4*)(bias + col0 + bj * HALF + 4);
                    f32x4 o0 = v0, o1 = v1;
                    o0 = (v0 * c - v1 * s) * sc; o1 = (v1 * c + v0 * s) * sc;
                    *(u32x4*)(rowp + bj * HALF) = pack8(o0, o1);
                }
            }
    }
};
struct EpiStore {
    static constexpr bool PERM = true, AFTER_DRAIN = false;
    bf16_t* O; int ldc;
    __device__ __forceinline__ void operator()(const f32x4 (&acc)[2][2][4][2], const Unit& u, int wr, int wc, int fr, int fq) const {
        const int row0 = u.pm * BM + wr * 64 + fr, col0 = u.pn * BM + wc * 32 + 8 * fq;
#pragma unroll
        for (int ai = 0; ai < 2; ++ai)
#pragma unroll
            for (int m = 0; m < 4; ++m) { bf16_t* rowp = O + (size_t)(row0 + ai * HALF + m * 16) * ldc + col0;
#pragma unroll
                for (int bj = 0; bj < 2; ++bj) *(u32x4*)(rowp + bj * HALF) = pack8(acc[ai][bj][m][0], acc[ai][bj][m][1]); }
    }
};
struct EpiStore2 {
    static constexpr bool PERM = true, AFTER_DRAIN = false;
    bf16_t* O1; bf16_t* O2; int nsplit; int ldc;
    __device__ __forceinline__ void operator()(const f32x4 (&acc)[2][2][4][2], const Unit& u, int wr, int wc, int fr, int fq) const {
        const bool first = u.pn < nsplit; bf16_t* O = first ? O1 : O2;
        const int row0 = u.pm * BM + wr * 64 + fr, col0 = (first ? u.pn : u.pn - nsplit) * BM + wc * 32 + 8 * fq;
#pragma unroll
        for (int ai = 0; ai < 2; ++ai)
#pragma unroll
            for (int m = 0; m < 4; ++m) { bf16_t* rowp = O + (size_t)(row0 + ai * HALF + m * 16) * ldc + col0;
#pragma unroll
                for (int bj = 0; bj < 2; ++bj) *(u32x4*)(rowp + bj * HALF) = pack8(acc[ai][bj][m][0], acc[ai][bj][m][1]); }
    }
};
template <bool BF> struct EpiRes {
    static constexpr bool PERM = true, AFTER_DRAIN = false;
    const void* base; bf16_t* O;
    __device__ __forceinline__ void operator()(const f32x4 (&acc)[2][2][4][2], const Unit& u, int wr, int wc, int fr, int fq) const {
        const int row0 = u.pm * BM + wr * 64 + fr, col0 = u.pn * BM + wc * 32 + 8 * fq;
#pragma unroll
        for (int ai = 0; ai < 2; ++ai)
#pragma unroll
            for (int m = 0; m < 4; ++m) { const size_t off = (size_t)(row0 + ai * HALF + m * 16) * 1024 + col0;
#pragma unroll
                for (int bj = 0; bj < 2; ++bj) { f32x4 b0, b1;
                    if (BF) { unpack8(*(const u32x4*)((const bf16_t*)base + off + bj * HALF), b0, b1); }
                    else { b0 = *(const f32x4*)((const float*)base + off + bj * HALF); b1 = *(const f32x4*)((const float*)base + off + bj * HALF + 4); }
                    *(u32x4*)(O + off + bj * HALF) = pack8(b0 + acc[ai][bj][m][0], b1 + acc[ai][bj][m][1]); } }
    }
};
template <bool F32OUT> struct EpiGate {
    static constexpr bool PERM = true, AFTER_DRAIN = false;
    const bf16_t* hpre; const bf16_t* pp; void* O;
    __device__ __forceinline__ void operator()(const f32x4 (&acc)[2][2][4][2], const Unit& u, int wr, int wc, int fr, int fq) const {
        const int row0 = u.pm * BM + wr * 64 + fr, col0 = u.pn * BM + wc * 32 + 8 * fq;
#pragma unroll
        for (int ai = 0; ai < 2; ++ai)
#pragma unroll
            for (int m = 0; m < 4; ++m) { const size_t off = (size_t)(row0 + ai * HALF + m * 16) * 1024 + col0;
#pragma unroll
                for (int bj = 0; bj < 2; ++bj) { f32x4 h0, h1, p0, p1;
                    unpack8(*(const u32x4*)(hpre + off + bj * HALF), h0, h1); unpack8(*(const u32x4*)(pp + off + bj * HALF), p0, p1);
                    f32x4 g0, g1;
#pragma unroll
                    for (int e = 0; e < 4; ++e) { g0[e] = fsigmoid(acc[ai][bj][m][0][e]); g1[e] = fsigmoid(acc[ai][bj][m][1][e]); }
                    const f32x4 o0 = h0 + g0 * p0, o1 = h1 + g1 * p1;
                    if (F32OUT) { *(f32x4*)((float*)O + off + bj * HALF) = o0; *(f32x4*)((float*)O + off + bj * HALF + 4) = o1; }
                    else *(u32x4*)((bf16_t*)O + off + bj * HALF) = pack8(o0, o1); } }
    }
};
struct EpiWA {
    static constexpr bool PERM = true, AFTER_DRAIN = false;
    bf16_t* O; const float* w0; const float* a0;
    __device__ __forceinline__ void operator()(const f32x4 (&acc)[2][2][4][2], const Unit& u, int wr, int wc, int fr, int fq) const {
        const int row0 = u.pm * BM + wr * 64 + fr, col0 = u.pn * BM + wc * 32 + 8 * fq;
        const bool isw = u.pn < 4; const float* bvec = isw ? (w0 + col0) : (a0 + col0 - 1024); const float mul = isw ? -0.6065306597126334f : 1.0f;
#pragma unroll
        for (int ai = 0; ai < 2; ++ai)
#pragma unroll
            for (int m = 0; m < 4; ++m) { bf16_t* rowp = O + (size_t)(row0 + ai * HALF + m * 16) * 2048 + col0;
#pragma unroll
                for (int bj = 0; bj < 2; ++bj) { f32x4 o0, o1; const f32x4 b0 = *(const f32x4*)(bvec + bj * HALF), b1 = *(const f32x4*)(bvec + bj * HALF + 4);
#pragma unroll
                    for (int e = 0; e < 4; ++e) { o0[e] = mul * fsigmoid(acc[ai][bj][m][0][e] + b0[e]); o1[e] = mul * fsigmoid(acc[ai][bj][m][1][e] + b1[e]); }
                    *(u32x4*)(rowp + bj * HALF) = pack8(o0, o1); } }
    }
};
template <class Epi, class Sched, bool ALIGN_EPI = false, bool SP2 = false>
__device__ __forceinline__ void gemm_phase(PG8_LAS unsigned char* lds, const Gemm g, const Sched& S, const Epi& E, const int tid_in) {
    const int tid = tid_in, wid = __builtin_amdgcn_readfirstlane(tid >> 6), lane = tid & 63, wr = wid >> 2, wc = wid & 3, fr = lane & 15, fq = lane >> 4;
    const int K = g.K, nt = K / BK;
    unsigned voffA[2], voffB[2];
#pragma unroll
    for (int i = 0; i < 2; ++i) { int R, C; stage_rc(tid * 16 + i * 8192, R, C); const int Rb = Epi::PERM ? ((R & ~31) + perm32(R & 31)) : R;
        voffA[i] = (unsigned)(R * K + C) * 2u; voffB[i] = (unsigned)(Rb * K + C) * 2u; }
    const size_t kstep = (size_t)(BK * 2);
    const size_t hstep = (size_t)HALF * K * 2;
    const size_t tstep = 2 * hstep;
    const unsigned ldsw = (unsigned)wid * 1024u;
    const int aoff = lds_byte(wr * 64 + fr, fq * 8), boff = lds_byte(wc * 32 + fr, fq * 8);
#define PG8_SA(b, h) (((b) * 2 + (h)) * HTB)
#define PG8_SB(b, h) ((4 + (b) * 2 + (h)) * HTB)
#define PG8_STAGE(bufoff, gbase, voff) do { _Pragma("unroll") for (int _i = 0; _i < 2; ++_i) \
        __builtin_amdgcn_global_load_lds((const unsigned*)((const char*)(gbase) + (voff)[_i]), (PG8_LAS unsigned*)(lds + (bufoff) + ldsw + _i * 8192), 16, 0, 0); } while (0)
#define PG8_LDA(dst, b, h) do { _Pragma("unroll") for (int m = 0; m < 4; ++m) _Pragma("unroll") for (int k = 0; k < 2; ++k) dst[m][k] = *(const PG8_LAS bf16x8*)(lds + PG8_SA(b, h) + aoff + m * 2048 + k * 1024); } while (0)
#define PG8_LDB(dst, b, h) do { _Pragma("unroll") for (int n = 0; n < 2; ++n) _Pragma("unroll") for (int k = 0; k < 2; ++k) dst[n][k] = *(const PG8_LAS bf16x8*)(lds + PG8_SB(b, h) + boff + n * 2048 + k * 1024); } while (0)
#define PG8_MMA(ai, bj, At, Bt) do { __builtin_amdgcn_s_setprio(1); _Pragma("unroll") for (int m = 0; m < 4; ++m) _Pragma("unroll") for (int n = 0; n < 2; ++n) _Pragma("unroll") for (int k = 0; k < 2; ++k) \
        acc[ai][bj][m][n] = __builtin_amdgcn_mfma_f32_16x16x32_bf16(Bt[n][k], At[m][k], acc[ai][bj][m][n], 0, 0, 0); __builtin_amdgcn_s_setprio(0); } while (0)
#define PG8_WAIT_V(n) asm volatile("s_waitcnt vmcnt(" #n ")" ::: "memory")
#define PG8_WAIT_L(n) asm volatile("s_waitcnt lgkmcnt(" #n ")" ::: "memory")
#define PG8_BAR __builtin_amdgcn_s_barrier()
#define PG8_SCHED __builtin_amdgcn_sched_barrier(0)
    Unit cur, nxt; int ui = 0;
    if (!S.next(0, cur)) return;
    f32x4 acc[2][2][4][2];
#pragma unroll
    for (int a = 0; a < 2; ++a)
#pragma unroll
        for (int b = 0; b < 2; ++b)
#pragma unroll
            for (int m = 0; m < 4; ++m)
#pragma unroll
                for (int n = 0; n < 2; ++n) acc[a][b][m][n] = (f32x4){0.f, 0.f, 0.f, 0.f};
    bf16x8 At[4][2], B0[2][2], B1[2][2];
    const char* cA = (const char*)g.asel(cur.pn) + (size_t)cur.pm * tstep; const char* cB = (const char*)g.Bt + (size_t)cur.pn * tstep;
    S.a_ready(cur);
    if constexpr (SP2) {
        PG8_STAGE(PG8_SB(0, 0), cB, voffB); PG8_STAGE(PG8_SB(0, 1), cB + hstep, voffB); PG8_STAGE(PG8_SA(0, 0), cA, voffA); PG8_STAGE(PG8_SA(0, 1), cA + hstep, voffA);
        if (wr == 1) PG8_BAR;
        PG8_WAIT_V(2); PG8_BAR;
        PG8_STAGE(PG8_SB(1, 0), cB + kstep, voffB); PG8_STAGE(PG8_SA(1, 0), cA + kstep, voffA); PG8_STAGE(PG8_SB(1, 1), cB + hstep + kstep, voffB);
        PG8_WAIT_V(6); PG8_BAR;
    } else {
        PG8_STAGE(PG8_SB(0, 0), cB, voffB); PG8_STAGE(PG8_SA(0, 0), cA, voffA); PG8_STAGE(PG8_SB(0, 1), cB + hstep, voffB); PG8_STAGE(PG8_SA(0, 1), cA + hstep, voffA);
        if (wr == 1) PG8_BAR;
        PG8_WAIT_V(4); PG8_BAR;
        PG8_STAGE(PG8_SB(1, 0), cB + kstep, voffB); PG8_STAGE(PG8_SA(1, 0), cA + kstep, voffA); PG8_STAGE(PG8_SB(1, 1), cB + hstep + kstep, voffB);
        PG8_WAIT_V(6); PG8_BAR;
    }
    for (;;) {
        const bool has_next = S.next(ui + 1, nxt);
        const char* nA = has_next ? (const char*)g.asel(nxt.pn) + (size_t)nxt.pm * tstep : cA; const char* nB = has_next ? (const char*)g.Bt + (size_t)nxt.pn * tstep : cB;
        for (int t = 0; t < nt; t += 2) {
            const bool last = (t == nt - 2);
            const char* a1 = cA + (size_t)(t + 1) * kstep;
            const char* a2 = last ? nA : cA + (size_t)(t + 2) * kstep; const char* b2 = last ? nB : cB + (size_t)(t + 2) * kstep;
            const char* a3 = a2 + kstep; const char* b3 = b2 + kstep;
            if (last && has_next) S.a_ready(nxt);
            if constexpr (SP2) {
            PG8_LDB(B0, 0, 0); PG8_LDB(B1, 0, 1); PG8_SCHED; PG8_LDA(At, 0, 0); PG8_STAGE(PG8_SA(1, 1), a1 + hstep, voffA);
            PG8_WAIT_V(8); PG8_WAIT_L(0); PG8_BAR; PG8_MMA(0, 0, At, B0); PG8_MMA(0, 1, At, B1); PG8_BAR; PG8_SCHED;
            PG8_LDA(At, 0, 1); PG8_STAGE(PG8_SB(0, 0), b2, voffB); PG8_STAGE(PG8_SB(0, 1), b2 + hstep, voffB); PG8_STAGE(PG8_SA(0, 0), a2, voffA);
            PG8_WAIT_V(8); PG8_WAIT_L(0); PG8_BAR; PG8_MMA(1, 0, At, B0); PG8_MMA(1, 1, At, B1); PG8_BAR; PG8_SCHED;
            PG8_LDB(B0, 1, 0); PG8_LDB(B1, 1, 1); PG8_SCHED; PG8_LDA(At, 1, 0); PG8_STAGE(PG8_SA(0, 1), a2 + hstep, voffA);
            PG8_WAIT_V(8); PG8_WAIT_L(0); PG8_BAR; PG8_MMA(0, 0, At, B0); PG8_MMA(0, 1, At, B1); PG8_BAR; PG8_SCHED;
            PG8_LDA(At, 1, 1); PG8_STAGE(PG8_SB(1, 0), b3, voffB); PG8_STAGE(PG8_SB(1, 1), b3 + hstep, voffB); PG8_STAGE(PG8_SA(1, 0), a3, voffA);
            PG8_WAIT_V(8); PG8_WAIT_L(0); PG8_BAR; PG8_MMA(1, 0, At, B0); PG8_MMA(1, 1, At, B1); PG8_BAR; PG8_SCHED;
            } else {
            PG8_LDB(B0, 0, 0); PG8_SCHED; PG8_LDA(At, 0, 0); PG8_STAGE(PG8_SA(1, 1), a1 + hstep, voffA);
            PG8_WAIT_L(8); PG8_BAR; PG8_WAIT_L(0); PG8_MMA(0, 0, At, B0); PG8_BAR; PG8_SCHED;
            PG8_LDB(B1, 0, 1); PG8_STAGE(PG8_SB(0, 0), b2, voffB);
            PG8_BAR; PG8_WAIT_L(0); PG8_MMA(0, 1, At, B1); PG8_BAR;
            PG8_LDA(At, 0, 1); PG8_STAGE(PG8_SA(0, 0), a2, voffA);
            PG8_BAR; PG8_WAIT_L(0); PG8_MMA(1, 0, At, B0); PG8_BAR; PG8_SCHED;
            PG8_STAGE(PG8_SB(0, 1), b2 + hstep, voffB);
            PG8_WAIT_V(6); PG8_BAR; PG8_MMA(1, 1, At, B1); PG8_BAR;
            PG8_LDB(B0, 1, 0); PG8_SCHED; PG8_LDA(At, 1, 0); PG8_STAGE(PG8_SA(0, 1), a2 + hstep, voffA);
            PG8_WAIT_L(8); PG8_BAR; PG8_WAIT_L(0); PG8_MMA(0, 0, At, B0); PG8_BAR; PG8_SCHED;
            PG8_LDB(B1, 1, 1); PG8_STAGE(PG8_SB(1, 0), b3, voffB);
            PG8_BAR; PG8_WAIT_L(0); PG8_MMA(0, 1, At, B1); PG8_BAR;
            PG8_LDA(At, 1, 1); PG8_STAGE(PG8_SA(1, 0), a3, voffA);
            PG8_BAR; PG8_WAIT_L(0); PG8_MMA(1, 0, At, B0); PG8_BAR; PG8_SCHED;
            PG8_STAGE(PG8_SB(1, 1), b3 + hstep, voffB);
            PG8_WAIT_V(6); PG8_BAR; PG8_MMA(1, 1, At, B1); PG8_BAR;
            }
        }
        if constexpr (ALIGN_EPI) { if (wr == 0) PG8_BAR; }
        if constexpr (!Epi::AFTER_DRAIN) { E(acc, cur, wr, wc, fr, fq); S.done(cur); }
        if (!has_next) break;
#pragma unroll
        for (int a = 0; a < 2; ++a)
#pragma unroll
            for (int b = 0; b < 2; ++b)
#pragma unroll
                for (int m = 0; m < 4; ++m)
#pragma unroll
                    for (int n = 0; n < 2; ++n) acc[a][b][m][n] = (f32x4){0.f, 0.f, 0.f, 0.f};
        cur = nxt; cA = nA; cB = nB; ++ui;
        if constexpr (ALIGN_EPI) { if (wr == 1) PG8_BAR; }
    }
    PG8_WAIT_V(0);
    if constexpr (!ALIGN_EPI) { if (wr == 0) PG8_BAR; }
    PG8_BAR;
    if constexpr (Epi::AFTER_DRAIN) { E.fused(acc, cur, wr, wc, fr, fq, lds, wid, lane); S.done(cur); }
#undef PG8_SA
#undef PG8_SB
#undef PG8_STAGE
#undef PG8_LDA
#undef PG8_LDB
#undef PG8_MMA
#undef PG8_WAIT_V
#undef PG8_WAIT_L
#undef PG8_BAR
#undef PG8_SCHED
}
}
using pg8::bf16_t; using pg8::bf16x8; using pg8::f32x4; using pg8::u32x4; using pg8::cvt_pk_bf16; using pg8::bf2f; using pg8::bflo; using pg8::bfhi; using pg8::fsigmoid; using pg8::pack8; using pg8::unpack8;
#define LAS __attribute__((address_space(3)))
typedef unsigned u32x2 __attribute__((ext_vector_type(2)));
typedef float f32x2 __attribute__((ext_vector_type(2)));

constexpr int NB = 8, T = 4096, D = 1024, M = NB * T, PLE = 256, ATT_IN = 2560;
constexpr int NWAVES = 8, NTHR = 512;
constexpr int LDS_BYTES = 147456;

constexpr size_t MiB = 1u << 20;
constexpr size_t WS_WQKVZ = 0;
constexpr size_t WS_WO0   = 5 * MiB;
constexpr size_t WS_WG0   = 7 * MiB;
constexpr size_t WS_WG1   = 9 * MiB;
constexpr size_t WS_WO1   = 11 * MiB;
constexpr size_t WS_WR    = 13 * MiB;
constexpr size_t WS_WP0   = 21 * MiB;
constexpr size_t WS_WP1   = 21 * MiB + 512 * 1024;
constexpr size_t WS_WL    = 22 * MiB;
constexpr size_t WS_W2    = 22 * MiB + 512 * 1024;
constexpr size_t WS_COS   = 23 * MiB;
constexpr size_t WS_SIN   = 23 * MiB + 512 * 1024;
constexpr size_t WS_BIAS  = 24 * MiB;
constexpr size_t WS_CTL   = 25 * MiB;
constexpr size_t WS_PB0   = 32 * MiB;
constexpr size_t WS_L     = 32 * MiB;
constexpr size_t WS_PB1   = 48 * MiB;
constexpr size_t WS_S1    = 64 * MiB;
constexpr size_t WS_QKVZ  = 128 * MiB;
constexpr size_t WS_XS0   = 128 * MiB, WS_XS1 = 192 * MiB, WS_WA = 128 * MiB, WS_A2 = 256 * MiB;
constexpr size_t WS_S2    = 288 * MiB;
constexpr size_t WS_S3    = 352 * MiB;
constexpr size_t WS_S4    = 416 * MiB;
constexpr size_t WS_END   = 480 * MiB;

__device__ __forceinline__ float wave_sum(float v) {
#pragma unroll
    for (int o = 1; o < 64; o <<= 1) v += __shfl_xor(v, o);
    return v;
}
__device__ __forceinline__ float dpp_add(float x, const int ctrl_dummy) { return x; }
#define DPP_XADD(x, ctrl) ((x) + __builtin_bit_cast(float, __builtin_amdgcn_update_dpp(0, __builtin_bit_cast(int, (x)), (ctrl), 0xF, 0xF, true)))
__device__ __forceinline__ float row16_sum(float x) {
    x = DPP_XADD(x, 0xB1);
    x = DPP_XADD(x, 0x4E);
    x = DPP_XADD(x, 0x141);
    x = DPP_XADD(x, 0x140);
    return x;
}

__device__ __forceinline__ void grid_bar(unsigned* ctr, unsigned target, int tid) {
    asm volatile("s_waitcnt vmcnt(0)" ::: "memory");
    __syncthreads();
    if (tid == 0) {
        __builtin_amdgcn_fence(__ATOMIC_RELEASE, "agent");
        asm volatile("s_waitcnt vmcnt(0)" ::: "memory");
        __hip_atomic_fetch_add(ctr, 1u, __ATOMIC_RELAXED, __HIP_MEMORY_SCOPE_AGENT);
        while (__hip_atomic_load(ctr, __ATOMIC_RELAXED, __HIP_MEMORY_SCOPE_AGENT) < target) __builtin_amdgcn_s_sleep(2);
        __builtin_amdgcn_fence(__ATOMIC_ACQUIRE, "agent");
        asm volatile("s_waitcnt vmcnt(0)" ::: "memory");
    }
    __syncthreads();
}
#define XB_TMO      128
#define XB_XCNT(j)  (256  + 64 * (j))
#define XB_XSUB(j)  (1280 + 64 * (j))
#define XB_XGEN(j)  (2304 + 64 * (j))
#define XB_TOP      3328
#define XB_TOPGEN   3392
#define XCD_BAR_WORDS 3456
#define XB_SPIN_CAP (1u << 18)

__device__ __forceinline__ unsigned xb_ld(unsigned* p)              { return __hip_atomic_load(p, __ATOMIC_RELAXED, __HIP_MEMORY_SCOPE_AGENT); }
__device__ __forceinline__ unsigned xb_add(unsigned* p, unsigned v) { return __hip_atomic_fetch_add(p, v, __ATOMIC_RELAXED, __HIP_MEMORY_SCOPE_AGENT); }
__device__ __forceinline__ unsigned xb_xcc_id() { return (unsigned)__builtin_amdgcn_s_getreg((3 << 11) | 20) & 0xFu; }
#define XB_SPIN(cond, bar) do { unsigned _sp = 0; while (cond) { __builtin_amdgcn_s_sleep(1); \
    if ((++_sp & 255u) == 0u) { if (xb_ld(&(bar)[XB_TMO])) break; if (_sp > XB_SPIN_CAP) { atomicAdd(&(bar)[XB_TMO], 1u); break; } } } } while (0)

struct XcdBarrier {
    unsigned* bar; unsigned x;
    volatile LAS unsigned* st;
};

__device__ __forceinline__ XcdBarrier xcd_barrier_post(unsigned* bar, volatile LAS unsigned* st, const int tid_) {
    XcdBarrier b; b.bar = bar; b.x = xb_xcc_id(); b.st = st;
    if (tid_ == 0) (void)xb_add(&bar[XB_XCNT(b.x)], 1u);
    return b;
}
__device__ __forceinline__ void xcd_barrier_complete(unsigned* bar, unsigned x, unsigned& nloc, unsigned& nx) {
    const unsigned G = gridDim.x * gridDim.y * gridDim.z;
    unsigned sum, cnt, mine, sp = 0u;
    for (;;) {
        sum = 0u; cnt = 0u; mine = 0u;
#pragma unroll
        for (unsigned j = 0; j < 16; ++j) { const unsigned c = xb_ld(&bar[XB_XCNT(j)]); sum += c; cnt += (c > 0u) ? 1u : 0u; mine = (j == x) ? c : mine; }
        if (sum == G) break;
        __builtin_amdgcn_s_sleep(1);
        if ((++sp & 255u) == 0u) { if (xb_ld(&bar[XB_TMO])) break; if (sp > XB_SPIN_CAP) { atomicAdd(&bar[XB_TMO], 1u); break; } }
    }
    nloc = mine > 0u ? mine : 1u; nx = cnt > 0u ? cnt : 1u;
}

__device__ __forceinline__ void xcd_barrier(const XcdBarrier& b, const int tid_) {
    asm volatile("s_waitcnt vmcnt(0)" ::: "memory");
    __syncthreads();
    if (tid_ == 0) {
        unsigned* bar = b.bar;
        __builtin_amdgcn_s_waitcnt(0);
        unsigned nloc = b.st[0], nx = b.st[1];
        if (nloc == 0u) { xcd_barrier_complete(bar, b.x, nloc, nx); b.st[0] = nloc; b.st[1] = nx; }
        const unsigned old = xb_add(&bar[XB_XSUB(b.x)], 1u);
        const unsigned gen = old / nloc;
        if (old + 1u == (gen + 1u) * nloc) {
            __builtin_amdgcn_fence(__ATOMIC_RELEASE, "agent");
            asm volatile("s_waitcnt vmcnt(0)" ::: "memory");
            const unsigned og = xb_add(&bar[XB_TOP], 1u);
            const unsigned tg = og / nx;
            if (og + 1u == (tg + 1u) * nx) xb_add(&bar[XB_TOPGEN], 1u);
            else XB_SPIN(xb_ld(&bar[XB_TOPGEN]) == tg, bar);
            __builtin_amdgcn_fence(__ATOMIC_ACQUIRE, "agent");
            xb_add(&bar[XB_XGEN(b.x)], 1u);
            asm volatile("s_waitcnt vmcnt(0)" ::: "memory");
        } else {
            XB_SPIN(xb_ld(&bar[XB_XGEN(b.x)]) == gen, bar);
            __builtin_amdgcn_fence(__ATOMIC_ACQUIRE, "agent");
            asm volatile("s_waitcnt vmcnt(0)" ::: "memory");
        }
    }
    __syncthreads();
}

__device__ __forceinline__ int qk_perm_row(int n) {
    if (n >= 1280) return n;
    const int hd = n & ~63, d = n & 63, dd = d & 31;
    return hd + 8 * (dd >> 2) + 4 * (d >> 5) + (dd & 3);
}
template <int MODE>
__device__ __forceinline__ void transpose_item(const float* W, int K, int N, bf16_t* WT, int row_off, LAS float* scr, int item, int lane, const float* s) {
    const int nblk = N / 32, kb = item / nblk, nb = item % nblk, k0 = 64 * kb, n0 = 32 * nb;
#pragma unroll 8
    for (int i = 0; i < 32; ++i) { const int kk = 2 * i + (lane >> 5); float v = W[(size_t)(k0 + kk) * N + n0 + (lane & 31)];
        if (MODE == 2) v *= s[k0 + kk]; if (MODE == 3) v *= 1.0f - s[k0 + kk];
        scr[kk * 33 + (lane & 31)] = v; }
    asm volatile("s_waitcnt lgkmcnt(0)" ::: "memory");
    const int c = lane & 7;
#pragma unroll
    for (int j = 0; j < 4; ++j) { const int n = (lane >> 3) + 8 * j; const LAS float* sp = scr + (8 * c) * 33 + n;
        u32x4 o; o.x = cvt_pk_bf16(sp[0 * 33], sp[1 * 33]); o.y = cvt_pk_bf16(sp[2 * 33], sp[3 * 33]); o.z = cvt_pk_bf16(sp[4 * 33], sp[5 * 33]); o.w = cvt_pk_bf16(sp[6 * 33], sp[7 * 33]);
        const int dn = (MODE == 1) ? qk_perm_row(n0 + n) : (n0 + n);
        *(u32x4*)(WT + (size_t)(row_off + dn) * K + k0 + 8 * c) = o; }
    asm volatile("s_waitcnt lgkmcnt(0)" ::: "memory");
}

struct Args { const float* in[24]; float* out; unsigned char* ws; int ph_lo, ph_hi; };
typedef const __attribute__((address_space(4))) unsigned char* kptr_t;
__device__ __forceinline__ kptr_t kargs() { kptr_t p = (kptr_t)__builtin_amdgcn_kernarg_segment_ptr(); asm volatile("" : "+s"(p)); return p; }
#define GAS __attribute__((address_space(1)))
__device__ __forceinline__ const float* kin(kptr_t p, int i) { return (const float*)(const GAS float*)*(const unsigned long long __attribute__((address_space(4)))*)(p + 8 * i); }
__device__ __forceinline__ float* kout(kptr_t p) { return (float*)(GAS float*)*(const unsigned long long __attribute__((address_space(4)))*)(p + 8 * 24); }
__device__ __forceinline__ unsigned char* kws(kptr_t p) { return (unsigned char*)(GAS unsigned char*)*(const unsigned long long __attribute__((address_space(4)))*)(p + 8 * 25); }

enum { I_X = 0, I_P, I_NORMG, I_AWIN, I_ABIN, I_ASINK, I_AWOUT, I_MU, I_RWIN, I_W0, I_W1, I_W2, I_A0, I_A1, I_A2, I_KK, I_KA, I_RK, I_GNG, I_GNB, I_RWOUT, I_PWP, I_PWG, I_FNG };
__device__ __forceinline__ void p0_prologue(LAS unsigned char* lds, int G, int bid, int tid) {
    kptr_t kp = kargs();
    const int wave = __builtin_amdgcn_readfirstlane(tid >> 6), lane = tid & 63;
    LAS float* scr = (LAS float*)(lds + wave * 16384);
    const int gw = bid * NWAVES + wave, NGW = G * NWAVES;
    unsigned char* ws = kws(kp);
    const float* mu = kin(kp, I_MU);
    constexpr int N1 = 1280, N2 = 512, N5 = 2048, N6 = 128, N7 = 32;
    constexpr int NITEMS = N1 + 4 * N2 + N5 + 2 * N6 + 4 * N7;
    for (int it = gw; it < NITEMS; it += NGW) {
        int r = it;
        if (r < N1) { transpose_item<1>(kin(kp, I_AWIN), 1024, 2560, (bf16_t*)(ws + WS_WQKVZ), 0, scr, r, lane, nullptr); continue; } r -= N1;
        if (r < N2) { transpose_item<0>(kin(kp, I_AWOUT), 1024, 1024, (bf16_t*)(ws + WS_WO0), 0, scr, r, lane, nullptr); continue; } r -= N2;
        if (r < N2) { transpose_item<0>(kin(kp, I_PWG), 1024, 1024, (bf16_t*)(ws + WS_WG0), 0, scr, r, lane, nullptr); continue; } r -= N2;
        if (r < N2) { transpose_item<0>(kin(kp, I_PWG) + 1024 * 1024, 1024, 1024, (bf16_t*)(ws + WS_WG1), 0, scr, r, lane, nullptr); continue; } r -= N2;
        if (r < N2) { transpose_item<0>(kin(kp, I_RWOUT), 1024, 1024, (bf16_t*)(ws + WS_WO1), 0, scr, r, lane, nullptr); continue; } r -= N2;
        if (r < N5) { transpose_item<0>(kin(kp, I_RWIN), 1024, 4096, (bf16_t*)(ws + WS_WR), 0, scr, r, lane, nullptr); continue; } r -= N5;
        if (r < N6) { transpose_item<0>(kin(kp, I_PWP), 256, 1024, (bf16_t*)(ws + WS_WP0), 0, scr, r, lane, nullptr); continue; } r -= N6;
        if (r < N6) { transpose_item<0>(kin(kp, I_PWP) + 256 * 1024, 256, 1024, (bf16_t*)(ws + WS_WP1), 0, scr, r, lane, nullptr); continue; } r -= N6;
        if (r < N7) { transpose_item<3>(kin(kp, I_W1), 1024, 64, (bf16_t*)(ws + WS_WL), 0, scr, r, lane, mu + 4 * 1024); continue; } r -= N7;
        if (r < N7) { transpose_item<2>(kin(kp, I_W1), 1024, 64, (bf16_t*)(ws + WS_WL), 64, scr, r, lane, mu + 4 * 1024); continue; } r -= N7;
        if (r < N7) { transpose_item<3>(kin(kp, I_A1), 1024, 64, (bf16_t*)(ws + WS_WL), 128, scr, r, lane, mu + 5 * 1024); continue; } r -= N7;
        transpose_item<2>(kin(kp, I_A1), 1024, 64, (bf16_t*)(ws + WS_WL), 192, scr, r, lane, mu + 5 * 1024);
    }
    {
        const float* g0 = kin(kp, I_NORMG); bf16_t* XN = (bf16_t*)(ws + WS_S1);
        f32x4 gv[4];
#pragma unroll
        for (int j = 0; j < 4; ++j) gv[j] = *((const f32x4*)g0 + lane + 64 * j);
        const float* xin = kin(kp, I_X);
        f32x4 nx[4];
        if (gw < M) {
#pragma unroll
            for (int j = 0; j < 4; ++j) nx[j] = *((const f32x4*)(xin + (size_t)gw * D) + lane + 64 * j); }
        for (int m = gw; m < M; m += NGW) {
            f32x4 v[4]; float s = 0.f;
#pragma unroll
            for (int j = 0; j < 4; ++j) { v[j] = nx[j]; s += (v[j].x * v[j].x + v[j].y * v[j].y) + (v[j].z * v[j].z + v[j].w * v[j].w); }
            if (m + NGW < M) {
#pragma unroll
                for (int j = 0; j < 4; ++j) nx[j] = *((const f32x4*)(xin + (size_t)(m + NGW) * D) + lane + 64 * j); }
            const float rstd = 1.0f / sqrtf(wave_sum(s) * (1.0f / D) + 1e-6f);
            u32x2* o8 = (u32x2*)(XN + (size_t)m * D) + lane;
#pragma unroll
            for (int j = 0; j < 4; ++j) { const f32x4 o = v[j] * rstd * gv[j]; u32x2 w; w.x = cvt_pk_bf16(o.x, o.y); w.y = cvt_pk_bf16(o.z, o.w); o8[64 * j] = w; }
        }
    }
    const int gt = bid * NTHR + tid, NGT = G * NTHR;
    {
        const f32x4* p4 = (const f32x4*)kin(kp, I_P); u32x4* o = (u32x4*)(ws + WS_PB0);
        for (int i = gt; i < 2 * M * PLE / 8; i += NGT) { const f32x4 x0 = p4[2 * i], x1 = p4[2 * i + 1]; o[i] = pack8(x0, x1); }
    }
    {
        float* cs = (float*)(ws + WS_COS); float* sn = (float*)(ws + WS_SIN);
        for (int i = gt; i < T * 32; i += NGT) {
            const int pos = i >> 5, f = i & 31;
            const float inv = (float)exp2(-(double)f * (13.287712379549449 / 32.0));
            const float ang = (float)pos * inv;
            double rev = (double)ang * 0.15915494309189535; rev -= floor(rev);
            sn[i] = __builtin_amdgcn_sinf((float)rev); cs[i] = __builtin_amdgcn_cosf((float)rev);
        }
    }
    {
        float* bp = (float*)(ws + WS_BIAS);
        for (int i = gt; i < ATT_IN; i += NGT) bp[qk_perm_row(i)] = kin(kp, I_ABIN)[i];
    }
    {
        bf16_t* W2T = (bf16_t*)(ws + WS_W2); const float* w2 = kin(kp, I_W2); const float* a2 = kin(kp, I_A2);
        for (int i = gt; i < 2048 * 128; i += NGT) {
            const int k = i >> 11, nn = i & 2047;
            float v;
            if (nn < 1024) v = (k < 64) ? w2[k * 1024 + nn] : 0.f; else v = (k >= 64) ? a2[(k - 64) * 1024 + (nn - 1024)] : 0.f;
            W2T[(size_t)nn * 128 + k] = (bf16_t)(cvt_pk_bf16(v, 0.f) & 0xffffu);
        }
    }
}

__device__ __forceinline__ void attn_phase(LAS unsigned char* lds, const bf16_t* QKVZ, const float* sinks, bf16_t* OG, int G, int bid, int tid) {
    const int wave = __builtin_amdgcn_readfirstlane(tid >> 6), lane = tid & 63, fr = lane & 15, fq = lane >> 4;
    constexpr int KP = 144, VP = 528;
    LAS unsigned char* Kl = lds; LAS unsigned char* Vt = lds + 256 * KP;
    u32x4 pkv[4], pvv[4];
#define ATT_LOAD(uu) do { const int kvh_ = (uu) & 3, n_ = ((uu) >> 2) & 31, b_ = (uu) >> 7; _Pragma("unroll") for (int i = 0; i < 4; ++i) { \
        const int c_ = tid + 512 * i, key_ = c_ >> 3, ch_ = c_ & 7, t_ = 128 * (n_ - 1) + key_; \
        pkv[i] = (u32x4){0u, 0u, 0u, 0u}; pvv[i] = (u32x4){0u, 0u, 0u, 0u}; \
        if (t_ >= 0) { const bf16_t* rp_ = QKVZ + (size_t)(b_ * T + t_) * ATT_IN + kvh_ * 64 + ch_ * 8; pkv[i] = *(const u32x4*)(rp_ + 1024); pvv[i] = *(const u32x4*)(rp_ + 1280); } } } while (0)
    if (bid < 1024) ATT_LOAD(bid);
    for (int unit = bid; unit < 1024; unit += G) {
        const int kvh = unit & 3, n = (unit >> 2) & 31, b = unit >> 7;
        __syncthreads();
#pragma unroll
        for (int i = 0; i < 4; ++i) {
            const int c = tid + 512 * i, key = c >> 3, ch = c & 7;
            const u32x4 kv = pkv[i], vv = pvv[i];
            *(LAS u32x4*)(Kl + key * KP + ch * 16) = kv;
            LAS unsigned short* vp = (LAS unsigned short*)(Vt + (ch * 8) * VP + ((key ^ (ch << 2)) * 2));
            vp[0 * (VP / 2)] = (unsigned short)(vv.x & 0xffffu); vp[1 * (VP / 2)] = (unsigned short)(vv.x >> 16);
            vp[2 * (VP / 2)] = (unsigned short)(vv.y & 0xffffu); vp[3 * (VP / 2)] = (unsigned short)(vv.y >> 16);
            vp[4 * (VP / 2)] = (unsigned short)(vv.z & 0xffffu); vp[5 * (VP / 2)] = (unsigned short)(vv.z >> 16);
            vp[6 * (VP / 2)] = (unsigned short)(vv.w & 0xffffu); vp[7 * (VP / 2)] = (unsigned short)(vv.w >> 16);
        }
        if (unit + G < 1024) ATT_LOAD(unit + G);
        __syncthreads();
        const int g = wave >> 1, qh = wave & 1, h = kvh * 4 + g;
        const float sink2 = sinks[h] * 1.4426950408889634f;
        for (int mt = 0; mt < 4; ++mt) {
            const int qo0 = qh * 64 + mt * 16;
            const size_t row = (size_t)(b * T + n * 128 + qo0 + fr);
            const bf16_t* qp = QKVZ + row * ATT_IN + h * 64 + fq * 8;
            const bf16x8 q0 = *(const bf16x8*)qp, q1 = *(const bf16x8*)(qp + 32);
            const int kt0 = (qh * 4 + mt) < 6 ? (qh * 4 + mt) : 6;
            f32x4 s[10];
#pragma unroll
            for (int kt = 0; kt < 10; ++kt) {
                const LAS unsigned char* kp = Kl + ((kt0 + kt) * 16 + fr) * KP + fq * 16;
                const bf16x8 k0 = *(const LAS bf16x8*)kp, k1 = *(const LAS bf16x8*)(kp + 64);
                f32x4 acc = (f32x4){0.f, 0.f, 0.f, 0.f};
                acc = __builtin_amdgcn_mfma_f32_16x16x32_bf16(k0, q0, acc, 0, 0, 0);
                acc = __builtin_amdgcn_mfma_f32_16x16x32_bf16(k1, q1, acc, 0, 0, 0);
                s[kt] = acc;
            }
            const int qi = 128 + qo0 + fr;
            float mx = sink2;
#pragma unroll
            for (int kt = 0; kt < 10; ++kt)
#pragma unroll
                for (int r = 0; r < 4; ++r) { const int si = (kt0 + kt) * 16 + 4 * fq + r, df = qi - si; const bool ok = (df >= 0) && (df < 128) && (n > 0 || si >= 128);
                    const float v = ok ? s[kt][r] : -1e30f; s[kt][r] = v; mx = fmaxf(mx, v); }
            mx = fmaxf(mx, __shfl_xor(mx, 16)); mx = fmaxf(mx, __shfl_xor(mx, 32));
            float sum = 0.f;
#pragma unroll
            for (int kt = 0; kt < 10; ++kt)
#pragma unroll
                for (int r = 0; r < 4; ++r) { const float p = __builtin_amdgcn_exp2f(s[kt][r] - mx); s[kt][r] = p; sum += p; }
            sum += __shfl_xor(sum, 16); sum += __shfl_xor(sum, 32);
            sum += __builtin_amdgcn_exp2f(sink2 - mx);
            const float inv = 1.0f / sum;
            f32x4 o[4];
#pragma unroll
            for (int dt = 0; dt < 4; ++dt) o[dt] = (f32x4){0.f, 0.f, 0.f, 0.f};
#pragma unroll
            for (int kk = 0; kk < 5; ++kk) {
                const u32x4 pw = pack8(s[2 * kk], s[2 * kk + 1]);
                const bf16x8 pf = __builtin_bit_cast(bf16x8, pw);
#pragma unroll
                for (int dt = 0; dt < 4; ++dt) {
                    const int d = dt * 16 + fr, sw = ((d >> 3) & 7) << 2, keyA = 16 * (kt0 + 2 * kk) + 4 * fq, keyB = keyA + 16;
                    const u32x2 va = *(const LAS u32x2*)(Vt + d * VP + ((keyA ^ sw) * 2)), vb = *(const LAS u32x2*)(Vt + d * VP + ((keyB ^ sw) * 2));
                    const u32x4 vw = (u32x4){va.x, va.y, vb.x, vb.y};
                    o[dt] = __builtin_amdgcn_mfma_f32_16x16x32_bf16(__builtin_bit_cast(bf16x8, vw), pf, o[dt], 0, 0, 0);
                }
            }
            const bf16_t* zp = QKVZ + row * ATT_IN + 1536 + h * 64 + 4 * fq;
            bf16_t* op = OG + row * D + h * 64 + 4 * fq;
#pragma unroll
            for (int dt = 0; dt < 4; ++dt) {
                const u32x2 zw = *(const u32x2*)(zp + dt * 16);
                const float z0 = bflo(zw.x), z1 = bfhi(zw.x), z2 = bflo(zw.y), z3 = bfhi(zw.y);
                const float r0 = o[dt][0] * inv * z0 * fsigmoid(z0), r1 = o[dt][1] * inv * z1 * fsigmoid(z1), r2 = o[dt][2] * inv * z2 * fsigmoid(z2), r3 = o[dt][3] * inv * z3 * fsigmoid(z3);
                u32x2 w; w.x = cvt_pk_bf16(r0, r1); w.y = cvt_pk_bf16(r2, r3);
                *(u32x2*)(op + dt * 16) = w;
            }
        }
    }
}
template <int ROUND>
__device__ __forceinline__ void lerp_phase(const bf16_t* H1, const float* g1, const float* mu, bf16_t* HN, bf16_t* XS0, bf16_t* XS1, int G, int bid, int tid) {
    const int wave = __builtin_amdgcn_readfirstlane(tid >> 6), lane = tid & 63;
    const int gw = bid * NWAVES + wave, NGW = G * NWAVES;
    const float* mu0 = mu + (ROUND == 0 ? 0 : 2) * 1024; const float* mu1 = mu0 + 1024;
    f32x4 gq[4], m0q[4], m1q[4];
#pragma unroll
    for (int q = 0; q < 4; ++q) { const int col = (q >> 1) * 512 + lane * 8 + 4 * (q & 1); gq[q] = *(const f32x4*)(g1 + col); m0q[q] = *(const f32x4*)(mu0 + col); m1q[q] = *(const f32x4*)(mu1 + col); }
    u32x4 rc_[2], rp_[2];
#define LERP_LOAD(mm) do { const bool hp_ = ((mm) & (T - 1)) != 0; _Pragma("unroll") for (int j = 0; j < 2; ++j) { const size_t off_ = (size_t)(mm) * D + j * 512 + lane * 8; \
        rc_[j] = *(const u32x4*)(H1 + off_); rp_[j] = hp_ ? *(const u32x4*)(H1 + off_ - D) : (u32x4){0u, 0u, 0u, 0u}; } } while (0)
    if (gw < M) LERP_LOAD(gw);
    for (int m = gw; m < M; m += NGW) {
        f32x4 c[4], p[4];
        float sc = 0.f, sp = 0.f;
#pragma unroll
        for (int j = 0; j < 2; ++j) { unpack8(rc_[j], c[2 * j], c[2 * j + 1]); unpack8(rp_[j], p[2 * j], p[2 * j + 1]); }
        if (m + NGW < M) LERP_LOAD(m + NGW);
#pragma unroll
        for (int q = 0; q < 4; ++q) { sc += (c[q].x * c[q].x + c[q].y * c[q].y) + (c[q].z * c[q].z + c[q].w * c[q].w); sp += (p[q].x * p[q].x + p[q].y * p[q].y) + (p[q].z * p[q].z + p[q].w * p[q].w); }
        const float rc = 1.0f / sqrtf(wave_sum(sc) * (1.0f / D) + 1e-6f), rp = 1.0f / sqrtf(wave_sum(sp) * (1.0f / D) + 1e-6f);
#pragma unroll
        for (int j = 0; j < 2; ++j) {
            const int col = j * 512 + lane * 8; const size_t off = (size_t)m * D + col;
            f32x4 hn[2], xx[2], o0[2], o1[2];
#pragma unroll
            for (int e = 0; e < 2; ++e) {
                const f32x4 gv = gq[2 * j + e];
                hn[e] = c[2 * j + e] * rc * gv; xx[e] = p[2 * j + e] * rp * gv - hn[e];
                o0[e] = hn[e] + xx[e] * m0q[2 * j + e];
                o1[e] = hn[e] + xx[e] * m1q[2 * j + e];
            }
            if (ROUND == 0) *(u32x4*)(HN + off) = pack8(hn[0], hn[1]);
            *(u32x4*)(XS0 + off) = pack8(o0[0], o0[1]);
            *(u32x4*)(XS1 + off) = pack8(o1[0], o1[1]);
        }
    }
}
__device__ __forceinline__ void lora_mid_phase(const bf16_t* L, bf16_t* A2, int G, int bid, int tid) {
    const int gt = bid * NTHR + tid, NGT = G * NTHR;
    for (int i = gt; i < M * 16; i += NGT) {
        const int m = i >> 4, ch = i & 15, isA = ch >> 3, c8 = (ch & 7) * 8;
        const bool hasprev = (m & (T - 1)) != 0;
        f32x4 u0, u1, v0 = (f32x4){0.f, 0.f, 0.f, 0.f}, v1 = v0;
        unpack8(*(const u32x4*)(L + (size_t)m * 256 + isA * 128 + c8), u0, u1);
        if (hasprev) unpack8(*(const u32x4*)(L + (size_t)(m - 1) * 256 + isA * 128 + 64 + c8), v0, v1);
        u0 += v0; u1 += v1;
        if (!isA) {
#pragma unroll
            for (int e = 0; e < 4; ++e) { u0[e] = tanhf(u0[e]); u1[e] = tanhf(u1[e]); }
        }
        *(u32x4*)(A2 + (size_t)m * 128 + ch * 8) = pack8(u0, u1);
    }
}
#ifndef MK_SCAN_CHUNKED
#define MK_SCAN_CHUNKED 1
#endif
#if MK_SCAN_CHUNKED
typedef __bf16 ck_bf16x2_t __attribute__((ext_vector_type(2)));
__device__ __forceinline__ unsigned ck_cvt(float lo, float hi) { const f32x2 v = {lo, hi}; return __builtin_bit_cast(unsigned, __builtin_convertvector(v, ck_bf16x2_t)); }
constexpr int CK_RP = 144;
constexpr int CK_TP = 40;
constexpr int CK_ABAR = 0, CK_RBAR = 2304, CK_BTIL = 4608, CK_KTIL = 6912;
constexpr int CK_BT_T = 9216, CK_KT_T = 11776;
constexpr int CK_VT = 14336;
constexpr int CK_GAM = 15616;
constexpr int CK_BUF = 15872;
constexpr int CK_LD = 2 * CK_BUF;
constexpr int CK_PRIV = CK_LD + 2 * 4096;
constexpr int CK_PRIV_SZ = 2560;
__device__ __forceinline__ bf16x8 ck_ld2(const LAS unsigned char* p, int off2) {
    const u32x2 a = *(const LAS u32x2*)p, b = *(const LAS u32x2*)(p + off2); return __builtin_bit_cast(bf16x8, (u32x4){a.x, a.y, b.x, b.y}); }
__device__ __forceinline__ bf16x8 ck_ld1(const LAS unsigned char* p) {
    const u32x2 a = *(const LAS u32x2*)p; return __builtin_bit_cast(bf16x8, (u32x4){a.x, a.y, 0u, 0u}); }
__device__ __forceinline__ bf16x8 ck_pk4(const f32x4 x) { return __builtin_bit_cast(bf16x8, (u32x4){ck_cvt(x[0], x[1]), ck_cvt(x[2], x[3]), 0u, 0u}); }
#define CK_MFMA(a, b, c) __builtin_amdgcn_mfma_f32_16x16x32_bf16((a), (b), (c), 0, 0, 0)

constexpr int CK_STG = CK_PRIV + 2 * CK_PRIV_SZ;
constexpr int CK_STG_SZ = 4 * 4096 + 1024;
__device__ __forceinline__ void scan_phase(LAS unsigned char* lds, const bf16_t* R, const bf16_t* Kb, const bf16_t* V, const bf16_t* WA, const float* k_k, const float* k_a, bf16_t* Y, int G, int bid, int tid) {
    const int wave = __builtin_amdgcn_readfirstlane(tid >> 6), lane = tid & 63, c = lane & 15, g = lane >> 4;
    const int wq = (wave & 1) + ((wave >> 2) << 1);
    const int pid = wq * 64 + lane, pt = (pid >> 4) & 15, pj = pid & 15;
    const int pid1 = tid - 256, pta = (pid1 >> 4) & 7, ptb = pta + 8;
    const bool producer = (wave == 2) || (wave == 3) || (wave >= 6), producer1 = (wave == 4) || (wave == 5), consumer = wave < 2;
    constexpr int NCH = T / 16;
    for (int unit = bid; unit < 256; unit += G) {
        const int b = unit >> 5, h = (unit >> 1) & 15, half = unit & 1;
        const size_t rowbase = (size_t)b * T;
        f32x4 kkw = (f32x4){0.f, 0.f, 0.f, 0.f}, kaw = kkw;
        if (producer1) { kkw = *(const f32x4*)(k_k + h * 64 + 4 * pj); kaw = *(const f32x4*)(k_a + h * 64 + 4 * pj); }
        u32x2 rkA = (u32x2){0u, 0u}, rrA = rkA, raA = rkA, rlA = rkA, rkB = rkA, rrB = rkA, raB = rkA, rlB = rkA; unsigned rvA = 0u, rvB = 0u;
#define CK_LOAD(X, ptx, cn) do { const size_t m_ = rowbase + (size_t)(cn) * 16 + (ptx); \
            rk##X = *(const u32x2*)(Kb + m_ * D + h * 64 + 4 * pj); rr##X = *(const u32x2*)(R + m_ * D + h * 64 + 4 * pj); \
            rl##X = *(const u32x2*)(WA + m_ * 2048 + h * 64 + 4 * pj); ra##X = *(const u32x2*)(WA + m_ * 2048 + 1024 + h * 64 + 4 * pj); \
            rv##X = *(const unsigned*)(V + m_ * D + h * 64 + half * 32 + 2 * pj); } while (0)
#define CK_P1(X, ptx, cn) do { \
            const f32x4 kf_ = (f32x4){bflo(rk##X.x), bfhi(rk##X.x), bflo(rk##X.y), bfhi(rk##X.y)}, af_ = (f32x4){bflo(ra##X.x), bfhi(ra##X.x), bflo(ra##X.y), bfhi(ra##X.y)}; \
            const f32x4 lf_ = (f32x4){bflo(rl##X.x), bfhi(rl##X.x), bflo(rl##X.y), bfhi(rl##X.y)}, rf_ = (f32x4){bflo(rr##X.x), bfhi(rr##X.x), bflo(rr##X.y), bfhi(rr##X.y)}; \
            const f32x4 kv_ = kf_ * kkw; \
            float ss_ = (kv_.x * kv_.x + kv_.y * kv_.y) + (kv_.z * kv_.z + kv_.w * kv_.w); \
            ss_ = row16_sum(ss_); \
            const float invn_ = (ss_ > 1e-24f) ? __builtin_amdgcn_rsqf(ss_) : 1e12f;        \
            const f32x4 kk_ = kv_ * invn_; \
            LAS unsigned char* st_ = lds + CK_STG + ((cn) & 1) * CK_STG_SZ + ((ptx) * 64 + 4 * pj) * 4; \
            *(LAS f32x4*)(st_) = -kk_; *(LAS f32x4*)(st_ + 4096) = kk_ * af_; *(LAS f32x4*)(st_ + 8192) = kf_ * (1.0f + (af_ - 1.0f) * kaw); *(LAS f32x4*)(st_ + 12288) = rf_; \
            *(LAS unsigned*)(lds + CK_STG + ((cn) & 1) * CK_STG_SZ + 16384 + ((ptx) * 16 + pj) * 4) = rv##X; \
            *(LAS f32x4*)(lds + CK_LD + ((cn) & 1) * 4096 + ((ptx) * 64 + 4 * pj) * 4) = lf_; } while (0)
        if (producer1) { CK_LOAD(A, pta, 0); CK_LOAD(B, ptb, 0); CK_P1(A, pta, 0); CK_P1(B, ptb, 0); CK_LOAD(A, pta, 1); CK_LOAD(B, ptb, 1); }
        f32x4 H[4];
#pragma unroll
        for (int kt = 0; kt < 4; ++kt) H[kt] = (f32x4){0.f, 0.f, 0.f, 0.f};
        __syncthreads();
        for (int it = 0; it <= NCH; ++it) {
            if (producer1 && it + 1 < NCH) { CK_P1(A, pta, it + 1); CK_P1(B, ptb, it + 1); if (it + 2 < NCH) { CK_LOAD(A, pta, it + 2); CK_LOAD(B, ptb, it + 2); } }
            if (producer && it < NCH) {
                LAS unsigned char* buf = lds + (it & 1) * CK_BUF;
                const LAS unsigned char* ldp = lds + CK_LD + (it & 1) * 4096 + 16 * pj;
                const LAS unsigned char* stp = lds + CK_STG + (it & 1) * CK_STG_SZ + (pt * 64 + 4 * pj) * 4;
                f32x4 nkk = *(const LAS f32x4*)(stp), be = *(const LAS f32x4*)(stp + 4096), kp = *(const LAS f32x4*)(stp + 8192), rf = *(const LAS f32x4*)(stp + 12288), lf = *(const LAS f32x4*)(ldp + pt * 256);
                unsigned vsave = *(const LAS unsigned*)(lds + CK_STG + (it & 1) * CK_STG_SZ + 16384 + (pt * 16 + pj) * 4);
                asm volatile("" : "+v"(nkk), "+v"(be), "+v"(kp), "+v"(rf), "+v"(lf), "+v"(vsave));
                f32x4 Gc = (f32x4){0.f, 0.f, 0.f, 0.f};
                const int w4 = 4 * wq;
#pragma unroll
                for (int s4 = 0; s4 < 16; s4 += 4) {
                    if (s4 <= w4) {
                        f32x4 x0 = *(const LAS f32x4*)(ldp + (s4 + 0) * 256), x1 = *(const LAS f32x4*)(ldp + (s4 + 1) * 256), x2 = *(const LAS f32x4*)(ldp + (s4 + 2) * 256), x3 = *(const LAS f32x4*)(ldp + (s4 + 3) * 256);
                        asm volatile("" : "+v"(x0), "+v"(x1), "+v"(x2), "+v"(x3));
                        if (s4 < w4) Gc += (x0 + x1) + (x2 + x3);
                        else { const f32x4 z4 = (f32x4){0.f, 0.f, 0.f, 0.f};
                            Gc += (s4 + 0 <= pt) ? x0 : z4; Gc += (s4 + 1 <= pt) ? x1 : z4; Gc += (s4 + 2 <= pt) ? x2 : z4; Gc += (s4 + 3 <= pt) ? x3 : z4; }
                    }
                }
                const f32x4 Gm = Gc - lf;
                f32x4 eA, eR, eN;
#pragma unroll
                for (int e = 0; e < 4; ++e) { eA[e] = __expf(Gm[e]); eR[e] = __expf(Gc[e]); eN[e] = __expf(-Gc[e]); }
                const f32x4 ab = nkk * eA, rb = rf * eR, bt = be * eN, kt_ = kp * eN;
                const unsigned ab0 = ck_cvt(ab.x, ab.y), ab1 = ck_cvt(ab.z, ab.w), rb0 = ck_cvt(rb.x, rb.y), rb1 = ck_cvt(rb.z, rb.w);
                const unsigned bt0 = ck_cvt(bt.x, bt.y), bt1 = ck_cvt(bt.z, bt.w), kt0 = ck_cvt(kt_.x, kt_.y), kt1 = ck_cvt(kt_.z, kt_.w);
                LAS unsigned char* rowp = buf + pt * CK_RP + 64 * (pj >> 3) + 16 * (pj & 3) + 8 * ((pj >> 2) & 1);
                *(LAS u32x2*)(rowp + CK_ABAR) = (u32x2){ab0, ab1}; *(LAS u32x2*)(rowp + CK_RBAR) = (u32x2){rb0, rb1};
                *(LAS u32x2*)(rowp + CK_BTIL) = (u32x2){bt0, bt1}; *(LAS u32x2*)(rowp + CK_KTIL) = (u32x2){kt0, kt1};
                constexpr int TS = CK_TP / 2;
                {
                    const int rrow = lane >> 4;
#define CK_T4(x0, x1, x2, x3) do { auto s0_ = __builtin_amdgcn_permlane32_swap(x0, x2, false, false); auto s1_ = __builtin_amdgcn_permlane32_swap(x1, x3, false, false); \
                        auto t0_ = __builtin_amdgcn_permlane16_swap(s0_[0], s1_[0], false, false); auto t1_ = __builtin_amdgcn_permlane16_swap(s0_[1], s1_[1], false, false); \
                        x0 = t0_[0]; x1 = t0_[1]; x2 = t1_[0]; x3 = t1_[1]; } while (0)
                    unsigned b0_ = __float_as_uint(bt.x), b1_ = __float_as_uint(bt.y), b2_ = __float_as_uint(bt.z), b3_ = __float_as_uint(bt.w);
                    unsigned k0_ = __float_as_uint(kt_.x), k1_ = __float_as_uint(kt_.y), k2_ = __float_as_uint(kt_.z), k3_ = __float_as_uint(kt_.w);
                    CK_T4(b0_, b1_, b2_, b3_); CK_T4(k0_, k1_, k2_, k3_);
#undef CK_T4
                    const int toff = (4 * pj + rrow) * CK_TP + 8 * wq;
                    *(LAS u32x2*)(buf + CK_BT_T + toff) = (u32x2){ck_cvt(__uint_as_float(b0_), __uint_as_float(b1_)), ck_cvt(__uint_as_float(b2_), __uint_as_float(b3_))};
                    *(LAS u32x2*)(buf + CK_KT_T + toff) = (u32x2){ck_cvt(__uint_as_float(k0_), __uint_as_float(k1_)), ck_cvt(__uint_as_float(k2_), __uint_as_float(k3_))};
                }
                LAS unsigned short* vT = (LAS unsigned short*)(buf + CK_VT + (2 * pj) * CK_TP + pt * 2);
                vT[0] = (unsigned short)(vsave & 0xffffu); vT[TS] = (unsigned short)(vsave >> 16);
                if (pt == 15) *(LAS f32x4*)(buf + CK_GAM + 16 * pj) = eR;
            }
            if (consumer && it > 0) {
                const int cn = it - 1;
                const LAS unsigned char* buf = lds + (cn & 1) * CK_BUF;
                LAS unsigned char* priv = lds + CK_PRIV + wave * CK_PRIV_SZ;
                LAS float* AabT = (LAS float*)priv; LAS float* Xch = (LAS float*)(priv + 1024); LAS unsigned char* UT = priv + 2048;
                f32x4 xab = (f32x4){0.f, 0.f, 0.f, 0.f}, xak = xab, xrb = xab, xrk = xab;
                bf16x8 pa[2], pr[2];
#pragma unroll
                for (int ks = 0; ks < 2; ++ks) {
                    const LAS unsigned char* rp = buf + c * CK_RP + 64 * ks + 16 * g;
                    pa[ks] = *(const LAS bf16x8*)(rp + CK_ABAR); pr[ks] = *(const LAS bf16x8*)(rp + CK_RBAR);
                    const bf16x8 pb = *(const LAS bf16x8*)(rp + CK_BTIL), pk = *(const LAS bf16x8*)(rp + CK_KTIL);
                    xab = CK_MFMA(pb, pa[ks], xab); xak = CK_MFMA(pk, pa[ks], xak); xrb = CK_MFMA(pb, pr[ks], xrb); xrk = CK_MFMA(pk, pr[ks], xrk);
                }
#pragma unroll
                for (int r = 0; r < 4; ++r) { const int s = 4 * g + r; if (!(s < c)) { xab[r] = 0.f; xak[r] = 0.f; } if (!(s <= c)) { xrb[r] = 0.f; xrk[r] = 0.f; } }
#pragma unroll
                for (int r = 0; r < 4; ++r) AabT[(4 * g + r) * 16 + c] = xab[r];
                const bf16x8 opak = ck_pk4(xak), oprb = ck_pk4(xrb), oprk = ck_pk4(xrk);
                bf16x8 oph[2];
#pragma unroll
                for (int ks = 0; ks < 2; ++ks) oph[ks] = __builtin_bit_cast(bf16x8, (u32x4){ck_cvt(H[2 * ks][0], H[2 * ks][1]), ck_cvt(H[2 * ks][2], H[2 * ks][3]), ck_cvt(H[2 * ks + 1][0], H[2 * ks + 1][1]), ck_cvt(H[2 * ks + 1][2], H[2 * ks + 1][3])});
                const bf16x8 opv = ck_ld1(buf + CK_VT + (wave * 16 + c) * CK_TP + g * 8);
                f32x4 rhs = (f32x4){0.f, 0.f, 0.f, 0.f};
                rhs = CK_MFMA(pa[0], oph[0], rhs); rhs = CK_MFMA(pa[1], oph[1], rhs); rhs = CK_MFMA(opak, opv, rhs);
                float u[16];
#pragma unroll
                for (int r = 0; r < 4; ++r) {
                    const unsigned a_ = __float_as_uint(rhs[r]);
                    const auto h_ = __builtin_amdgcn_permlane32_swap(a_, a_, false, false);
                    const auto lo_ = __builtin_amdgcn_permlane16_swap(h_[0], h_[0], false, false);
                    const auto hi_ = __builtin_amdgcn_permlane16_swap(h_[1], h_[1], false, false);
                    u[r] = __uint_as_float(lo_[0]); u[4 + r] = __uint_as_float(lo_[1]); u[8 + r] = __uint_as_float(hi_[0]); u[12 + r] = __uint_as_float(hi_[1]);
                }
                asm volatile("s_waitcnt lgkmcnt(0)" ::: "memory");
                f32x4 cw[15][4];
#define CK_COLLD(ss) do { _Pragma("unroll") for (int q_ = ((ss) + 1) / 4; q_ < 4; ++q_) cw[(ss)][q_] = *(const LAS f32x4*)(AabT + (ss) * 16 + 4 * q_); } while (0)
                CK_COLLD(0); CK_COLLD(1);
#pragma unroll
                for (int s = 0; s < 15; ++s) {
                    if (s + 2 < 15) CK_COLLD(s + 2);
                    __builtin_amdgcn_sched_barrier(0);
#pragma unroll
                    for (int t = s + 1; t < 16; ++t) u[t] += cw[s][t >> 2][t & 3] * u[s];
                }
#undef CK_COLLD
                bf16x8 opu;
                { const bool g1 = (g & 1) != 0, g2 = (g & 2) != 0;
                  const float a0 = g1 ? u[4] : u[0], a1 = g1 ? u[5] : u[1], a2 = g1 ? u[6] : u[2], a3 = g1 ? u[7] : u[3];
                  const float b0 = g1 ? u[12] : u[8], b1 = g1 ? u[13] : u[9], b2 = g1 ? u[14] : u[10], b3 = g1 ? u[15] : u[11];
                  opu = __builtin_bit_cast(bf16x8, (u32x4){ck_cvt(g2 ? b0 : a0, g2 ? b1 : a1), ck_cvt(g2 ? b2 : a2, g2 ? b3 : a3), 0u, 0u}); }
                f32x4 yy = (f32x4){0.f, 0.f, 0.f, 0.f};
                yy = CK_MFMA(pr[0], oph[0], yy); yy = CK_MFMA(pr[1], oph[1], yy); yy = CK_MFMA(oprb, opu, yy); yy = CK_MFMA(oprk, opv, yy);
                {
                    bf16_t* yp = Y + (rowbase + (size_t)cn * 16 + 4 * g) * D + h * 64 + half * 32 + wave * 16 + c;
#pragma unroll
                    for (int r = 0; r < 4; ++r) yp[(size_t)r * D] = (bf16_t)(ck_cvt(yy[r], 0.f) & 0xffffu);
                }
#pragma unroll
                for (int kt = 0; kt < 4; ++kt) {
                    const bf16x8 opb = ck_ld1(buf + CK_BT_T + (16 * kt + c) * CK_TP + g * 8), opk = ck_ld1(buf + CK_KT_T + (16 * kt + c) * CK_TP + g * 8);
                    f32x4 hh = H[kt];
                    hh = CK_MFMA(opb, opu, hh); hh = CK_MFMA(opk, opv, hh);
                    H[kt] = hh * *(const LAS f32x4*)(buf + CK_GAM + (16 * kt + 4 * g) * 4);
                }
            }
            __syncthreads();
        }
    }
#undef CK_LOAD
#undef CK_P1
}
#else
constexpr int TC = 32;
constexpr int SC_VEC = TC * 5 * 64 * 4;
constexpr int SC_VP = 36;
constexpr int SC_V = 32 * SC_VP * 4;
constexpr int SC_Y = TC * 32 * 4;
constexpr int SC_BUF = SC_VEC + SC_V + SC_Y;
__device__ __forceinline__ void scan_phase(LAS unsigned char* lds, const bf16_t* R, const bf16_t* Kb, const bf16_t* V, const bf16_t* WA, const float* k_k, const float* k_a, bf16_t* Y, int G, int bid, int tid) {
    const int wave = __builtin_amdgcn_readfirstlane(tid >> 6), lane = tid & 63, rg = lane >> 4, cc = lane & 15;
    const int pt = tid >> 4, pj = tid & 15;
    for (int unit = bid; unit < 256; unit += G) {
        const int b = unit >> 5, h = (unit >> 1) & 15, half = unit & 1;
        const size_t rowbase = (size_t)b * T;
        const f32x4 kkw = *(const f32x4*)(k_k + h * 64 + 4 * pj), kaw = *(const f32x4*)(k_a + h * 64 + 4 * pj);
        f32x2 S01 = (f32x2){0.f, 0.f}, S23 = (f32x2){0.f, 0.f};
        u32x2 rk, rr, ra, rl; unsigned rv;
#define SCAN_LOAD(cn) do { const size_t m_ = rowbase + (size_t)(cn) * TC + pt; \
            rk = *(const u32x2*)(Kb + m_ * D + h * 64 + 4 * pj); rr = *(const u32x2*)(R + m_ * D + h * 64 + 4 * pj); \
            rl = *(const u32x2*)(WA + m_ * 2048 + h * 64 + 4 * pj); ra = *(const u32x2*)(WA + m_ * 2048 + 1024 + h * 64 + 4 * pj); \
            rv = *(const unsigned*)(V + m_ * D + h * 64 + half * 32 + 2 * pj); } while (0)
        SCAN_LOAD(0);
        __syncthreads();
        for (int cn = 0; cn < T / TC; ++cn) {
            LAS unsigned char* buf = lds + (cn & 1) * SC_BUF;
            {
                const f32x4 kf = (f32x4){bflo(rk.x), bfhi(rk.x), bflo(rk.y), bfhi(rk.y)}, af = (f32x4){bflo(ra.x), bfhi(ra.x), bflo(ra.y), bfhi(ra.y)};
                const f32x4 lf = (f32x4){bflo(rl.x), bfhi(rl.x), bflo(rl.y), bfhi(rl.y)}, rf = (f32x4){bflo(rr.x), bfhi(rr.x), bflo(rr.y), bfhi(rr.y)};
                const f32x4 kv = kf * kkw;
                float ss = (kv.x * kv.x + kv.y * kv.y) + (kv.z * kv.z + kv.w * kv.w);
                ss = row16_sum(ss);
                const float invn = 1.0f / fmaxf(sqrtf(ss), 1e-12f);
                const f32x4 kk = kv * invn;
                const f32x4 kp = kf * (1.0f + (af - 1.0f) * kaw);
                f32x4 dd; dd.x = __expf(lf.x); dd.y = __expf(lf.y); dd.z = __expf(lf.z); dd.w = __expf(lf.w);
                LAS f32x4* vp = (LAS f32x4*)(buf + pt * 1280) + pj;
                vp[0] = -kk; vp[16] = dd; vp[32] = kk * af; vp[48] = kp; vp[64] = rf;
                LAS float* vv = (LAS float*)(buf + SC_VEC) + (2 * pj) * SC_VP + pt;
                vv[0] = bflo(rv); vv[SC_VP] = bfhi(rv);
            }
            if (cn + 1 < T / TC) SCAN_LOAD(cn + 1);
            __syncthreads();
            if (cn > 0) {
                const LAS float* yb = (const LAS float*)(lds + ((cn - 1) & 1) * SC_BUF + SC_VEC + SC_V + pt * 128) + 2 * pj;
                const size_t m_ = rowbase + (size_t)(cn - 1) * TC + pt;
                *(unsigned*)(Y + m_ * D + h * 64 + half * 32 + 2 * pj) = cvt_pk_bf16(yb[0], yb[1]);
            }
            const int rloc = wave * 4 + rg;
            LAS float* yrow = (LAS float*)(buf + SC_VEC + SC_V) + rloc;
            const unsigned va0 = (unsigned)(size_t)(buf + cc * 16), ra0 = (unsigned)(size_t)(buf + SC_VEC + rloc * SC_VP * 4);
#define SC_LD5(NK, DD, BE, KP, RF, AR, OFF) do { \
                asm volatile("ds_read_b128 %0, %1 offset:%2" : "=&v"(NK) : "v"(AR), "i"((OFF))); asm volatile("ds_read_b128 %0, %1 offset:%2" : "=&v"(DD) : "v"(AR), "i"((OFF) + 256)); \
                asm volatile("ds_read_b128 %0, %1 offset:%2" : "=&v"(BE) : "v"(AR), "i"((OFF) + 512)); asm volatile("ds_read_b128 %0, %1 offset:%2" : "=&v"(KP) : "v"(AR), "i"((OFF) + 768)); \
                asm volatile("ds_read_b128 %0, %1 offset:%2" : "=&v"(RF) : "v"(AR), "i"((OFF) + 1024)); } while (0)
            f32x4 nk, dd, be, kp, rf, nk1, dd1, be1, kp1, rf1, nk2, dd2, be2, kp2, rf2, vcur, vnxt;
            SC_LD5(nk, dd, be, kp, rf, va0, 0); SC_LD5(nk1, dd1, be1, kp1, rf1, va0, 1280);
            asm volatile("ds_read_b128 %0, %1" : "=&v"(vcur) : "v"(ra0));
            asm volatile("s_waitcnt lgkmcnt(0)" : "+v"(nk), "+v"(dd), "+v"(be), "+v"(kp), "+v"(rf), "+v"(nk1), "+v"(dd1), "+v"(be1), "+v"(kp1), "+v"(rf1), "+v"(vcur));
            vnxt = vcur;
            float sa;
            { f32x2 pa = S01 * (f32x2){nk.x, nk.y}; pa = S23 * (f32x2){nk.z, nk.w} + pa; sa = row16_sum(pa.x + pa.y); }
            float ykeep = 0.f;
#define SC_STEP(J, VSEL, LDV, VOFF, WAITN) do { \
                SC_LD5(nk2, dd2, be2, kp2, rf2, va8, ((J) + 2) * 1280); \
                if (LDV) asm volatile("ds_read_b128 %0, %1 offset:%2" : "=&v"(vnxt) : "v"(ra8), "i"((VOFF))); \
                asm volatile("s_waitcnt lgkmcnt(" #WAITN ")" : "+v"(nk1), "+v"(dd1), "+v"(be1), "+v"(kp1), "+v"(rf1)); \
                const float vv_ = (VSEL); \
                S01 = S01 * (f32x2){dd.x, dd.y} + (f32x2){be.x, be.y} * sa + (f32x2){kp.x, kp.y} * vv_; \
                S23 = S23 * (f32x2){dd.z, dd.w} + (f32x2){be.z, be.w} * sa + (f32x2){kp.z, kp.w} * vv_; \
                f32x2 pa_ = S01 * (f32x2){nk1.x, nk1.y}; pa_ = S23 * (f32x2){nk1.z, nk1.w} + pa_; \
                f32x2 py_ = S01 * (f32x2){rf.x, rf.y}; py_ = S23 * (f32x2){rf.z, rf.w} + py_; \
                float y_ = py_.x + py_.y, a2_ = pa_.x + pa_.y; \
                y_ = DPP_XADD(y_, 0xB1); a2_ = DPP_XADD(a2_, 0xB1); y_ = DPP_XADD(y_, 0x4E); a2_ = DPP_XADD(a2_, 0x4E); \
                y_ = DPP_XADD(y_, 0x141); a2_ = DPP_XADD(a2_, 0x141); y_ = DPP_XADD(y_, 0x140); a2_ = DPP_XADD(a2_, 0x140); \
                sa = a2_; \
                ykeep = __builtin_bit_cast(float, __builtin_amdgcn_update_dpp(__builtin_bit_cast(int, y_), __builtin_bit_cast(int, ykeep), 0x111, 0xF, 0xF, false));   \
                nk = nk1; dd = dd1; be = be1; kp = kp1; rf = rf1; nk1 = nk2; dd1 = dd2; be1 = be2; kp1 = kp2; rf1 = rf2; } while (0)
#pragma unroll 1
            for (int t8 = 0; t8 < TC; t8 += 8) {
                const unsigned va8 = va0 + (unsigned)t8 * 1280u, ra8 = ra0 + (unsigned)t8 * 4u;
                SC_STEP(0, vcur.x, 0, 0, 5); SC_STEP(1, vcur.y, 0, 0, 5); SC_STEP(2, vcur.z, 1, 16, 6); SC_STEP(3, vcur.w, 0, 0, 5);
                asm volatile("" : "+v"(vnxt)); vcur = vnxt;
                SC_STEP(4, vcur.x, 0, 0, 5); SC_STEP(5, vcur.y, 0, 0, 5); SC_STEP(6, vcur.z, 1, 32, 6); SC_STEP(7, vcur.w, 0, 0, 5);
                asm volatile("" : "+v"(vnxt)); vcur = vnxt;
                if (t8 & 8) yrow[(t8 + 7 - cc) * 32] = ykeep;
            }
            asm volatile("s_waitcnt lgkmcnt(0)" ::: "memory");
#undef SC_STEP
#undef SC_LD5
        }
        __syncthreads();
        {
            const int cn = T / TC;
            const LAS float* yb = (const LAS float*)(lds + ((cn - 1) & 1) * SC_BUF + SC_VEC + SC_V + pt * 128) + 2 * pj;
            const size_t m_ = rowbase + (size_t)(cn - 1) * TC + pt;
            *(unsigned*)(Y + m_ * D + h * 64 + half * 32 + 2 * pj) = cvt_pk_bf16(yb[0], yb[1]);
        }
        __syncthreads();
    }
#undef SCAN_LOAD
}
#endif
__device__ __forceinline__ void gn_phase(bf16_t* Y, const bf16_t* R, const bf16_t* Kb, const bf16_t* V, const bf16_t* Z, const bf16_t* WA, const float* k_a, const float* r_k, const float* gn_g, const float* gn_b, int G, int bid, int tid) {
    const int wave = __builtin_amdgcn_readfirstlane(tid >> 6), lane = tid & 63;
    const int gw = bid * NWAVES + wave, NGW = G * NWAVES;
    const int col = lane * 16;
    f32x4 kaq[4], rkq[4], ggq[4], gbq[4];
#pragma unroll
    for (int q = 0; q < 4; ++q) { kaq[q] = *(const f32x4*)(k_a + col + 4 * q); rkq[q] = *(const f32x4*)(r_k + col + 4 * q); ggq[q] = *(const f32x4*)(gn_g + col + 4 * q); gbq[q] = *(const f32x4*)(gn_b + col + 4 * q); }
    u32x4 ry_[2], rr_[2], rk_[2], rv_[2], rz_[2], ra_[2];
#define GN_LOAD(mm) do { const size_t off_ = (size_t)(mm) * D + col; _Pragma("unroll") for (int j = 0; j < 2; ++j) { ry_[j] = *(const u32x4*)(Y + off_ + 8 * j); rr_[j] = *(const u32x4*)(R + off_ + 8 * j); \
        rk_[j] = *(const u32x4*)(Kb + off_ + 8 * j); rv_[j] = *(const u32x4*)(V + off_ + 8 * j); rz_[j] = *(const u32x4*)(Z + off_ + 8 * j); ra_[j] = *(const u32x4*)(WA + (size_t)(mm) * 2048 + 1024 + col + 8 * j); } } while (0)
    if (gw < M) GN_LOAD(gw);
    for (int m = gw; m < M; m += NGW) {
        const size_t off = (size_t)m * D + col;
        f32x4 y[4], r[4], k[4], v[4], z[4], aa[4];
#pragma unroll
        for (int j = 0; j < 2; ++j) { unpack8(ry_[j], y[2 * j], y[2 * j + 1]); unpack8(rr_[j], r[2 * j], r[2 * j + 1]); unpack8(rk_[j], k[2 * j], k[2 * j + 1]);
            unpack8(rv_[j], v[2 * j], v[2 * j + 1]); unpack8(rz_[j], z[2 * j], z[2 * j + 1]); unpack8(ra_[j], aa[2 * j], aa[2 * j + 1]); }
        if (m + NGW < M) GN_LOAD(m + NGW);
        float s = 0.f, bs = 0.f;
#pragma unroll
        for (int q = 0; q < 4; ++q) {
            s += (y[q].x + y[q].y) + (y[q].z + y[q].w);
            const f32x4 kp = k[q] * (1.0f + (aa[q] - 1.0f) * kaq[q]);
            const f32x4 t = r[q] * kp * rkq[q];
            bs += (t.x + t.y) + (t.z + t.w);
        }
        s += __shfl_xor(s, 1); s += __shfl_xor(s, 2); bs += __shfl_xor(bs, 1); bs += __shfl_xor(bs, 2);
        const float mean = s * (1.0f / 64.0f);
        float q2 = 0.f;
#pragma unroll
        for (int q = 0; q < 4; ++q) { const f32x4 dlt = y[q] - mean; q2 += (dlt.x * dlt.x + dlt.y * dlt.y) + (dlt.z * dlt.z + dlt.w * dlt.w); }
        q2 += __shfl_xor(q2, 1); q2 += __shfl_xor(q2, 2);
        const float rstd = 1.0f / sqrtf(q2 * (1.0f / 64.0f) + 64e-5f);
        f32x4 o[4];
#pragma unroll
        for (int q = 0; q < 4; ++q) {
            const f32x4 yn = (y[q] - mean) * rstd * ggq[q] + gbq[q] + bs * v[q];
#pragma unroll
            for (int e = 0; e < 4; ++e) o[q][e] = yn[e] * z[q][e] * fsigmoid(z[q][e]);
        }
        *(u32x4*)(Y + off) = pack8(o[0], o[1]); *(u32x4*)(Y + off + 8) = pack8(o[2], o[3]);
    }
}
__device__ __forceinline__ void final_norm_phase(const bf16_t* H2, float* out, const float* g, int G, int bid, int tid) {
    const int wave = __builtin_amdgcn_readfirstlane(tid >> 6), lane = tid & 63;
    const int gw = bid * NWAVES + wave, NGW = G * NWAVES;
    f32x4 gv[4];
#pragma unroll
    for (int j = 0; j < 2; ++j) { gv[2 * j] = *(const f32x4*)(g + j * 512 + lane * 8); gv[2 * j + 1] = *(const f32x4*)(g + j * 512 + lane * 8 + 4); }
    u32x4 rh_[2];
    if (gw < M) { rh_[0] = *(const u32x4*)(H2 + (size_t)gw * D + lane * 8); rh_[1] = *(const u32x4*)(H2 + (size_t)gw * D + 512 + lane * 8); }
    for (int m = gw; m < M; m += NGW) {
        f32x4 v[4]; float s = 0.f;
        unpack8(rh_[0], v[0], v[1]); unpack8(rh_[1], v[2], v[3]);
        if (m + NGW < M) { rh_[0] = *(const u32x4*)(H2 + (size_t)(m + NGW) * D + lane * 8); rh_[1] = *(const u32x4*)(H2 + (size_t)(m + NGW) * D + 512 + lane * 8); }
#pragma unroll
        for (int q = 0; q < 4; ++q) s += (v[q].x * v[q].x + v[q].y * v[q].y) + (v[q].z * v[q].z + v[q].w * v[q].w);
        const float rstd = 1.0f / sqrtf(wave_sum(s) * (1.0f / D) + 1e-6f);
#pragma unroll
        for (int j = 0; j < 2; ++j) { float* o = out + (size_t)m * D + j * 512 + lane * 8; *(f32x4*)o = v[2 * j] * rstd * gv[2 * j]; *(f32x4*)(o + 4) = v[2 * j + 1] * rstd * gv[2 * j + 1]; }
    }
}
#ifndef MK_PER_PHASE
#define MK_PER_PHASE 0
#endif
constexpr int NPHASE = 15;
#ifndef MK_REP_PHASE
#define MK_REP_PHASE -1
#endif
#ifndef MK_REP_N
#define MK_REP_N 2
#endif
#define REPS(k) ((k) == MK_REP_PHASE ? MK_REP_N : 1)

__global__ void __launch_bounds__(NTHR, 2) hybrid_fwd(Args a) {
    extern __shared__ __attribute__((aligned(16))) unsigned char lds_raw[];
    LAS unsigned char* lds = (LAS unsigned char*)lds_raw;
    cg::grid_group grid = cg::this_grid();
    const int wave_s = __builtin_amdgcn_readfirstlane((int)threadIdx.x >> 6);
    const int bid = blockIdx.x, G = gridDim.x;
#define TID() int lane_v_; asm volatile("v_mbcnt_lo_u32_b32 %0, -1, 0\n\tv_mbcnt_hi_u32_b32 %0, -1, %0" : "=v"(lane_v_)); const int tid = wave_s * 64 + lane_v_
    { TID(); if (tid < 16) ((LAS unsigned*)(lds + LDS_BYTES - 64))[tid] = 0u; __syncthreads();
#if !MK_PER_PHASE
      kptr_t kpb = kargs(); (void)xcd_barrier_post((unsigned*)(kws(kpb) + WS_CTL), (volatile LAS unsigned*)(lds + LDS_BYTES - 64), tid);
#endif
    }
    int lo, hi; { kptr_t kp0 = kargs(); lo = *(const int __attribute__((address_space(4)))*)(kp0 + 8 * 26); hi = *(const int __attribute__((address_space(4)))*)(kp0 + 8 * 26 + 4); }
#ifndef PH_MASK
#define PH_MASK 0x7fff
#endif
#define IN(k) (((PH_MASK >> (k)) & 1) && lo <= (k) && (k) < hi)
#define SEAM(k) do { if (IN(k) && IN((k) + 1)) { if ((k) == 0) grid.sync(); else { TID(); kptr_t kpb = kargs(); XcdBarrier xb_; xb_.bar = (unsigned*)(kws(kpb) + WS_CTL); xb_.x = xb_xcc_id(); xb_.st = (volatile LAS unsigned*)(lds + LDS_BYTES - 64); xcd_barrier(xb_, tid); } } } while (0)
#define PTRS() kptr_t kp = kargs(); unsigned char* ws = kws(kp); (void)ws
#define S1 ((bf16_t*)(ws + WS_S1))
#define S2 ((bf16_t*)(ws + WS_S2))
#define S3 ((bf16_t*)(ws + WS_S3))
#define S4 ((bf16_t*)(ws + WS_S4))
#define QKVZ ((bf16_t*)(ws + WS_QKVZ))
#define XS0 ((bf16_t*)(ws + WS_XS0))
#define XS1 ((bf16_t*)(ws + WS_XS1))
#define WAb ((bf16_t*)(ws + WS_WA))
#define A2 ((bf16_t*)(ws + WS_A2))
#define Lb ((bf16_t*)(ws + WS_L))
#define Kr ((bf16_t*)kout(kp))
#define Vr ((bf16_t*)kout(kp) + (size_t)M * D)
#define WR ((const bf16_t*)(ws + WS_WR))

    if (IN(0)) for (int rep_ = 0; rep_ < REPS(0); ++rep_) { TID(); p0_prologue(lds, G, bid, tid); }
    SEAM(0);
    if (IN(1)) for (int rep_ = 0; rep_ < REPS(1); ++rep_) { TID(); PTRS();
        { pg8::Gemm g{S1, (const bf16_t*)(ws + WS_WQKVZ), M, ATT_IN, D}; pg8::StaticOrder S; S.init(M, ATT_IN, G, bid);
          pg8::EpiQKVZ E{QKVZ, (const float*)(ws + WS_BIAS), (const float*)(ws + WS_COS), (const float*)(ws + WS_SIN)};
          pg8::gemm_phase<pg8::EpiQKVZ, pg8::StaticOrder, true, true>(lds, g, S, E, tid); }
        __syncthreads();
        { pg8::Gemm g{(const bf16_t*)(ws + WS_PB0), (const bf16_t*)(ws + WS_WP0), M, D, PLE}; pg8::StaticOrder S; S.init(M, D, G, bid);
          pg8::EpiStore E{S2, D};
          pg8::gemm_phase<pg8::EpiStore, pg8::StaticOrder, true, true>(lds, g, S, E, tid); }
    }
    SEAM(1);
    if (IN(2)) for (int rep_ = 0; rep_ < REPS(2); ++rep_) { TID(); PTRS(); attn_phase(lds, QKVZ, kin(kp, I_ASINK), S1, G, bid, tid); }
    SEAM(2);
    if (IN(3)) for (int rep_ = 0; rep_ < REPS(3); ++rep_) { TID(); PTRS();
        pg8::Gemm g{S1, (const bf16_t*)(ws + WS_WO0), M, D, D}; pg8::StaticOrder S; S.init(M, D, G, bid);
        pg8::EpiRes<false> E{(const void*)kin(kp, I_X), S3};
        pg8::gemm_phase<pg8::EpiRes<false>, pg8::StaticOrder, true, true>(lds, g, S, E, tid);
    }
    SEAM(3);
    if (IN(4)) for (int rep_ = 0; rep_ < REPS(4); ++rep_) { TID(); PTRS();
        pg8::Gemm g{S3, (const bf16_t*)(ws + WS_WG0), M, D, D}; pg8::StaticOrder S; S.init(M, D, G, bid);
        pg8::EpiGate<false> E{S3, S2, (void*)S4};
        pg8::gemm_phase<pg8::EpiGate<false>, pg8::StaticOrder, true, true>(lds, g, S, E, tid);
    }
    SEAM(4);
    if (IN(5)) for (int rep_ = 0; rep_ < REPS(5); ++rep_) { TID(); PTRS(); lerp_phase<0>(S4, kin(kp, I_NORMG) + D, kin(kp, I_MU), S1, XS0, XS1, G, bid, tid); }
    SEAM(5);
    if (IN(6)) for (int rep_ = 0; rep_ < REPS(6); ++rep_) { TID(); PTRS();
        { pg8::Gemm g{XS0, WR, M, 2 * D, D, XS1, 4}; pg8::StaticOrder S; S.init(M, 2 * D, G, bid); pg8::EpiStore2 E{S3, Kr, 4, D};
          pg8::gemm_phase<pg8::EpiStore2, pg8::StaticOrder, true, true>(lds, g, S, E, tid); }
        __syncthreads();
        { pg8::Gemm g{S1, (const bf16_t*)(ws + WS_WL), M, 256, D}; pg8::StaticOrder S; S.init(M, 256, G, bid); pg8::EpiStore E{Lb, 256};
          pg8::gemm_phase<pg8::EpiStore, pg8::StaticOrder, true, true>(lds, g, S, E, tid); }
    }
    SEAM(6);
    if (IN(7)) for (int rep_ = 0; rep_ < REPS(7); ++rep_) { TID(); PTRS(); lerp_phase<1>(S4, kin(kp, I_NORMG) + D, kin(kp, I_MU), nullptr, XS0, XS1, G, bid, tid); lora_mid_phase(Lb, A2, G, bid, tid); }
    SEAM(7);
    if (IN(8)) for (int rep_ = 0; rep_ < REPS(8); ++rep_) { TID(); PTRS();
        { pg8::Gemm g{XS0, WR + (size_t)2 * D * D, M, 2 * D, D, XS1, 4}; pg8::StaticOrder S; S.init(M, 2 * D, G, bid); pg8::EpiStore2 E{Vr, S2, 4, D};
          pg8::gemm_phase<pg8::EpiStore2, pg8::StaticOrder, true, true>(lds, g, S, E, tid); }
    }
    SEAM(8);
    if (IN(9)) for (int rep_ = 0; rep_ < REPS(9); ++rep_) { TID(); PTRS();
        pg8::Gemm g{A2, (const bf16_t*)(ws + WS_W2), M, 2048, 128}; pg8::StaticOrder S; S.init(M, 2048, G, bid);
        pg8::EpiWA E{WAb, kin(kp, I_W0), kin(kp, I_A0)};
        pg8::gemm_phase<pg8::EpiWA, pg8::StaticOrder, true, true>(lds, g, S, E, tid);
    }
    SEAM(9);
    if (IN(10)) for (int rep_ = 0; rep_ < REPS(10); ++rep_) { TID(); PTRS(); scan_phase(lds, S3, Kr, Vr, WAb, kin(kp, I_KK), kin(kp, I_KA), S1, G, bid, tid); }
    SEAM(10);
    if (IN(11)) for (int rep_ = 0; rep_ < REPS(11); ++rep_) { TID(); PTRS(); gn_phase(S1, S3, Kr, Vr, S2, WAb, kin(kp, I_KA), kin(kp, I_RK), kin(kp, I_GNG), kin(kp, I_GNB), G, bid, tid); }
    SEAM(11);
    if (IN(12)) for (int rep_ = 0; rep_ < REPS(12); ++rep_) { TID(); PTRS();
        { pg8::Gemm g{S1, (const bf16_t*)(ws + WS_WO1), M, D, D}; pg8::StaticOrder S; S.init(M, D, G, bid); pg8::EpiRes<true> E{(const void*)S4, S3};
          pg8::gemm_phase<pg8::EpiRes<true>, pg8::StaticOrder, true, true>(lds, g, S, E, tid); }
        __syncthreads();
        { pg8::Gemm g{(const bf16_t*)(ws + WS_PB1), (const bf16_t*)(ws + WS_WP1), M, D, PLE}; pg8::StaticOrder S; S.init(M, D, G, bid); pg8::EpiStore E{S2, D};
          pg8::gemm_phase<pg8::EpiStore, pg8::StaticOrder, true, true>(lds, g, S, E, tid); }
    }
    SEAM(12);
    if (IN(13)) for (int rep_ = 0; rep_ < REPS(13); ++rep_) { TID(); PTRS();
        pg8::Gemm g{S3, (const bf16_t*)(ws + WS_WG1), M, D, D}; pg8::StaticOrder S; S.init(M, D, G, bid);
        pg8::EpiGate<false> E{S3, S2, (void*)S1};
        pg8::gemm_phase<pg8::EpiGate<false>, pg8::StaticOrder, true, true>(lds, g, S, E, tid);
    }
    SEAM(13);
    if (IN(14)) for (int rep_ = 0; rep_ < REPS(14); ++rep_) { TID(); PTRS(); final_norm_phase(S1, kout(kp), kin(kp, I_FNG), G, bid, tid); }
#undef IN
#undef SEAM
}

extern "C" void kernel_launch(void* const* d_in, const int* in_sizes, int n_in, void* d_out, int out_size, void* d_ws, size_t ws_size, hipStream_t stream) {
    static int grid = 0;
    if (grid == 0) {
        if (n_in != 24 || out_size != M * D || ws_size < WS_END) { fprintf(stderr, "kernel_launch: unexpected shapes (n_in %d, out %d, ws %zu)\n", n_in, out_size, ws_size); grid = -1; return; }
        int dev = 0, cus = 0, per_cu = 0;
        (void)hipGetDevice(&dev); (void)hipDeviceGetAttribute(&cus, hipDeviceAttributeMultiprocessorCount, dev);
        if (hipFuncSetAttribute((const void*)hybrid_fwd, hipFuncAttributeMaxDynamicSharedMemorySize, LDS_BYTES) != hipSuccess) { fprintf(stderr, "kernel_launch: hipFuncSetAttribute failed\n"); grid = -1; return; }
        if (hipOccupancyMaxActiveBlocksPerMultiprocessor(&per_cu, (const void*)hybrid_fwd, NTHR, LDS_BYTES) != hipSuccess || per_cu < 1) { fprintf(stderr, "kernel_launch: occupancy query reports %d\n", per_cu); per_cu = 1; }
        (void)hipGetLastError();
        grid = cus > 0 ? cus : 256;
    }
    if (grid < 0) return;
    Args a{};
    for (int i = 0; i < 24; ++i) a.in[i] = (const float*)d_in[i];
    a.out = (float*)d_out; a.ws = (unsigned char*)d_ws;
#if MK_PER_PHASE
    for (int ph = 0; ph < NPHASE; ++ph) { a.ph_lo = ph; a.ph_hi = ph + 1; hipLaunchKernelGGL(hybrid_fwd, dim3(grid), dim3(NTHR), LDS_BYTES, stream, a); }
#else
    a.ph_lo = 0; a.ph_hi = NPHASE;
    (void)hipMemsetAsync((unsigned char*)d_ws + WS_CTL, 0, 16384, stream);
    void* args[] = {&a};
    hipError_t e = hipLaunchCooperativeKernel((const void*)hybrid_fwd, dim3(grid), dim3(NTHR), args, LDS_BYTES, stream);
    if (e != hipSuccess) fprintf(stderr, "cooperative launch failed: %s (grid %d)\n", hipGetErrorString(e), grid);
#endif
}
```

```cpp
#include <hip/hip_runtime.h>
#include <hip/hip_cooperative_groups.h>
#include <cstdio>
#include <cstdint>
namespace cg = cooperative_groups;
namespace pg8 {
#define PG8_LAS __attribute__((address_space(3)))
typedef unsigned short bf16_t;
typedef short bf16x8 __attribute__((ext_vector_type(8)));
typedef float f32x4 __attribute__((ext_vector_type(4)));
typedef unsigned u32x4 __attribute__((ext_vector_type(4)));
constexpr int BM = 256, BK = 64, HALF = 128, HTB = HALF * BK * 2  , STAGE_BYTES = 8 * HTB, NXCD = 8, WGM = 12;

__host__ __device__ __forceinline__ int lds_byte(int r, int c) { const int st = (r >> 4) * 2 + (c >> 5), rr = r & 15, cc = c & 31, ob = rr * 64 + cc * 2; return st * 1024 + (ob ^ (((ob >> 9) & 1) << 5)); }
__host__ __device__ __forceinline__ void stage_rc(int b, int& R, int& C) { const int st = b / 1024, sb = b % 1024, swz = sb ^ (((sb >> 9) & 1) << 5); R = (st >> 1) * 16 + swz / 64; C = (st & 1) * 32 + (swz % 64) / 2; }
__host__ __device__ __forceinline__ int perm32(int rho) { const int n = rho >> 4, i = rho & 15; return 8 * (i >> 2) + 4 * n + (i & 3); }

struct Unit { int pm, pn; };
struct Gemm { const bf16_t* A; const bf16_t* Bt; int M, N, K; const bf16_t* A2 = nullptr; int nsplit = 1 << 30;
    __host__ __device__ __forceinline__ const bf16_t* asel(int pn) const { return pn < nsplit ? A : A2; } };

struct StaticOrder {
    int nM, nN, nwg, G, c;
    __host__ __device__ void init(int M, int N, int G_, int c_) { nM = M / BM; nN = N / BM; nwg = nM * nN; G = G_; c = c_; }
    __host__ __device__ bool next(int i, Unit& u) const {
        const long L = (long)i * G + c; if (L >= nwg) return false;
        int wgid = (int)L; { const int q = nwg / NXCD, r = nwg % NXCD, xcd = wgid % NXCD, off = wgid / NXCD; wgid = (xcd < r ? xcd * (q + 1) : r * (q + 1) + (xcd - r) * q) + off; }
        const int nig = WGM * nN, gid = wgid / nig, fm = gid * WGM, gsz = (nM - fm) < WGM ? (nM - fm) : WGM;
        u.pm = fm + ((wgid % nig) % gsz); u.pn = (wgid % nig) / gsz; return true;
    }
    __device__ __forceinline__ void a_ready(const Unit&) const {}
    __device__ __forceinline__ void done(const Unit&) const {}
};

__device__ __forceinline__ unsigned cvt_pk_bf16(float lo, float hi) { unsigned r; asm volatile("v_cvt_pk_bf16_f32 %0, %1, %2" : "=v"(r) : "v"(lo), "v"(hi)); return r; }
typedef float f32x2 __attribute__((ext_vector_type(2)));
__device__ __forceinline__ float bf2f(unsigned short b) { return __uint_as_float((unsigned)b << 16); }
__device__ __forceinline__ float bflo(unsigned w) { return __uint_as_float(w << 16); }
__device__ __forceinline__ float bfhi(unsigned w) { return __uint_as_float(w & 0xffff0000u); }
__device__ __forceinline__ float fsigmoid(float x) { return __builtin_amdgcn_rcpf(1.0f + __expf(-x)); }
__device__ __forceinline__ u32x4 pack8(const f32x4 a, const f32x4 b) { u32x4 w; w.x = cvt_pk_bf16(a[0], a[1]); w.y = cvt_pk_bf16(a[2], a[3]); w.z = cvt_pk_bf16(b[0], b[1]); w.w = cvt_pk_bf16(b[2], b[3]); return w; }
__device__ __forceinline__ void unpack8(const u32x4 w, f32x4& a, f32x4& b) { a = (f32x4){bflo(w.x), bfhi(w.x), bflo(w.y), bfhi(w.y)}; b = (f32x4){bflo(w.z), bfhi(w.z), bflo(w.w), bfhi(w.w)}; }

constexpr float QSCALE = 0.125f * 1.4426950408889634f;

struct EpiQKVZ {
    static constexpr bool PERM = true, AFTER_DRAIN = false;
    bf16_t* O; const float* bias; const float* cs; const float* sn;
    __device__ __forceinline__ void operator()(const f32x4 (&acc)[2][2][4][2], const Unit& u, int wr, int wc, int fr, int fq) const {
        const int row0 = u.pm * BM + wr * 64 + fr, col0 = u.pn * BM + wc * 32 + 8 * fq;
        const bool rope = u.pn < 5; const float sc = u.pn < 4 ? QSCALE : 1.0f;
        const int j4 = 4 * (4 * (wc & 1) + fq);
#pragma unroll
        for (int ai = 0; ai < 2; ++ai)
#pragma unroll
            for (int m = 0; m < 4; ++m) {
                const int row = row0 + ai * HALF + m * 16, pos = row & 4095;
                f32x4 c = (f32x4){1.f, 1.f, 1.f, 1.f}, s = (f32x4){0.f, 0.f, 0.f, 0.f};
                if (rope) { c = *(const f32x4*)(cs + pos * 32 + j4); s = *(const f32x4*)(sn + pos * 32 + j4); }
                bf16_t* rowp = O + (size_t)row * 2560 + col0;
#pragma unroll
                for (int bj = 0; bj < 2; ++bj) {
                    const f32x4 v0 = acc[ai][bj][m][0] + *(const f32x4*)(bias + col0 + bj * HALF), v1 = acc[ai][bj][m][1] + *(const f32x4*)(bias + col0 + bj * HALF + 4);
                    f32x4 o0 = v0, o1 = v1;
                    o0 = (v0 * c - v1 * s) * sc; o1 = (v1 * c + v0 * s) * sc;
                    *(u32x4*)(rowp + bj * HALF) = pack8(o0, o1);
                }
            }
    }
};
struct EpiStore {
    static constexpr bool PERM = true, AFTER_DRAIN = false;
    bf16_t* O; int ldc;
    __device__ __forceinline__ void operator()(const f32x4 (&acc)[2][2][4][2], const Unit& u, int wr, int wc, int fr, int fq) const {
        const int row0 = u.pm * BM + wr * 64 + fr, col0 = u.pn * BM + wc * 32 + 8 * fq;
#pragma unroll
        for (int ai = 0; ai < 2; ++ai)
#pragma unroll
            for (int m = 0; m < 4; ++m) { bf16_t* rowp = O + (size_t)(row0 + ai * HALF + m * 16) * ldc + col0;
#pragma unroll
                for (int bj = 0; bj < 2; ++bj) *(u32x4*)(rowp + bj * HALF) = pack8(acc[ai][bj][m][0], acc[ai][bj][m][1]); }
    }
};
struct EpiStore2 {
    static constexpr bool PERM = true, AFTER_DRAIN = false;
    bf16_t* O1; bf16_t* O2; int nsplit; int ldc;
    __device__ __forceinline__ void operator()(const f32x4 (&acc)[2][2][4][2], const Unit& u, int wr, int wc, int fr, int fq) const {
        const bool first = u.pn < nsplit; bf16_t* O = first ? O1 : O2;
        const int row0 = u.pm * BM + wr * 64 + fr, col0 = (first ? u.pn : u.pn - nsplit) * BM + wc * 32 + 8 * fq;
#pragma unroll
        for (int ai = 0; ai < 2; ++ai)
#pragma unroll
            for (int m = 0; m < 4; ++m) { bf16_t* rowp = O + (size_t)(row0 + ai * HALF + m * 16) * ldc + col0;
#pragma unroll
                for (int bj = 0; bj < 2; ++bj) *(u32x4*)(rowp + bj * HALF) = pack8(acc[ai][bj][m][0], acc[ai][bj][m][1]); }
    }
};
template <bool BF> struct EpiRes {
    static constexpr bool PERM = true, AFTER_DRAIN = false;
    const void* base; bf16_t* O;
    __device__ __forceinline__ void operator()(const f32x4 (&acc)[2][2][4][2], const Unit& u, int wr, int wc, int fr, int fq) const {
        const int row0 = u.pm * BM + wr * 64 + fr, col0 = u.pn * BM + wc * 32 + 8 * fq;
#pragma unroll
        for (int ai = 0; ai < 2; ++ai)
#pragma unroll
            for (int m = 0; m < 4; ++m) { const size_t off = (size_t)(row0 + ai * HALF + m * 16) * 1024 + col0;
#pragma unroll
                for (int bj = 0; bj < 2; ++bj) { f32x4 b0, b1;
                    if (BF) { unpack8(*(const u32x4*)((const bf16_t*)base + off + bj * HALF), b0, b1); }
                    else { b0 = *(const f32x4*)((const float*)base + off + bj * HALF); b1 = *(const f32x4*)((const float*)base + off + bj * HALF + 4); }
                    *(u32x4*)(O + off + bj * HALF) = pack8(b0 + acc[ai][bj][m][0], b1 + acc[ai][bj][m][1]); } }
    }
};
template <bool F32OUT> struct EpiGate {
    static constexpr bool PERM = true, AFTER_DRAIN = false;
    const bf16_t* hpre; const bf16_t* pp; void* O;
    __device__ __forceinline__ void operator()(const f32x4 (&acc)[2][2][4][2], const Unit& u, int wr, int wc, int fr, int fq) const {
        const int row0 = u.pm * BM + wr * 64 + fr, col0 = u.pn * BM + wc * 32 + 8 * fq;
#pragma unroll
        for (int ai = 0; ai < 2; ++ai)
#pragma unroll
            for (int m = 0; m < 4; ++m) { const size_t off = (size_t)(row0 + ai * HALF + m * 16) * 1024 + col0;
#pragma unroll
                for (int bj = 0; bj < 2; ++bj) { f32x4 h0, h1, p0, p1;
                    unpack8(*(const u32x4*)(hpre + off + bj * HALF), h0, h1); unpack8(*(const u32x4*)(pp + off + bj * HALF), p0, p1);
                    f32x4 g0, g1;
#pragma unroll
                    for (int e = 0; e < 4; ++e) { g0[e] = fsigmoid(acc[ai][bj][m][0][e]); g1[e] = fsigmoid(acc[ai][bj][m][1][e]); }
                    const f32x4 o0 = h0 + g0 * p0, o1 = h1 + g1 * p1;
                    if (F32OUT) { *(f32x4*)((float*)O + off + bj * HALF) = o0; *(f32x4*)((float*)O + off + bj * HALF + 4) = o1; }
                    else *(u32x4*)((bf16_t*)O + off + bj * HALF) = pack8(o0, o1); } }
    }
};
struct EpiWA {
    static constexpr bool PERM = true, AFTER_DRAIN = false;
    bf16_t* O; const float* w0; const float* a0;
    __device__ __forceinline__ void operator()(const f32x4 (&acc)[2][2][4][2], const Unit& u, int wr, int wc, int fr, int fq) const {
        const int row0 = u.pm * BM + wr * 64 + fr, col0 = u.pn * BM + wc * 32 + 8 * fq;
        const bool isw = u.pn < 4; const float* bvec = isw ? (w0 + col0) : (a0 + col0 - 1024); const float mul = isw ? -0.6065306597126334f : 1.0f;
#pragma unroll
        for (int ai = 0; ai < 2; ++ai)
#pragma unroll
            for (int m = 0; m < 4; ++m) { bf16_t* rowp = O + (size_t)(row0 + ai * HALF + m * 16) * 2048 + col0;
#pragma unroll
                for (int bj = 0; bj < 2; ++bj) { f32x4 o0, o1; const f32x4 b0 = *(const f32x4*)(bvec + bj * HALF), b1 = *(const f32x4*)(bvec + bj * HALF + 4);
#pragma unroll
                    for (int e = 0; e < 4; ++e) { o0[e] = mul * fsigmoid(acc[ai][bj][m][0][e] + b0[e]); o1[e] = mul * fsigmoid(acc[ai][bj][m][1][e] + b1[e]); }
                    *(u32x4*)(rowp + bj * HALF) = pack8(o0, o1); } }
    }
};
template <class Epi, class Sched, bool ALIGN_EPI = false, bool SP2 = false>
__device__ __forceinline__ void gemm_phase(PG8_LAS unsigned char* lds, const Gemm g, const Sched& S, const Epi& E, const int tid_in) {
    const int tid = tid_in, wid = __builtin_amdgcn_readfirstlane(tid >> 6), lane = tid & 63, wr = wid >> 2, wc = wid & 3, fr = lane & 15, fq = lane >> 4;
    const int K = g.K, nt = K / BK;
    unsigned voffA[2], voffB[2];
#pragma unroll
    for (int i = 0; i < 2; ++i) { int R, C; stage_rc(tid * 16 + i * 8192, R, C); const int Rb = Epi::PERM ? ((R & ~31) + perm32(R & 31)) : R;
        voffA[i] = (unsigned)(R * K + C) * 2u; voffB[i] = (unsigned)(Rb * K + C) * 2u; }
    const size_t kstep = (size_t)(BK * 2);
    const size_t hstep = (size_t)HALF * K * 2;
    const size_t tstep = 2 * hstep;
    const unsigned ldsw = (unsigned)wid * 1024u;
    const int aoff = lds_byte(wr * 64 + fr, fq * 8), boff = lds_byte(wc * 32 + fr, fq * 8);
#define PG8_SA(b, h) (((b) * 2 + (h)) * HTB)
#define PG8_SB(b, h) ((4 + (b) * 2 + (h)) * HTB)
#define PG8_STAGE(bufoff, gbase, voff) do { _Pragma("unroll") for (int _i = 0; _i < 2; ++_i) \
        __builtin_amdgcn_global_load_lds((const unsigned*)((const char*)(gbase) + (voff)[_i]), (PG8_LAS unsigned*)(lds + (bufoff) + ldsw + _i * 8192), 16, 0, 0); } while (0)
#define PG8_LDA(dst, b, h) do { _Pragma("unroll") for (int m = 0; m < 4; ++m) _Pragma("unroll") for (int k = 0; k < 2; ++k) dst[m][k] = *(const PG8_LAS bf16x8*)(lds + PG8_SA(b, h) + aoff + m * 2048 + k * 1024); } while (0)
#define PG8_LDB(dst, b, h) do { _Pragma("unroll") for (int n = 0; n < 2; ++n) _Pragma("unroll") for (int k = 0; k < 2; ++k) dst[n][k] = *(const PG8_LAS bf16x8*)(lds + PG8_SB(b, h) + boff + n * 2048 + k * 1024); } while (0)
#define PG8_MMA(ai, bj, At, Bt) do { __builtin_amdgcn_s_setprio(1); _Pragma("unroll") for (int m = 0; m < 4; ++m) _Pragma("unroll") for (int n = 0; n < 2; ++n) _Pragma("unroll") for (int k = 0; k < 2; ++k) \
        acc[ai][bj][m][n] = __builtin_amdgcn_mfma_f32_16x16x32_bf16(Bt[n][k], At[m][k], acc[ai][bj][m][n], 0, 0, 0); __builtin_amdgcn_s_setprio(0); } while (0)
#define PG8_WAIT_V(n) asm volatile("s_waitcnt vmcnt(" #n ")" ::: "memory")
#define PG8_WAIT_L(n) asm volatile("s_waitcnt lgkmcnt(" #n ")" ::: "memory")
#define PG8_BAR __builtin_amdgcn_s_barrier()
#define PG8_SCHED __builtin_amdgcn_sched_barrier(0)
    Unit cur, nxt; int ui = 0;
    if (!S.next(0, cur)) return;
    f32x4 acc[2][2][4][2];
#pragma unroll
    for (int a = 0; a < 2; ++a)
#pragma unroll
        for (int b = 0; b < 2; ++b)
#pragma unroll
            for (int m = 0; m < 4; ++m)
#pragma unroll
                for (int n = 0; n < 2; ++n) acc[a][b][m][n] = (f32x4){0.f, 0.f, 0.f, 0.f};
    bf16x8 At[4][2], B0[2][2], B1[2][2];
    const char* cA = (const char*)g.asel(cur.pn) + (size_t)cur.pm * tstep; const char* cB = (const char*)g.Bt + (size_t)cur.pn * tstep;
    S.a_ready(cur);
    if constexpr (SP2) {
        PG8_STAGE(PG8_SB(0, 0), cB, voffB); PG8_STAGE(PG8_SB(0, 1), cB + hstep, voffB); PG8_STAGE(PG8_SA(0, 0), cA, voffA); PG8_STAGE(PG8_SA(0, 1), cA + hstep, voffA);
        if (wr == 1) PG8_BAR;
        PG8_WAIT_V(2); PG8_BAR;
        PG8_STAGE(PG8_SB(1, 0), cB + kstep, voffB); PG8_STAGE(PG8_SA(1, 0), cA + kstep, voffA); PG8_STAGE(PG8_SB(1, 1), cB + hstep + kstep, voffB);
        PG8_WAIT_V(6); PG8_BAR;
    } else {
        PG8_STAGE(PG8_SB(0, 0), cB, voffB); PG8_STAGE(PG8_SA(0, 0), cA, voffA); PG8_STAGE(PG8_SB(0, 1), cB + hstep, voffB); PG8_STAGE(PG8_SA(0, 1), cA + hstep, voffA);
        if (wr == 1) PG8_BAR;
        PG8_WAIT_V(4); PG8_BAR;
        PG8_STAGE(PG8_SB(1, 0), cB + kstep, voffB); PG8_STAGE(PG8_SA(1, 0), cA + kstep, voffA); PG8_STAGE(PG8_SB(1, 1), cB + hstep + kstep, voffB);
        PG8_WAIT_V(6); PG8_BAR;
    }
    for (;;) {
        const bool has_next = S.next(ui + 1, nxt);
        const char* nA = has_next ? (const char*)g.asel(nxt.pn) + (size_t)nxt.pm * tstep : cA; const char* nB = has_next ? (const char*)g.Bt + (size_t)nxt.pn * tstep : cB;
        for (int t = 0; t < nt; t += 2) {
            const bool last = (t == nt - 2);
            const char* a1 = cA + (size_t)(t + 1) * kstep;
            const char* a2 = last ? nA : cA + (size_t)(t + 2) * kstep; const char* b2 = last ? nB : cB + (size_t)(t + 2) * kstep;
            const char* a3 = a2 + kstep; const char* b3 = b2 + kstep;
            if (last && has_next) S.a_ready(nxt);
            if constexpr (SP2) {
            PG8_LDB(B0, 0, 0); PG8_LDB(B1, 0, 1); PG8_SCHED; PG8_LDA(At, 0, 0); PG8_STAGE(PG8_SA(1, 1), a1 + hstep, voffA);
            PG8_WAIT_V(8); PG8_WAIT_L(0); PG8_BAR; PG8_MMA(0, 0, At, B0); PG8_MMA(0, 1, At, B1); PG8_BAR; PG8_SCHED;
            PG8_LDA(At, 0, 1); PG8_STAGE(PG8_SB(0, 0), b2, voffB); PG8_STAGE(PG8_SB(0, 1), b2 + hstep, voffB); PG8_STAGE(PG8_SA(0, 0), a2, voffA);
            PG8_WAIT_V(8); PG8_WAIT_L(0); PG8_BAR; PG8_MMA(1, 0, At, B0); PG8_MMA(1, 1, At, B1); PG8_BAR; PG8_SCHED;
            PG8_LDB(B0, 1, 0); PG8_LDB(B1, 1, 1); PG8_SCHED; PG8_LDA(At, 1, 0); PG8_STAGE(PG8_SA(0, 1), a2 + hstep, voffA);
            PG8_WAIT_V(8); PG8_WAIT_L(0); PG8_BAR; PG8_MMA(0, 0, At, B0); PG8_MMA(0, 1, At, B1); PG8_BAR; PG8_SCHED;
            PG8_LDA(At, 1, 1); PG8_STAGE(PG8_SB(1, 0), b3, voffB); PG8_STAGE(PG8_SB(1, 1), b3 + hstep, voffB); PG8_STAGE(PG8_SA(1, 0), a3, voffA);
            PG8_WAIT_V(8); PG8_WAIT_L(0); PG8_BAR; PG8_MMA(1, 0, At, B0); PG8_MMA(1, 1, At, B1); PG8_BAR; PG8_SCHED;
            } else {
            PG8_LDB(B0, 0, 0); PG8_SCHED; PG8_LDA(At, 0, 0); PG8_STAGE(PG8_SA(1, 1), a1 + hstep, voffA);
            PG8_WAIT_L(8); PG8_BAR; PG8_WAIT_L(0); PG8_MMA(0, 0, At, B0); PG8_BAR; PG8_SCHED;
            PG8_LDB(B1, 0, 1); PG8_STAGE(PG8_SB(0, 0), b2, voffB);
            PG8_BAR; PG8_WAIT_L(0); PG8_MMA(0, 1, At, B1); PG8_BAR;
            PG8_LDA(At, 0, 1); PG8_STAGE(PG8_SA(0, 0), a2, voffA);
            PG8_BAR; PG8_WAIT_L(0); PG8_MMA(1, 0, At, B0); PG8_BAR; PG8_SCHED;
            PG8_STAGE(PG8_SB(0, 1), b2 + hstep, voffB);
            PG8_WAIT_V(6); PG8_BAR; PG8_MMA(1, 1, At, B1); PG8_BAR;
            PG8_LDB(B0, 1, 0); PG8_SCHED; PG8_LDA(At, 1, 0); PG8_STAGE(PG8_SA(0, 1), a2 + hstep, voffA);
            PG8_WAIT_L(8); PG8_BAR; PG8_WAIT_L(0); PG8_MMA(0, 0, At, B0); PG8_BAR; PG8_SCHED;
            PG8_LDB(B1, 1, 1); PG8_STAGE(PG8_SB(1, 0), b3, voffB);
            PG8_BAR; PG8_WAIT_L(0); PG8_MMA(0, 1, At, B1); PG8_BAR;
            PG8_LDA(At, 1, 1); PG8_STAGE(PG8_SA(1, 0), a3, voffA);
            PG8_BAR; PG8_WAIT_L(0); PG8_MMA(1, 0, At, B0); PG8_BAR; PG8_SCHED;
            PG8_STAGE(PG8_SB(1, 1), b3 + hstep, voffB);
            PG8_WAIT_V(6); PG8_BAR; PG8_MMA(1, 1, At, B1); PG8_BAR;
            }
        }
        if constexpr (ALIGN_EPI) { if (wr == 0) PG8_BAR; }
        if constexpr (!Epi::AFTER_DRAIN) { E(acc, cur, wr, wc, fr, fq); S.done(cur); }
        if (!has_next) break;
#pragma unroll
        for (int a = 0; a < 2; ++a)
#pragma unroll
            for (int b = 0; b < 2; ++b)
#pragma unroll
                for (int m = 0; m < 4; ++m)
#pragma unroll
                    for (int n = 0; n < 2; ++n) acc[a][b][m][n] = (f32x4){0.f, 0.f, 0.f, 0.f};
        cur = nxt; cA = nA; cB = nB; ++ui;
        if constexpr (ALIGN_EPI) { if (wr == 1) PG8_BAR; }
    }
    PG8_WAIT_V(0);
    if constexpr (!ALIGN_EPI) { if (wr == 0) PG8_BAR; }
    PG8_BAR;
    if constexpr (Epi::AFTER_DRAIN) { E.fused(acc, cur, wr, wc, fr, fq, lds, wid, lane); S.done(cur); }
#undef PG8_SA
#undef PG8_SB
#undef PG8_STAGE
#undef PG8_LDA
#undef PG8_LDB
#undef PG8_MMA
#undef PG8_WAIT_V
#undef PG8_WAIT_L
#undef PG8_BAR
#undef PG8_SCHED
}
}
using pg8::bf16_t; using pg8::bf16x8; using pg8::f32x4; using pg8::u32x4; using pg8::cvt_pk_bf16; using pg8::bf2f; using pg8::bflo; using pg8::bfhi; using pg8::fsigmoid; using pg8::pack8; using pg8::unpack8;
#define LAS __attribute__((address_space(3)))
typedef unsigned u32x2 __attribute__((ext_vector_type(2)));
typedef float f32x2 __attribute__((ext_vector_type(2)));

constexpr int NB = 8, T = 4096, D = 1024, M = NB * T, PLE = 256, ATT_IN = 2560;
constexpr int NWAVES = 8, NTHR = 512;
constexpr int LDS_BYTES = 147456;

constexpr size_t MiB = 1u << 20;
constexpr size_t WS_WQKVZ = 0;
constexpr size_t WS_WO0   = 5 * MiB;
constexpr size_t WS_WG0   = 7 * MiB;
constexpr size_t WS_WG1   = 9 * MiB;
constexpr size_t WS_WO1   = 11 * MiB;
constexpr size_t WS_WR    = 13 * MiB;
constexpr size_t WS_WP0   = 21 * MiB;
constexpr size_t WS_WP1   = 21 * MiB + 512 * 1024;
constexpr size_t WS_WL    = 22 * MiB;
constexpr size_t WS_W2    = 22 * MiB + 512 * 1024;
constexpr size_t WS_COS   = 23 * MiB;
constexpr size_t WS_SIN   = 23 * MiB + 512 * 1024;
constexpr size_t WS_BIAS  = 24 * MiB;
constexpr size_t WS_CTL   = 25 * MiB;
constexpr size_t WS_PB0   = 32 * MiB;
constexpr size_t WS_L     = 32 * MiB;
constexpr size_t WS_PB1   = 48 * MiB;
constexpr size_t WS_S1    = 64 * MiB;
constexpr size_t WS_QKVZ  = 128 * MiB;
constexpr size_t WS_XS0   = 128 * MiB, WS_XS1 = 192 * MiB, WS_WA = 128 * MiB, WS_A2 = 256 * MiB;
constexpr size_t WS_S2    = 288 * MiB;
constexpr size_t WS_S3    = 352 * MiB;
constexpr size_t WS_S4    = 416 * MiB;
constexpr size_t WS_END   = 480 * MiB;

__device__ __forceinline__ float wave_sum(float v) {
#pragma unroll
    for (int o = 1; o < 64; o <<= 1) v += __shfl_xor(v, o);
    return v;
}
__device__ __forceinline__ float dpp_add(float x, const int ctrl_dummy) { return x; }
#define DPP_XADD(x, ctrl) ((x) + __builtin_bit_cast(float, __builtin_amdgcn_update_dpp(0, __builtin_bit_cast(int, (x)), (ctrl), 0xF, 0xF, true)))
__device__ __forceinline__ float row16_sum(float x) {
    x = DPP_XADD(x, 0xB1);
    x = DPP_XADD(x, 0x4E);
    x = DPP_XADD(x, 0x141);
    x = DPP_XADD(x, 0x140);
    return x;
}

__device__ __forceinline__ void grid_bar(unsigned* ctr, unsigned target, int tid) {
    asm volatile("s_waitcnt vmcnt(0)" ::: "memory");
    __syncthreads();
    if (tid == 0) {
        __builtin_amdgcn_fence(__ATOMIC_RELEASE, "agent");
        asm volatile("s_waitcnt vmcnt(0)" ::: "memory");
        __hip_atomic_fetch_add(ctr, 1u, __ATOMIC_RELAXED, __HIP_MEMORY_SCOPE_AGENT);
        while (__hip_atomic_load(ctr, __ATOMIC_RELAXED, __HIP_MEMORY_SCOPE_AGENT) < target) __builtin_amdgcn_s_sleep(2);
        __builtin_amdgcn_fence(__ATOMIC_ACQUIRE, "agent");
        asm volatile("s_waitcnt vmcnt(0)" ::: "memory");
    }
    __syncthreads();
}
#define XB_TMO      128
#define XB_XCNT(j)  (256  + 64 * (j))
#define XB_XSUB(j)  (1280 + 64 * (j))
#define XB_XGEN(j)  (2304 + 64 * (j))
#define XB_TOP      3328
#define XB_TOPGEN   3392
#define XCD_BAR_WORDS 3456
#define XB_SPIN_CAP (1u << 18)

__device__ __forceinline__ unsigned xb_ld(unsigned* p)              { return __hip_atomic_load(p, __ATOMIC_RELAXED, __HIP_MEMORY_SCOPE_AGENT); }
__device__ __forceinline__ unsigned xb_add(unsigned* p, unsigned v) { return __hip_atomic_fetch_add(p, v, __ATOMIC_RELAXED, __HIP_MEMORY_SCOPE_AGENT); }
__device__ __forceinline__ unsigned xb_xcc_id() { return (unsigned)__builtin_amdgcn_s_getreg((3 << 11) | 20) & 0xFu; }
#define XB_SPIN(cond, bar) do { unsigned _sp = 0; while (cond) { __builtin_amdgcn_s_sleep(1); \
    if ((++_sp & 255u) == 0u) { if (xb_ld(&(bar)[XB_TMO])) break; if (_sp > XB_SPIN_CAP) { atomicAdd(&(bar)[XB_TMO], 1u); break; } } } } while (0)

struct XcdBarrier {
    unsigned* bar; unsigned x;
    volatile LAS unsigned* st;
};

__device__ __forceinline__ XcdBarrier xcd_barrier_post(unsigned* bar, volatile LAS unsigned* st, const int tid_) {
    XcdBarrier b; b.bar = bar; b.x = xb_xcc_id(); b.st = st;
    if (tid_ == 0) (void)xb_add(&bar[XB_XCNT(b.x)], 1u);
    return b;
}
__device__ __forceinline__ void xcd_barrier_complete(unsigned* bar, unsigned x, unsigned& nloc, unsigned& nx) {
    const unsigned G = gridDim.x * gridDim.y * gridDim.z;
    unsigned sum, cnt, mine, sp = 0u;
    for (;;) {
        sum = 0u; cnt = 0u; mine = 0u;
#pragma unroll
        for (unsigned j = 0; j < 16; ++j) { const unsigned c = xb_ld(&bar[XB_XCNT(j)]); sum += c; cnt += (c > 0u) ? 1u : 0u; mine = (j == x) ? c : mine; }
        if (sum == G) break;
        __builtin_amdgcn_s_sleep(1);
        if ((++sp & 255u) == 0u) { if (xb_ld(&bar[XB_TMO])) break; if (sp > XB_SPIN_CAP) { atomicAdd(&bar[XB_TMO], 1u); break; } }
    }
    nloc = mine > 0u ? mine : 1u; nx = cnt > 0u ? cnt : 1u;
}

__device__ __forceinline__ void xcd_barrier(const XcdBarrier& b, const int tid_) {
    asm volatile("s_waitcnt vmcnt(0)" ::: "memory");
    __syncthreads();
    if (tid_ == 0) {
        unsigned* bar = b.bar;
        __builtin_amdgcn_s_waitcnt(0);
        unsigned nloc = b.st[0], nx = b.st[1];
        if (nloc == 0u) { xcd_barrier_complete(bar, b.x, nloc, nx); b.st[0] = nloc; b.st[1] = nx; }
        const unsigned old = xb_add(&bar[XB_XSUB(b.x)], 1u);
        const unsigned gen = old / nloc;
        if (old + 1u == (gen + 1u) * nloc) {
            __builtin_amdgcn_fence(__ATOMIC_RELEASE, "agent");
            asm volatile("s_waitcnt vmcnt(0)" ::: "memory");
            const unsigned og = xb_add(&bar[XB_TOP], 1u);
            const unsigned tg = og / nx;
            if (og + 1u == (tg + 1u) * nx) xb_add(&bar[XB_TOPGEN], 1u);
            else XB_SPIN(xb_ld(&bar[XB_TOPGEN]) == tg, bar);
            __builtin_amdgcn_fence(__ATOMIC_ACQUIRE, "agent");
            xb_add(&bar[XB_XGEN(b.x)], 1u);
            asm volatile("s_waitcnt vmcnt(0)" ::: "memory");
        } else {
            XB_SPIN(xb_ld(&bar[XB_XGEN(b.x)]) == gen, bar);
            __builtin_amdgcn_fence(__ATOMIC_ACQUIRE, "agent");
            asm volatile("s_waitcnt vmcnt(0)" ::: "memory");
        }
    }
    __syncthreads();
}

__device__ __forceinline__ int qk_perm_row(int n) {
    if (n >= 1280) return n;
    const int hd = n & ~63, d = n & 63, dd = d & 31;
    return hd + 8 * (dd >> 2) + 4 * (d >> 5) + (dd & 3);
}
template <int MODE>
__device__ __forceinline__ void transpose_item(const float* W, int K, int N, bf16_t* WT, int row_off, LAS float* scr, int item, int lane, const float* s) {
    const int nblk = N / 32, kb = item / nblk, nb = item % nblk, k0 = 64 * kb, n0 = 32 * nb;
#pragma unroll 8
    for (int i = 0; i < 32; ++i) { const int kk = 2 * i + (lane >> 5); float v = W[(size_t)(k0 + kk) * N + n0 + (lane & 31)];
        if (MODE == 2) v *= s[k0 + kk]; if (MODE == 3) v *= 1.0f - s[k0 + kk];
        scr[kk * 33 + (lane & 31)] = v; }
    asm volatile("s_waitcnt lgkmcnt(0)" ::: "memory");
    const int c = lane & 7;
#pragma unroll
    for (int j = 0; j < 4; ++j) { const int n = (lane >> 3) + 8 * j; const LAS float* sp = scr + (8 * c) * 33 + n;
        u32x4 o; o.x = cvt_pk_bf16(sp[0 * 33], sp[1 * 33]); o.y = cvt_pk_bf16(sp[2 * 33], sp[3 * 33]); o.z = cvt_pk_bf16(sp[4 * 33], sp[5 * 33]); o.w = cvt_pk_bf16(sp[6 * 33], sp[7 * 33]);
        const int dn = (MODE == 1) ? qk_perm_row(n0 + n) : (n0 + n);
        *(u32x4*)(WT + (size_t)(row_off + dn) * K + k0 + 8 * c) = o; }
    asm volatile("s_waitcnt lgkmcnt(0)" ::: "memory");
}

struct Args { const float* in[24]; float* out; unsigned char* ws; int ph_lo, ph_hi; };
typedef const __attribute__((address_space(4))) unsigned char* kptr_t;
__device__ __forceinline__ kptr_t kargs() { kptr_t p = (kptr_t)__builtin_amdgcn_kernarg_segment_ptr(); asm volatile("" : "+s"(p)); return p; }
#define GAS __attribute__((address_space(1)))
__device__ __forceinline__ const float* kin(kptr_t p, int i) { return (const float*)(const GAS float*)*(const unsigned long long __attribute__((address_space(4)))*)(p + 8 * i); }
__device__ __forceinline__ float* kout(kptr_t p) { return (float*)(GAS float*)*(const unsigned long long __attribute__((address_space(4)))*)(p + 8 * 24); }
__device__ __forceinline__ unsigned char* kws(kptr_t p) { return (unsigned char*)(GAS unsigned char*)*(const unsigned long long __attribute__((address_space(4)))*)(p + 8 * 25); }

enum { I_X = 0, I_P, I_NORMG, I_AWIN, I_ABIN, I_ASINK, I_AWOUT, I_MU, I_RWIN, I_W0, I_W1, I_W2, I_A0, I_A1, I_A2, I_KK, I_KA, I_RK, I_GNG, I_GNB, I_RWOUT, I_PWP, I_PWG, I_FNG };
__device__ __forceinline__ void p0_prologue(LAS unsigned char* lds, int G, int bid, int tid) {
    kptr_t kp = kargs();
    const int wave = __builtin_amdgcn_readfirstlane(tid >> 6), lane = tid & 63;
    LAS float* scr = (LAS float*)(lds + wave * 16384);
    const int gw = bid * NWAVES + wave, NGW = G * NWAVES;
    unsigned char* ws = kws(kp);
    const float* mu = kin(kp, I_MU);
    constexpr int N1 = 1280, N2 = 512, N5 = 2048, N6 = 128, N7 = 32;
    constexpr int NITEMS = N1 + 4 * N2 + N5 + 2 * N6 + 4 * N7;
    for (int it = gw; it < NITEMS; it += NGW) {
        int r = it;
        if (r < N1) { transpose_item<1>(kin(kp, I_AWIN), 1024, 2560, (bf16_t*)(ws + WS_WQKVZ), 0, scr, r, lane, nullptr); continue; } r -= N1;
        if (r < N2) { transpose_item<0>(kin(kp, I_AWOUT), 1024, 1024, (bf16_t*)(ws + WS_WO0), 0, scr, r, lane, nullptr); continue; } r -= N2;
        if (r < N2) { transpose_item<0>(kin(kp, I_PWG), 1024, 1024, (bf16_t*)(ws + WS_WG0), 0, scr, r, lane, nullptr); continue; } r -= N2;
        if (r < N2) { transpose_item<0>(kin(kp, I_PWG) + 1024 * 1024, 1024, 1024, (bf16_t*)(ws + WS_WG1), 0, scr, r, lane, nullptr); continue; } r -= N2;
        if (r < N2) { transpose_item<0>(kin(kp, I_RWOUT), 1024, 1024, (bf16_t*)(ws + WS_WO1), 0, scr, r, lane, nullptr); continue; } r -= N2;
        if (r < N5) { transpose_item<0>(kin(kp, I_RWIN), 1024, 4096, (bf16_t*)(ws + WS_WR), 0, scr, r, lane, nullptr); continue; } r -= N5;
        if (r < N6) { transpose_item<0>(kin(kp, I_PWP), 256, 1024, (bf16_t*)(ws + WS_WP0), 0, scr, r, lane, nullptr); continue; } r -= N6;
        if (r < N6) { transpose_item<0>(kin(kp, I_PWP) + 256 * 1024, 256, 1024, (bf16_t*)(ws + WS_WP1), 0, scr, r, lane, nullptr); continue; } r -= N6;
        if (r < N7) { transpose_item<3>(kin(kp, I_W1), 1024, 64, (bf16_t*)(ws + WS_WL), 0, scr, r, lane, mu + 4 * 1024); continue; } r -= N7;
        if (r < N7) { transpose_item<2>(kin(kp, I_W1), 1024, 64, (bf16_t*)(ws + WS_WL), 64, scr, r, lane, mu + 4 * 1024); continue; } r -= N7;
        if (r < N7) { transpose_item<3>(kin(kp, I_A1), 1024, 64, (bf16_t*)(ws + WS_WL), 128, scr, r, lane, mu + 5 * 1024); continue; } r -= N7;
        transpose_item<2>(kin(kp, I_A1), 1024, 64, (bf16_t*)(ws + WS_WL), 192, scr, r, lane, mu + 5 * 1024);
    }
    {
        const float* g0 = kin(kp, I_NORMG); bf16_t* XN = (bf16_t*)(ws + WS_S1);
        f32x4 gv[4];
#pragma unroll
        for (int j = 0; j < 4; ++j) gv[j] = *((const f32x4*)g0 + lane + 64 * j);
        const float* xin = kin(kp, I_X);
        f32x4 nx[4];
        if (gw < M) {
#pragma unroll
            for (int j = 0; j < 4; ++j) nx[j] = *((const f32x4*)(xin + (size_t)gw * D) + lane + 64 * j); }
        for (int m = gw; m < M; m += NGW) {
            f32x4 v[4]; float s = 0.f;
#pragma unroll
            for (int j = 0; j < 4; ++j) { v[j] = nx[j]; s += (v[j].x * v[j].x + v[j].y * v[j].y) + (v[j].z * v[j].z + v[j].w * v[j].w); }
            if (m + NGW < M) {
#pragma unroll
                for (int j = 0; j < 4; ++j) nx[j] = *((const f32x4*)(xin + (size_t)(m + NGW) * D) + lane + 64 * j); }
            const float rstd = 1.0f / sqrtf(wave_sum(s) * (1.0f / D) + 1e-6f);
            u32x2* o8 = (u32x2*)(XN + (size_t)m * D) + lane;
#pragma unroll
            for (int j = 0; j < 4; ++j) { const f32x4 o = v[j] * rstd * gv[j]; u32x2 w; w.x = cvt_pk_bf16(o.x, o.y); w.y = cvt_pk_bf16(o.z, o.w); o8[64 * j] = w; }
        }
    }
    const int gt = bid * NTHR + tid, NGT = G * NTHR;
    {
        const f32x4* p4 = (const f32x4*)kin(kp, I_P); u32x4* o = (u32x4*)(ws + WS_PB0);
        for (int i = gt; i < 2 * M * PLE / 8; i += NGT) { const f32x4 x0 = p4[2 * i], x1 = p4[2 * i + 1]; o[i] = pack8(x0, x1); }
    }
    {
        float* cs = (float*)(ws + WS_COS); float* sn = (float*)(ws + WS_SIN);
        for (int i = gt; i < T * 32; i += NGT) {
            const int pos = i >> 5, f = i & 31;
            const float inv = (float)exp2(-(double)f * (13.287712379549449 / 32.0));
            const float ang = (float)pos * inv;
            double rev = (double)ang * 0.15915494309189535; rev -= floor(rev);
            sn[i] = __builtin_amdgcn_sinf((float)rev); cs[i] = __builtin_amdgcn_cosf((float)rev);
        }
    }
    {
        float* bp = (float*)(ws + WS_BIAS);
        for (int i = gt; i < ATT_IN; i += NGT) bp[qk_perm_row(i)] = kin(kp, I_ABIN)[i];
    }
    {
        bf16_t* W2T = (bf16_t*)(ws + WS_W2); const float* w2 = kin(kp, I_W2); const float* a2 = kin(kp, I_A2);
        for (int i = gt; i < 2048 * 128; i += NGT) {
            const int k = i >> 11, nn = i & 2047;
            float v;
            if (nn < 1024) v = (k < 64) ? w2[k * 1024 + nn] : 0.f; else v = (k >= 64) ? a2[(k - 64) * 1024 + (nn - 1024)] : 0.f;
            W2T[(size_t)nn * 128 + k] = (bf16_t)(cvt_pk_bf16(v, 0.f) & 0xffffu);
        }
    }
}

__device__ __forceinline__ void attn_phase(LAS unsigned char* lds, const bf16_t* QKVZ, const float* sinks, bf16_t* OG, int G, int bid, int tid) {
    const int wave = __builtin_amdgcn_readfirstlane(tid >> 6), lane = tid & 63, fr = lane & 15, fq = lane >> 4;
    constexpr int KP = 144, VP = 528;
    LAS unsigned char* Kl = lds; LAS unsigned char* Vt = lds + 256 * KP;
    u32x4 pkv[4], pvv[4];
#define ATT_LOAD(uu) do { const int kvh_ = (uu) & 3, n_ = ((uu) >> 2) & 31, b_ = (uu) >> 7; _Pragma("unroll") for (int i = 0; i < 4; ++i) { \
        const int c_ = tid + 512 * i, key_ = c_ >> 3, ch_ = c_ & 7, t_ = 128 * (n_ - 1) + key_; \
        pkv[i] = (u32x4){0u, 0u, 0u, 0u}; pvv[i] = (u32x4){0u, 0u, 0u, 0u}; \
        if (t_ >= 0) { const bf16_t* rp_ = QKVZ + (size_t)(b_ * T + t_) * ATT_IN + kvh_ * 64 + ch_ * 8; pkv[i] = *(const u32x4*)(rp_ + 1024); pvv[i] = *(const u32x4*)(rp_ + 1280); } } } while (0)
    if (bid < 1024) ATT_LOAD(bid);
    for (int unit = bid; unit < 1024; unit += G) {
        const int kvh = unit & 3, n = (unit >> 2) & 31, b = unit >> 7;
        __syncthreads();
#pragma unroll
        for (int i = 0; i < 4; ++i) {
            const int c = tid + 512 * i, key = c >> 3, ch = c & 7;
            const u32x4 kv = pkv[i], vv = pvv[i];
            *(LAS u32x4*)(Kl + key * KP + ch * 16) = kv;
            LAS unsigned short* vp = (LAS unsigned short*)(Vt + (ch * 8) * VP + ((key ^ (ch << 2)) * 2));
            vp[0 * (VP / 2)] = (unsigned short)(vv.x & 0xffffu); vp[1 * (VP / 2)] = (unsigned short)(vv.x >> 16);
            vp[2 * (VP / 2)] = (unsigned short)(vv.y & 0xffffu); vp[3 * (VP / 2)] = (unsigned short)(vv.y >> 16);
            vp[4 * (VP / 2)] = (unsigned short)(vv.z & 0xffffu); vp[5 * (VP / 2)] = (unsigned short)(vv.z >> 16);
            vp[6 * (VP / 2)] = (unsigned short)(vv.w & 0xffffu); vp[7 * (VP / 2)] = (unsigned short)(vv.w >> 16);
        }
        if (unit + G < 1024) ATT_LOAD(unit + G);
        __syncthreads();
        const int g = wave >> 1, qh = wave & 1, h = kvh * 4 + g;
        const float sink2 = sinks[h] * 1.4426950408889634f;
        for (int mt = 0; mt < 4; ++mt) {
            const int qo0 = qh * 64 + mt * 16;
            const size_t row = (size_t)(b * T + n * 128 + qo0 + fr);
            const bf16_t* qp = QKVZ + row * ATT_IN + h * 64 + fq * 8;
            const bf16x8 q0 = *(const bf16x8*)qp, q1 = *(const bf16x8*)(qp + 32);
            const int kt0 = (qh * 4 + mt) < 6 ? (qh * 4 + mt) : 6;
            f32x4 s[10];
#pragma unroll
            for (int kt = 0; kt < 10; ++kt) {
                const LAS unsigned char* kp = Kl + ((kt0 + kt) * 16 + fr) * KP + fq * 16;
                const bf16x8 k0 = *(const LAS bf16x8*)kp, k1 = *(const LAS bf16x8*)(kp + 64);
                f32x4 acc = (f32x4){0.f, 0.f, 0.f, 0.f};
                acc = __builtin_amdgcn_mfma_f32_16x16x32_bf16(k0, q0, acc, 0, 0, 0);
                acc = __builtin_amdgcn_mfma_f32_16x16x32_bf16(k1, q1, acc, 0, 0, 0);
                s[kt] = acc;
            }
            const int qi = 128 + qo0 + fr;
            float mx = sink2;
#pragma unroll
            for (int kt = 0; kt < 10; ++kt)
#pragma unroll
                for (int r = 0; r < 4; ++r) { const int si = (kt0 + kt) * 16 + 4 * fq + r, df = qi - si; const bool ok = (df >= 0) && (df < 128) && (n > 0 || si >= 128);
                    const float v = ok ? s[kt][r] : -1e30f; s[kt][r] = v; mx = fmaxf(mx, v); }
            mx = fmaxf(mx, __shfl_xor(mx, 16)); mx = fmaxf(mx, __shfl_xor(mx, 32));
            float sum = 0.f;
#pragma unroll
            for (int kt = 0; kt < 10; ++kt)
#pragma unroll
                for (int r = 0; r < 4; ++r) { const float p = __builtin_amdgcn_exp2f(s[kt][r] - mx); s[kt][r] = p; sum += p; }
            sum += __shfl_xor(sum, 16); sum += __shfl_xor(sum, 32);
            sum += __builtin_amdgcn_exp2f(sink2 - mx);
            const float inv = 1.0f / sum;
            f32x4 o[4];
#pragma unroll
            for (int dt = 0; dt < 4; ++dt) o[dt] = (f32x4){0.f, 0.f, 0.f, 0.f};
#pragma unroll
            for (int kk = 0; kk < 5; ++kk) {
                const u32x4 pw = pack8(s[2 * kk], s[2 * kk + 1]);
                const bf16x8 pf = __builtin_bit_cast(bf16x8, pw);
#pragma unroll
                for (int dt = 0; dt < 4; ++dt) {
                    const int d = dt * 16 + fr, sw = ((d >> 3) & 7) << 2, keyA = 16 * (kt0 + 2 * kk) + 4 * fq, keyB = keyA + 16;
                    const u32x2 va = *(const LAS u32x2*)(Vt + d * VP + ((keyA ^ sw) * 2)), vb = *(const LAS u32x2*)(Vt + d * VP + ((keyB ^ sw) * 2));
                    const u32x4 vw = (u32x4){va.x, va.y, vb.x, vb.y};
                    o[dt] = __builtin_amdgcn_mfma_f32_16x16x32_bf16(__builtin_bit_cast(bf16x8, vw), pf, o[dt], 0, 0, 0);
                }
            }
            const bf16_t* zp = QKVZ + row * ATT_IN + 1536 + h * 64 + 4 * fq;
            bf16_t* op = OG + row * D + h * 64 + 4 * fq;
#pragma unroll
            for (int dt = 0; dt < 4; ++dt) {
                const u32x2 zw = *(const u32x2*)(zp + dt * 16);
                const float z0 = bflo(zw.x), z1 = bfhi(zw.x), z2 = bflo(zw.y), z3 = bfhi(zw.y);
                const float r0 = o[dt][0] * inv * z0 * fsigmoid(z0), r1 = o[dt][1] * inv * z1 * fsigmoid(z1), r2 = o[dt][2] * inv * z2 * fsigmoid(z2), r3 = o[dt][3] * inv * z3 * fsigmoid(z3);
                u32x2 w; w.x = cvt_pk_bf16(r0, r1); w.y = cvt_pk_bf16(r2, r3);
                *(u32x2*)(op + dt * 16) = w;
            }
        }
    }
}
template <int ROUND>
__device__ __forceinline__ void lerp_phase(const bf16_t* H1, const float* g1, const float* mu, bf16_t* HN, bf16_t* XS0, bf16_t* XS1, int G, int bid, int tid) {
    const int wave = __builtin_amdgcn_readfirstlane(tid >> 6), lane = tid & 63;
    const int gw = bid * NWAVES + wave, NGW = G * NWAVES;
    const float* mu0 = mu + (ROUND == 0 ? 0 : 2) * 1024; const float* mu1 = mu0 + 1024;
    f32x4 gq[4], m0q[4], m1q[4];
#pragma unroll
    for (int q = 0; q < 4; ++q) { const int col = (q >> 1) * 512 + lane * 8 + 4 * (q & 1); gq[q] = *(const f32x4*)(g1 + col); m0q[q] = *(const f32x4*)(mu0 + col); m1q[q] = *(const f32x4*)(mu1 + col); }
    u32x4 rc_[2], rp_[2];
#define LERP_LOAD(mm) do { const bool hp_ = ((mm) & (T - 1)) != 0; _Pragma("unroll") for (int j = 0; j < 2; ++j) { const size_t off_ = (size_t)(mm) * D + j * 512 + lane * 8; \
        rc_[j] = *(const u32x4*)(H1 + off_); rp_[j] = hp_ ? *(const u32x4*)(H1 + off_ - D) : (u32x4){0u, 0u, 0u, 0u}; } } while (0)
    if (gw < M) LERP_LOAD(gw);
    for (int m = gw; m < M; m += NGW) {
        f32x4 c[4], p[4];
        float sc = 0.f, sp = 0.f;
#pragma unroll
        for (int j = 0; j < 2; ++j) { unpack8(rc_[j], c[2 * j], c[2 * j + 1]); unpack8(rp_[j], p[2 * j], p[2 * j + 1]); }
        if (m + NGW < M) LERP_LOAD(m + NGW);
#pragma unroll
        for (int q = 0; q < 4; ++q) { sc += (c[q].x * c[q].x + c[q].y * c[q].y) + (c[q].z * c[q].z + c[q].w * c[q].w); sp += (p[q].x * p[q].x + p[q].y * p[q].y) + (p[q].z * p[q].z + p[q].w * p[q].w); }
        const float rc = 1.0f / sqrtf(wave_sum(sc) * (1.0f / D) + 1e-6f), rp = 1.0f / sqrtf(wave_sum(sp) * (1.0f / D) + 1e-6f);
#pragma unroll
        for (int j = 0; j < 2; ++j) {
            const int col = j * 512 + lane * 8; const size_t off = (size_t)m * D + col;
            f32x4 hn[2], xx[2], o0[2], o1[2];
#pragma unroll
            for (int e = 0; e < 2; ++e) {
                const f32x4 gv = gq[2 * j + e];
                hn[e] = c[2 * j + e] * rc * gv; xx[e] = p[2 * j + e] * rp * gv - hn[e];
                o0[e] = hn[e] + xx[e] * m0q[2 * j + e];
                o1[e] = hn[e] + xx[e] * m1q[2 * j + e];
            }
            if (ROUND == 0) *(u32x4*)(HN + off) = pack8(hn[0], hn[1]);
            *(u32x4*)(XS0 + off) = pack8(o0[0], o0[1]);
            *(u32x4*)(XS1 + off) = pack8(o1[0], o1[1]);
        }
    }
}
__device__ __forceinline__ void lora_mid_phase(const bf16_t* L, bf16_t* A2, int G, int bid, int tid) {
    const int gt = bid * NTHR + tid, NGT = G * NTHR;
    for (int i = gt; i < M * 16; i += NGT) {
        const int m = i >> 4, ch = i & 15, isA = ch >> 3, c8 = (ch & 7) * 8;
        const bool hasprev = (m & (T - 1)) != 0;
        f32x4 u0, u1, v0 = (f32x4){0.f, 0.f, 0.f, 0.f}, v1 = v0;
        unpack8(*(const u32x4*)(L + (size_t)m * 256 + isA * 128 + c8), u0, u1);
        if (hasprev) unpack8(*(const u32x4*)(L + (size_t)(m - 1) * 256 + isA * 128 + 64 + c8), v0, v1);
        u0 += v0; u1 += v1;
        if (!isA) {
#pragma unroll
            for (int e = 0; e < 4; ++e) { u0[e] = tanhf(u0[e]); u1[e] = tanhf(u1[e]); }
        }
        *(u32x4*)(A2 + (size_t)m * 128 + ch * 8) = pack8(u0, u1);
    }
}
#ifndef MK_SCAN_CHUNKED
#define MK_SCAN_CHUNKED 1
#endif
#if MK_SCAN_CHUNKED
typedef __bf16 ck_bf16x2_t __attribute__((ext_vector_type(2)));
__device__ __forceinline__ unsigned ck_cvt(float lo, float hi) { const f32x2 v = {lo, hi}; return __builtin_bit_cast(unsigned, __builtin_convertvector(v, ck_bf16x2_t)); }
constexpr int CK_RP = 144;
constexpr int CK_TP = 40;
constexpr int CK_ABAR = 0, CK_RBAR = 2304, CK_BTIL = 4608, CK_KTIL = 6912;
constexpr int CK_BT_T = 9216, CK_KT_T = 11776;
constexpr int CK_VT = 14336;
constexpr int CK_GAM = 15616;
constexpr int CK_BUF = 15872;
constexpr int CK_LD = 2 * CK_BUF;
constexpr int CK_PRIV = CK_LD + 2 * 4096;
constexpr int CK_PRIV_SZ = 2560;
__device__ __forceinline__ bf16x8 ck_ld2(const LAS unsigned char* p, int off2) {
    const u32x2 a = *(const LAS u32x2*)p, b = *(const LAS u32x2*)(p + off2); return __builtin_bit_cast(bf16x8, (u32x4){a.x, a.y, b.x, b.y}); }
__device__ __forceinline__ bf16x8 ck_ld1(const LAS unsigned char* p) {
    const u32x2 a = *(const LAS u32x2*)p; return __builtin_bit_cast(bf16x8, (u32x4){a.x, a.y, 0u, 0u}); }
__device__ __forceinline__ bf16x8 ck_pk4(const f32x4 x) { return __builtin_bit_cast(bf16x8, (u32x4){ck_cvt(x[0], x[1]), ck_cvt(x[2], x[3]), 0u, 0u}); }
#define CK_MFMA(a, b, c) __builtin_amdgcn_mfma_f32_16x16x32_bf16((a), (b), (c), 0, 0, 0)

constexpr int CK_STG = CK_PRIV + 2 * CK_PRIV_SZ;
constexpr int CK_STG_SZ = 4 * 4096 + 1024;
__device__ __forceinline__ void scan_phase(LAS unsigned char* lds, const bf16_t* R, const bf16_t* Kb, const bf16_t* V, const bf16_t* WA, const float* k_k, const float* k_a, bf16_t* Y, int G, int bid, int tid) {
    const int wave = __builtin_amdgcn_readfirstlane(tid >> 6), lane = tid & 63, c = lane & 15, g = lane >> 4;
    const int wq = (wave & 1) + ((wave >> 2) << 1);
    const int pid = wq * 64 + lane, pt = (pid >> 4) & 15, pj = pid & 15;
    const int pid1 = tid - 256, pta = (pid1 >> 4) & 7, ptb = pta + 8;
    const bool producer = (wave == 2) || (wave == 3) || (wave >= 6), producer1 = (wave == 4) || (wave == 5), consumer = wave < 2;
    constexpr int NCH = T / 16;
    for (int unit = bid; unit < 256; unit += G) {
        const int b = unit >> 5, h = (unit >> 1) & 15, half = unit & 1;
        const size_t rowbase = (size_t)b * T;
        f32x4 kkw = (f32x4){0.f, 0.f, 0.f, 0.f}, kaw = kkw;
        if (producer1) { kkw = *(const f32x4*)(k_k + h * 64 + 4 * pj); kaw = *(const f32x4*)(k_a + h * 64 + 4 * pj); }
        u32x2 rkA = (u32x2){0u, 0u}, rrA = rkA, raA = rkA, rlA = rkA, rkB = rkA, rrB = rkA, raB = rkA, rlB = rkA; unsigned rvA = 0u, rvB = 0u;
#define CK_LOAD(X, ptx, cn) do { const size_t m_ = rowbase + (size_t)(cn) * 16 + (ptx); \
            rk##X = *(const u32x2*)(Kb + m_ * D + h * 64 + 4 * pj); rr##X = *(const u32x2*)(R + m_ * D + h * 64 + 4 * pj); \
            rl##X = *(const u32x2*)(WA + m_ * 2048 + h * 64 + 4 * pj); ra##X = *(const u32x2*)(WA + m_ * 2048 + 1024 + h * 64 + 4 * pj); \
            rv##X = *(const unsigned*)(V + m_ * D + h * 64 + half * 32 + 2 * pj); } while (0)
#define CK_P1(X, ptx, cn) do { \
            const f32x4 kf_ = (f32x4){bflo(rk##X.x), bfhi(rk##X.x), bflo(rk##X.y), bfhi(rk##X.y)}, af_ = (f32x4){bflo(ra##X.x), bfhi(ra##X.x), bflo(ra##X.y), bfhi(ra##X.y)}; \
            const f32x4 lf_ = (f32x4){bflo(rl##X.x), bfhi(rl##X.x), bflo(rl##X.y), bfhi(rl##X.y)}, rf_ = (f32x4){bflo(rr##X.x), bfhi(rr##X.x), bflo(rr##X.y), bfhi(rr##X.y)}; \
            const f32x4 kv_ = kf_ * kkw; \
            float ss_ = (kv_.x * kv_.x + kv_.y * kv_.y) + (kv_.z * kv_.z + kv_.w * kv_.w); \
            ss_ = row16_sum(ss_); \
            const float invn_ = (ss_ > 1e-24f) ? __builtin_amdgcn_rsqf(ss_) : 1e12f;        \
            const f32x4 kk_ = kv_ * invn_; \
            LAS unsigned char* st_ = lds + CK_STG + ((cn) & 1) * CK_STG_SZ + ((ptx) * 64 + 4 * pj) * 4; \
            *(LAS f32x4*)(st_) = -kk_; *(LAS f32x4*)(st_ + 4096) = kk_ * af_; *(LAS f32x4*)(st_ + 8192) = kf_ * (1.0f + (af_ - 1.0f) * kaw); *(LAS f32x4*)(st_ + 12288) = rf_; \
            *(LAS unsigned*)(lds + CK_STG + ((cn) & 1) * CK_STG_SZ + 16384 + ((ptx) * 16 + pj) * 4) = rv##X; \
            *(LAS f32x4*)(lds + CK_LD + ((cn) & 1) * 4096 + ((ptx) * 64 + 4 * pj) * 4) = lf_; } while (0)
        if (producer1) { CK_LOAD(A, pta, 0); CK_LOAD(B, ptb, 0); CK_P1(A, pta, 0); CK_P1(B, ptb, 0); CK_LOAD(A, pta, 1); CK_LOAD(B, ptb, 1); }
        f32x4 H[4];
#pragma unroll
        for (int kt = 0; kt < 4; ++kt) H[kt] = (f32x4){0.f, 0.f, 0.f, 0.f};
        __syncthreads();
        for (int it = 0; it <= NCH; ++it) {
            if (producer1 && it + 1 < NCH) { CK_P1(A, pta, it + 1); CK_P1(B, ptb, it + 1); if (it + 2 < NCH) { CK_LOAD(A, pta, it + 2); CK_LOAD(B, ptb, it + 2); } }
            if (producer && it < NCH) {
                LAS unsigned char* buf = lds + (it & 1) * CK_BUF;
                const LAS unsigned char* ldp = lds + CK_LD + (it & 1) * 4096 + 16 * pj;
                const LAS unsigned char* stp = lds + CK_STG + (it & 1) * CK_STG_SZ + (pt * 64 + 4 * pj) * 4;
                f32x4 nkk = *(const LAS f32x4*)(stp), be = *(const LAS f32x4*)(stp + 4096), kp = *(const LAS f32x4*)(stp + 8192), rf = *(const LAS f32x4*)(stp + 12288), lf = *(const LAS f32x4*)(ldp + pt * 256);
                unsigned vsave = *(const LAS unsigned*)(lds + CK_STG + (it & 1) * CK_STG_SZ + 16384 + (pt * 16 + pj) * 4);
                asm volatile("" : "+v"(nkk), "+v"(be), "+v"(kp), "+v"(rf), "+v"(lf), "+v"(vsave));
                f32x4 Gc = (f32x4){0.f, 0.f, 0.f, 0.f};
                const int w4 = 4 * wq;
#pragma unroll
                for (int s4 = 0; s4 < 16; s4 += 4) {
                    if (s4 <= w4) {
                        f32x4 x0 = *(const LAS f32x4*)(ldp + (s4 + 0) * 256), x1 = *(const LAS f32x4*)(ldp + (s4 + 1) * 256), x2 = *(const LAS f32x4*)(ldp + (s4 + 2) * 256), x3 = *(const LAS f32x4*)(ldp + (s4 + 3) * 256);
                        asm volatile("" : "+v"(x0), "+v"(x1), "+v"(x2), "+v"(x3));
                        if (s4 < w4) Gc += (x0 + x1) + (x2 + x3);
                        else { const f32x4 z4 = (f32x4){0.f, 0.f, 0.f, 0.f};
                            Gc += (s4 + 0 <= pt) ? x0 : z4; Gc += (s4 + 1 <= pt) ? x1 : z4; Gc += (s4 + 2 <= pt) ? x2 : z4; Gc += (s4 + 3 <= pt) ? x3 : z4; }
                    }
                }
                const f32x4 Gm = Gc - lf;
                f32x4 eA, eR, eN;
#pragma unroll
                for (int e = 0; e < 4; ++e) { eA[e] = __expf(Gm[e]); eR[e] = __expf(Gc[e]); eN[e] = __expf(-Gc[e]); }
                const f32x4 ab = nkk * eA, rb = rf * eR, bt = be * eN, kt_ = kp * eN;
                const unsigned ab0 = ck_cvt(ab.x, ab.y), ab1 = ck_cvt(ab.z, ab.w), rb0 = ck_cvt(rb.x, rb.y), rb1 = ck_cvt(rb.z, rb.w);
                const unsigned bt0 = ck_cvt(bt.x, bt.y), bt1 = ck_cvt(bt.z, bt.w), kt0 = ck_cvt(kt_.x, kt_.y), kt1 = ck_cvt(kt_.z, kt_.w);
                LAS unsigned char* rowp = buf + pt * CK_RP + 64 * (pj >> 3) + 16 * (pj & 3) + 8 * ((pj >> 2) & 1);
                *(LAS u32x2*)(rowp + CK_ABAR) = (u32x2){ab0, ab1}; *(LAS u32x2*)(rowp + CK_RBAR) = (u32x2){rb0, rb1};
                *(LAS u32x2*)(rowp + CK_BTIL) = (u32x2){bt0, bt1}; *(LAS u32x2*)(rowp + CK_KTIL) = (u32x2){kt0, kt1};
                constexpr int TS = CK_TP / 2;
                {
                    const int rrow = lane >> 4;
#define CK_T4(x0, x1, x2, x3) do { auto s0_ = __builtin_amdgcn_permlane32_swap(x0, x2, false, false); auto s1_ = __builtin_amdgcn_permlane32_swap(x1, x3, false, false); \
                        auto t0_ = __builtin_amdgcn_permlane16_swap(s0_[0], s1_[0], false, false); auto t1_ = __builtin_amdgcn_permlane16_swap(s0_[1], s1_[1], false, false); \
                        x0 = t0_[0]; x1 = t0_[1]; x2 = t1_[0]; x3 = t1_[1]; } while (0)
                    unsigned b0_ = __float_as_uint(bt.x), b1_ = __float_as_uint(bt.y), b2_ = __float_as_uint(bt.z), b3_ = __float_as_uint(bt.w);
                    unsigned k0_ = __float_as_uint(kt_.x), k1_ = __float_as_uint(kt_.y), k2_ = __float_as_uint(kt_.z), k3_ = __float_as_uint(kt_.w);
                    CK_T4(b0_, b1_, b2_, b3_); CK_T4(k0_, k1_, k2_, k3_);
#undef CK_T4
                    const int toff = (4 * pj + rrow) * CK_TP + 8 * wq;
                    *(LAS u32x2*)(buf + CK_BT_T + toff) = (u32x2){ck_cvt(__uint_as_float(b0_), __uint_as_float(b1_)), ck_cvt(__uint_as_float(b2_), __uint_as_float(b3_))};
                    *(LAS u32x2*)(buf + CK_KT_T + toff) = (u32x2){ck_cvt(__uint_as_float(k0_), __uint_as_float(k1_)), ck_cvt(__uint_as_float(k2_), __uint_as_float(k3_))};
                }
                LAS unsigned short* vT = (LAS unsigned short*)(buf + CK_VT + (2 * pj) * CK_TP + pt * 2);
                vT[0] = (unsigned short)(vsave & 0xffffu); vT[TS] = (unsigned short)(vsave >> 16);
                if (pt == 15) *(LAS f32x4*)(buf + CK_GAM + 16 * pj) = eR;
            }
            if (consumer && it > 0) {
                const int cn = it - 1;
                const LAS unsigned char* buf = lds + (cn & 1) * CK_BUF;
                LAS unsigned char* priv = lds + CK_PRIV + wave * CK_PRIV_SZ;
                LAS float* AabT = (LAS float*)priv; LAS float* Xch = (LAS float*)(priv + 1024); LAS unsigned char* UT = priv + 2048;
                f32x4 xab = (f32x4){0.f, 0.f, 0.f, 0.f}, xak = xab, xrb = xab, xrk = xab;
                bf16x8 pa[2], pr[2];
#pragma unroll
                for (int ks = 0; ks < 2; ++ks) {
                    const LAS unsigned char* rp = buf + c * CK_RP + 64 * ks + 16 * g;
                    pa[ks] = *(const LAS bf16x8*)(rp + CK_ABAR); pr[ks] = *(const LAS bf16x8*)(rp + CK_RBAR);
                    const bf16x8 pb = *(const LAS bf16x8*)(rp + CK_BTIL), pk = *(const LAS bf16x8*)(rp + CK_KTIL);
                    xab = CK_MFMA(pb, pa[ks], xab); xak = CK_MFMA(pk, pa[ks], xak); xrb = CK_MFMA(pb, pr[ks], xrb); xrk = CK_MFMA(pk, pr[ks], xrk);
                }
#pragma unroll
                for (int r = 0; r < 4; ++r) { const int s = 4 * g + r; if (!(s < c)) { xab[r] = 0.f; xak[r] = 0.f; } if (!(s <= c)) { xrb[r] = 0.f; xrk[r] = 0.f; } }
#pragma unroll
                for (int r = 0; r < 4; ++r) AabT[(4 * g + r) * 16 + c] = xab[r];
                const bf16x8 opak = ck_pk4(xak), oprb = ck_pk4(xrb), oprk = ck_pk4(xrk);
                bf16x8 oph[2];
#pragma unroll
                for (int ks = 0; ks < 2; ++ks) oph[ks] = __builtin_bit_cast(bf16x8, (u32x4){ck_cvt(H[2 * ks][0], H[2 * ks][1]), ck_cvt(H[2 * ks][2], H[2 * ks][3]), ck_cvt(H[2 * ks + 1][0], H[2 * ks + 1][1]), ck_cvt(H[2 * ks + 1][2], H[2 * ks + 1][3])});
                const bf16x8 opv = ck_ld1(buf + CK_VT + (wave * 16 + c) * CK_TP + g * 8);
                f32x4 rhs = (f32x4){0.f, 0.f, 0.f, 0.f};
                rhs = CK_MFMA(pa[0], oph[0], rhs); rhs = CK_MFMA(pa[1], oph[1], rhs); rhs = CK_MFMA(opak, opv, rhs);
                float u[16];
#pragma unroll
                for (int r = 0; r < 4; ++r) {
                    const unsigned a_ = __float_as_uint(rhs[r]);
                    const auto h_ = __builtin_amdgcn_permlane32_swap(a_, a_, false, false);
                    const auto lo_ = __builtin_amdgcn_permlane16_swap(h_[0], h_[0], false, false);
                    const auto hi_ = __builtin_amdgcn_permlane16_swap(h_[1], h_[1], false, false);
                    u[r] = __uint_as_float(lo_[0]); u[4 + r] = __uint_as_float(lo_[1]); u[8 + r] = __uint_as_float(hi_[0]); u[12 + r] = __uint_as_float(hi_[1]);
                }
                asm volatile("s_waitcnt lgkmcnt(0)" ::: "memory");
                f32x4 cw[15][4];
#define CK_COLLD(ss) do { _Pragma("unroll") for (int q_ = ((ss) + 1) / 4; q_ < 4; ++q_) cw[(ss)][q_] = *(const LAS f32x4*)(AabT + (ss) * 16 + 4 * q_); } while (0)
                CK_COLLD(0); CK_COLLD(1);
#pragma unroll
                for (int s = 0; s < 15; ++s) {
                    if (s + 2 < 15) CK_COLLD(s + 2);
                    __builtin_amdgcn_sched_barrier(0);
#pragma unroll
                    for (int t = s + 1; t < 16; ++t) u[t] += cw[s][t >> 2][t & 3] * u[s];
                }
#undef CK_COLLD
                bf16x8 opu;
                { const bool g1 = (g & 1) != 0, g2 = (g & 2) != 0;
                  const float a0 = g1 ? u[4] : u[0], a1 = g1 ? u[5] : u[1], a2 = g1 ? u[6] : u[2], a3 = g1 ? u[7] : u[3];
                  const float b0 = g1 ? u[12] : u[8], b1 = g1 ? u[13] : u[9], b2 = g1 ? u[14] : u[10], b3 = g1 ? u[15] : u[11];
                  opu = __builtin_bit_cast(bf16x8, (u32x4){ck_cvt(g2 ? b0 : a0, g2 ? b1 : a1), ck_cvt(g2 ? b2 : a2, g2 ? b3 : a3), 0u, 0u}); }
                f32x4 yy = (f32x4){0.f, 0.f, 0.f, 0.f};
                yy = CK_MFMA(pr[0], oph[0], yy); yy = CK_MFMA(pr[1], oph[1], yy); yy = CK_MFMA(oprb, opu, yy); yy = CK_MFMA(oprk, opv, yy);
                {
                    bf16_t* yp = Y + (rowbase + (size_t)cn * 16 + 4 * g) * D + h * 64 + half * 32 + wave * 16 + c;
#pragma unroll
                    for (int r = 0; r < 4; ++r) yp[(size_t)r * D] = (bf16_t)(ck_cvt(yy[r], 0.f) & 0xffffu);
                }
#pragma unroll
                for (int kt = 0; kt < 4; ++kt) {
                    const bf16x8 opb = ck_ld1(buf + CK_BT_T + (16 * kt + c) * CK_TP + g * 8), opk = ck_ld1(buf + CK_KT_T + (16 * kt + c) * CK_TP + g * 8);
                    f32x4 hh = H[kt];
                    hh = CK_MFMA(opb, opu, hh); hh = CK_MFMA(opk, opv, hh);
                    H[kt] = hh * *(const LAS f32x4*)(buf + CK_GAM + (16 * kt + 4 * g) * 4);
                }
            }
            __syncthreads();
        }
    }
#undef CK_LOAD
#undef CK_P1
}
#else
constexpr int TC = 32;
constexpr int SC_VEC = TC * 5 * 64 * 4;
constexpr int SC_VP = 36;
constexpr int SC_V = 32 * SC_VP * 4;
constexpr int SC_Y = TC * 32 * 4;
constexpr int SC_BUF = SC_VEC + SC_V + SC_Y;
__device__ __forceinline__ void scan_phase(LAS unsigned char* lds, const bf16_t* R, const bf16_t* Kb, const bf16_t* V, const bf16_t* WA, const float* k_k, const float* k_a, bf16_t* Y, int G, int bid, int tid) {
    const int wave = __builtin_amdgcn_readfirstlane(tid >> 6), lane = tid & 63, rg = lane >> 4, cc = lane & 15;
    const int pt = tid >> 4, pj = tid & 15;
    for (int unit = bid; unit < 256; unit += G) {
        const int b = unit >> 5, h = (unit >> 1) & 15, half = unit & 1;
        const size_t rowbase = (size_t)b * T;
        const f32x4 kkw = *(const f32x4*)(k_k + h * 64 + 4 * pj), kaw = *(const f32x4*)(k_a + h * 64 + 4 * pj);
        f32x2 S01 = (f32x2){0.f, 0.f}, S23 = (f32x2){0.f, 0.f};
        u32x2 rk, rr, ra, rl; unsigned rv;
#define SCAN_LOAD(cn) do { const size_t m_ = rowbase + (size_t)(cn) * TC + pt; \
            rk = *(const u32x2*)(Kb + m_ * D + h * 64 + 4 * pj); rr = *(const u32x2*)(R + m_ * D + h * 64 + 4 * pj); \
            rl = *(const u32x2*)(WA + m_ * 2048 + h * 64 + 4 * pj); ra = *(const u32x2*)(WA + m_ * 2048 + 1024 + h * 64 + 4 * pj); \
            rv = *(const unsigned*)(V + m_ * D + h * 64 + half * 32 + 2 * pj); } while (0)
        SCAN_LOAD(0);
        __syncthreads();
        for (int cn = 0; cn < T / TC; ++cn) {
            LAS unsigned char* buf = lds + (cn & 1) * SC_BUF;
            {
                const f32x4 kf = (f32x4){bflo(rk.x), bfhi(rk.x), bflo(rk.y), bfhi(rk.y)}, af = (f32x4){bflo(ra.x), bfhi(ra.x), bflo(ra.y), bfhi(ra.y)};
                const f32x4 lf = (f32x4){bflo(rl.x), bfhi(rl.x), bflo(rl.y), bfhi(rl.y)}, rf = (f32x4){bflo(rr.x), bfhi(rr.x), bflo(rr.y), bfhi(rr.y)};
                const f32x4 kv = kf * kkw;
                float ss = (kv.x * kv.x + kv.y * kv.y) + (kv.z * kv.z + kv.w * kv.w);
                ss = row16_sum(ss);
                const float invn = 1.0f / fmaxf(sqrtf(ss), 1e-12f);
                const f32x4 kk = kv * invn;
                const f32x4 kp = kf * (1.0f + (af - 1.0f) * kaw);
                f32x4 dd; dd.x = __expf(lf.x); dd.y = __expf(lf.y); dd.z = __expf(lf.z); dd.w = __expf(lf.w);
                LAS f32x4* vp = (LAS f32x4*)(buf + pt * 1280) + pj;
                vp[0] = -kk; vp[16] = dd; vp[32] = kk * af; vp[48] = kp; vp[64] = rf;
                LAS float* vv = (LAS float*)(buf + SC_VEC) + (2 * pj) * SC_VP + pt;
                vv[0] = bflo(rv); vv[SC_VP] = bfhi(rv);
            }
            if (cn + 1 < T / TC) SCAN_LOAD(cn + 1);
            __syncthreads();
            if (cn > 0) {
                const LAS float* yb = (const LAS float*)(lds + ((cn - 1) & 1) * SC_BUF + SC_VEC + SC_V + pt * 128) + 2 * pj;
                const size_t m_ = rowbase + (size_t)(cn - 1) * TC + pt;
                *(unsigned*)(Y + m_ * D + h * 64 + half * 32 + 2 * pj) = cvt_pk_bf16(yb[0], yb[1]);
            }
            const int rloc = wave * 4 + rg;
            LAS float* yrow = (LAS float*)(buf + SC_VEC + SC_V) + rloc;
            const unsigned va0 = (unsigned)(size_t)(buf + cc * 16), ra0 = (unsigned)(size_t)(buf + SC_VEC + rloc * SC_VP * 4);
#define SC_LD5(NK, DD, BE, KP, RF, AR, OFF) do { \
                asm volatile("ds_read_b128 %0, %1 offset:%2" : "=&v"(NK) : "v"(AR), "i"((OFF))); asm volatile("ds_read_b128 %0, %1 offset:%2" : "=&v"(DD) : "v"(AR), "i"((OFF) + 256)); \
                asm volatile("ds_read_b128 %0, %1 offset:%2" : "=&v"(BE) : "v"(AR), "i"((OFF) + 512)); asm volatile("ds_read_b128 %0, %1 offset:%2" : "=&v"(KP) : "v"(AR), "i"((OFF) + 768)); \
                asm volatile("ds_read_b128 %0, %1 offset:%2" : "=&v"(RF) : "v"(AR), "i"((OFF) + 1024)); } while (0)
            f32x4 nk, dd, be, kp, rf, nk1, dd1, be1, kp1, rf1, nk2, dd2, be2, kp2, rf2, vcur, vnxt;
            SC_LD5(nk, dd, be, kp, rf, va0, 0); SC_LD5(nk1, dd1, be1, kp1, rf1, va0, 1280);
            asm volatile("ds_read_b128 %0, %1" : "=&v"(vcur) : "v"(ra0));
            asm volatile("s_waitcnt lgkmcnt(0)" : "+v"(nk), "+v"(dd), "+v"(be), "+v"(kp), "+v"(rf), "+v"(nk1), "+v"(dd1), "+v"(be1), "+v"(kp1), "+v"(rf1), "+v"(vcur));
            vnxt = vcur;
            float sa;
            { f32x2 pa = S01 * (f32x2){nk.x, nk.y}; pa = S23 * (f32x2){nk.z, nk.w} + pa; sa = row16_sum(pa.x + pa.y); }
            float ykeep = 0.f;
#define SC_STEP(J, VSEL, LDV, VOFF, WAITN) do { \
                SC_LD5(nk2, dd2, be2, kp2, rf2, va8, ((J) + 2) * 1280); \
                if (LDV) asm volatile("ds_read_b128 %0, %1 offset:%2" : "=&v"(vnxt) : "v"(ra8), "i"((VOFF))); \
                asm volatile("s_waitcnt lgkmcnt(" #WAITN ")" : "+v"(nk1), "+v"(dd1), "+v"(be1), "+v"(kp1), "+v"(rf1)); \
                const float vv_ = (VSEL); \
                S01 = S01 * (f32x2){dd.x, dd.y} + (f32x2){be.x, be.y} * sa + (f32x2){kp.x, kp.y} * vv_; \
                S23 = S23 * (f32x2){dd.z, dd.w} + (f32x2){be.z, be.w} * sa + (f32x2){kp.z, kp.w} * vv_; \
                f32x2 pa_ = S01 * (f32x2){nk1.x, nk1.y}; pa_ = S23 * (f32x2){nk1.z, nk1.w} + pa_; \
                f32x2 py_ = S01 * (f32x2){rf.x, rf.y}; py_ = S23 * (f32x2){rf.z, rf.w} + py_; \
                float y_ = py_.x + py_.y, a2_ = pa_.x + pa_.y; \
                y_ = DPP_XADD(y_, 0xB1); a2_ = DPP_XADD(a2_, 0xB1); y_ = DPP_XADD(y_, 0x4E); a2_ = DPP_XADD(a2_, 0x4E); \
                y_ = DPP_XADD(y_, 0x141); a2_ = DPP_XADD(a2_, 0x141); y_ = DPP_XADD(y_, 0x140); a2_ = DPP_XADD(a2_, 0x140); \
                sa = a2_; \
                ykeep = __builtin_bit_cast(float, __builtin_amdgcn_update_dpp(__builtin_bit_cast(int, y_), __builtin_bit_cast(int, ykeep), 0x111, 0xF, 0xF, false));   \
                nk = nk1; dd = dd1; be = be1; kp = kp1; rf = rf1; nk1 = nk2; dd1 = dd2; be1 = be2; kp1 = kp2; rf1 = rf2; } while (0)
#pragma unroll 1
            for (int t8 = 0; t8 < TC; t8 += 8) {
                const unsigned va8 = va0 + (unsigned)t8 * 1280u, ra8 = ra0 + (unsigned)t8 * 4u;
                SC_STEP(0, vcur.x, 0, 0, 5); SC_STEP(1, vcur.y, 0, 0, 5); SC_STEP(2, vcur.z, 1, 16, 6); SC_STEP(3, vcur.w, 0, 0, 5);
                asm volatile("" : "+v"(vnxt)); vcur = vnxt;
                SC_STEP(4, vcur.x, 0, 0, 5); SC_STEP(5, vcur.y, 0, 0, 5); SC_STEP(6, vcur.z, 1, 32, 6); SC_STEP(7, vcur.w, 0, 0, 5);
                asm volatile("" : "+v"(vnxt)); vcur = vnxt;
                if (t8 & 8) yrow[(t8 + 7 - cc) * 32] = ykeep;
            }
            asm volatile("s_waitcnt lgkmcnt(0)" ::: "memory");
#undef SC_STEP
#undef SC_LD5
        }
        __syncthreads();
        {
            const int cn = T / TC;
            const LAS float* yb = (const LAS float*)(lds + ((cn - 1) & 1) * SC_BUF + SC_VEC + SC_V + pt * 128) + 2 * pj;
            const size_t m_ = rowbase + (size_t)(cn - 1) * TC + pt;
            *(unsigned*)(Y + m_ * D + h * 64 + half * 32 + 2 * pj) = cvt_pk_bf16(yb[0], yb[1]);
        }
        __syncthreads();
    }
#undef SCAN_LOAD
}
#endif
__device__ __forceinline__ void gn_phase(bf16_t* Y, const bf16_t* R, const bf16_t* Kb, const bf16_t* V, const bf16_t* Z, const bf16_t* WA, const float* k_a, const float* r_k, const float* gn_g, const float* gn_b, int G, int bid, int tid) {
    const int wave = __builtin_amdgcn_readfirstlane(tid >> 6), lane = tid & 63;
    const int gw = bid * NWAVES + wave, NGW = G * NWAVES;
    const int col = lane * 16;
    f32x4 kaq[4], rkq[4], ggq[4], gbq[4];
#pragma unroll
    for (int q = 0; q < 4; ++q) { kaq[q] = *(const f32x4*)(k_a + col + 4 * q); rkq[q] = *(const f32x4*)(r_k + col + 4 * q); ggq[q] = *(const f32x4*)(gn_g + col + 4 * q); gbq[q] = *(const f32x4*)(gn_b + col + 4 * q); }
    u32x4 ry_[2], rr_[2], rk_[2], rv_[2], rz_[2], ra_[2];
#define GN_LOAD(mm) do { const size_t off_ = (size_t)(mm) * D + col; _Pragma("unroll") for (int j = 0; j < 2; ++j) { ry_[j] = *(const u32x4*)(Y + off_ + 8 * j); rr_[j] = *(const u32x4*)(R + off_ + 8 * j); \
        rk_[j] = *(const u32x4*)(Kb + off_ + 8 * j); rv_[j] = *(const u32x4*)(V + off_ + 8 * j); rz_[j] = *(const u32x4*)(Z + off_ + 8 * j); ra_[j] = *(const u32x4*)(WA + (size_t)(mm) * 2048 + 1024 + col + 8 * j); } } while (0)
    if (gw < M) GN_LOAD(gw);
    for (int m = gw; m < M; m += NGW) {
        const size_t off = (size_t)m * D + col;
        f32x4 y[4], r[4], k[4], v[4], z[4], aa[4];
#pragma unroll
        for (int j = 0; j < 2; ++j) { unpack8(ry_[j], y[2 * j], y[2 * j + 1]); unpack8(rr_[j], r[2 * j], r[2 * j + 1]); unpack8(rk_[j], k[2 * j], k[2 * j + 1]);
            unpack8(rv_[j], v[2 * j], v[2 * j + 1]); unpack8(rz_[j], z[2 * j], z[2 * j + 1]); unpack8(ra_[j], aa[2 * j], aa[2 * j + 1]); }
        if (m + NGW < M) GN_LOAD(m + NGW);
        float s = 0.f, bs = 0.f;
#pragma unroll
        for (int q = 0; q < 4; ++q) {
            s += (y[q].x + y[q].y) + (y[q].z + y[q].w);
            const f32x4 kp = k[q] * (1.0f + (aa[q] - 1.0f) * kaq[q]);
            const f32x4 t = r[q] * kp * rkq[q];
            bs += (t.x + t.y) + (t.z + t.w);
        }
        s += __shfl_xor(s, 1); s += __shfl_xor(s, 2); bs += __shfl_xor(bs, 1); bs += __shfl_xor(bs, 2);
        const float mean = s * (1.0f / 64.0f);
        float q2 = 0.f;
#pragma unroll
        for (int q = 0; q < 4; ++q) { const f32x4 dlt = y[q] - mean; q2 += (dlt.x * dlt.x + dlt.y * dlt.y) + (dlt.z * dlt.z + dlt.w * dlt.w); }
        q2 += __shfl_xor(q2, 1); q2 += __shfl_xor(q2, 2);
        const float rstd = 1.0f / sqrtf(q2 * (1.0f / 64.0f) + 64e-5f);
        f32x4 o[4];
#pragma unroll
        for (int q = 0; q < 4; ++q) {
            const f32x4 yn = (y[q] - mean) * rstd * ggq[q] + gbq[q] + bs * v[q];
#pragma unroll
            for (int e = 0; e < 4; ++e) o[q][e] = yn[e] * z[q][e] * fsigmoid(z[q][e]);
        }
        *(u32x4*)(Y + off) = pack8(o[0], o[1]); *(u32x4*)(Y + off + 8) = pack8(o[2], o[3]);
    }
}
__device__ __forceinline__ void final_norm_phase(const bf16_t* H2, float* out, const float* g, int G, int bid, int tid) {
    const int wave = __builtin_amdgcn_readfirstlane(tid >> 6), lane = tid & 63;
    const int gw = bid * NWAVES + wave, NGW = G * NWAVES;
    f32x4 gv[4];
#pragma unroll
    for (int j = 0; j < 2; ++j) { gv[2 * j] = *(const f32x4*)(g + j * 512 + lane * 8); gv[2 * j + 1] = *(const f32x4*)(g + j * 512 + lane * 8 + 4); }
    u32x4 rh_[2];
    if (gw < M) { rh_[0] = *(const u32x4*)(H2 + (size_t)gw * D + lane * 8); rh_[1] = *(const u32x4*)(H2 + (size_t)gw * D + 512 + lane * 8); }
    for (int m = gw; m < M; m += NGW) {
        f32x4 v[4]; float s = 0.f;
        unpack8(rh_[0], v[0], v[1]); unpack8(rh_[1], v[2], v[3]);
        if (m + NGW < M) { rh_[0] = *(const u32x4*)(H2 + (size_t)(m + NGW) * D + lane * 8); rh_[1] = *(const u32x4*)(H2 + (size_t)(m + NGW) * D + 512 + lane * 8); }
#pragma unroll
        for (int q = 0; q < 4; ++q) s += (v[q].x * v[q].x + v[q].y * v[q].y) + (v[q].z * v[q].z + v[q].w * v[q].w);
        const float rstd = 1.0f / sqrtf(wave_sum(s) * (1.0f / D) + 1e-6f);
#pragma unroll
        for (int j = 0; j < 2; ++j) { float* o = out + (size_t)m * D + j * 512 + lane * 8; *(f32x4*)o = v[2 * j] * rstd * gv[2 * j]; *(f32x4*)(o + 4) = v[2 * j + 1] * rstd * gv[2 * j + 1]; }
    }
}
#ifndef MK_PER_PHASE
#define MK_PER_PHASE 0
#endif
constexpr int NPHASE = 15;
#ifndef MK_REP_PHASE
#define MK_REP_PHASE -1
#endif
#ifndef MK_REP_N
#define MK_REP_N 2
#endif
#define REPS(k) ((k) == MK_REP_PHASE ? MK_REP_N : 1)

__global__ void __launch_bounds__(NTHR, 2) hybrid_fwd(Args a) {
    extern __shared__ __attribute__((aligned(16))) unsigned char lds_raw[];
    LAS unsigned char* lds = (LAS unsigned char*)lds_raw;
    cg::grid_group grid = cg::this_grid();
    const int wave_s = __builtin_amdgcn_readfirstlane((int)threadIdx.x >> 6);
    const int bid = blockIdx.x, G = gridDim.x;
#define TID() int lane_v_; asm volatile("v_mbcnt_lo_u32_b32 %0, -1, 0\n\tv_mbcnt_hi_u32_b32 %0, -1, %0" : "=v"(lane_v_)); const int tid = wave_s * 64 + lane_v_
    { TID(); if (tid < 16) ((LAS unsigned*)(lds + LDS_BYTES - 64))[tid] = 0u; __syncthreads();
#if !MK_PER_PHASE
      kptr_t kpb = kargs(); (void)xcd_barrier_post((unsigned*)(kws(kpb) + WS_CTL), (volatile LAS unsigned*)(lds + LDS_BYTES - 64), tid);
#endif
    }
    int lo, hi; { kptr_t kp0 = kargs(); lo = *(const int __attribute__((address_space(4)))*)(kp0 + 8 * 26); hi = *(const int __attribute__((address_space(4)))*)(kp0 + 8 * 26 + 4); }
#ifndef PH_MASK
#define PH_MASK 0x7fff
#endif
#define IN(k) (((PH_MASK >> (k)) & 1) && lo <= (k) && (k) < hi)
#define SEAM(k) do { if (IN(k) && IN((k) + 1)) { if ((k) == 0) grid.sync(); else { TID(); kptr_t kpb = kargs(); XcdBarrier xb_; xb_.bar = (unsigned*)(kws(kpb) + WS_CTL); xb_.x = xb_xcc_id(); xb_.st = (volatile LAS unsigned*)(lds + LDS_BYTES - 64); xcd_barrier(xb_, tid); } } } while (0)
#define PTRS() kptr_t kp = kargs(); unsigned char* ws = kws(kp); (void)ws
#define S1 ((bf16_t*)(ws + WS_S1))
#define S2 ((bf16_t*)(ws + WS_S2))
#define S3 ((bf16_t*)(ws + WS_S3))
#define S4 ((bf16_t*)(ws + WS_S4))
#define QKVZ ((bf16_t*)(ws + WS_QKVZ))
#define XS0 ((bf16_t*)(ws + WS_XS0))
#define XS1 ((bf16_t*)(ws + WS_XS1))
#define WAb ((bf16_t*)(ws + WS_WA))
#define A2 ((bf16_t*)(ws + WS_A2))
#define Lb ((bf16_t*)(ws + WS_L))
#define Kr ((bf16_t*)kout(kp))
#define Vr ((bf16_t*)kout(kp) + (size_t)M * D)
#define WR ((const bf16_t*)(ws + WS_WR))

    if (IN(0)) for (int rep_ = 0; rep_ < REPS(0); ++rep_) { TID(); p0_prologue(lds, G, bid, tid); }
    SEAM(0);
    if (IN(1)) for (int rep_ = 0; rep_ < REPS(1); ++rep_) { TID(); PTRS();
        { pg8::Gemm g{S1, (const bf16_t*)(ws + WS_WQKVZ), M, ATT_IN, D}; pg8::StaticOrder S; S.init(M, ATT_IN, G, bid);
          pg8::EpiQKVZ E{QKVZ, (const float*)(ws + WS_BIAS), (const float*)(ws + WS_COS), (const float*)(ws + WS_SIN)};
          pg8::gemm_phase<pg8::EpiQKVZ, pg8::StaticOrder, true, true>(lds, g, S, E, tid); }
        __syncthreads();
        { pg8::Gemm g{(const bf16_t*)(ws + WS_PB0), (const bf16_t*)(ws + WS_WP0), M, D, PLE}; pg8::StaticOrder S; S.init(M, D, G, bid);
          pg8::EpiStore E{S2, D};
          pg8::gemm_phase<pg8::EpiStore, pg8::StaticOrder, true, true>(lds, g, S, E, tid); }
    }
    SEAM(1);
    if (IN(2)) for (int rep_ = 0; rep_ < REPS(2); ++rep_) { TID(); PTRS(); attn_phase(lds, QKVZ, kin(kp, I_ASINK), S1, G, bid, tid); }
    SEAM(2);
    if (IN(3)) for (int rep_ = 0; rep_ < REPS(3); ++rep_) { TID(); PTRS();
        pg8::Gemm g{S1, (const bf16_t*)(ws + WS_WO0), M, D, D}; pg8::StaticOrder S; S.init(M, D, G, bid);
        pg8::EpiRes<false> E{(const void*)kin(kp, I_X), S3};
        pg8::gemm_phase<pg8::EpiRes<false>, pg8::StaticOrder, true, true>(lds, g, S, E, tid);
    }
    SEAM(3);
    if (IN(4)) for (int rep_ = 0; rep_ < REPS(4); ++rep_) { TID(); PTRS();
        pg8::Gemm g{S3, (const bf16_t*)(ws + WS_WG0), M, D, D}; pg8::StaticOrder S; S.init(M, D, G, bid);
        pg8::EpiGate<false> E{S3, S2, (void*)S4};
        pg8::gemm_phase<pg8::EpiGate<false>, pg8::StaticOrder, true, true>(lds, g, S, E, tid);
    }
    SEAM(4);
    if (IN(5)) for (int rep_ = 0; rep_ < REPS(5); ++rep_) { TID(); PTRS(); lerp_phase<0>(S4, kin(kp, I_NORMG) + D, kin(kp, I_MU), S1, XS0, XS1, G, bid, tid); }
    SEAM(5);
    if (IN(6)) for (int rep_ = 0; rep_ < REPS(6); ++rep_) { TID(); PTRS();
        { pg8::Gemm g{XS0, WR, M, 2 * D, D, XS1, 4}; pg8::StaticOrder S; S.init(M, 2 * D, G, bid); pg8::EpiStore2 E{S3, Kr, 4, D};
          pg8::gemm_phase<pg8::EpiStore2, pg8::StaticOrder, true, true>(lds, g, S, E, tid); }
        __syncthreads();
        { pg8::Gemm g{S1, (const bf16_t*)(ws + WS_WL), M, 256, D}; pg8::StaticOrder S; S.init(M, 256, G, bid); pg8::EpiStore E{Lb, 256};
          pg8::gemm_phase<pg8::EpiStore, pg8::StaticOrder, true, true>(lds, g, S, E, tid); }
    }
    SEAM(6);
    if (IN(7)) for (int rep_ = 0; rep_ < REPS(7); ++rep_) { TID(); PTRS(); lerp_phase<1>(S4, kin(kp, I_NORMG) + D, kin(kp, I_MU), nullptr, XS0, XS1, G, bid, tid); lora_mid_phase(Lb, A2, G, bid, tid); }
    SEAM(7);
    if (IN(8)) for (int rep_ = 0; rep_ < REPS(8); ++rep_) { TID(); PTRS();
        { pg8::Gemm g{XS0, WR + (size_t)2 * D * D, M, 2 * D, D, XS1, 4}; pg8::StaticOrder S; S.init(M, 2 * D, G, bid); pg8::EpiStore2 E{Vr, S2, 4, D};
          pg8::gemm_phase<pg8::EpiStore2, pg8::StaticOrder, true, true>(lds, g, S, E, tid); }
    }
    SEAM(8);
    if (IN(9)) for (int rep_ = 0; rep_ < REPS(9); ++rep_) { TID(); PTRS();
        pg8::Gemm g{A2, (const bf16_t*)(ws + WS_W2), M, 2048, 128}; pg8::StaticOrder S; S.init(M, 2048, G, bid);
        pg8::EpiWA E{WAb, kin(kp, I_W0), kin(kp, I_A0)};
        pg8::gemm_phase<pg8::EpiWA, pg8::StaticOrder, true, true>(lds, g, S, E, tid);
    }
    SEAM(9);
    if (IN(10)) for (int rep_ = 0; rep_ < REPS(10); ++rep_) { TID(); PTRS(); scan_phase(lds, S3, Kr, Vr, WAb, kin(kp, I_KK), kin(kp, I_KA), S1, G, bid, tid); }
    SEAM(10);
    if (IN(11)) for (int rep_ = 0; rep_ < REPS(11); ++rep_) { TID(); PTRS(); gn_phase(S1, S3, Kr, Vr, S2, WAb, kin(kp, I_KA), kin(kp, I_RK), kin(kp, I_GNG), kin(kp, I_GNB), G, bid, tid); }
    SEAM(11);
    if (IN(12)) for (int rep_ = 0; rep_ < REPS(12); ++rep_) { TID(); PTRS();
        { pg8::Gemm g{S1, (const bf16_t*)(ws + WS_WO1), M, D, D}; pg8::StaticOrder S; S.init(M, D, G, bid); pg8::EpiRes<true> E{(const void*)S4, S3};
          pg8::gemm_phase<pg8::EpiRes<true>, pg8::StaticOrder, true, true>(lds, g, S, E, tid); }
        __syncthreads();
        { pg8::Gemm g{(const bf16_t*)(ws + WS_PB1), (const bf16_t*)(ws + WS_WP1), M, D, PLE}; pg8::StaticOrder S; S.init(M, D, G, bid); pg8::EpiStore E{S2, D};
          pg8::gemm_phase<pg8::EpiStore, pg8::StaticOrder, true, true>(lds, g, S, E, tid); }
    }
    SEAM(12);
    if (IN(13)) for (int rep_ = 0; rep_ < REPS(13); ++rep_) { TID(); PTRS();
        pg8::Gemm g{S3, (const bf16_t*)(ws + WS_WG1), M, D, D}; pg8::StaticOrder S; S.init(M, D, G, bid);
        pg8::EpiGate<false> E{S3, S2, (void*)S1};
        pg8::gemm_phase<pg8::EpiGate<false>, pg8::StaticOrder, true, true>(lds, g, S, E, tid);
    }
    SEAM(13);
    if (IN(14)) for (int rep_ = 0; rep_ < REPS(14); ++rep_) { TID(); PTRS(); final_norm_phase(S1, kout(kp), kin(kp, I_FNG), G, bid, tid); }
#undef IN
#undef SEAM
}

extern "C" void kernel_launch(void* const* d_in, const int* in_sizes, int n_in, void* d_out, int out_size, void* d_ws, size_t ws_size, hipStream_t stream) {
    static int grid = 0;
    if (grid == 0) {
        if (n_in != 24 || out_size != M * D || ws_size < WS_END) { fprintf(stderr, "kernel_launch: unexpected shapes (n_in %d, out %d, ws %zu)\n", n_in, out_size, ws_size); grid = -1; return; }
        int dev = 0, cus = 0, per_cu = 0;
        (void)hipGetDevice(&dev); (void)hipDeviceGetAttribute(&cus, hipDeviceAttributeMultiprocessorCount, dev);
        if (hipFuncSetAttribute((const void*)hybrid_fwd, hipFuncAttributeMaxDynamicSharedMemorySize, LDS_BYTES) != hipSuccess) { fprintf(stderr, "kernel_launch: hipFuncSetAttribute failed\n"); grid = -1; return; }
        if (hipOccupancyMaxActiveBlocksPerMultiprocessor(&per_cu, (const void*)hybrid_fwd, NTHR, LDS_BYTES) != hipSuccess || per_cu < 1) { fprintf(stderr, "kernel_launch: occupancy query reports %d\n", per_cu); per_cu = 1; }
        (void)hipGetLastError();
        grid = cus > 0 ? cus : 256;
    }
    if (grid < 0) return;
    Args a{};
    for (int i = 0; i < 24; ++i) a.in[i] = (const float*)d_in[i];
    a.out = (float*)d_out; a.ws = (unsigned char*)d_ws;
#if MK_PER_PHASE
    for (int ph = 0; ph < NPHASE; ++ph) { a.ph_lo = ph; a.ph_hi = ph + 1; hipLaunchKernelGGL(hybrid_fwd, dim3(grid), dim3(NTHR), LDS_BYTES, stream, a); }
#else
    a.ph_lo = 0; a.ph_hi = NPHASE;
    (void)hipMemsetAsync((unsigned char*)d_ws + WS_CTL, 0, 16384, stream);
    void* args[] = {&a};
    hipError_t e = hipLaunchCooperativeKernel((const void*)hybrid_fwd, dim3(grid), dim3(NTHR), args, LDS_BYTES, stream);
    if (e != hipSuccess) fprintf(stderr, "cooperative launch failed: %s (grid %d)\n", hipGetErrorString(e), grid);
#endif
}
```
